# Optimizing an MI355X kernel written in HIP

```python
import jax, jax.numpy as jnp
from jax import lax
import numpy as np

D_MODEL = 2048
BATCH = 4
SEQ = 8192
DEPTH = 4

N_MIXERS = 3
GRID_W = 64
BRANCH_W = D_MODEL
NORM_EPS = 1e-6

POOL_WINDOWS = (2, 4, 8, 16)
N_POOL_GROUPS = 4
POOL_GROUP_DIM = BRANCH_W // N_POOL_GROUPS

GLA_HEADS = 4
GLA_KEY_W = D_MODEL // 2
GLA_VAL_W = BRANCH_W
GLA_DK = GLA_KEY_W // GLA_HEADS
GLA_DV = GLA_VAL_W // GLA_HEADS
GLA_LOWRANK = 16
GLA_TAU = 16.0
GLA_CHUNK = 64

ATTN_HEAD_DIM = 128
ATTN_HEADS = BRANCH_W // ATTN_HEAD_DIM
ATTN_KV_HEADS = 4
ATTN_GROUP = ATTN_HEADS // ATTN_KV_HEADS
ATTN_Q_W = ATTN_HEADS * ATTN_HEAD_DIM
ATTN_KV_W = ATTN_KV_HEADS * ATTN_HEAD_DIM
ATTN_BLOCK = 128
ROPE_AXIS_DIM = ATTN_HEAD_DIM // 2
ROPE_THETA = 10000.0

kernel_name = "hybrid_pool_gla_gqa_encoder"


def rms_norm(x, eps=NORM_EPS):
    xf = x.astype(jnp.float32)
    return (xf * lax.rsqrt(jnp.mean(xf * xf, axis=-1, keepdims=True) + eps)).astype(x.dtype)


def ada_modulation(c, w, b):
    m = jnp.dot(jax.nn.silu(c), w) + b
    shift, scale, gate = jnp.split(m, 3, axis=-1)
    return shift[:, None], scale[:, None], gate[:, None]


def centred_window_mean(u, w):
    T = u.shape[1]
    csum = jnp.cumsum(u.astype(jnp.float32), axis=1)
    P = jnp.concatenate([jnp.zeros_like(csum[:, :1]), csum], axis=1)
    t = jnp.arange(T)
    lo = jnp.maximum(t - w // 2, 0)
    hi = jnp.minimum(t + w // 2, T)
    cnt = (hi - lo).astype(jnp.float32)
    return ((P[:, hi] - P[:, lo]) / cnt[None, :, None]).astype(u.dtype)


def pool_mixer(h, w_in, w_grp, scale, w_out):
    B, T, _ = h.shape
    u, g = jnp.split(h @ w_in, 2, axis=-1)
    ug = u.reshape(B, T, N_POOL_GROUPS, POOL_GROUP_DIM)
    pooled = jnp.stack(
        [centred_window_mean(ug[:, :, i], w) - ug[:, :, i] for i, w in enumerate(POOL_WINDOWS)],
        axis=2)
    y = jnp.einsum('btgc,gcd->btgd', pooled, w_grp).reshape(B, T, BRANCH_W) * scale
    return (y * jax.nn.silu(g)) @ w_out


def gla_chunked_scan(q, k, v, log_a, include_diag):
    B, T, H, DK = q.shape
    DV = v.shape[-1]
    nc = T // GLA_CHUNK

    def to_chunks(z):
        return z.astype(jnp.float32).reshape(B, nc, GLA_CHUNK, H, z.shape[-1]).transpose(1, 0, 3, 2, 4)

    qc, kc, vc, ac = to_chunks(q), to_chunks(k), to_chunks(v), to_chunks(log_a)
    mask = jnp.tril(jnp.ones((GLA_CHUNK, GLA_CHUNK), dtype=bool), 0 if include_diag else -1)

    def step(S, inp):
        qi, ki, vi, ai = inp
        b = jnp.cumsum(ai, axis=2)
        o_inter = jnp.einsum('bhcd,bhde->bhce', qi * jnp.exp(b), S)
        diff = b[:, :, :, None, :] - b[:, :, None, :, :]
        decay = jnp.exp(jnp.where(mask[:, :, None], diff, -jnp.inf))
        A = jnp.sum(qi[:, :, :, None, :] * ki[:, :, None, :, :] * decay, axis=-1)
        o_intra = jnp.einsum('bhij,bhje->bhie', A, vi)
        b_last = b[:, :, -1:, :]
        S_new = jnp.exp(b_last[:, :, 0, :])[..., None] * S + jnp.einsum(
            'bhjd,bhje->bhde', ki * jnp.exp(b_last - b), vi)
        return S_new, o_inter + o_intra

    S0 = jnp.zeros((B, H, DK, DV), jnp.float32)
    _, o = lax.scan(step, S0, (qc, kc, vc, ac))
    return o.transpose(1, 0, 3, 2, 4).reshape(B, T, H, DV)


def gla_mixer(h, w_in, fwd_w1, fwd_w2, fwd_b, bwd_w1, bwd_w2, bwd_b, norm_g, w_out):
    B, T, _ = h.shape
    q, k, v, g = jnp.split(h @ w_in, [GLA_KEY_W, 2 * GLA_KEY_W, 2 * GLA_KEY_W + GLA_VAL_W], axis=-1)
    q = (q * GLA_DK ** -0.5).reshape(B, T, GLA_HEADS, GLA_DK)
    k = k.reshape(B, T, GLA_HEADS, GLA_DK)
    v = v.reshape(B, T, GLA_HEADS, GLA_DV)

    def log_decay(w1, w2, b):
        z = ((h @ w1) @ w2 + b).astype(jnp.float32)
        return (jax.nn.log_sigmoid(z) / GLA_TAU).reshape(B, T, GLA_HEADS, GLA_DK)

    rev = lambda z: z[:, ::-1]
    o_fwd = gla_chunked_scan(q, k, v, log_decay(fwd_w1, fwd_w2, fwd_b), include_diag=True)
    o_bwd = rev(gla_chunked_scan(rev(q), rev(k), rev(v), rev(log_decay(bwd_w1, bwd_w2, bwd_b)),
                                 include_diag=False))
    o = (rms_norm(o_fwd + o_bwd) * norm_g).reshape(B, T, GLA_VAL_W).astype(h.dtype)
    return (o * jax.nn.silu(g)) @ w_out


def axial_rope_tables(T):
    rows = T // GRID_W
    t = jnp.arange(T)
    row = (t // GRID_W - rows // 2).astype(jnp.float32)
    col = (t % GRID_W - GRID_W // 2).astype(jnp.float32)
    inv = ROPE_THETA ** (-jnp.arange(0, ROPE_AXIS_DIM, 2, dtype=jnp.float32) / ROPE_AXIS_DIM)
    ang = jnp.concatenate([row[:, None] * inv, col[:, None] * inv], axis=-1)
    return jnp.cos(ang), jnp.sin(ang)


def apply_rope(x, cos, sin):
    shp = (cos.shape[0],) + (1,) * (x.ndim - 3) + (cos.shape[1],)
    cos = cos.reshape(shp).astype(x.dtype)
    sin = sin.reshape(shp).astype(x.dtype)
    xr = x.reshape(x.shape[:-1] + (-1, 2))
    x0, x1 = xr[..., 0], xr[..., 1]
    return jnp.stack([x0 * cos - x1 * sin, x0 * sin + x1 * cos], axis=-1).reshape(x.shape)


def attn_mixer(h, w_in, q_norm_g, k_norm_g, w_out):
    B, T, _ = h.shape
    q, k, v, g = jnp.split(h @ w_in, [ATTN_Q_W, ATTN_Q_W + ATTN_KV_W, ATTN_Q_W + 2 * ATTN_KV_W], axis=-1)
    q = rms_norm(q.reshape(B, T, ATTN_KV_HEADS, ATTN_GROUP, ATTN_HEAD_DIM)) * q_norm_g
    k = rms_norm(k.reshape(B, T, ATTN_KV_HEADS, ATTN_HEAD_DIM)) * k_norm_g
    v = v.reshape(B, T, ATTN_KV_HEADS, ATTN_HEAD_DIM)
    cos, sin = axial_rope_tables(T)
    q = apply_rope(q, cos, sin) * ATTN_HEAD_DIM ** -0.5
    k = apply_rope(k, cos, sin)
    nb = T // ATTN_BLOCK
    qb = q.reshape(B, nb, ATTN_BLOCK, ATTN_KV_HEADS, ATTN_GROUP, ATTN_HEAD_DIM).transpose(1, 0, 2, 3, 4, 5)

    def block(qi):
        s = jnp.einsum('bqkgd,bskd->bkgqs', qi, k, preferred_element_type=jnp.float32)
        p = jax.nn.softmax(s, axis=-1).astype(v.dtype)
        return jnp.einsum('bkgqs,bskd->bqkgd', p, v)

    o = lax.map(block, qb).transpose(1, 0, 2, 3, 4, 5).reshape(B, T, ATTN_Q_W)
    return (o * jax.nn.silu(g)) @ w_out


def setup_inputs(seed: int = 0) -> dict:
    key = jax.random.key(seed)
    ks = iter(jax.random.split(key, 40))
    n_pool = len(range(0, DEPTH, N_MIXERS))
    n_gla = len(range(1, DEPTH, N_MIXERS))
    n_attn = len(range(2, DEPTH, N_MIXERS))
    D = D_MODEL

    def nrm(shape, scale):
        return jax.random.normal(next(ks), shape, jnp.float32) * scale

    def gain(shape):
        return 1.0 + 0.1 * jax.random.normal(next(ks), shape, jnp.float32)

    return {
        "x": nrm((BATCH, SEQ, D), 1.0),
        "c": nrm((BATCH, D), 1.0),
        "w_mod": nrm((DEPTH, D, 3 * D), 0.5 * D ** -0.5),
        "b_mod": nrm((DEPTH, 3 * D), 0.02),
        "pool_w_in": nrm((n_pool, D, 2 * BRANCH_W), D ** -0.5),
        "pool_w_grp": nrm((n_pool, N_POOL_GROUPS, POOL_GROUP_DIM, POOL_GROUP_DIM), POOL_GROUP_DIM ** -0.5),
        "pool_scale": gain((n_pool, BRANCH_W)),
        "pool_w_out": nrm((n_pool, BRANCH_W, D), BRANCH_W ** -0.5),
        "gla_w_in": nrm((n_gla, D, 2 * GLA_KEY_W + 2 * GLA_VAL_W), D ** -0.5),
        "gla_fwd_w1": nrm((n_gla, D, GLA_LOWRANK), D ** -0.5),
        "gla_fwd_w2": nrm((n_gla, GLA_LOWRANK, GLA_KEY_W), GLA_LOWRANK ** -0.5),
        "gla_fwd_b": nrm((n_gla, GLA_KEY_W), 0.1),
        "gla_bwd_w1": nrm((n_gla, D, GLA_LOWRANK), D ** -0.5),
        "gla_bwd_w2": nrm((n_gla, GLA_LOWRANK, GLA_KEY_W), GLA_LOWRANK ** -0.5),
        "gla_bwd_b": nrm((n_gla, GLA_KEY_W), 0.1),
        "gla_norm_g": gain((n_gla, GLA_DV)),
        "gla_w_out": nrm((n_gla, GLA_VAL_W, D), GLA_VAL_W ** -0.5),
        "attn_w_in": nrm((n_attn, D, 2 * ATTN_Q_W + 2 * ATTN_KV_W), D ** -0.5),
        "attn_q_norm_g": gain((n_attn, ATTN_HEAD_DIM)),
        "attn_k_norm_g": gain((n_attn, ATTN_HEAD_DIM)),
        "attn_w_out": nrm((n_attn, ATTN_Q_W, D), ATTN_Q_W ** -0.5),
        "final_norm_g": gain((D,)),
    }


def reference(x, c, w_mod, b_mod, pool_w_in, pool_w_grp, pool_scale, pool_w_out,
              gla_w_in, gla_fwd_w1, gla_fwd_w2, gla_fwd_b, gla_bwd_w1, gla_bwd_w2, gla_bwd_b,
              gla_norm_g, gla_w_out, attn_w_in, attn_q_norm_g, attn_k_norm_g, attn_w_out,
              final_norm_g):
    for i in range(DEPTH):
        shift, scale, gate = ada_modulation(c, w_mod[i], b_mod[i])
        h = rms_norm(x) * (1.0 + scale) + shift
        kind, j = i % N_MIXERS, i // N_MIXERS
        if kind == 0:
            y = pool_mixer(h, pool_w_in[j], pool_w_grp[j], pool_scale[j], pool_w_out[j])
        elif kind == 1:
            y = gla_mixer(h, gla_w_in[j], gla_fwd_w1[j], gla_fwd_w2[j], gla_fwd_b[j],
                          gla_bwd_w1[j], gla_bwd_w2[j], gla_bwd_b[j], gla_norm_g[j], gla_w_out[j])
        else:
            y = attn_mixer(h, attn_w_in[j], attn_q_norm_g[j], attn_k_norm_g[j], attn_w_out[j])
        x = x + gate * y
    return rms_norm(x) * final_norm_g
```

```cpp
#include <hip/hip_runtime.h>
#include <hip/hip_bf16.h>
#include <hip/hip_cooperative_groups.h>
#include <cstdio>
#include <cstdint>
#include <cmath>
namespace cg = cooperative_groups;

constexpr int NB = 4, SEQ = 8192, DM = 2048, MTOK = NB * SEQ;
constexpr float NEPS = 1e-6f;
constexpr size_t MiB = (size_t)1 << 20;
constexpr size_t WS_MOD = 0;
constexpr size_t WS_ROPE = 1 * MiB;
constexpr size_t WS_R = 5 * MiB;
constexpr size_t WS_DL = 9 * MiB;
constexpr size_t WS_W1T = 13 * MiB;
constexpr size_t WS_WB = 16 * MiB;
constexpr size_t WS_HB = 52 * MiB;
constexpr size_t WS_PROJ = 180 * MiB;
constexpr size_t WS_QKK = 564 * MiB;
constexpr size_t WS_END = 948 * MiB;

typedef unsigned short bf16_t;
typedef short bf16x8 __attribute__((ext_vector_type(8)));
typedef float f32x4 __attribute__((ext_vector_type(4)));
typedef unsigned u32x4 __attribute__((ext_vector_type(4)));
typedef unsigned u32x2 __attribute__((ext_vector_type(2)));
#define LAS __attribute__((address_space(3)))

typedef float f32x2 __attribute__((ext_vector_type(2)));
typedef __bf16 bf16x2_t __attribute__((ext_vector_type(2)));
__device__ __forceinline__ unsigned cvt_pk_bf16(float lo, float hi) { f32x2 v = {lo, hi}; bf16x2_t b = __builtin_convertvector(v, bf16x2_t); return __builtin_bit_cast(unsigned, b); }
__device__ __forceinline__ float bf_lo(unsigned w) { return __uint_as_float(w << 16); }
__device__ __forceinline__ float bf_hi(unsigned w) { return __uint_as_float(w & 0xffff0000u); }
__device__ __forceinline__ float bf2f(bf16_t b) { return __uint_as_float(((unsigned)b) << 16); }
__device__ __forceinline__ bf16_t f2bf(float f) { unsigned u = __float_as_uint(f); u += 0x7fffu + ((u >> 16) & 1u); return (bf16_t)(u >> 16); }
__device__ __forceinline__ float silu_f(float v) { return v * __builtin_amdgcn_rcpf(1.f + __builtin_amdgcn_exp2f(-1.4426950408889634f * v)); }
__device__ __forceinline__ float wave_sum(float v) {
#pragma unroll
    for (int o = 1; o < 64; o <<= 1) v += __shfl_xor(v, o);
    return v;
}
__device__ __forceinline__ int opaque_tid() { int t; asm volatile("v_mov_b32 %0, %1" : "=v"(t) : "v"((int)threadIdx.x)); return t; }

namespace pg8 {
#define PG8_LAS __attribute__((address_space(3)))
constexpr int BM = 256, BK = 64, HALF = 128, HTB = HALF * BK * 2  , STAGE_BYTES = 8 * HTB, NXCD = 8, WGM = 8;
__host__ __device__ __forceinline__ int lds_byte(int r, int c) { const int st = (r >> 4) * 2 + (c >> 5), rr = r & 15, cc = c & 31, ob = rr * 64 + cc * 2; return st * 1024 + (ob ^ (((ob >> 9) & 1) << 5)); }
__host__ __device__ __forceinline__ void stage_rc(int b, int& R, int& C) { const int st = b / 1024, sb = b % 1024, swz = sb ^ (((sb >> 9) & 1) << 5); R = (st >> 1) * 16 + swz / 64; C = (st & 1) * 32 + (swz % 64) / 2; }
__host__ __device__ __forceinline__ int perm32(int rho) { const int n = rho >> 4, i = rho & 15; return 8 * (i >> 2) + 4 * n + (i & 3); }
struct Unit { int pm, pn; };
struct Gemm { const bf16_t* A; const bf16_t* Bt; int M, N, K, lda, ldb, grp;
    __device__ __forceinline__ const char* aptr(const Unit& u) const { return (const char*)(A + (size_t)u.pm * BM * lda + (grp ? (size_t)(u.pn >> 1) * K : (size_t)0)); }
    __device__ __forceinline__ const char* bptr(const Unit& u) const { return (const char*)(Bt + (size_t)u.pn * BM * ldb); } };
struct StaticOrder {
    int nM, nN, nwg, G, c;
    __host__ __device__ void init(int M, int N, int G_, int c_) { nM = M / BM; nN = N / BM; nwg = nM * nN; G = G_; c = c_; }
    __host__ __device__ bool next(int i, Unit& u) const {
        const long L = (long)i * G + c; if (L >= nwg) return false;
        int wgid = (int)L; { const int q = nwg / NXCD, r = nwg % NXCD, xcd = wgid % NXCD, off = wgid / NXCD; wgid = (xcd < r ? xcd * (q + 1) : r * (q + 1) + (xcd - r) * q) + off; }
        const int nig = WGM * nN, gid = wgid / nig, fm = gid * WGM, gsz = (nM - fm) < WGM ? (nM - fm) : WGM;
        u.pm = fm + ((wgid % nig) % gsz); u.pn = (wgid % nig) / gsz; return true;
    }
    __device__ __forceinline__ void a_ready(const Unit&) const {}
    __device__ __forceinline__ void done(const Unit&) const {}
};
struct EpiStore {
    static constexpr bool PERM = true, AFTER_DRAIN = false;
    bf16_t* O; int ldc;
    __device__ __forceinline__ void operator()(const f32x4 (&acc)[2][2][4][2], const Unit& u, int wr, int wc, int fr, int fq) const {
        const int row0 = u.pm * BM + wr * 64 + fr, col0 = u.pn * BM + wc * 32 + 8 * fq;
#pragma unroll
        for (int ai = 0; ai < 2; ++ai)
#pragma unroll
            for (int m = 0; m < 4; ++m) { bf16_t* rowp = O + (size_t)(row0 + ai * HALF + m * 16) * ldc + col0;
#pragma unroll
                for (int bj = 0; bj < 2; ++bj) { const f32x4 v0 = acc[ai][bj][m][0], v1 = acc[ai][bj][m][1];
                    u32x4 w; w.x = cvt_pk_bf16(v0[0], v0[1]); w.y = cvt_pk_bf16(v0[2], v0[3]); w.z = cvt_pk_bf16(v1[0], v1[1]); w.w = cvt_pk_bf16(v1[2], v1[3]);
                    *(u32x4*)(rowp + bj * HALF) = w; } }
    }
};
struct EpiPool {
    static constexpr bool PERM = true, AFTER_DRAIN = false;
    bf16_t* O; const bf16_t* G; int ldg; const float* scale;
    __device__ __forceinline__ void operator()(const f32x4 (&acc)[2][2][4][2], const Unit& u, int wr, int wc, int fr, int fq) const {
        const int row0 = u.pm * BM + wr * 64 + fr, col0 = u.pn * BM + wc * 32 + 8 * fq;
        f32x4 sv[2][2];
#pragma unroll
        for (int bj = 0; bj < 2; ++bj)
#pragma unroll
            for (int n = 0; n < 2; ++n) sv[bj][n] = *(const f32x4*)(scale + col0 + bj * HALF + 4 * n);
#pragma unroll
        for (int ai = 0; ai < 2; ++ai)
#pragma unroll
            for (int m = 0; m < 4; ++m) { const size_t row = (size_t)(row0 + ai * HALF + m * 16);
#pragma unroll
                for (int bj = 0; bj < 2; ++bj) { const u32x4 gw = *(const u32x4*)(G + row * ldg + col0 + bj * HALF);
                    const f32x4 v0 = acc[ai][bj][m][0] * sv[bj][0], v1 = acc[ai][bj][m][1] * sv[bj][1];
                    u32x4 w;
                    w.x = cvt_pk_bf16(v0[0] * silu_f(bf_lo(gw.x)), v0[1] * silu_f(bf_hi(gw.x))); w.y = cvt_pk_bf16(v0[2] * silu_f(bf_lo(gw.y)), v0[3] * silu_f(bf_hi(gw.y)));
                    w.z = cvt_pk_bf16(v1[0] * silu_f(bf_lo(gw.z)), v1[1] * silu_f(bf_hi(gw.z))); w.w = cvt_pk_bf16(v1[2] * silu_f(bf_lo(gw.w)), v1[3] * silu_f(bf_hi(gw.w)));
                    *(u32x4*)(O + row * 2048 + col0 + bj * HALF) = w; } }
    }
};
struct EpiRes {
    static constexpr bool PERM = false, AFTER_DRAIN = false;
    const float* xi; float* xo; const float* gate;
    __device__ __forceinline__ void operator()(const f32x4 (&acc)[2][2][4][2], const Unit& u, int wr, int wc, int fr, int fq) const {
        const int row0 = u.pm * BM + wr * 64 + fr, col0 = u.pn * BM + wc * 32 + 4 * fq;
        const float* gp = gate + (size_t)((u.pm * BM) / SEQ) * 6144 + col0;
        f32x4 gv[2][2];
#pragma unroll
        for (int bj = 0; bj < 2; ++bj)
#pragma unroll
            for (int n = 0; n < 2; ++n) gv[bj][n] = *(const f32x4*)(gp + bj * HALF + n * 16);
#pragma unroll
        for (int ai = 0; ai < 2; ++ai)
#pragma unroll
            for (int m = 0; m < 4; ++m) { const size_t off = (size_t)(row0 + ai * HALF + m * 16) * 2048 + col0;
#pragma unroll
                for (int bj = 0; bj < 2; ++bj)
#pragma unroll
                    for (int n = 0; n < 2; ++n) { const f32x4 xv = *(const f32x4*)(xi + off + bj * HALF + n * 16);
                        *(f32x4*)(xo + off + bj * HALF + n * 16) = xv + gv[bj][n] * acc[ai][bj][m][n]; }
                asm volatile("" ::: "memory"); }
    }
};
template <class Epi, class Sched>
__device__ __forceinline__ void gemm_phase(PG8_LAS unsigned char* lds, const Gemm g, const Sched& S, const Epi& E) {
    const int tid = opaque_tid(), wid = __builtin_amdgcn_readfirstlane(tid >> 6), lane = tid & 63, wr = wid >> 2, wc = wid & 3, fr = lane & 15, fq = lane >> 4;
    const int K = g.K, nt = K / BK;
    unsigned voffA[2], voffB[2];
#pragma unroll
    for (int i = 0; i < 2; ++i) { int R, C; stage_rc(tid * 16 + i * 8192, R, C); const int Rb = Epi::PERM ? ((R & ~31) + perm32(R & 31)) : R;
        voffA[i] = (unsigned)(R * g.lda + C) * 2u; voffB[i] = (unsigned)(Rb * g.ldb + C) * 2u; }
    const size_t kstep = (size_t)(BK * 2);
    const size_t hstepA = (size_t)HALF * g.lda * 2, hstepB = (size_t)HALF * g.ldb * 2;
    const unsigned ldsw = (unsigned)wid * 1024u;
    const int aoff = lds_byte(wr * 64 + fr, fq * 8), boff = lds_byte(wc * 32 + fr, fq * 8);
#define PG8_SA(b, h) (((b) * 2 + (h)) * HTB)
#define PG8_SB(b, h) ((4 + (b) * 2 + (h)) * HTB)
#define PG8_STAGE(bufoff, gbase, voff) do { _Pragma("unroll") for (int _i = 0; _i < 2; ++_i) \
        __builtin_amdgcn_global_load_lds((const unsigned*)((const char*)(gbase) + (voff)[_i]), (PG8_LAS unsigned*)(lds + (bufoff) + ldsw + _i * 8192), 16, 0, 0); } while (0)
#define PG8_LDA(dst, b, h) do { _Pragma("unroll") for (int m = 0; m < 4; ++m) _Pragma("unroll") for (int k = 0; k < 2; ++k) dst[m][k] = *(const PG8_LAS bf16x8*)(lds + PG8_SA(b, h) + aoff + m * 2048 + k * 1024); } while (0)
#define PG8_LDB(dst, b, h) do { _Pragma("unroll") for (int n = 0; n < 2; ++n) _Pragma("unroll") for (int k = 0; k < 2; ++k) dst[n][k] = *(const PG8_LAS bf16x8*)(lds + PG8_SB(b, h) + boff + n * 2048 + k * 1024); } while (0)
#define PG8_MMA(ai, bj, At, Bt) do { __builtin_amdgcn_s_setprio(1); _Pragma("unroll") for (int m = 0; m < 4; ++m) _Pragma("unroll") for (int n = 0; n < 2; ++n) _Pragma("unroll") for (int k = 0; k < 2; ++k) \
        acc[ai][bj][m][n] = __builtin_amdgcn_mfma_f32_16x16x32_bf16(Bt[n][k], At[m][k], acc[ai][bj][m][n], 0, 0, 0); __builtin_amdgcn_s_setprio(0); } while (0)
#define PG8_WAIT_V(n) asm volatile("s_waitcnt vmcnt(" #n ")" ::: "memory")
#define PG8_WAIT_L(n) asm volatile("s_waitcnt lgkmcnt(" #n ")" ::: "memory")
#define PG8_BAR __builtin_amdgcn_s_barrier()
#define PG8_SCHED __builtin_amdgcn_sched_barrier(0)
    Unit cur, nxt; int ui = 0;
    if (!S.next(0, cur)) return;
    f32x4 acc[2][2][4][2];
#pragma unroll
    for (int a = 0; a < 2; ++a)
#pragma unroll
        for (int b = 0; b < 2; ++b)
#pragma unroll
            for (int m = 0; m < 4; ++m)
#pragma unroll
                for (int n = 0; n < 2; ++n) acc[a][b][m][n] = (f32x4){0.f, 0.f, 0.f, 0.f};
    bf16x8 At[4][2], B0[2][2], B1[2][2];
    const char* cA = g.aptr(cur); const char* cB = g.bptr(cur);
    S.a_ready(cur);
    PG8_STAGE(PG8_SB(0, 0), cB, voffB); PG8_STAGE(PG8_SA(0, 0), cA, voffA); PG8_STAGE(PG8_SB(0, 1), cB + hstepB, voffB); PG8_STAGE(PG8_SA(0, 1), cA + hstepA, voffA);
    if (wr == 1) PG8_BAR;
    PG8_WAIT_V(4); PG8_BAR;
    PG8_STAGE(PG8_SB(1, 0), cB + kstep, voffB); PG8_STAGE(PG8_SA(1, 0), cA + kstep, voffA); PG8_STAGE(PG8_SB(1, 1), cB + hstepB + kstep, voffB);
    PG8_WAIT_V(6); PG8_BAR;
    for (;;) {
        const bool has_next = S.next(ui + 1, nxt);
        const char* nA = has_next ? g.aptr(nxt) : cA; const char* nB = has_next ? g.bptr(nxt) : cB;
        for (int t = 0; t < nt; t += 2) {
            const bool last = (t == nt - 2);
            const char* a1 = cA + (size_t)(t + 1) * kstep;
            const char* a2 = last ? nA : cA + (size_t)(t + 2) * kstep; const char* b2 = last ? nB : cB + (size_t)(t + 2) * kstep;
            const char* a3 = a2 + kstep; const char* b3 = b2 + kstep;
            if (last && has_next) S.a_ready(nxt);
            PG8_LDB(B0, 0, 0); PG8_SCHED; PG8_LDA(At, 0, 0); PG8_STAGE(PG8_SA(1, 1), a1 + hstepA, voffA);
            PG8_WAIT_L(8); PG8_BAR; PG8_WAIT_L(0); PG8_MMA(0, 0, At, B0); PG8_BAR; PG8_SCHED;
            PG8_LDB(B1, 0, 1); PG8_STAGE(PG8_SB(0, 0), b2, voffB);
            PG8_BAR; PG8_WAIT_L(0); PG8_MMA(0, 1, At, B1); PG8_BAR;
            PG8_LDA(At, 0, 1); PG8_STAGE(PG8_SA(0, 0), a2, voffA);
            PG8_BAR; PG8_WAIT_L(0); PG8_MMA(1, 0, At, B0); PG8_BAR; PG8_SCHED;
            PG8_STAGE(PG8_SB(0, 1), b2 + hstepB, voffB);
            PG8_WAIT_V(6); PG8_BAR; PG8_MMA(1, 1, At, B1); PG8_BAR;
            PG8_LDB(B0, 1, 0); PG8_SCHED; PG8_LDA(At, 1, 0); PG8_STAGE(PG8_SA(0, 1), a2 + hstepA, voffA);
            PG8_WAIT_L(8); PG8_BAR; PG8_WAIT_L(0); PG8_MMA(0, 0, At, B0); PG8_BAR; PG8_SCHED;
            PG8_LDB(B1, 1, 1); PG8_STAGE(PG8_SB(1, 0), b3, voffB);
            PG8_BAR; PG8_WAIT_L(0); PG8_MMA(0, 1, At, B1); PG8_BAR;
            PG8_LDA(At, 1, 1); PG8_STAGE(PG8_SA(1, 0), a3, voffA);
            PG8_BAR; PG8_WAIT_L(0); PG8_MMA(1, 0, At, B0); PG8_BAR; PG8_SCHED;
            PG8_STAGE(PG8_SB(1, 1), b3 + hstepB, voffB);
            PG8_WAIT_V(6); PG8_BAR; PG8_MMA(1, 1, At, B1); PG8_BAR;
        }
            if constexpr (!Epi::AFTER_DRAIN) { E(acc, cur, wr, wc, fr, fq); S.done(cur); }
            if (!has_next) break;
#pragma unroll
        for (int a = 0; a < 2; ++a)
#pragma unroll
            for (int b = 0; b < 2; ++b)
#pragma unroll
                for (int m = 0; m < 4; ++m)
#pragma unroll
                    for (int n = 0; n < 2; ++n) acc[a][b][m][n] = (f32x4){0.f, 0.f, 0.f, 0.f};
        cur = nxt; cA = nA; cB = nB; ++ui;
    }
    PG8_WAIT_V(0);
    if (wr == 0) PG8_BAR;
    PG8_BAR;
    if constexpr (Epi::AFTER_DRAIN) { E.fused(acc, cur, wr, wc, fr, fq, lds, wid, lane); S.done(cur); }
#undef PG8_SA
#undef PG8_SB
#undef PG8_STAGE
#undef PG8_LDA
#undef PG8_LDB
#undef PG8_MMA
#undef PG8_WAIT_V
#undef PG8_WAIT_L
#undef PG8_BAR
#undef PG8_SCHED
}
}


namespace attn {
using bf16 = __hip_bfloat16;
constexpr int   D = 128, NW = 8, QBLK = 32, KVBLK = 64;
constexpr float SCALE = 0.088388347648318440f;
constexpr float THR = 8.f;
constexpr int SDEPTH = 1;
constexpr int LDQ = 5120, LDK = 5120, LDO = 2048;
constexpr size_t SHM_V = KVBLK * D * 2, SHM_K = KVBLK * D * 2, SHM_ATTN = 2 * SHM_V + 2 * SHM_K + NW * 64 * 4;
using bf16x8 = __attribute__((ext_vector_type(8))) short;
using s16x4  = __attribute__((ext_vector_type(4))) short;
using f32x16 = __attribute__((ext_vector_type(16))) float;
using f32x8  = __attribute__((ext_vector_type(8))) float;
using u32x4  = __attribute__((ext_vector_type(4))) unsigned;
#define KSWZ(row, colB) ((row) * 256 + ((colB) ^ (((row) & 7) << 4)))
#define SBAR() __builtin_amdgcn_sched_barrier(0)
__device__ __forceinline__ int crow(int r, int hi) { return (r & 3) + 8 * (r >> 2) + 4 * hi; }
__device__ __forceinline__ unsigned cvtpk(float lo, float hi) {
  unsigned r; asm volatile("v_cvt_pk_bf16_f32 %0, %1, %2" : "=v"(r) : "v"(lo), "v"(hi)); return r;
}
template <typename TIn> struct Stage;
template <> struct Stage<bf16>  { using T = bf16x8;
  __device__ static __forceinline__ T ld8(const bf16* p) { return *reinterpret_cast<const bf16x8*>(p); }
  __device__ static __forceinline__ bf16x8 tobf(T x) { return x; } };
template <> struct Stage<float> { using T = f32x8;
  __device__ static __forceinline__ T ld8(const float* p) { return *reinterpret_cast<const f32x8*>(p); }
  __device__ static __forceinline__ bf16x8 tobf(T x) {
    u32x4 w = {cvtpk(x[0], x[1]), cvtpk(x[2], x[3]), cvtpk(x[4], x[5]), cvtpk(x[6], x[7])}; return *reinterpret_cast<bf16x8*>(&w); } };

__device__ __forceinline__ void partialSM(f32x16& p0, f32x16& p1, float& m_reg, float& mn, float& alpha) {
  constexpr float C = SCALE * 1.4426950408889634f;
  float pmax = p0[0]; for (int r = 1; r < 16; ++r) pmax = fmaxf(pmax, p0[r]); for (int r = 0; r < 16; ++r) pmax = fmaxf(pmax, p1[r]);
  { auto rr = __builtin_amdgcn_permlane32_swap(__float_as_uint(pmax), __float_as_uint(pmax), false, false);
    pmax = fmaxf(__uint_as_float(rr[0]), __uint_as_float(rr[1])); }
  if (__builtin_expect(__all(pmax - m_reg <= THR / SCALE), 1)) { mn = m_reg; alpha = 1.f; }
  else { mn = fmaxf(m_reg, pmax); alpha = __builtin_amdgcn_exp2f((m_reg - mn) * C); m_reg = mn; }
  float mnC = -mn * C;
  for (int r = 0; r < 16; ++r) p0[r] = fmaf(p0[r], C, mnC); for (int r = 0; r < 16; ++r) p1[r] = fmaf(p1[r], C, mnC);
  for (int r = 0; r < 16; ++r) p0[r] = __builtin_amdgcn_exp2f(p0[r]);
}
__device__ __forceinline__ void finishSM(f32x16& p0, f32x16& p1, float alpha, float& l_reg, bf16x8& pa0, bf16x8& pa1, bf16x8& pa2, bf16x8& pa3) {
  for (int r = 0; r < 16; ++r) p1[r] = __builtin_amdgcn_exp2f(p1[r]);
  float ps = 0; for (int r = 0; r < 16; ++r) ps += p0[r]; for (int r = 0; r < 16; ++r) ps += p1[r];
  { auto rr = __builtin_amdgcn_permlane32_swap(__float_as_uint(ps), __float_as_uint(ps), false, false);
    ps = __uint_as_float(rr[0]) + __uint_as_float(rr[1]); }
  l_reg = l_reg * alpha + ps;
#define PK4(P, BASE, OUT) do { unsigned a0 = cvtpk(P[BASE + 0], P[BASE + 1]), a1 = cvtpk(P[BASE + 2], P[BASE + 3]);   \
    unsigned b0 = cvtpk(P[BASE + 4], P[BASE + 5]), b1 = cvtpk(P[BASE + 6], P[BASE + 7]);                              \
    auto r0 = __builtin_amdgcn_permlane32_swap(a0, b0, false, false); auto r1 = __builtin_amdgcn_permlane32_swap(a1, b1, false, false); \
    u32x4 w = {r0[0], r1[0], r0[1], r1[1]}; OUT = *reinterpret_cast<bf16x8*>(&w); } while (0)
  PK4(p0, 0, pa0); PK4(p0, 8, pa1); PK4(p1, 0, pa2); PK4(p1, 8, pa3);
#undef PK4
}
__device__ __forceinline__ void qkt(f32x16& p0, f32x16& p1, const bf16* Ks, const bf16x8* qr, int r32, int hi) {
  p0 = f32x16{}; p1 = f32x16{};
  for (int d0 = 0; d0 < 8; ++d0) { int cb = (d0 * 16 + hi * 8) * 2;
    bf16x8 b0 = *reinterpret_cast<const bf16x8*>((const char*)Ks + KSWZ(r32, cb));
    bf16x8 b1 = *reinterpret_cast<const bf16x8*>((const char*)Ks + KSWZ(32 + r32, cb));
    p0 = __builtin_amdgcn_mfma_f32_32x32x16_bf16(b0, qr[d0], p0, 0, 0, 0);
    p1 = __builtin_amdgcn_mfma_f32_32x32x16_bf16(b1, qr[d0], p1, 0, 0, 0); }
}
__device__ __forceinline__ int v_st(int k, int c) { const int kk = (k & ~0xC) | ((k & 4) << 1) | ((k & 8) >> 1); return ((kk >> 3) * 4 + (c >> 5)) * 512 + ((kk & 7) * 32 + (c & 31)) * 2; }
__device__ __forceinline__ int v_rd_base(int lane) { return ((lane & 3) << 3) | (((lane >> 2) & 3) << 6) | (((lane >> 4) & 1) << 5) | (((lane >> 5) & 1) << 8); }
constexpr int v_rd_off(int d0, int ks, int half) { return d0 * 512 + ks * 4096 + half * 2048; }
template <int OFF> __device__ __forceinline__ s16x4 tr_read(int vb) {
  s16x4 r; asm volatile("ds_read_b64_tr_b16 %0, %1 offset:%2" : "=&v"(r) : "v"(vb), "i"(OFF) : "memory"); return r;
}
template <int D0> __device__ __forceinline__ void pv_one(f32x16& od, int vb, bf16x8 pa0, bf16x8 pa1, bf16x8 pa2, bf16x8 pa3) {
  const s16x4 l0 = tr_read<v_rd_off(D0, 0, 0)>(vb), h0 = tr_read<v_rd_off(D0, 0, 1)>(vb), l1 = tr_read<v_rd_off(D0, 1, 0)>(vb), h1 = tr_read<v_rd_off(D0, 1, 1)>(vb);
  const s16x4 l2 = tr_read<v_rd_off(D0, 2, 0)>(vb), h2 = tr_read<v_rd_off(D0, 2, 1)>(vb), l3 = tr_read<v_rd_off(D0, 3, 0)>(vb), h3 = tr_read<v_rd_off(D0, 3, 1)>(vb);
  asm volatile("s_waitcnt lgkmcnt(0)" ::: "memory"); SBAR();
#define PK(L, H) (bf16x8){L[0], L[1], L[2], L[3], H[0], H[1], H[2], H[3]}
  od = __builtin_amdgcn_mfma_f32_32x32x16_bf16(pa0, PK(l0, h0), od, 0, 0, 0);
  od = __builtin_amdgcn_mfma_f32_32x32x16_bf16(pa1, PK(l1, h1), od, 0, 0, 0);
  od = __builtin_amdgcn_mfma_f32_32x32x16_bf16(pa2, PK(l2, h2), od, 0, 0, 0);
  od = __builtin_amdgcn_mfma_f32_32x32x16_bf16(pa3, PK(l3, h3), od, 0, 0, 0);
#undef PK
}
__device__ __forceinline__ void pv_d0(f32x16* o, int vb, bf16x8 pa0, bf16x8 pa1, bf16x8 pa2, bf16x8 pa3) {
  pv_one<0>(o[0], vb, pa0, pa1, pa2, pa3); pv_one<1>(o[1], vb, pa0, pa1, pa2, pa3); pv_one<2>(o[2], vb, pa0, pa1, pa2, pa3); pv_one<3>(o[3], vb, pa0, pa1, pa2, pa3);
}

template <typename TQ>
__device__ __forceinline__ void attn_dense_body(const TQ* __restrict__ Qb, const bf16* __restrict__ Kh, const bf16* __restrict__ Vh,
                                                const unsigned short* __restrict__ Gb, unsigned short* __restrict__ Ob, int seq, char* lds) {
  using St = Stage<bf16>; using SQ = Stage<TQ>;
  const int tid = opaque_tid(), wid = tid >> 6, lane = tid & 63, r32 = lane & 31, hi = lane >> 5;
  bf16* V_lds = (bf16*)lds; bf16* K_lds = (bf16*)(lds + 2 * SHM_V);
  float* ws = (float*)(lds + 2 * SHM_V + 2 * SHM_K) + wid * 64; float* li_l = ws; float* al_l = ws + 32;
  float m_reg = -1e30f, l_reg = 0; f32x16 o[4] = {}; bf16x8 qr[8];
  const TQ* Qw = Qb + (long)(wid * QBLK + r32) * LDQ + hi * 8;
#pragma unroll
  for (int d0 = 0; d0 < 8; ++d0) qr[d0] = SQ::tobf(SQ::ld8(Qw + d0 * 16));
  const int sr = tid >> 4, sc = (tid & 15) * 8, vst0 = v_st(sr, sc), vst1 = v_st(32 + sr, sc);
  const int vb0 = (int)(uintptr_t)V_lds + v_rd_base(lane);
  struct { typename St::T vs0, vs1, ks0, ks1; } sr_[SDEPTH];
#define SLOAD(i, k0) do { sr_[i].vs0 = St::ld8(&Vh[(long)((k0) + sr) * LDK + sc]); sr_[i].vs1 = St::ld8(&Vh[(long)((k0) + 32 + sr) * LDK + sc]); \
    sr_[i].ks0 = St::ld8(&Kh[(long)((k0) + sr) * LDK + sc]); sr_[i].ks1 = St::ld8(&Kh[(long)((k0) + 32 + sr) * LDK + sc]); } while (0)
#define SWRITE(b, i) do { *(bf16x8*)((char*)V_lds + (b) * SHM_V + vst0) = St::tobf(sr_[i].vs0);          \
    *(bf16x8*)((char*)V_lds + (b) * SHM_V + vst1) = St::tobf(sr_[i].vs1); int kc = sc * 2;               \
    *(bf16x8*)((char*)K_lds + (b) * SHM_K + KSWZ(sr, kc)) = St::tobf(sr_[i].ks0);                       \
    *(bf16x8*)((char*)K_lds + (b) * SHM_K + KSWZ(32 + sr, kc)) = St::tobf(sr_[i].ks1); } while (0)
#define SWAIT() do { if constexpr (SDEPTH == 2) asm volatile("s_waitcnt vmcnt(4)" ::: "memory"); else asm volatile("s_waitcnt vmcnt(0)" ::: "memory"); } while (0)
#define RESC(a) do { if (__any((a) < 1.f)) { if (hi == 0) al_l[r32] = (a); asm volatile("s_waitcnt lgkmcnt(0)" ::: "memory"); \
    for (int d = 0; d < 4; ++d) for (int r = 0; r < 16; ++r) o[d][r] *= al_l[crow(r, hi)]; } } while (0)
  f32x16 pA0, pA1, pB0, pB1; float mnA, mnB, alA, alB; bf16x8 pa0, pa1, pa2, pa3; const int NT = seq / KVBLK;
  constexpr int SE = 0, SO = SDEPTH - 1;
  SLOAD(SE, 0); asm volatile("s_waitcnt vmcnt(0)" ::: "memory"); SWRITE(0, SE); __syncthreads();
  qkt(pA0, pA1, K_lds, qr, r32, hi); partialSM(pA0, pA1, m_reg, mnA, alA);
  SLOAD(SO, KVBLK); if constexpr (SDEPTH == 2) { if (2 < NT) SLOAD(SE, 2 * KVBLK); }
  SWAIT(); SWRITE(1, SO); __syncthreads();
  for (int j = 1; j + 1 < NT; j += 2) {
    SBAR(); qkt(pB0, pB1, (bf16*)((char*)K_lds + SHM_K), qr, r32, hi);
    finishSM(pA0, pA1, alA, l_reg, pa0, pa1, pa2, pa3); SBAR();
    SLOAD(SO, (j + SDEPTH) * KVBLK); SBAR();
    pv_d0(o, vb0, pa0, pa1, pa2, pa3); partialSM(pB0, pB1, m_reg, mnB, alB);
    __syncthreads(); SWAIT(); SWRITE(0, SE);
    RESC(alB); __syncthreads();
    SBAR(); qkt(pA0, pA1, K_lds, qr, r32, hi);
    finishSM(pB0, pB1, alB, l_reg, pa0, pa1, pa2, pa3); SBAR();
    if (SDEPTH == 1 || j + 3 < NT) SLOAD(SE, (j + 1 + SDEPTH) * KVBLK); SBAR();
    pv_d0(o, vb0 + (int)SHM_V, pa0, pa1, pa2, pa3); partialSM(pA0, pA1, m_reg, mnA, alA);
    __syncthreads(); SWAIT(); SWRITE(1, SO);
    RESC(alA); __syncthreads();
  }
  SBAR(); qkt(pB0, pB1, (bf16*)((char*)K_lds + SHM_K), qr, r32, hi);
  finishSM(pA0, pA1, alA, l_reg, pa0, pa1, pa2, pa3); SBAR();
  pv_d0(o, vb0, pa0, pa1, pa2, pa3); partialSM(pB0, pB1, m_reg, mnB, alB);
  __syncthreads(); RESC(alB);
  finishSM(pB0, pB1, alB, l_reg, pa0, pa1, pa2, pa3); SBAR();
  pv_d0(o, vb0 + (int)SHM_V, pa0, pa1, pa2, pa3);
  if (hi == 0) li_l[r32] = l_reg; asm volatile("s_waitcnt lgkmcnt(0)" ::: "memory");
  float rli[16];
#pragma unroll
  for (int r = 0; r < 16; ++r) rli[r] = __builtin_amdgcn_rcpf(li_l[crow(r, hi)]);
  unsigned short* Ow = Ob + (long)(wid * QBLK) * LDO + r32; const unsigned short* Gw = Gb + (long)(wid * QBLK) * LDQ + r32;
#pragma unroll
  for (int r = 0; r < 16; ++r) { const int orow = crow(r, hi);
    const unsigned short* gp = Gw + (long)orow * LDQ; unsigned short* op = Ow + (long)orow * LDO;
    float gv[4];
#pragma unroll
    for (int d0 = 0; d0 < 4; ++d0) gv[d0] = __uint_as_float(((unsigned)gp[d0 * 32]) << 16);
#pragma unroll
    for (int d0 = 0; d0 < 4; ++d0) {
      const float sg = gv[d0] * __builtin_amdgcn_rcpf(1.f + __builtin_amdgcn_exp2f(-1.4426950408889634f * gv[d0]));
      const float val = o[d0][r] * rli[r] * sg; unsigned u = __float_as_uint(val); u += 0x7fffu + ((u >> 16) & 1u);
      op[d0 * 32] = (unsigned short)(u >> 16); }
    asm volatile("" ::: "memory"); }
#undef SLOAD
#undef SWRITE
#undef SWAIT
#undef RESC
}
}

struct Args {
    const float *x, *c, *w_mod, *b_mod, *pool_w_in, *pool_w_grp, *pool_scale, *pool_w_out;
    const float *gla_w_in, *gla_fwd_w1, *gla_fwd_w2, *gla_fwd_b, *gla_bwd_w1, *gla_bwd_w2, *gla_bwd_b, *gla_norm_g, *gla_w_out;
    const float *attn_w_in, *attn_qg, *attn_kg, *attn_w_out, *final_g;
    float* out; unsigned char* ws;
};
#define LDS_WAIT() asm volatile("s_waitcnt lgkmcnt(0)" ::: "memory")

__device__ __forceinline__ void transpose_item(const float* W, int K, int N, bf16_t* WT, int row_off, LAS float* scr, int item, int lane) {
    const int nblk = N / 32, kb = item / nblk, nb = item % nblk, k0 = 64 * kb, n0 = 32 * nb;
#pragma unroll 8
    for (int i = 0; i < 32; ++i) { const int kk = 2 * i + (lane >> 5); scr[kk * 33 + (lane & 31)] = W[(size_t)(k0 + kk) * N + n0 + (lane & 31)]; }
    LDS_WAIT();
    const int c = lane & 7;
#pragma unroll
    for (int j = 0; j < 4; ++j) { const int n = (lane >> 3) + 8 * j; const LAS float* s = scr + (8 * c) * 33 + n;
        u32x4 o; o.x = cvt_pk_bf16(s[0 * 33], s[1 * 33]); o.y = cvt_pk_bf16(s[2 * 33], s[3 * 33]); o.z = cvt_pk_bf16(s[4 * 33], s[5 * 33]); o.w = cvt_pk_bf16(s[6 * 33], s[7 * 33]);
        *(u32x4*)(WT + (size_t)(row_off + n0 + n) * K + k0 + 8 * c) = o; }
    LDS_WAIT();
}
__device__ __forceinline__ void phase_weights(const Args& a, int L, LAS unsigned char* lds) {
    const int tid_ = opaque_tid(), lane = tid_ & 63, wave = __builtin_amdgcn_readfirstlane(tid_ >> 6), gw = blockIdx.x * 8 + wave, NGW = gridDim.x * 8; (void)wave; (void)gw; (void)NGW; (void)lane;
    LAS float* scr = (LAS float*)(lds + wave * 8704);
    bf16_t* WB = (bf16_t*)(a.ws + WS_WB); bf16_t* WBG = (bf16_t*)(a.ws + WS_WB + 16 * MiB); bf16_t* WBO = (bf16_t*)(a.ws + WS_WB + 24 * MiB);
    const int kind = L % 3, j = L / 3;
    if (kind == 0) {
        const float* win = a.pool_w_in + (size_t)j * 2048 * 4096; const float* wgrp = a.pool_w_grp + (size_t)j * 4 * 512 * 512; const float* wout = a.pool_w_out + (size_t)j * 2048 * 2048;
        constexpr int I_IN = 32 * 128, I_G = 8 * 16, I_OUT = 32 * 64;
        for (int it = gw; it < I_IN + 4 * I_G + I_OUT; it += NGW) {
            int r = it;
            if (r < I_IN) { transpose_item(win, 2048, 4096, WB, 0, scr, r, lane); continue; } r -= I_IN;
            if (r < 4 * I_G) { const int g = r / I_G; transpose_item(wgrp + (size_t)g * 512 * 512, 512, 512, WBG, g * 512, scr, r % I_G, lane); continue; } r -= 4 * I_G;
            transpose_item(wout, 2048, 2048, WBO, 0, scr, r, lane);
        }
    } else if (kind == 1) {
        constexpr int I_IN = 32 * 192, I_OUT = 32 * 64;
        for (int it = gw; it < I_IN + I_OUT; it += NGW) {
            int r = it;
            if (r < I_IN) { transpose_item(a.gla_w_in, 2048, 6144, WB, 0, scr, r, lane); continue; } r -= I_IN;
            transpose_item(a.gla_w_out, 2048, 2048, WBO, 0, scr, r, lane);
        }
        bf16_t* W1T = (bf16_t*)(a.ws + WS_W1T);
        for (int i = gw * 64 + lane; i < 32 * 2048; i += NGW * 64) { const int n = i >> 11, k = i & 2047;
            W1T[i] = f2bf(n < 16 ? a.gla_fwd_w1[k * 16 + n] : a.gla_bwd_w1[k * 16 + n - 16]); }
    } else {
        constexpr int I_IN = 32 * 160, I_OUT = 32 * 64;
        for (int it = gw; it < I_IN + I_OUT; it += NGW) {
            int r = it;
            if (r < I_IN) { transpose_item(a.attn_w_in, 2048, 5120, WB, 0, scr, r, lane); continue; } r -= I_IN;
            transpose_item(a.attn_w_out, 2048, 2048, WBO, 0, scr, r, lane);
        }
    }
}
__device__ __forceinline__ void phase_norm_mod(const float* x, const float* modL, bf16_t* hb) {
    const int tid_ = opaque_tid(), lane = tid_ & 63, wave = __builtin_amdgcn_readfirstlane(tid_ >> 6), gw = blockIdx.x * 8 + wave, NGW = gridDim.x * 8; (void)wave; (void)gw; (void)NGW; (void)lane;
    for (int m = gw; m < MTOK; m += NGW) {
        const f32x4* xr = (const f32x4*)(x + (size_t)m * DM) + lane;
        f32x4 v[8]; float s = 0.f;
#pragma unroll
        for (int j = 0; j < 8; ++j) { v[j] = xr[64 * j]; s += (v[j].x * v[j].x + v[j].y * v[j].y) + (v[j].z * v[j].z + v[j].w * v[j].w); }
        const float rstd = __builtin_amdgcn_rsqf(wave_sum(s) * (1.f / DM) + NEPS);
        const float* mp = modL + (size_t)(m / SEQ) * 6144;
        u32x2* o8 = (u32x2*)(hb + (size_t)m * DM) + lane;
#pragma unroll
        for (int j = 0; j < 8; ++j) { const f32x4 sh = *((const f32x4*)mp + lane + 64 * j), sc = *((const f32x4*)(mp + 2048) + lane + 64 * j);
            const f32x4 h = v[j] * rstd * (sc + 1.f) + sh; u32x2 w; w.x = cvt_pk_bf16(h.x, h.y); w.y = cvt_pk_bf16(h.z, h.w); o8[64 * j] = w; }
    }
}
__device__ __forceinline__ void phase_final_norm(float* x, const float* g) {
    const int tid_ = opaque_tid(), lane = tid_ & 63, wave = __builtin_amdgcn_readfirstlane(tid_ >> 6), gw = blockIdx.x * 8 + wave, NGW = gridDim.x * 8; (void)wave; (void)gw; (void)NGW; (void)lane;
    for (int m = gw; m < MTOK; m += NGW) {
        f32x4* xr = (f32x4*)(x + (size_t)m * DM) + lane;
        f32x4 v[8]; float s = 0.f;
#pragma unroll
        for (int j = 0; j < 8; ++j) { v[j] = xr[64 * j]; s += (v[j].x * v[j].x + v[j].y * v[j].y) + (v[j].z * v[j].z + v[j].w * v[j].w); }
        const float rstd = __builtin_amdgcn_rsqf(wave_sum(s) * (1.f / DM) + NEPS);
#pragma unroll
        for (int j = 0; j < 8; ++j) { const f32x4 gg = *((const f32x4*)g + lane + 64 * j); xr[64 * j] = v[j] * rstd * gg; }
    }
}
__device__ __forceinline__ void phase_mod(const Args& a, LAS unsigned char* lds, float* mod) {
    LAS float* sc = (LAS float*)lds; LAS float* part = (LAS float*)(lds + 32768);
    const int tid = opaque_tid();
    if ((int)blockIdx.x >= 192) return;
    for (int i = tid; i < 8192; i += 512) sc[i] = silu_f(a.c[i]);
    __syncthreads();
    for (int item = blockIdx.x; item < 192; item += gridDim.x) {
        const int layer = item / 48, n0 = (item % 48) * 128, ks = tid >> 5, cq = tid & 31;
        f32x4 acc[4];
#pragma unroll
        for (int b = 0; b < 4; ++b) acc[b] = (f32x4){0.f, 0.f, 0.f, 0.f};
        const float* wp = a.w_mod + ((size_t)layer * 2048 + ks * 128) * 6144 + n0 + cq * 4;
#pragma unroll 8
        for (int k = 0; k < 128; ++k) { const f32x4 w = *(const f32x4*)(wp + (size_t)k * 6144); const int kk = ks * 128 + k;
#pragma unroll
            for (int b = 0; b < 4; ++b) acc[b] += w * sc[b * 2048 + kk]; }
#pragma unroll
        for (int b = 0; b < 4; ++b) *(LAS f32x4*)(part + (ks * 4 + b) * 128 + cq * 4) = acc[b];
        __syncthreads();
        { const int b = tid >> 7, col = tid & 127; float s = a.b_mod[layer * 6144 + n0 + col];
#pragma unroll
          for (int q = 0; q < 16; ++q) s += part[(q * 4 + b) * 128 + col];
          mod[(size_t)(layer * 4 + b) * 6144 + n0 + col] = s; }
        __syncthreads();
    }
}
__device__ __forceinline__ void phase_rope_table(float* rc, float* rs) {
    for (int idx = blockIdx.x * 512 + opaque_tid(); idx < SEQ * 64; idx += gridDim.x * 512) {
        const int t = idx >> 6, i = idx & 63;
        const float pos = (i < 32) ? (float)((t >> 6) - 64) : (float)((t & 63) - 32);
        const float inv = __builtin_amdgcn_exp2f(-(float)(i & 31) * 0.41524101186092029f);
        const float ang = pos * inv;
        const double xd = (double)ang; const double n = __builtin_rint(xd * 0.63661977236758134); const float rf = (float)(xd - n * 1.5707963267948966);
        const int q = ((int)n) & 3; const float r2 = rf * rf;
        const float sn = rf + rf * r2 * (-1.6666667e-1f + r2 * (8.3333333e-3f + r2 * (-1.9841270e-4f + r2 * 2.7557319e-6f)));
        const float cs = 1.f + r2 * (-0.5f + r2 * (4.1666667e-2f + r2 * (-1.3888889e-3f + r2 * (2.4801587e-5f + r2 * -2.7557319e-7f))));
        const float co = (q == 0) ? cs : (q == 1) ? -sn : (q == 2) ? -cs : sn;
        const float si = (q == 0) ? sn : (q == 1) ? cs : (q == 2) ? -sn : -cs;
        rc[idx] = co; rs[idx] = si;
    }
}
__device__ __forceinline__ void phase_pool(const bf16_t* proj  , bf16_t* pooled) {
    const int tid_ = opaque_tid(), lane = tid_ & 63, wave = __builtin_amdgcn_readfirstlane(tid_ >> 6), gw = blockIdx.x * 8 + wave, NGW = gridDim.x * 8; (void)wave; (void)gw; (void)NGW; (void)lane;
    for (int m = gw; m < MTOK; m += NGW) {
        const int t = m & (SEQ - 1); const bf16_t* base = proj + (size_t)(m - t) * 4096;
#pragma unroll
        for (int j = 0; j < 4; ++j) {
            const int half = 1 << j, lo = (t - half) > 0 ? (t - half) : 0, hi = (t + half) < SEQ ? (t + half) : SEQ, c = (j * 64 + lane) * 8;
            float s[8];
#pragma unroll
            for (int q = 0; q < 8; ++q) s[q] = 0.f;
            for (int r = lo; r < hi; ++r) { const u32x4 w = *(const u32x4*)(base + (size_t)r * 4096 + c);
                s[0] += bf_lo(w.x); s[1] += bf_hi(w.x); s[2] += bf_lo(w.y); s[3] += bf_hi(w.y); s[4] += bf_lo(w.z); s[5] += bf_hi(w.z); s[6] += bf_lo(w.w); s[7] += bf_hi(w.w); }
            const u32x4 u = *(const u32x4*)(base + (size_t)t * 4096 + c); const float ic = 1.f / (float)(hi - lo);
            u32x4 o; o.x = cvt_pk_bf16(s[0] * ic - bf_lo(u.x), s[1] * ic - bf_hi(u.x)); o.y = cvt_pk_bf16(s[2] * ic - bf_lo(u.y), s[3] * ic - bf_hi(u.y));
            o.z = cvt_pk_bf16(s[4] * ic - bf_lo(u.z), s[5] * ic - bf_hi(u.z)); o.w = cvt_pk_bf16(s[6] * ic - bf_lo(u.w), s[7] * ic - bf_hi(u.w));
            *(u32x4*)(pooled + (size_t)m * 2048 + c) = o;
        }
    }
}
__device__ __forceinline__ void phase_qknorm_rope(bf16_t* proj, const float* qg, const float* kg, const float* rc, const float* rs) {
    const int tid_ = opaque_tid(), lane = tid_ & 63, wave = __builtin_amdgcn_readfirstlane(tid_ >> 6), gw = blockIdx.x * 8 + wave, NGW = gridDim.x * 8; (void)wave; (void)gw; (void)NGW; (void)lane;
    const float q0 = qg[2 * lane], q1 = qg[2 * lane + 1], k0 = kg[2 * lane], k1 = kg[2 * lane + 1];
    for (int m = gw; m < MTOK; m += NGW) {
        const int t = m & (SEQ - 1); const float co = rc[t * 64 + lane], si = rs[t * 64 + lane];
        unsigned* row = (unsigned*)(proj + (size_t)m * 5120) + lane;
        unsigned w[20];
#pragma unroll
        for (int h = 0; h < 20; ++h) w[h] = row[h * 64];
#pragma unroll
        for (int h = 0; h < 20; ++h) {
            const float x0 = bf_lo(w[h]), x1 = bf_hi(w[h]);
            const float rstd = __builtin_amdgcn_rsqf(wave_sum(x0 * x0 + x1 * x1) * (1.f / 128.f) + NEPS);
            const float y0 = x0 * rstd * (h < 16 ? q0 : k0), y1 = x1 * rstd * (h < 16 ? q1 : k1);
            row[h * 64] = cvt_pk_bf16(y0 * co - y1 * si, y0 * si + y1 * co);
        }
    }
}

__device__ __forceinline__ f32x4 mfma16(bf16x8 x, bf16x8 y, f32x4 acc) { return __builtin_amdgcn_mfma_f32_16x16x32_bf16(x, y, acc, 0, 0, 0); }

__device__ __forceinline__ void phase_gla_lowrank(const bf16_t* hb, const bf16_t* w1t, float* R) {
    const int tid_ = opaque_tid(), lane = tid_ & 63, wave = __builtin_amdgcn_readfirstlane(tid_ >> 6), gw = blockIdx.x * 8 + wave, NGW = gridDim.x * 8; (void)wave; (void)gw; (void)NGW; (void)lane;
    const int fr = lane & 15, fq = lane >> 4;
    for (int u = gw; u < MTOK / 16; u += NGW) {
        const bf16_t* ap = hb + (size_t)(u * 16 + fr) * 2048 + fq * 8; const bf16_t* wp = w1t + (size_t)fr * 2048 + fq * 8;
        f32x4 acc0 = (f32x4){0.f, 0.f, 0.f, 0.f}, acc1 = acc0;
#pragma unroll 8
        for (int ks = 0; ks < 64; ++ks) { const bf16x8 av = *(const bf16x8*)(ap + ks * 32);
            acc0 = mfma16(*(const bf16x8*)(wp + ks * 32), av, acc0); acc1 = mfma16(*(const bf16x8*)(wp + 16 * 2048 + ks * 32), av, acc1); }
        float* rp = R + (size_t)(u * 16 + fr) * 32 + 4 * fq;
        *(f32x4*)rp = acc0; *(f32x4*)(rp + 16) = acc1;
    }
}
__device__ __forceinline__ void phase_gla_prep(const Args& a, LAS unsigned char* lds) {
    LAS float* rl = (LAS float*)lds;
    const int tid = opaque_tid(), dir = __builtin_amdgcn_readfirstlane(tid >> 8), d = tid & 255;
    const bf16_t* proj = (const bf16_t*)(a.ws + WS_PROJ); const float* R = (const float*)(a.ws + WS_R); float* DL = (float*)(a.ws + WS_DL);
    bf16_t* QT = (bf16_t*)(a.ws + WS_QKK) + (size_t)dir * MTOK * 1024; bf16_t* KT = (bf16_t*)(a.ws + WS_QKK + 128 * MiB) + (size_t)dir * MTOK * 1024;
    bf16_t* KH = (bf16_t*)(a.ws + WS_QKK + 256 * MiB);
    const float* w2 = dir ? a.gla_bwd_w2 : a.gla_fwd_w2; const float* bs = dir ? a.gla_bwd_b : a.gla_fwd_b;
    for (int u = blockIdx.x; u < 2048; u += gridDim.x) {
        const int b = u >> 9, cc = (u >> 2) & 127, h = u & 3, col = h * 256 + d; const size_t tok0 = (size_t)b * SEQ + cc * 64;
        *(LAS f32x4*)(rl + tid * 4) = *(const f32x4*)(R + tok0 * 32 + tid * 4);
        float w2c[16];
#pragma unroll
        for (int c = 0; c < 16; ++c) w2c[c] = w2[c * 1024 + col];
        const float bias = bs[col];
        __syncthreads();
        float bb[64]; float run = 0.f;
#pragma unroll
        for (int i = 0; i < 64; ++i) { const int t = dir ? 63 - i : i; float z = bias;
#pragma unroll
            for (int c4 = 0; c4 < 4; ++c4) { const f32x4 rv = *(const LAS f32x4*)(rl + t * 32 + dir * 16 + c4 * 4);
                z += rv.x * w2c[c4 * 4] + rv.y * w2c[c4 * 4 + 1] + rv.z * w2c[c4 * 4 + 2] + rv.w * w2c[c4 * 4 + 3]; }
            const float ls = fminf(z, 0.f) - __logf(1.f + __expf(-fabsf(z)));
            run += ls * 0.0625f; bb[i] = run; }
        const float blast = run;
        bf16_t* khp = KH + ((((size_t)dir * 4 + b) * 128 + cc) * 4 + h) * (256 * 64) + (size_t)d * 64;
#pragma unroll
        for (int gi = 0; gi < 8; ++gi) {
            float kh[8];
#pragma unroll
            for (int q = 0; q < 8; ++q) { const int i = gi * 8 + q, t = dir ? 63 - i : i;
                const float qv = bf2f(proj[(tok0 + t) * 6144 + col]), kv = bf2f(proj[(tok0 + t) * 6144 + 1024 + col]);
                QT[(tok0 + t) * 1024 + col] = f2bf(qv * 0.0625f * __expf(bb[i])); KT[(tok0 + t) * 1024 + col] = f2bf(kv * __expf(-bb[i]));
                kh[q] = kv * __expf(blast - bb[i]); }
            u32x4 o;
            if (dir) { o.x = cvt_pk_bf16(kh[7], kh[6]); o.y = cvt_pk_bf16(kh[5], kh[4]); o.z = cvt_pk_bf16(kh[3], kh[2]); o.w = cvt_pk_bf16(kh[1], kh[0]); }
            else     { o.x = cvt_pk_bf16(kh[0], kh[1]); o.y = cvt_pk_bf16(kh[2], kh[3]); o.z = cvt_pk_bf16(kh[4], kh[5]); o.w = cvt_pk_bf16(kh[6], kh[7]); }
            *(u32x4*)(khp + (dir ? 56 - gi * 8 : gi * 8)) = o;
        }
        DL[(((size_t)dir * 4 + b) * 128 + cc) * 1024 + col] = __expf(blast);
        __syncthreads();
    }
}
constexpr int SC_PQ = 528, SC_PS = 144;
constexpr int SC_QT = 0, SC_KT = SC_QT + 64 * SC_PQ, SC_KH = SC_KT + 64 * SC_PQ, SC_VT = SC_KH + 256 * SC_PS, SC_ST = SC_VT + 64 * SC_PS, SC_AM = SC_ST + 64 * SC_PQ, SC_DL = SC_AM + 64 * SC_PS, SC_END = SC_DL + 1024;
__device__ __forceinline__ bf16x8 frag(const LAS unsigned char* base, int pitch, int row, int ks, int fq) { return *(const LAS bf16x8*)(base + row * pitch + ks * 64 + fq * 16); }
__device__ __forceinline__ void phase_gla_scan(const Args& a, LAS unsigned char* lds) {
    const int tid = opaque_tid(), wave = __builtin_amdgcn_readfirstlane(tid >> 6), lane = tid & 63, fr = lane & 15, fq = lane >> 4;
    const bf16_t* proj = (const bf16_t*)(a.ws + WS_PROJ); const float* DLg = (const float*)(a.ws + WS_DL);
    for (int item = blockIdx.x; item < 256; item += gridDim.x) {
        const int xcd = item & 7, jj = item >> 3, bhd = xcd * 4 + (jj >> 3), es = jj & 7, b = bhd >> 3, h = (bhd >> 1) & 3, dir = bhd & 1;
        const bf16_t* QT = (const bf16_t*)(a.ws + WS_QKK) + (size_t)dir * MTOK * 1024 + h * 256;
        const bf16_t* KT = (const bf16_t*)(a.ws + WS_QKK + 128 * MiB) + (size_t)dir * MTOK * 1024 + h * 256;
        const bf16_t* KH = (const bf16_t*)(a.ws + WS_QKK + 256 * MiB);
        const bf16_t* V = proj + 2048 + h * 512 + es * 64;
        bf16_t* O = dir ? ((bf16_t*)(a.ws + WS_PROJ) + h * 512 + es * 64) : ((bf16_t*)(a.ws + WS_HB) + h * 512 + es * 64); const int ldo = dir ? 6144 : 2048;
        for (int i = tid; i < 64 * SC_PQ / 16; i += 512) *(LAS u32x4*)(lds + SC_ST + i * 16) = (u32x4){0u, 0u, 0u, 0u};
        f32x4 S[2][4];
#pragma unroll
        for (int i = 0; i < 2; ++i)
#pragma unroll
            for (int j = 0; j < 4; ++j) S[i][j] = (f32x4){0.f, 0.f, 0.f, 0.f};
        u32x4 rq[4], rk[4], rkh[4], rv; f32x4 rdl = (f32x4){0.f, 0.f, 0.f, 0.f};
#define SC_LOAD(c) do { const int cc_ = dir ? 127 - (c) : (c); const size_t tok0_ = (size_t)b * SEQ + cc_ * 64; \
        _Pragma("unroll") for (int i_ = 0; i_ < 4; ++i_) { const int idx_ = tid + 512 * i_; rq[i_] = *(const u32x4*)(QT + (tok0_ + (idx_ >> 5)) * 1024 + (idx_ & 31) * 8); rk[i_] = *(const u32x4*)(KT + (tok0_ + (idx_ >> 5)) * 1024 + (idx_ & 31) * 8); } \
        const bf16_t* khc_ = KH + ((((size_t)dir * 4 + b) * 128 + cc_) * 4 + h) * (256 * 64); \
        _Pragma("unroll") for (int i_ = 0; i_ < 4; ++i_) rkh[i_] = *(const u32x4*)(khc_ + (size_t)(tid + 512 * i_) * 8); \
        rv = *(const u32x4*)(V + (tok0_ + (tid >> 3)) * 6144 + (tid & 7) * 8); \
        if (tid < 64) rdl = *(const f32x4*)(DLg + (((size_t)dir * 4 + b) * 128 + cc_) * 1024 + h * 256 + tid * 4); } while (0)
        SC_LOAD(0);
        for (int c = 0; c < 128; ++c) {
            const int cc = dir ? 127 - c : c; const size_t tok0 = (size_t)b * SEQ + cc * 64;
#pragma unroll
            for (int i = 0; i < 4; ++i) { const int idx = tid + 512 * i; *(LAS u32x4*)(lds + SC_QT + (idx >> 5) * SC_PQ + (idx & 31) * 16) = rq[i]; *(LAS u32x4*)(lds + SC_KT + (idx >> 5) * SC_PQ + (idx & 31) * 16) = rk[i];
                *(LAS u32x4*)(lds + SC_KH + (idx >> 3) * SC_PS + (idx & 7) * 16) = rkh[i]; }
            { LAS bf16_t* vt = (LAS bf16_t*)(lds + SC_VT) + ((tid & 7) * 8) * (SC_PS / 2) + (tid >> 3);
              vt[0 * (SC_PS / 2)] = (bf16_t)(rv.x & 0xffffu); vt[1 * (SC_PS / 2)] = (bf16_t)(rv.x >> 16); vt[2 * (SC_PS / 2)] = (bf16_t)(rv.y & 0xffffu); vt[3 * (SC_PS / 2)] = (bf16_t)(rv.y >> 16);
              vt[4 * (SC_PS / 2)] = (bf16_t)(rv.z & 0xffffu); vt[5 * (SC_PS / 2)] = (bf16_t)(rv.z >> 16); vt[6 * (SC_PS / 2)] = (bf16_t)(rv.w & 0xffffu); vt[7 * (SC_PS / 2)] = (bf16_t)(rv.w >> 16); }
            if (tid < 64) *(LAS f32x4*)(lds + SC_DL + tid * 16) = rdl;
            __syncthreads();
            if (c + 1 < 128) SC_LOAD(c + 1);
            const int it = wave >> 1, et0 = (wave & 1) * 2;
            f32x4 oacc[2], am[2];
#pragma unroll
            for (int n = 0; n < 2; ++n) { oacc[n] = (f32x4){0.f, 0.f, 0.f, 0.f}; am[n] = (f32x4){0.f, 0.f, 0.f, 0.f}; }
#pragma unroll
            for (int ks = 0; ks < 8; ++ks) { const bf16x8 fqt = frag(lds + SC_QT, SC_PQ, it * 16 + fr, ks, fq);
#pragma unroll
                for (int n = 0; n < 2; ++n) { oacc[n] = mfma16(frag(lds + SC_ST, SC_PQ, (et0 + n) * 16 + fr, ks, fq), fqt, oacc[n]);
                                              am[n] = mfma16(frag(lds + SC_KT, SC_PQ, (et0 + n) * 16 + fr, ks, fq), fqt, am[n]); } }
#pragma unroll
            for (int n = 0; n < 2; ++n) { const int i = it * 16 + fr, j0 = (et0 + n) * 16 + 4 * fq; float v[4];
#pragma unroll
                for (int r = 0; r < 4; ++r) { const int j = j0 + r; const bool keep = dir ? (j > i) : (j <= i); v[r] = keep ? am[n][r] : 0.f; }
                u32x2 w; w.x = cvt_pk_bf16(v[0], v[1]); w.y = cvt_pk_bf16(v[2], v[3]); *(LAS u32x2*)(lds + SC_AM + i * SC_PS + j0 * 2) = w; }
            __syncthreads();
#pragma unroll
            for (int ks = 0; ks < 2; ++ks) { const bf16x8 fa = frag(lds + SC_AM, SC_PS, it * 16 + fr, ks, fq);
#pragma unroll
                for (int n = 0; n < 2; ++n) oacc[n] = mfma16(frag(lds + SC_VT, SC_PS, (et0 + n) * 16 + fr, ks, fq), fa, oacc[n]); }
#pragma unroll
            for (int n = 0; n < 2; ++n) { u32x2 w; w.x = cvt_pk_bf16(oacc[n][0], oacc[n][1]); w.y = cvt_pk_bf16(oacc[n][2], oacc[n][3]);
                *(u32x2*)(O + (tok0 + it * 16 + fr) * ldo + (et0 + n) * 16 + 4 * fq) = w; }
#pragma unroll
            for (int i = 0; i < 2; ++i) { const f32x4 dl4 = *(const LAS f32x4*)(lds + SC_DL + ((wave * 2 + i) * 16 + 4 * fq) * 4);
#pragma unroll
                for (int j = 0; j < 4; ++j) S[i][j] *= dl4; }
#pragma unroll
            for (int ks = 0; ks < 2; ++ks) {
                bf16x8 fv[4];
#pragma unroll
                for (int j = 0; j < 4; ++j) fv[j] = frag(lds + SC_VT, SC_PS, j * 16 + fr, ks, fq);
#pragma unroll
                for (int i = 0; i < 2; ++i) { const bf16x8 fk = frag(lds + SC_KH, SC_PS, (wave * 2 + i) * 16 + fr, ks, fq);
#pragma unroll
                    for (int j = 0; j < 4; ++j) S[i][j] = mfma16(fk, fv[j], S[i][j]); } }
            __syncthreads();
#pragma unroll
            for (int i = 0; i < 2; ++i)
#pragma unroll
                for (int j = 0; j < 4; ++j) { u32x2 w; w.x = cvt_pk_bf16(S[i][j][0], S[i][j][1]); w.y = cvt_pk_bf16(S[i][j][2], S[i][j][3]);
                    *(LAS u32x2*)(lds + SC_ST + (j * 16 + fr) * SC_PQ + ((wave * 2 + i) * 16 + 4 * fq) * 2) = w; }
        }
        __syncthreads();
#undef SC_LOAD
    }
}
__device__ __forceinline__ void phase_gla_post(bf16_t* hb, const bf16_t* proj, const float* ng) {
    const int tid_ = opaque_tid(), lane = tid_ & 63, wave = __builtin_amdgcn_readfirstlane(tid_ >> 6), gw = blockIdx.x * 8 + wave, NGW = gridDim.x * 8; (void)wave; (void)gw; (void)NGW; (void)lane;
    float g8[8];
#pragma unroll
    for (int q = 0; q < 8; ++q) g8[q] = ng[lane * 8 + q];
    for (int m = gw; m < MTOK; m += NGW) {
#pragma unroll
        for (int hh = 0; hh < 4; ++hh) { const int c = hh * 512 + lane * 8;
            const u32x4 wf = *(const u32x4*)(hb + (size_t)m * 2048 + c), wb = *(const u32x4*)(proj + (size_t)m * 6144 + c), wg = *(const u32x4*)(proj + (size_t)m * 6144 + 4096 + c);
            float o[8] = {bf_lo(wf.x) + bf_lo(wb.x), bf_hi(wf.x) + bf_hi(wb.x), bf_lo(wf.y) + bf_lo(wb.y), bf_hi(wf.y) + bf_hi(wb.y), bf_lo(wf.z) + bf_lo(wb.z), bf_hi(wf.z) + bf_hi(wb.z), bf_lo(wf.w) + bf_lo(wb.w), bf_hi(wf.w) + bf_hi(wb.w)};
            const float g[8] = {bf_lo(wg.x), bf_hi(wg.x), bf_lo(wg.y), bf_hi(wg.y), bf_lo(wg.z), bf_hi(wg.z), bf_lo(wg.w), bf_hi(wg.w)};
            float s = 0.f;
#pragma unroll
            for (int q = 0; q < 8; ++q) s += o[q] * o[q];
            const float rstd = __builtin_amdgcn_rsqf(wave_sum(s) * (1.f / 512.f) + NEPS);
#pragma unroll
            for (int q = 0; q < 8; ++q) o[q] = o[q] * rstd * g8[q] * silu_f(g[q]);
            u32x4 w; w.x = cvt_pk_bf16(o[0], o[1]); w.y = cvt_pk_bf16(o[2], o[3]); w.z = cvt_pk_bf16(o[4], o[5]); w.w = cvt_pk_bf16(o[6], o[7]);
            *(u32x4*)(hb + (size_t)m * 2048 + c) = w; }
    }
}

constexpr int LDS_BYTES = 160 * 1024;
static_assert(SC_END <= LDS_BYTES && (int)attn::SHM_ATTN <= LDS_BYTES && pg8::STAGE_BYTES <= LDS_BYTES, "LDS map");

#define GRID_SYNC() do { asm volatile("s_waitcnt vmcnt(0) lgkmcnt(0)" ::: "memory"); grid.sync(); __builtin_amdgcn_fence(__ATOMIC_ACQUIRE, "agent"); asm volatile("s_waitcnt vmcnt(0)" ::: "memory"); } while (0)
__global__ void __launch_bounds__(512, 2) fwd_megakernel(Args a) {
    extern __shared__ __attribute__((aligned(16))) unsigned char lds_raw[];
    LAS unsigned char* lds = (LAS unsigned char*)lds_raw;
    cg::grid_group grid = cg::this_grid();
    const int G = gridDim.x;
    float* mod = (float*)(a.ws + WS_MOD); float* rc = (float*)(a.ws + WS_ROPE); float* rs = rc + SEQ * 64;
    bf16_t* WB = (bf16_t*)(a.ws + WS_WB); bf16_t* WBG = (bf16_t*)(a.ws + WS_WB + 16 * MiB); bf16_t* WBO = (bf16_t*)(a.ws + WS_WB + 24 * MiB);
    bf16_t* HB = (bf16_t*)(a.ws + WS_HB); bf16_t* PROJ = (bf16_t*)(a.ws + WS_PROJ); bf16_t* YB = (bf16_t*)(a.ws + WS_QKK);

    phase_mod(a, lds, mod);
    __syncthreads();
    phase_rope_table(rc, rs);
    phase_weights(a, 0, lds);
    GRID_SYNC();

#ifndef NLAYERS
#define NLAYERS 4
#endif
    for (int L = 0; L < NLAYERS; ++L) {
        const int kind = L % 3, j = L / 3;
        const float* xin = (L == 0) ? a.x : a.out;
        const float* modL = mod + (size_t)L * 4 * 6144;
        if (L > 0) phase_weights(a, L, lds);
        phase_norm_mod(xin, modL, HB);
        GRID_SYNC();
        if (kind == 0) {
            { pg8::Gemm g{HB, WB, MTOK, 4096, 2048, 2048, 2048, 0}; pg8::StaticOrder S; S.init(MTOK, 4096, G, (int)blockIdx.x);
              pg8::EpiStore E{PROJ, 4096}; pg8::gemm_phase<pg8::EpiStore, pg8::StaticOrder>(lds, g, S, E); }
            GRID_SYNC();
            phase_pool(PROJ, HB);
            GRID_SYNC();
            { pg8::Gemm g{HB, WBG, MTOK, 2048, 512, 2048, 512, 1}; pg8::StaticOrder S; S.init(MTOK, 2048, G, (int)blockIdx.x);
              pg8::EpiPool E{YB, PROJ + 2048, 4096, a.pool_scale + (size_t)j * 2048}; pg8::gemm_phase<pg8::EpiPool, pg8::StaticOrder>(lds, g, S, E); }
            GRID_SYNC();
            { pg8::Gemm g{YB, WBO, MTOK, 2048, 2048, 2048, 2048, 0}; pg8::StaticOrder S; S.init(MTOK, 2048, G, (int)blockIdx.x);
              pg8::EpiRes E{xin, a.out, modL + 4096}; pg8::gemm_phase<pg8::EpiRes, pg8::StaticOrder>(lds, g, S, E); }
            GRID_SYNC();
        } else if (kind == 1) {
            phase_gla_lowrank(HB, (const bf16_t*)(a.ws + WS_W1T), (float*)(a.ws + WS_R));
            { pg8::Gemm g{HB, WB, MTOK, 6144, 2048, 2048, 2048, 0}; pg8::StaticOrder S; S.init(MTOK, 6144, G, (int)blockIdx.x);
              pg8::EpiStore E{PROJ, 6144}; pg8::gemm_phase<pg8::EpiStore, pg8::StaticOrder>(lds, g, S, E); }
            GRID_SYNC();
            phase_gla_prep(a, lds);
            GRID_SYNC();
            phase_gla_scan(a, lds);
            GRID_SYNC();
            phase_gla_post(HB, PROJ, a.gla_norm_g);
            GRID_SYNC();
            { pg8::Gemm g{HB, WBO, MTOK, 2048, 2048, 2048, 2048, 0}; pg8::StaticOrder S; S.init(MTOK, 2048, G, (int)blockIdx.x);
              pg8::EpiRes E{xin, a.out, modL + 4096}; pg8::gemm_phase<pg8::EpiRes, pg8::StaticOrder>(lds, g, S, E); }
            GRID_SYNC();
        } else {
            { pg8::Gemm g{HB, WB, MTOK, 5120, 2048, 2048, 2048, 0}; pg8::StaticOrder S; S.init(MTOK, 5120, G, (int)blockIdx.x);
              pg8::EpiStore E{PROJ, 5120}; pg8::gemm_phase<pg8::EpiStore, pg8::StaticOrder>(lds, g, S, E); }
            GRID_SYNC();
            phase_qknorm_rope(PROJ, a.attn_qg, a.attn_kg, rc, rs);
            GRID_SYNC();
            for (int u = blockIdx.x; u < 2048; u += G) {
                const int bk = u >> 7, b = bk >> 2, kvh = bk & 3, hq = kvh * 4 + ((u >> 5) & 3), qb = u & 31;
                const size_t row0 = (size_t)b * SEQ + qb * 256;
                attn::attn_dense_body<attn::bf16>((const attn::bf16*)(PROJ + row0 * 5120 + hq * 128), (const attn::bf16*)(PROJ + (size_t)b * SEQ * 5120 + 2048 + kvh * 128),
                    (const attn::bf16*)(PROJ + (size_t)b * SEQ * 5120 + 2560 + kvh * 128), PROJ + row0 * 5120 + 3072 + hq * 128, YB + row0 * 2048 + hq * 128, SEQ, (char*)lds_raw);
                __syncthreads();
            }
            GRID_SYNC();
            { pg8::Gemm g{YB, WBO, MTOK, 2048, 2048, 2048, 2048, 0}; pg8::StaticOrder S; S.init(MTOK, 2048, G, (int)blockIdx.x);
              pg8::EpiRes E{xin, a.out, modL + 4096}; pg8::gemm_phase<pg8::EpiRes, pg8::StaticOrder>(lds, g, S, E); }
            GRID_SYNC();
        }
    }
    phase_final_norm(a.out, a.final_g);
}

extern "C" void kernel_launch(void* const* d_in, const int* in_sizes, int n_in, void* d_out, int out_size, void* d_ws, size_t ws_size, hipStream_t stream) {
    static int grid = 0;
    if (grid == 0) {
        if (n_in != 22 || in_sizes[0] != MTOK * DM || out_size != MTOK * DM || ws_size < WS_END) {
            fprintf(stderr, "kernel_launch: unexpected shapes: n_in %d in0 %d out %d ws %zu (need %zu)\n", n_in, n_in > 0 ? in_sizes[0] : -1, out_size, ws_size, (size_t)WS_END); grid = -1; return; }
        int dev = 0, cus = 0, per_cu = 0;
        hipGetDevice(&dev); hipDeviceGetAttribute(&cus, hipDeviceAttributeMultiprocessorCount, dev);
        if (hipFuncSetAttribute((const void*)fwd_megakernel, hipFuncAttributeMaxDynamicSharedMemorySize, LDS_BYTES) != hipSuccess) { fprintf(stderr, "kernel_launch: hipFuncSetAttribute failed\n"); grid = -1; return; }
        if (hipOccupancyMaxActiveBlocksPerMultiprocessor(&per_cu, (const void*)fwd_megakernel, 512, LDS_BYTES) != hipSuccess || per_cu < 1) { fprintf(stderr, "kernel_launch: occupancy query gave %d\n", per_cu); per_cu = 1; }
        (void)hipGetLastError();
        grid = cus;
        fprintf(stderr, "kernel_launch: cus %d per_cu %d grid %d\n", cus, per_cu, grid);
    }
    if (grid < 0) return;
    Args a{};
    const float** p = (const float**)&a;
    for (int i = 0; i < 22; ++i) p[i] = (const float*)d_in[i];
    a.out = (float*)d_out; a.ws = (unsigned char*)d_ws;
    void* args[] = {&a};
    hipError_t e = hipLaunchCooperativeKernel((const void*)fwd_megakernel, dim3(grid), dim3(512), args, LDS_BYTES, stream);
    if (e != hipSuccess) fprintf(stderr, "kernel_launch: cooperative launch failed: %s (grid %d)\n", hipGetErrorString(e), grid);
}
```

```cpp
#include <hip/hip_runtime.h>
#include <hip/hip_bf16.h>
#include <hip/hip_cooperative_groups.h>
#include <cstdio>
#include <cstdint>
#include <cmath>
namespace cg = cooperative_groups;

constexpr int NB = 4, SEQ = 8192, DM = 2048, MTOK = NB * SEQ;
constexpr float NEPS = 1e-6f;
constexpr size_t MiB = (size_t)1 << 20;
constexpr size_t WS_MOD = 0;
constexpr size_t WS_ROPE = 1 * MiB;
constexpr size_t WS_R = 5 * MiB;
constexpr size_t WS_DL = 9 * MiB;
constexpr size_t WS_W1T = 13 * MiB;
constexpr size_t WS_BAR = 15 * MiB;
constexpr size_t WS_WB = 16 * MiB;
constexpr size_t WS_HB = 52 * MiB;
constexpr size_t WS_PROJ = 180 * MiB;
constexpr size_t WS_QKK = 564 * MiB;
constexpr size_t WS_END = 948 * MiB;

typedef unsigned short bf16_t;
typedef short bf16x8 __attribute__((ext_vector_type(8)));
typedef float f32x4 __attribute__((ext_vector_type(4)));
typedef unsigned u32x4 __attribute__((ext_vector_type(4)));
typedef unsigned u32x2 __attribute__((ext_vector_type(2)));
#define LAS __attribute__((address_space(3)))

typedef float f32x2 __attribute__((ext_vector_type(2)));
typedef __bf16 bf16x2_t __attribute__((ext_vector_type(2)));
__device__ __forceinline__ unsigned cvt_pk_bf16(float lo, float hi) { f32x2 v = {lo, hi}; bf16x2_t b = __builtin_convertvector(v, bf16x2_t); return __builtin_bit_cast(unsigned, b); }
__device__ __forceinline__ float bf_lo(unsigned w) { return __uint_as_float(w << 16); }
__device__ __forceinline__ float bf_hi(unsigned w) { return __uint_as_float(w & 0xffff0000u); }
__device__ __forceinline__ float bf2f(bf16_t b) { return __uint_as_float(((unsigned)b) << 16); }
__device__ __forceinline__ bf16_t f2bf(float f) { unsigned u = __float_as_uint(f); u += 0x7fffu + ((u >> 16) & 1u); return (bf16_t)(u >> 16); }
__device__ __forceinline__ float silu_f(float v) { return v * __builtin_amdgcn_rcpf(1.f + __builtin_amdgcn_exp2f(-1.4426950408889634f * v)); }
__device__ __forceinline__ float wave_sum(float v) {
#pragma unroll
    for (int o = 1; o < 64; o <<= 1) v += __shfl_xor(v, o);
    return v;
}
__device__ __forceinline__ int opaque_tid() { int t; asm volatile("v_mov_b32 %0, %1" : "=v"(t) : "v"((int)threadIdx.x)); return t; }

namespace pg8 {
#define PG8_LAS __attribute__((address_space(3)))
constexpr int BM = 256, BK = 64, HALF = 128, HTB = HALF * BK * 2  , STAGE_BYTES = 8 * HTB, NXCD = 8, WGM = 8;
__host__ __device__ __forceinline__ int lds_byte(int r, int c) { const int st = (r >> 4) * 2 + (c >> 5), rr = r & 15, cc = c & 31, ob = rr * 64 + cc * 2; return st * 1024 + (ob ^ (((ob >> 9) & 1) << 5)); }
__host__ __device__ __forceinline__ void stage_rc(int b, int& R, int& C) { const int st = b / 1024, sb = b % 1024, swz = sb ^ (((sb >> 9) & 1) << 5); R = (st >> 1) * 16 + swz / 64; C = (st & 1) * 32 + (swz % 64) / 2; }
__host__ __device__ __forceinline__ int perm32(int rho) { const int n = rho >> 4, i = rho & 15; return 8 * (i >> 2) + 4 * n + (i & 3); }
struct Unit { int pm, pn; };
struct Gemm { const bf16_t* A; const bf16_t* Bt; int M, N, K, lda, ldb, grp;
    __device__ __forceinline__ const char* aptr(const Unit& u) const { return (const char*)(A + (size_t)u.pm * BM * lda + (grp ? (size_t)(u.pn >> 1) * K : (size_t)0)); }
    __device__ __forceinline__ const char* bptr(const Unit& u) const { return (const char*)(Bt + (size_t)u.pn * BM * ldb); } };
struct StaticOrder {
    int nM, nN, nwg, G, c;
    __host__ __device__ void init(int M, int N, int G_, int c_) { nM = M / BM; nN = N / BM; nwg = nM * nN; G = G_; c = c_; }
    __host__ __device__ bool next(int i, Unit& u) const {
        const long L = (long)i * G + c; if (L >= nwg) return false;
        int wgid = (int)L; { const int q = nwg / NXCD, r = nwg % NXCD, xcd = wgid % NXCD, off = wgid / NXCD; wgid = (xcd < r ? xcd * (q + 1) : r * (q + 1) + (xcd - r) * q) + off; }
        const int nig = WGM * nN, gid = wgid / nig, fm = gid * WGM, gsz = (nM - fm) < WGM ? (nM - fm) : WGM;
        u.pm = fm + ((wgid % nig) % gsz); u.pn = (wgid % nig) / gsz; return true;
    }
    __device__ __forceinline__ void a_ready(const Unit&) const {}
    __device__ __forceinline__ void done(const Unit&) const {}
};
struct EpiStore {
    static constexpr bool PERM = true, AFTER_DRAIN = false;
    bf16_t* O; int ldc;
    __device__ __forceinline__ void operator()(const f32x4 (&acc)[2][2][4][2], const Unit& u, int wr, int wc, int fr, int fq) const {
        const int row0 = u.pm * BM + wr * 64 + fr, col0 = u.pn * BM + wc * 32 + 8 * fq;
#pragma unroll
        for (int ai = 0; ai < 2; ++ai)
#pragma unroll
            for (int m = 0; m < 4; ++m) { bf16_t* rowp = O + (size_t)(row0 + ai * HALF + m * 16) * ldc + col0;
#pragma unroll
                for (int bj = 0; bj < 2; ++bj) { const f32x4 v0 = acc[ai][bj][m][0], v1 = acc[ai][bj][m][1];
                    u32x4 w; w.x = cvt_pk_bf16(v0[0], v0[1]); w.y = cvt_pk_bf16(v0[2], v0[3]); w.z = cvt_pk_bf16(v1[0], v1[1]); w.w = cvt_pk_bf16(v1[2], v1[3]);
                    *(u32x4*)(rowp + bj * HALF) = w; } }
    }
};
struct EpiPool {
    static constexpr bool PERM = true, AFTER_DRAIN = false;
    bf16_t* O; const bf16_t* G; int ldg; const float* scale;
    __device__ __forceinline__ void operator()(const f32x4 (&acc)[2][2][4][2], const Unit& u, int wr, int wc, int fr, int fq) const {
        const int row0 = u.pm * BM + wr * 64 + fr, col0 = u.pn * BM + wc * 32 + 8 * fq;
        f32x4 sv[2][2];
#pragma unroll
        for (int bj = 0; bj < 2; ++bj)
#pragma unroll
            for (int n = 0; n < 2; ++n) sv[bj][n] = *(const f32x4*)(scale + col0 + bj * HALF + 4 * n);
#pragma unroll
        for (int ai = 0; ai < 2; ++ai)
#pragma unroll
            for (int m = 0; m < 4; ++m) { const size_t row = (size_t)(row0 + ai * HALF + m * 16);
#pragma unroll
                for (int bj = 0; bj < 2; ++bj) { const u32x4 gw = *(const u32x4*)(G + row * ldg + col0 + bj * HALF);
                    const f32x4 v0 = acc[ai][bj][m][0] * sv[bj][0], v1 = acc[ai][bj][m][1] * sv[bj][1];
                    u32x4 w;
                    w.x = cvt_pk_bf16(v0[0] * silu_f(bf_lo(gw.x)), v0[1] * silu_f(bf_hi(gw.x))); w.y = cvt_pk_bf16(v0[2] * silu_f(bf_lo(gw.y)), v0[3] * silu_f(bf_hi(gw.y)));
                    w.z = cvt_pk_bf16(v1[0] * silu_f(bf_lo(gw.z)), v1[1] * silu_f(bf_hi(gw.z))); w.w = cvt_pk_bf16(v1[2] * silu_f(bf_lo(gw.w)), v1[3] * silu_f(bf_hi(gw.w)));
                    *(u32x4*)(O + row * 2048 + col0 + bj * HALF) = w; } }
    }
};
struct EpiRes {
    static constexpr bool PERM = false, AFTER_DRAIN = false;
    const float* xi; float* xo; const float* gate;
    __device__ __forceinline__ void operator()(const f32x4 (&acc)[2][2][4][2], const Unit& u, int wr, int wc, int fr, int fq) const {
        const int row0 = u.pm * BM + wr * 64 + fr, col0 = u.pn * BM + wc * 32 + 4 * fq;
        const float* gp = gate + (size_t)((u.pm * BM) / SEQ) * 6144 + col0;
        f32x4 gv[2][2];
#pragma unroll
        for (int bj = 0; bj < 2; ++bj)
#pragma unroll
            for (int n = 0; n < 2; ++n) gv[bj][n] = *(const f32x4*)(gp + bj * HALF + n * 16);
#pragma unroll
        for (int ai = 0; ai < 2; ++ai)
#pragma unroll
            for (int m = 0; m < 4; ++m) { const size_t off = (size_t)(row0 + ai * HALF + m * 16) * 2048 + col0;
#pragma unroll
                for (int bj = 0; bj < 2; ++bj)
#pragma unroll
                    for (int n = 0; n < 2; ++n) { const f32x4 xv = *(const f32x4*)(xi + off + bj * HALF + n * 16);
                        *(f32x4*)(xo + off + bj * HALF + n * 16) = xv + gv[bj][n] * acc[ai][bj][m][n]; }
                asm volatile("" ::: "memory"); }
    }
};
template <class Epi, class Sched>
__device__ __forceinline__ void gemm_phase(PG8_LAS unsigned char* lds, const Gemm g, const Sched& S, const Epi& E) {
    const int tid = opaque_tid(), wid = __builtin_amdgcn_readfirstlane(tid >> 6), lane = tid & 63, wr = wid >> 2, wc = wid & 3, fr = lane & 15, fq = lane >> 4;
    const int K = g.K, nt = K / BK;
    unsigned voffA[2], voffB[2];
#pragma unroll
    for (int i = 0; i < 2; ++i) { int R, C; stage_rc(tid * 16 + i * 8192, R, C); const int Rb = Epi::PERM ? ((R & ~31) + perm32(R & 31)) : R;
        voffA[i] = (unsigned)(R * g.lda + C) * 2u; voffB[i] = (unsigned)(Rb * g.ldb + C) * 2u; }
    const size_t kstep = (size_t)(BK * 2);
    const size_t hstepA = (size_t)HALF * g.lda * 2, hstepB = (size_t)HALF * g.ldb * 2;
    const unsigned ldsw = (unsigned)wid * 1024u;
    const int aoff = lds_byte(wr * 64 + fr, fq * 8), boff = lds_byte(wc * 32 + fr, fq * 8);
#define PG8_SA(b, h) (((b) * 2 + (h)) * HTB)
#define PG8_SB(b, h) ((4 + (b) * 2 + (h)) * HTB)
#define PG8_STAGE(bufoff, gbase, voff) do { _Pragma("unroll") for (int _i = 0; _i < 2; ++_i) \
        __builtin_amdgcn_global_load_lds((const unsigned*)((const char*)(gbase) + (voff)[_i]), (PG8_LAS unsigned*)(lds + (bufoff) + ldsw + _i * 8192), 16, 0, 0); } while (0)
#define PG8_LDA(dst, b, h) do { _Pragma("unroll") for (int m = 0; m < 4; ++m) _Pragma("unroll") for (int k = 0; k < 2; ++k) dst[m][k] = *(const PG8_LAS bf16x8*)(lds + PG8_SA(b, h) + aoff + m * 2048 + k * 1024); } while (0)
#define PG8_LDB(dst, b, h) do { _Pragma("unroll") for (int n = 0; n < 2; ++n) _Pragma("unroll") for (int k = 0; k < 2; ++k) dst[n][k] = *(const PG8_LAS bf16x8*)(lds + PG8_SB(b, h) + boff + n * 2048 + k * 1024); } while (0)
#define PG8_MMA(ai, bj, At, Bt) do { __builtin_amdgcn_s_setprio(1); _Pragma("unroll") for (int m = 0; m < 4; ++m) _Pragma("unroll") for (int n = 0; n < 2; ++n) _Pragma("unroll") for (int k = 0; k < 2; ++k) \
        acc[ai][bj][m][n] = __builtin_amdgcn_mfma_f32_16x16x32_bf16(Bt[n][k], At[m][k], acc[ai][bj][m][n], 0, 0, 0); __builtin_amdgcn_s_setprio(0); } while (0)
#define PG8_WAIT_V(n) asm volatile("s_waitcnt vmcnt(" #n ")" ::: "memory")
#define PG8_WAIT_L(n) asm volatile("s_waitcnt lgkmcnt(" #n ")" ::: "memory")
#define PG8_BAR __builtin_amdgcn_s_barrier()
#define PG8_SCHED __builtin_amdgcn_sched_barrier(0)
    Unit cur, nxt; int ui = 0;
    if (!S.next(0, cur)) return;
    f32x4 acc[2][2][4][2];
#pragma unroll
    for (int a = 0; a < 2; ++a)
#pragma unroll
        for (int b = 0; b < 2; ++b)
#pragma unroll
            for (int m = 0; m < 4; ++m)
#pragma unroll
                for (int n = 0; n < 2; ++n) acc[a][b][m][n] = (f32x4){0.f, 0.f, 0.f, 0.f};
    bf16x8 At[4][2], B0[2][2], B1[2][2];
    const char* cA = g.aptr(cur); const char* cB = g.bptr(cur);
    S.a_ready(cur);
    PG8_STAGE(PG8_SB(0, 0), cB, voffB); PG8_STAGE(PG8_SA(0, 0), cA, voffA); PG8_STAGE(PG8_SB(0, 1), cB + hstepB, voffB); PG8_STAGE(PG8_SA(0, 1), cA + hstepA, voffA);
    if (wr == 1) PG8_BAR;
    PG8_WAIT_V(4); PG8_BAR;
    PG8_STAGE(PG8_SB(1, 0), cB + kstep, voffB); PG8_STAGE(PG8_SA(1, 0), cA + kstep, voffA); PG8_STAGE(PG8_SB(1, 1), cB + hstepB + kstep, voffB);
    PG8_WAIT_V(6); PG8_BAR;
    for (;;) {
        const bool has_next = S.next(ui + 1, nxt);
        const char* nA = has_next ? g.aptr(nxt) : cA; const char* nB = has_next ? g.bptr(nxt) : cB;
        for (int t = 0; t < nt; t += 2) {
            const bool last = (t == nt - 2);
            const char* a1 = cA + (size_t)(t + 1) * kstep;
            const char* a2 = last ? nA : cA + (size_t)(t + 2) * kstep; const char* b2 = last ? nB : cB + (size_t)(t + 2) * kstep;
            const char* a3 = a2 + kstep; const char* b3 = b2 + kstep;
            if (last && has_next) S.a_ready(nxt);
            PG8_LDB(B0, 0, 0); PG8_SCHED; PG8_LDA(At, 0, 0); PG8_STAGE(PG8_SA(1, 1), a1 + hstepA, voffA);
            PG8_WAIT_L(8); PG8_BAR; PG8_WAIT_L(0); PG8_MMA(0, 0, At, B0); PG8_BAR; PG8_SCHED;
            PG8_LDB(B1, 0, 1); PG8_STAGE(PG8_SB(0, 0), b2, voffB);
            PG8_BAR; PG8_WAIT_L(0); PG8_MMA(0, 1, At, B1); PG8_BAR;
            PG8_LDA(At, 0, 1); PG8_STAGE(PG8_SA(0, 0), a2, voffA);
            PG8_BAR; PG8_WAIT_L(0); PG8_MMA(1, 0, At, B0); PG8_BAR; PG8_SCHED;
            PG8_STAGE(PG8_SB(0, 1), b2 + hstepB, voffB);
            PG8_WAIT_V(6); PG8_BAR; PG8_MMA(1, 1, At, B1); PG8_BAR;
            PG8_LDB(B0, 1, 0); PG8_SCHED; PG8_LDA(At, 1, 0); PG8_STAGE(PG8_SA(0, 1), a2 + hstepA, voffA);
            PG8_WAIT_L(8); PG8_BAR; PG8_WAIT_L(0); PG8_MMA(0, 0, At, B0); PG8_BAR; PG8_SCHED;
            PG8_LDB(B1, 1, 1); PG8_STAGE(PG8_SB(1, 0), b3, voffB);
            PG8_BAR; PG8_WAIT_L(0); PG8_MMA(0, 1, At, B1); PG8_BAR;
            PG8_LDA(At, 1, 1); PG8_STAGE(PG8_SA(1, 0), a3, voffA);
            PG8_BAR; PG8_WAIT_L(0); PG8_MMA(1, 0, At, B0); PG8_BAR; PG8_SCHED;
            PG8_STAGE(PG8_SB(1, 1), b3 + hstepB, voffB);
            PG8_WAIT_V(6); PG8_BAR; PG8_MMA(1, 1, At, B1); PG8_BAR;
        }
            if constexpr (!Epi::AFTER_DRAIN) { E(acc, cur, wr, wc, fr, fq); S.done(cur); }
            if (!has_next) break;
#pragma unroll
        for (int a = 0; a < 2; ++a)
#pragma unroll
            for (int b = 0; b < 2; ++b)
#pragma unroll
                for (int m = 0; m < 4; ++m)
#pragma unroll
                    for (int n = 0; n < 2; ++n) acc[a][b][m][n] = (f32x4){0.f, 0.f, 0.f, 0.f};
        cur = nxt; cA = nA; cB = nB; ++ui;
    }
    PG8_WAIT_V(0);
    if (wr == 0) PG8_BAR;
    PG8_BAR;
    if constexpr (Epi::AFTER_DRAIN) { E.fused(acc, cur, wr, wc, fr, fq, lds, wid, lane); S.done(cur); }
#undef PG8_SA
#undef PG8_SB
#undef PG8_STAGE
#undef PG8_LDA
#undef PG8_LDB
#undef PG8_MMA
#undef PG8_WAIT_V
#undef PG8_WAIT_L
#undef PG8_BAR
#undef PG8_SCHED
}
}


namespace attn {
using bf16 = __hip_bfloat16;
constexpr int   D = 128, NW = 8, QBLK = 32, KVBLK = 64;
constexpr float SCALE = 0.088388347648318440f;
constexpr float THR = 8.f;
constexpr int SDEPTH = 1;
constexpr int LDQ = 5120, LDK = 5120, LDO = 2048;
constexpr size_t SHM_V = KVBLK * D * 2, SHM_K = KVBLK * D * 2, SHM_ATTN = 2 * SHM_V + 2 * SHM_K + NW * 64 * 4;
using bf16x8 = __attribute__((ext_vector_type(8))) short;
using s16x4  = __attribute__((ext_vector_type(4))) short;
using f32x16 = __attribute__((ext_vector_type(16))) float;
using f32x8  = __attribute__((ext_vector_type(8))) float;
using u32x4  = __attribute__((ext_vector_type(4))) unsigned;
#define KSWZ(row, colB) ((row) * 256 + ((colB) ^ (((row) & 7) << 4)))
#define SBAR() __builtin_amdgcn_sched_barrier(0)
__device__ __forceinline__ int crow(int r, int hi) { return (r & 3) + 8 * (r >> 2) + 4 * hi; }
__device__ __forceinline__ unsigned cvtpk(float lo, float hi) {
  unsigned r; asm volatile("v_cvt_pk_bf16_f32 %0, %1, %2" : "=v"(r) : "v"(lo), "v"(hi)); return r;
}
template <typename TIn> struct Stage;
template <> struct Stage<bf16>  { using T = bf16x8;
  __device__ static __forceinline__ T ld8(const bf16* p) { return *reinterpret_cast<const bf16x8*>(p); }
  __device__ static __forceinline__ bf16x8 tobf(T x) { return x; } };
template <> struct Stage<float> { using T = f32x8;
  __device__ static __forceinline__ T ld8(const float* p) { return *reinterpret_cast<const f32x8*>(p); }
  __device__ static __forceinline__ bf16x8 tobf(T x) {
    u32x4 w = {cvtpk(x[0], x[1]), cvtpk(x[2], x[3]), cvtpk(x[4], x[5]), cvtpk(x[6], x[7])}; return *reinterpret_cast<bf16x8*>(&w); } };

__device__ __forceinline__ void partialSM(f32x16& p0, f32x16& p1, float& m_reg, float& mn, float& alpha) {
  constexpr float C = SCALE * 1.4426950408889634f;
  float pmax = p0[0]; for (int r = 1; r < 16; ++r) pmax = fmaxf(pmax, p0[r]); for (int r = 0; r < 16; ++r) pmax = fmaxf(pmax, p1[r]);
  { auto rr = __builtin_amdgcn_permlane32_swap(__float_as_uint(pmax), __float_as_uint(pmax), false, false);
    pmax = fmaxf(__uint_as_float(rr[0]), __uint_as_float(rr[1])); }
  if (__builtin_expect(__all(pmax - m_reg <= THR / SCALE), 1)) { mn = m_reg; alpha = 1.f; }
  else { mn = fmaxf(m_reg, pmax); alpha = __builtin_amdgcn_exp2f((m_reg - mn) * C); m_reg = mn; }
  float mnC = -mn * C;
  for (int r = 0; r < 16; ++r) p0[r] = fmaf(p0[r], C, mnC); for (int r = 0; r < 16; ++r) p1[r] = fmaf(p1[r], C, mnC);
  for (int r = 0; r < 16; ++r) p0[r] = __builtin_amdgcn_exp2f(p0[r]);
}
__device__ __forceinline__ void finishSM(f32x16& p0, f32x16& p1, float alpha, float& l_reg, bf16x8& pa0, bf16x8& pa1, bf16x8& pa2, bf16x8& pa3) {
  for (int r = 0; r < 16; ++r) p1[r] = __builtin_amdgcn_exp2f(p1[r]);
  float ps = 0; for (int r = 0; r < 16; ++r) ps += p0[r]; for (int r = 0; r < 16; ++r) ps += p1[r];
  { auto rr = __builtin_amdgcn_permlane32_swap(__float_as_uint(ps), __float_as_uint(ps), false, false);
    ps = __uint_as_float(rr[0]) + __uint_as_float(rr[1]); }
  l_reg = l_reg * alpha + ps;
#define PK4(P, BASE, OUT) do { unsigned a0 = cvtpk(P[BASE + 0], P[BASE + 1]), a1 = cvtpk(P[BASE + 2], P[BASE + 3]);   \
    unsigned b0 = cvtpk(P[BASE + 4], P[BASE + 5]), b1 = cvtpk(P[BASE + 6], P[BASE + 7]);                              \
    auto r0 = __builtin_amdgcn_permlane32_swap(a0, b0, false, false); auto r1 = __builtin_amdgcn_permlane32_swap(a1, b1, false, false); \
    u32x4 w = {r0[0], r1[0], r0[1], r1[1]}; OUT = *reinterpret_cast<bf16x8*>(&w); } while (0)
  PK4(p0, 0, pa0); PK4(p0, 8, pa1); PK4(p1, 0, pa2); PK4(p1, 8, pa3);
#undef PK4
}
__device__ __forceinline__ void qkt(f32x16& p0, f32x16& p1, const bf16* Ks, const bf16x8* qr, int r32, int hi) {
  p0 = f32x16{}; p1 = f32x16{};
  for (int d0 = 0; d0 < 8; ++d0) { int cb = (d0 * 16 + hi * 8) * 2;
    bf16x8 b0 = *reinterpret_cast<const bf16x8*>((const char*)Ks + KSWZ(r32, cb));
    bf16x8 b1 = *reinterpret_cast<const bf16x8*>((const char*)Ks + KSWZ(32 + r32, cb));
    p0 = __builtin_amdgcn_mfma_f32_32x32x16_bf16(b0, qr[d0], p0, 0, 0, 0);
    p1 = __builtin_amdgcn_mfma_f32_32x32x16_bf16(b1, qr[d0], p1, 0, 0, 0); }
}
__device__ __forceinline__ int v_st(int k, int c) { const int kk = (k & ~0xC) | ((k & 4) << 1) | ((k & 8) >> 1); return ((kk >> 3) * 4 + (c >> 5)) * 512 + ((kk & 7) * 32 + (c & 31)) * 2; }
__device__ __forceinline__ int v_rd_base(int lane) { return ((lane & 3) << 3) | (((lane >> 2) & 3) << 6) | (((lane >> 4) & 1) << 5) | (((lane >> 5) & 1) << 8); }
constexpr int v_rd_off(int d0, int ks, int half) { return d0 * 512 + ks * 4096 + half * 2048; }
template <int OFF> __device__ __forceinline__ s16x4 tr_read(int vb) {
  s16x4 r; asm volatile("ds_read_b64_tr_b16 %0, %1 offset:%2" : "=&v"(r) : "v"(vb), "i"(OFF) : "memory"); return r;
}
template <int D0> __device__ __forceinline__ void pv_one(f32x16& od, int vb, bf16x8 pa0, bf16x8 pa1, bf16x8 pa2, bf16x8 pa3) {
  const s16x4 l0 = tr_read<v_rd_off(D0, 0, 0)>(vb), h0 = tr_read<v_rd_off(D0, 0, 1)>(vb), l1 = tr_read<v_rd_off(D0, 1, 0)>(vb), h1 = tr_read<v_rd_off(D0, 1, 1)>(vb);
  const s16x4 l2 = tr_read<v_rd_off(D0, 2, 0)>(vb), h2 = tr_read<v_rd_off(D0, 2, 1)>(vb), l3 = tr_read<v_rd_off(D0, 3, 0)>(vb), h3 = tr_read<v_rd_off(D0, 3, 1)>(vb);
  asm volatile("s_waitcnt lgkmcnt(0)" ::: "memory"); SBAR();
#define PK(L, H) (bf16x8){L[0], L[1], L[2], L[3], H[0], H[1], H[2], H[3]}
  od = __builtin_amdgcn_mfma_f32_32x32x16_bf16(pa0, PK(l0, h0), od, 0, 0, 0);
  od = __builtin_amdgcn_mfma_f32_32x32x16_bf16(pa1, PK(l1, h1), od, 0, 0, 0);
  od = __builtin_amdgcn_mfma_f32_32x32x16_bf16(pa2, PK(l2, h2), od, 0, 0, 0);
  od = __builtin_amdgcn_mfma_f32_32x32x16_bf16(pa3, PK(l3, h3), od, 0, 0, 0);
#undef PK
}
__device__ __forceinline__ void pv_d0(f32x16* o, int vb, bf16x8 pa0, bf16x8 pa1, bf16x8 pa2, bf16x8 pa3) {
  pv_one<0>(o[0], vb, pa0, pa1, pa2, pa3); pv_one<1>(o[1], vb, pa0, pa1, pa2, pa3); pv_one<2>(o[2], vb, pa0, pa1, pa2, pa3); pv_one<3>(o[3], vb, pa0, pa1, pa2, pa3);
}

template <typename TQ>
__device__ __forceinline__ void attn_dense_body(const TQ* __restrict__ Qb, const bf16* __restrict__ Kh, const bf16* __restrict__ Vh,
                                                const unsigned short* __restrict__ Gb, unsigned short* __restrict__ Ob, int seq, char* lds) {
  using St = Stage<bf16>; using SQ = Stage<TQ>;
  const int tid = opaque_tid(), wid = tid >> 6, lane = tid & 63, r32 = lane & 31, hi = lane >> 5;
  bf16* V_lds = (bf16*)lds; bf16* K_lds = (bf16*)(lds + 2 * SHM_V);
  float* ws = (float*)(lds + 2 * SHM_V + 2 * SHM_K) + wid * 64; float* li_l = ws; float* al_l = ws + 32;
  float m_reg = -1e30f, l_reg = 0; f32x16 o[4] = {}; bf16x8 qr[8];
  const TQ* Qw = Qb + (long)(wid * QBLK + r32) * LDQ + hi * 8;
#pragma unroll
  for (int d0 = 0; d0 < 8; ++d0) qr[d0] = SQ::tobf(SQ::ld8(Qw + d0 * 16));
  const int sr = tid >> 4, sc = (tid & 15) * 8, vst0 = v_st(sr, sc), vst1 = v_st(32 + sr, sc);
  const int vb0 = (int)(uintptr_t)V_lds + v_rd_base(lane);
  struct { typename St::T vs0, vs1, ks0, ks1; } sr_[SDEPTH];
#define SLOAD(i, k0) do { sr_[i].vs0 = St::ld8(&Vh[(long)((k0) + sr) * LDK + sc]); sr_[i].vs1 = St::ld8(&Vh[(long)((k0) + 32 + sr) * LDK + sc]); \
    sr_[i].ks0 = St::ld8(&Kh[(long)((k0) + sr) * LDK + sc]); sr_[i].ks1 = St::ld8(&Kh[(long)((k0) + 32 + sr) * LDK + sc]); } while (0)
#define SWRITE(b, i) do { *(bf16x8*)((char*)V_lds + (b) * SHM_V + vst0) = St::tobf(sr_[i].vs0);          \
    *(bf16x8*)((char*)V_lds + (b) * SHM_V + vst1) = St::tobf(sr_[i].vs1); int kc = sc * 2;               \
    *(bf16x8*)((char*)K_lds + (b) * SHM_K + KSWZ(sr, kc)) = St::tobf(sr_[i].ks0);                       \
    *(bf16x8*)((char*)K_lds + (b) * SHM_K + KSWZ(32 + sr, kc)) = St::tobf(sr_[i].ks1); } while (0)
#define SWAIT() do { if constexpr (SDEPTH == 2) asm volatile("s_waitcnt vmcnt(4)" ::: "memory"); else asm volatile("s_waitcnt vmcnt(0)" ::: "memory"); } while (0)
#define RESC(a) do { if (__any((a) < 1.f)) { if (hi == 0) al_l[r32] = (a); asm volatile("s_waitcnt lgkmcnt(0)" ::: "memory"); \
    for (int d = 0; d < 4; ++d) for (int r = 0; r < 16; ++r) o[d][r] *= al_l[crow(r, hi)]; } } while (0)
  f32x16 pA0, pA1, pB0, pB1; float mnA, mnB, alA, alB; bf16x8 pa0, pa1, pa2, pa3; const int NT = seq / KVBLK;
  constexpr int SE = 0, SO = SDEPTH - 1;
  SLOAD(SE, 0); asm volatile("s_waitcnt vmcnt(0)" ::: "memory"); SWRITE(0, SE); __syncthreads();
  qkt(pA0, pA1, K_lds, qr, r32, hi); partialSM(pA0, pA1, m_reg, mnA, alA);
  SLOAD(SO, KVBLK); if constexpr (SDEPTH == 2) { if (2 < NT) SLOAD(SE, 2 * KVBLK); }
  SWAIT(); SWRITE(1, SO); __syncthreads();
  for (int j = 1; j + 1 < NT; j += 2) {
    SBAR(); qkt(pB0, pB1, (bf16*)((char*)K_lds + SHM_K), qr, r32, hi);
    finishSM(pA0, pA1, alA, l_reg, pa0, pa1, pa2, pa3); SBAR();
    SLOAD(SO, (j + SDEPTH) * KVBLK); SBAR();
    pv_d0(o, vb0, pa0, pa1, pa2, pa3); partialSM(pB0, pB1, m_reg, mnB, alB);
    __syncthreads(); SWAIT(); SWRITE(0, SE);
    RESC(alB); __syncthreads();
    SBAR(); qkt(pA0, pA1, K_lds, qr, r32, hi);
    finishSM(pB0, pB1, alB, l_reg, pa0, pa1, pa2, pa3); SBAR();
    if (SDEPTH == 1 || j + 3 < NT) SLOAD(SE, (j + 1 + SDEPTH) * KVBLK); SBAR();
    pv_d0(o, vb0 + (int)SHM_V, pa0, pa1, pa2, pa3); partialSM(pA0, pA1, m_reg, mnA, alA);
    __syncthreads(); SWAIT(); SWRITE(1, SO);
    RESC(alA); __syncthreads();
  }
  SBAR(); qkt(pB0, pB1, (bf16*)((char*)K_lds + SHM_K), qr, r32, hi);
  finishSM(pA0, pA1, alA, l_reg, pa0, pa1, pa2, pa3); SBAR();
  pv_d0(o, vb0, pa0, pa1, pa2, pa3); partialSM(pB0, pB1, m_reg, mnB, alB);
  __syncthreads(); RESC(alB);
  finishSM(pB0, pB1, alB, l_reg, pa0, pa1, pa2, pa3); SBAR();
  pv_d0(o, vb0 + (int)SHM_V, pa0, pa1, pa2, pa3);
  if (hi == 0) li_l[r32] = l_reg; asm volatile("s_waitcnt lgkmcnt(0)" ::: "memory");
  float rli[16];
#pragma unroll
  for (int r = 0; r < 16; ++r) rli[r] = __builtin_amdgcn_rcpf(li_l[crow(r, hi)]);
  unsigned short* Ow = Ob + (long)(wid * QBLK) * LDO + r32; const unsigned short* Gw = Gb + (long)(wid * QBLK) * LDQ + r32;
#pragma unroll
  for (int r = 0; r < 16; ++r) { const int orow = crow(r, hi);
    const unsigned short* gp = Gw + (long)orow * LDQ; unsigned short* op = Ow + (long)orow * LDO;
    float gv[4];
#pragma unroll
    for (int d0 = 0; d0 < 4; ++d0) gv[d0] = __uint_as_float(((unsigned)gp[d0 * 32]) << 16);
#pragma unroll
    for (int d0 = 0; d0 < 4; ++d0) {
      const float sg = gv[d0] * __builtin_amdgcn_rcpf(1.f + __builtin_amdgcn_exp2f(-1.4426950408889634f * gv[d0]));
      const float val = o[d0][r] * rli[r] * sg; unsigned u = __float_as_uint(val); u += 0x7fffu + ((u >> 16) & 1u);
      op[d0 * 32] = (unsigned short)(u >> 16); }
    asm volatile("" ::: "memory"); }
#undef SLOAD
#undef SWRITE
#undef SWAIT
#undef RESC
}
}

struct Args {
    const float *x, *c, *w_mod, *b_mod, *pool_w_in, *pool_w_grp, *pool_scale, *pool_w_out;
    const float *gla_w_in, *gla_fwd_w1, *gla_fwd_w2, *gla_fwd_b, *gla_bwd_w1, *gla_bwd_w2, *gla_bwd_b, *gla_norm_g, *gla_w_out;
    const float *attn_w_in, *attn_qg, *attn_kg, *attn_w_out, *final_g;
    float* out; unsigned char* ws;
};
#define LDS_WAIT() asm volatile("s_waitcnt lgkmcnt(0)" ::: "memory")

__device__ __forceinline__ void transpose_item(const float* W, int K, int N, bf16_t* WT, int row_off, LAS float* scr, int item, int lane) {
    const int nblk = N / 32, kb = item / nblk, nb = item % nblk, k0 = 64 * kb, n0 = 32 * nb;
#pragma unroll 8
    for (int i = 0; i < 32; ++i) { const int kk = 2 * i + (lane >> 5); scr[kk * 33 + (lane & 31)] = W[(size_t)(k0 + kk) * N + n0 + (lane & 31)]; }
    LDS_WAIT();
    const int c = lane & 7;
#pragma unroll
    for (int j = 0; j < 4; ++j) { const int n = (lane >> 3) + 8 * j; const LAS float* s = scr + (8 * c) * 33 + n;
        u32x4 o; o.x = cvt_pk_bf16(s[0 * 33], s[1 * 33]); o.y = cvt_pk_bf16(s[2 * 33], s[3 * 33]); o.z = cvt_pk_bf16(s[4 * 33], s[5 * 33]); o.w = cvt_pk_bf16(s[6 * 33], s[7 * 33]);
        *(u32x4*)(WT + (size_t)(row_off + n0 + n) * K + k0 + 8 * c) = o; }
    LDS_WAIT();
}
__device__ __forceinline__ void phase_weights(const Args& a, int L, LAS unsigned char* lds) {
    const int tid_ = opaque_tid(), lane = tid_ & 63, wave = __builtin_amdgcn_readfirstlane(tid_ >> 6), gw = blockIdx.x * 8 + wave, NGW = gridDim.x * 8; (void)wave; (void)gw; (void)NGW; (void)lane;
    LAS float* scr = (LAS float*)(lds + wave * 8704);
    bf16_t* WB = (bf16_t*)(a.ws + WS_WB); bf16_t* WBG = (bf16_t*)(a.ws + WS_WB + 16 * MiB); bf16_t* WBO = (bf16_t*)(a.ws + WS_WB + 24 * MiB);
    const int kind = L % 3, j = L / 3;
    if (kind == 0) {
        const float* win = a.pool_w_in + (size_t)j * 2048 * 4096; const float* wgrp = a.pool_w_grp + (size_t)j * 4 * 512 * 512; const float* wout = a.pool_w_out + (size_t)j * 2048 * 2048;
        constexpr int I_IN = 32 * 128, I_G = 8 * 16, I_OUT = 32 * 64;
        for (int it = gw; it < I_IN + 4 * I_G + I_OUT; it += NGW) {
            int r = it;
            if (r < I_IN) { transpose_item(win, 2048, 4096, WB, 0, scr, r, lane); continue; } r -= I_IN;
            if (r < 4 * I_G) { const int g = r / I_G; transpose_item(wgrp + (size_t)g * 512 * 512, 512, 512, WBG, g * 512, scr, r % I_G, lane); continue; } r -= 4 * I_G;
            transpose_item(wout, 2048, 2048, WBO, 0, scr, r, lane);
        }
    } else if (kind == 1) {
        constexpr int I_IN = 32 * 192, I_OUT = 32 * 64;
        for (int it = gw; it < I_IN + I_OUT; it += NGW) {
            int r = it;
            if (r < I_IN) { transpose_item(a.gla_w_in, 2048, 6144, WB, 0, scr, r, lane); continue; } r -= I_IN;
            transpose_item(a.gla_w_out, 2048, 2048, WBO, 0, scr, r, lane);
        }
        bf16_t* W1T = (bf16_t*)(a.ws + WS_W1T);
        for (int i = gw * 64 + lane; i < 32 * 2048; i += NGW * 64) { const int n = i >> 11, k = i & 2047;
            W1T[i] = f2bf(n < 16 ? a.gla_fwd_w1[k * 16 + n] : a.gla_bwd_w1[k * 16 + n - 16]); }
    } else {
        constexpr int I_IN = 32 * 160, I_OUT = 32 * 64;
        for (int it = gw; it < I_IN + I_OUT; it += NGW) {
            int r = it;
            if (r < I_IN) { transpose_item(a.attn_w_in, 2048, 5120, WB, 0, scr, r, lane); continue; } r -= I_IN;
            transpose_item(a.attn_w_out, 2048, 2048, WBO, 0, scr, r, lane);
        }
    }
}
__device__ __forceinline__ void phase_norm_mod(const float* x, const float* modL, bf16_t* hb) {
    const int tid_ = opaque_tid(), lane = tid_ & 63, wave = __builtin_amdgcn_readfirstlane(tid_ >> 6), gw = blockIdx.x * 8 + wave, NGW = gridDim.x * 8; (void)wave; (void)gw; (void)NGW; (void)lane;
    for (int m = gw; m < MTOK; m += NGW) {
        const f32x4* xr = (const f32x4*)(x + (size_t)m * DM) + lane;
        f32x4 v[8]; float s = 0.f;
#pragma unroll
        for (int j = 0; j < 8; ++j) { v[j] = xr[64 * j]; s += (v[j].x * v[j].x + v[j].y * v[j].y) + (v[j].z * v[j].z + v[j].w * v[j].w); }
        const float rstd = __builtin_amdgcn_rsqf(wave_sum(s) * (1.f / DM) + NEPS);
        const float* mp = modL + (size_t)(m / SEQ) * 6144;
        u32x2* o8 = (u32x2*)(hb + (size_t)m * DM) + lane;
#pragma unroll
        for (int j = 0; j < 8; ++j) { const f32x4 sh = *((const f32x4*)mp + lane + 64 * j), sc = *((const f32x4*)(mp + 2048) + lane + 64 * j);
            const f32x4 h = v[j] * rstd * (sc + 1.f) + sh; u32x2 w; w.x = cvt_pk_bf16(h.x, h.y); w.y = cvt_pk_bf16(h.z, h.w); o8[64 * j] = w; }
    }
}
__device__ __forceinline__ void phase_final_norm(float* x, const float* g) {
    const int tid_ = opaque_tid(), lane = tid_ & 63, wave = __builtin_amdgcn_readfirstlane(tid_ >> 6), gw = blockIdx.x * 8 + wave, NGW = gridDim.x * 8; (void)wave; (void)gw; (void)NGW; (void)lane;
    for (int m = gw; m < MTOK; m += NGW) {
        f32x4* xr = (f32x4*)(x + (size_t)m * DM) + lane;
        f32x4 v[8]; float s = 0.f;
#pragma unroll
        for (int j = 0; j < 8; ++j) { v[j] = xr[64 * j]; s += (v[j].x * v[j].x + v[j].y * v[j].y) + (v[j].z * v[j].z + v[j].w * v[j].w); }
        const float rstd = __builtin_amdgcn_rsqf(wave_sum(s) * (1.f / DM) + NEPS);
#pragma unroll
        for (int j = 0; j < 8; ++j) { const f32x4 gg = *((const f32x4*)g + lane + 64 * j); xr[64 * j] = v[j] * rstd * gg; }
    }
}
__device__ __forceinline__ void phase_mod(const Args& a, LAS unsigned char* lds, float* mod) {
    LAS float* sc = (LAS float*)lds; LAS float* part = (LAS float*)(lds + 32768);
    const int tid = opaque_tid();
    if ((int)blockIdx.x >= 192) return;
    for (int i = tid; i < 8192; i += 512) sc[i] = silu_f(a.c[i]);
    __syncthreads();
    for (int item = blockIdx.x; item < 192; item += gridDim.x) {
        const int layer = item / 48, n0 = (item % 48) * 128, ks = tid >> 5, cq = tid & 31;
        f32x4 acc[4];
#pragma unroll
        for (int b = 0; b < 4; ++b) acc[b] = (f32x4){0.f, 0.f, 0.f, 0.f};
        const float* wp = a.w_mod + ((size_t)layer * 2048 + ks * 128) * 6144 + n0 + cq * 4;
#pragma unroll 8
        for (int k = 0; k < 128; ++k) { const f32x4 w = *(const f32x4*)(wp + (size_t)k * 6144); const int kk = ks * 128 + k;
#pragma unroll
            for (int b = 0; b < 4; ++b) acc[b] += w * sc[b * 2048 + kk]; }
#pragma unroll
        for (int b = 0; b < 4; ++b) *(LAS f32x4*)(part + (ks * 4 + b) * 128 + cq * 4) = acc[b];
        __syncthreads();
        { const int b = tid >> 7, col = tid & 127; float s = a.b_mod[layer * 6144 + n0 + col];
#pragma unroll
          for (int q = 0; q < 16; ++q) s += part[(q * 4 + b) * 128 + col];
          mod[(size_t)(layer * 4 + b) * 6144 + n0 + col] = s; }
        __syncthreads();
    }
}
__device__ __forceinline__ void phase_rope_table(float* rc, float* rs) {
    for (int idx = blockIdx.x * 512 + opaque_tid(); idx < SEQ * 64; idx += gridDim.x * 512) {
        const int t = idx >> 6, i = idx & 63;
        const float pos = (i < 32) ? (float)((t >> 6) - 64) : (float)((t & 63) - 32);
        const float inv = __builtin_amdgcn_exp2f(-(float)(i & 31) * 0.41524101186092029f);
        const float ang = pos * inv;
        const double xd = (double)ang; const double n = __builtin_rint(xd * 0.63661977236758134); const float rf = (float)(xd - n * 1.5707963267948966);
        const int q = ((int)n) & 3; const float r2 = rf * rf;
        const float sn = rf + rf * r2 * (-1.6666667e-1f + r2 * (8.3333333e-3f + r2 * (-1.9841270e-4f + r2 * 2.7557319e-6f)));
        const float cs = 1.f + r2 * (-0.5f + r2 * (4.1666667e-2f + r2 * (-1.3888889e-3f + r2 * (2.4801587e-5f + r2 * -2.7557319e-7f))));
        const float co = (q == 0) ? cs : (q == 1) ? -sn : (q == 2) ? -cs : sn;
        const float si = (q == 0) ? sn : (q == 1) ? cs : (q == 2) ? -sn : -cs;
        rc[idx] = co; rs[idx] = si;
    }
}
__device__ __forceinline__ void phase_pool(const bf16_t* proj  , bf16_t* pooled) {
    const int tid_ = opaque_tid(), lane = tid_ & 63, wave = __builtin_amdgcn_readfirstlane(tid_ >> 6), gw = blockIdx.x * 8 + wave, NGW = gridDim.x * 8; (void)wave; (void)gw; (void)NGW; (void)lane;
    for (int m = gw; m < MTOK; m += NGW) {
        const int t = m & (SEQ - 1); const bf16_t* base = proj + (size_t)(m - t) * 4096;
#pragma unroll
        for (int j = 0; j < 4; ++j) {
            const int half = 1 << j, lo = (t - half) > 0 ? (t - half) : 0, hi = (t + half) < SEQ ? (t + half) : SEQ, c = (j * 64 + lane) * 8;
            float s[8];
#pragma unroll
            for (int q = 0; q < 8; ++q) s[q] = 0.f;
            for (int r = lo; r < hi; ++r) { const u32x4 w = *(const u32x4*)(base + (size_t)r * 4096 + c);
                s[0] += bf_lo(w.x); s[1] += bf_hi(w.x); s[2] += bf_lo(w.y); s[3] += bf_hi(w.y); s[4] += bf_lo(w.z); s[5] += bf_hi(w.z); s[6] += bf_lo(w.w); s[7] += bf_hi(w.w); }
            const u32x4 u = *(const u32x4*)(base + (size_t)t * 4096 + c); const float ic = 1.f / (float)(hi - lo);
            u32x4 o; o.x = cvt_pk_bf16(s[0] * ic - bf_lo(u.x), s[1] * ic - bf_hi(u.x)); o.y = cvt_pk_bf16(s[2] * ic - bf_lo(u.y), s[3] * ic - bf_hi(u.y));
            o.z = cvt_pk_bf16(s[4] * ic - bf_lo(u.z), s[5] * ic - bf_hi(u.z)); o.w = cvt_pk_bf16(s[6] * ic - bf_lo(u.w), s[7] * ic - bf_hi(u.w));
            *(u32x4*)(pooled + (size_t)m * 2048 + c) = o;
        }
    }
}
__device__ __forceinline__ void phase_qknorm_rope(bf16_t* proj, const float* qg, const float* kg, const float* rc, const float* rs) {
    const int tid_ = opaque_tid(), lane = tid_ & 63, wave = __builtin_amdgcn_readfirstlane(tid_ >> 6), gw = blockIdx.x * 8 + wave, NGW = gridDim.x * 8; (void)wave; (void)gw; (void)NGW; (void)lane;
    const float q0 = qg[2 * lane], q1 = qg[2 * lane + 1], k0 = kg[2 * lane], k1 = kg[2 * lane + 1];
    for (int m = gw; m < MTOK; m += NGW) {
        const int t = m & (SEQ - 1); const float co = rc[t * 64 + lane], si = rs[t * 64 + lane];
        unsigned* row = (unsigned*)(proj + (size_t)m * 5120) + lane;
        unsigned w[20];
#pragma unroll
        for (int h = 0; h < 20; ++h) w[h] = row[h * 64];
#pragma unroll
        for (int h = 0; h < 20; ++h) {
            const float x0 = bf_lo(w[h]), x1 = bf_hi(w[h]);
            const float rstd = __builtin_amdgcn_rsqf(wave_sum(x0 * x0 + x1 * x1) * (1.f / 128.f) + NEPS);
            const float y0 = x0 * rstd * (h < 16 ? q0 : k0), y1 = x1 * rstd * (h < 16 ? q1 : k1);
            row[h * 64] = cvt_pk_bf16(y0 * co - y1 * si, y0 * si + y1 * co);
        }
    }
}

__device__ __forceinline__ f32x4 mfma16(bf16x8 x, bf16x8 y, f32x4 acc) { return __builtin_amdgcn_mfma_f32_16x16x32_bf16(x, y, acc, 0, 0, 0); }

__device__ __forceinline__ void phase_gla_lowrank(const bf16_t* hb, const bf16_t* w1t, float* R) {
    const int tid_ = opaque_tid(), lane = tid_ & 63, wave = __builtin_amdgcn_readfirstlane(tid_ >> 6), gw = blockIdx.x * 8 + wave, NGW = gridDim.x * 8; (void)wave; (void)gw; (void)NGW; (void)lane;
    const int fr = lane & 15, fq = lane >> 4;
    for (int u = gw; u < MTOK / 16; u += NGW) {
        const bf16_t* ap = hb + (size_t)(u * 16 + fr) * 2048 + fq * 8; const bf16_t* wp = w1t + (size_t)fr * 2048 + fq * 8;
        f32x4 acc0 = (f32x4){0.f, 0.f, 0.f, 0.f}, acc1 = acc0;
#pragma unroll 8
        for (int ks = 0; ks < 64; ++ks) { const bf16x8 av = *(const bf16x8*)(ap + ks * 32);
            acc0 = mfma16(*(const bf16x8*)(wp + ks * 32), av, acc0); acc1 = mfma16(*(const bf16x8*)(wp + 16 * 2048 + ks * 32), av, acc1); }
        float* rp = R + (size_t)(u * 16 + fr) * 32 + 4 * fq;
        *(f32x4*)rp = acc0; *(f32x4*)(rp + 16) = acc1;
    }
}
__device__ __forceinline__ void phase_gla_prep(const Args& a, LAS unsigned char* lds) {
    LAS float* rl = (LAS float*)lds;
    const int tid = opaque_tid(), dir = __builtin_amdgcn_readfirstlane(tid >> 8), d = tid & 255;
    const bf16_t* proj = (const bf16_t*)(a.ws + WS_PROJ); const float* R = (const float*)(a.ws + WS_R); float* DL = (float*)(a.ws + WS_DL);
    bf16_t* QT = (bf16_t*)(a.ws + WS_QKK) + (size_t)dir * MTOK * 1024; bf16_t* KT = (bf16_t*)(a.ws + WS_QKK + 128 * MiB) + (size_t)dir * MTOK * 1024;
    bf16_t* KH = (bf16_t*)(a.ws + WS_QKK + 256 * MiB);
    const float* w2 = dir ? a.gla_bwd_w2 : a.gla_fwd_w2; const float* bs = dir ? a.gla_bwd_b : a.gla_fwd_b;
    for (int u = blockIdx.x; u < 2048; u += gridDim.x) {
        const int b = u >> 9, cc = (u >> 2) & 127, h = u & 3, col = h * 256 + d; const size_t tok0 = (size_t)b * SEQ + cc * 64;
        *(LAS f32x4*)(rl + tid * 4) = *(const f32x4*)(R + tok0 * 32 + tid * 4);
        float w2c[16];
#pragma unroll
        for (int c = 0; c < 16; ++c) w2c[c] = w2[c * 1024 + col];
        const float bias = bs[col];
        __syncthreads();
        float bb[64]; float run = 0.f;
#pragma unroll
        for (int i = 0; i < 64; ++i) { const int t = dir ? 63 - i : i; float z = bias;
#pragma unroll
            for (int c4 = 0; c4 < 4; ++c4) { const f32x4 rv = *(const LAS f32x4*)(rl + t * 32 + dir * 16 + c4 * 4);
                z += rv.x * w2c[c4 * 4] + rv.y * w2c[c4 * 4 + 1] + rv.z * w2c[c4 * 4 + 2] + rv.w * w2c[c4 * 4 + 3]; }
            const float ls = fminf(z, 0.f) - __logf(1.f + __expf(-fabsf(z)));
            run += ls * 0.0625f; bb[i] = run; }
        const float blast = run;
        bf16_t* khp = KH + ((((size_t)dir * 4 + b) * 128 + cc) * 4 + h) * (256 * 64) + (size_t)d * 64;
#pragma unroll
        for (int gi = 0; gi < 8; ++gi) {
            float kh[8];
#pragma unroll
            for (int q = 0; q < 8; ++q) { const int i = gi * 8 + q, t = dir ? 63 - i : i;
                const float qv = bf2f(proj[(tok0 + t) * 6144 + col]), kv = bf2f(proj[(tok0 + t) * 6144 + 1024 + col]);
                QT[(tok0 + t) * 1024 + col] = f2bf(qv * 0.0625f * __expf(bb[i])); KT[(tok0 + t) * 1024 + col] = f2bf(kv * __expf(-bb[i]));
                kh[q] = kv * __expf(blast - bb[i]); }
            u32x4 o;
            if (dir) { o.x = cvt_pk_bf16(kh[7], kh[6]); o.y = cvt_pk_bf16(kh[5], kh[4]); o.z = cvt_pk_bf16(kh[3], kh[2]); o.w = cvt_pk_bf16(kh[1], kh[0]); }
            else     { o.x = cvt_pk_bf16(kh[0], kh[1]); o.y = cvt_pk_bf16(kh[2], kh[3]); o.z = cvt_pk_bf16(kh[4], kh[5]); o.w = cvt_pk_bf16(kh[6], kh[7]); }
            *(u32x4*)(khp + (dir ? 56 - gi * 8 : gi * 8)) = o;
        }
        DL[(((size_t)dir * 4 + b) * 128 + cc) * 1024 + col] = __expf(blast);
        __syncthreads();
    }
}
constexpr int SC_PQ = 528, SC_PS = 144;
constexpr int SC_QT = 0, SC_KT = SC_QT + 64 * SC_PQ, SC_KH = SC_KT + 64 * SC_PQ, SC_VT = SC_KH + 256 * SC_PS, SC_ST = SC_VT + 64 * SC_PS, SC_AM = SC_ST + 64 * SC_PQ, SC_DL = SC_AM + 64 * SC_PS, SC_END = SC_DL + 1024;
__device__ __forceinline__ bf16x8 frag(const LAS unsigned char* base, int pitch, int row, int ks, int fq) { return *(const LAS bf16x8*)(base + row * pitch + ks * 64 + fq * 16); }
__device__ __forceinline__ void phase_gla_scan(const Args& a, LAS unsigned char* lds) {
    const int tid = opaque_tid(), wave = __builtin_amdgcn_readfirstlane(tid >> 6), lane = tid & 63, fr = lane & 15, fq = lane >> 4;
    const bf16_t* proj = (const bf16_t*)(a.ws + WS_PROJ); const float* DLg = (const float*)(a.ws + WS_DL);
    for (int item = blockIdx.x; item < 256; item += gridDim.x) {
        const int xcd = item & 7, jj = item >> 3, bhd = xcd * 4 + (jj >> 3), es = jj & 7, b = bhd >> 3, h = (bhd >> 1) & 3, dir = bhd & 1;
        const bf16_t* QT = (const bf16_t*)(a.ws + WS_QKK) + (size_t)dir * MTOK * 1024 + h * 256;
        const bf16_t* KT = (const bf16_t*)(a.ws + WS_QKK + 128 * MiB) + (size_t)dir * MTOK * 1024 + h * 256;
        const bf16_t* KH = (const bf16_t*)(a.ws + WS_QKK + 256 * MiB);
        const bf16_t* V = proj + 2048 + h * 512 + es * 64;
        bf16_t* O = dir ? ((bf16_t*)(a.ws + WS_PROJ) + h * 512 + es * 64) : ((bf16_t*)(a.ws + WS_HB) + h * 512 + es * 64); const int ldo = dir ? 6144 : 2048;
        for (int i = tid; i < 64 * SC_PQ / 16; i += 512) *(LAS u32x4*)(lds + SC_ST + i * 16) = (u32x4){0u, 0u, 0u, 0u};
        f32x4 S[2][4];
#pragma unroll
        for (int i = 0; i < 2; ++i)
#pragma unroll
            for (int j = 0; j < 4; ++j) S[i][j] = (f32x4){0.f, 0.f, 0.f, 0.f};
        u32x4 rq[4], rk[4], rkh[4], rv; f32x4 rdl = (f32x4){0.f, 0.f, 0.f, 0.f};
#define SC_LOAD(c) do { const int cc_ = dir ? 127 - (c) : (c); const size_t tok0_ = (size_t)b * SEQ + cc_ * 64; \
        _Pragma("unroll") for (int i_ = 0; i_ < 4; ++i_) { const int idx_ = tid + 512 * i_; rq[i_] = *(const u32x4*)(QT + (tok0_ + (idx_ >> 5)) * 1024 + (idx_ & 31) * 8); rk[i_] = *(const u32x4*)(KT + (tok0_ + (idx_ >> 5)) * 1024 + (idx_ & 31) * 8); } \
        const bf16_t* khc_ = KH + ((((size_t)dir * 4 + b) * 128 + cc_) * 4 + h) * (256 * 64); \
        _Pragma("unroll") for (int i_ = 0; i_ < 4; ++i_) rkh[i_] = *(const u32x4*)(khc_ + (size_t)(tid + 512 * i_) * 8); \
        rv = *(const u32x4*)(V + (tok0_ + (tid >> 3)) * 6144 + (tid & 7) * 8); \
        if (tid < 64) rdl = *(const f32x4*)(DLg + (((size_t)dir * 4 + b) * 128 + cc_) * 1024 + h * 256 + tid * 4); } while (0)
        SC_LOAD(0);
        for (int c = 0; c < 128; ++c) {
            const int cc = dir ? 127 - c : c; const size_t tok0 = (size_t)b * SEQ + cc * 64;
#pragma unroll
            for (int i = 0; i < 4; ++i) { const int idx = tid + 512 * i; *(LAS u32x4*)(lds + SC_QT + (idx >> 5) * SC_PQ + (idx & 31) * 16) = rq[i]; *(LAS u32x4*)(lds + SC_KT + (idx >> 5) * SC_PQ + (idx & 31) * 16) = rk[i];
                *(LAS u32x4*)(lds + SC_KH + (idx >> 3) * SC_PS + (idx & 7) * 16) = rkh[i]; }
            { LAS bf16_t* vt = (LAS bf16_t*)(lds + SC_VT) + ((tid & 7) * 8) * (SC_PS / 2) + (tid >> 3);
              vt[0 * (SC_PS / 2)] = (bf16_t)(rv.x & 0xffffu); vt[1 * (SC_PS / 2)] = (bf16_t)(rv.x >> 16); vt[2 * (SC_PS / 2)] = (bf16_t)(rv.y & 0xffffu); vt[3 * (SC_PS / 2)] = (bf16_t)(rv.y >> 16);
              vt[4 * (SC_PS / 2)] = (bf16_t)(rv.z & 0xffffu); vt[5 * (SC_PS / 2)] = (bf16_t)(rv.z >> 16); vt[6 * (SC_PS / 2)] = (bf16_t)(rv.w & 0xffffu); vt[7 * (SC_PS / 2)] = (bf16_t)(rv.w >> 16); }
            if (tid < 64) *(LAS f32x4*)(lds + SC_DL + tid * 16) = rdl;
            __syncthreads();
            if (c + 1 < 128) SC_LOAD(c + 1);
            const int it = wave >> 1, et0 = (wave & 1) * 2;
            f32x4 oacc[2], am[2];
#pragma unroll
            for (int n = 0; n < 2; ++n) { oacc[n] = (f32x4){0.f, 0.f, 0.f, 0.f}; am[n] = (f32x4){0.f, 0.f, 0.f, 0.f}; }
#pragma unroll
            for (int ks = 0; ks < 8; ++ks) { const bf16x8 fqt = frag(lds + SC_QT, SC_PQ, it * 16 + fr, ks, fq);
#pragma unroll
                for (int n = 0; n < 2; ++n) { oacc[n] = mfma16(frag(lds + SC_ST, SC_PQ, (et0 + n) * 16 + fr, ks, fq), fqt, oacc[n]);
                                              am[n] = mfma16(frag(lds + SC_KT, SC_PQ, (et0 + n) * 16 + fr, ks, fq), fqt, am[n]); } }
#pragma unroll
            for (int n = 0; n < 2; ++n) { const int i = it * 16 + fr, j0 = (et0 + n) * 16 + 4 * fq; float v[4];
#pragma unroll
                for (int r = 0; r < 4; ++r) { const int j = j0 + r; const bool keep = dir ? (j > i) : (j <= i); v[r] = keep ? am[n][r] : 0.f; }
                u32x2 w; w.x = cvt_pk_bf16(v[0], v[1]); w.y = cvt_pk_bf16(v[2], v[3]); *(LAS u32x2*)(lds + SC_AM + i * SC_PS + j0 * 2) = w; }
            __syncthreads();
#pragma unroll
            for (int ks = 0; ks < 2; ++ks) { const bf16x8 fa = frag(lds + SC_AM, SC_PS, it * 16 + fr, ks, fq);
#pragma unroll
                for (int n = 0; n < 2; ++n) oacc[n] = mfma16(frag(lds + SC_VT, SC_PS, (et0 + n) * 16 + fr, ks, fq), fa, oacc[n]); }
#pragma unroll
            for (int n = 0; n < 2; ++n) { u32x2 w; w.x = cvt_pk_bf16(oacc[n][0], oacc[n][1]); w.y = cvt_pk_bf16(oacc[n][2], oacc[n][3]);
                *(u32x2*)(O + (tok0 + it * 16 + fr) * ldo + (et0 + n) * 16 + 4 * fq) = w; }
#pragma unroll
            for (int i = 0; i < 2; ++i) { const f32x4 dl4 = *(const LAS f32x4*)(lds + SC_DL + ((wave * 2 + i) * 16 + 4 * fq) * 4);
#pragma unroll
                for (int j = 0; j < 4; ++j) S[i][j] *= dl4; }
#pragma unroll
            for (int ks = 0; ks < 2; ++ks) {
                bf16x8 fv[4];
#pragma unroll
                for (int j = 0; j < 4; ++j) fv[j] = frag(lds + SC_VT, SC_PS, j * 16 + fr, ks, fq);
#pragma unroll
                for (int i = 0; i < 2; ++i) { const bf16x8 fk = frag(lds + SC_KH, SC_PS, (wave * 2 + i) * 16 + fr, ks, fq);
#pragma unroll
                    for (int j = 0; j < 4; ++j) S[i][j] = mfma16(fk, fv[j], S[i][j]); } }
            __syncthreads();
#pragma unroll
            for (int i = 0; i < 2; ++i)
#pragma unroll
                for (int j = 0; j < 4; ++j) { u32x2 w; w.x = cvt_pk_bf16(S[i][j][0], S[i][j][1]); w.y = cvt_pk_bf16(S[i][j][2], S[i][j][3]);
                    *(LAS u32x2*)(lds + SC_ST + (j * 16 + fr) * SC_PQ + ((wave * 2 + i) * 16 + 4 * fq) * 2) = w; }
        }
        __syncthreads();
#undef SC_LOAD
    }
}
__device__ __forceinline__ void phase_gla_post(bf16_t* hb, const bf16_t* proj, const float* ng) {
    const int tid_ = opaque_tid(), lane = tid_ & 63, wave = __builtin_amdgcn_readfirstlane(tid_ >> 6), gw = blockIdx.x * 8 + wave, NGW = gridDim.x * 8; (void)wave; (void)gw; (void)NGW; (void)lane;
    float g8[8];
#pragma unroll
    for (int q = 0; q < 8; ++q) g8[q] = ng[lane * 8 + q];
    for (int m = gw; m < MTOK; m += NGW) {
#pragma unroll
        for (int hh = 0; hh < 4; ++hh) { const int c = hh * 512 + lane * 8;
            const u32x4 wf = *(const u32x4*)(hb + (size_t)m * 2048 + c), wb = *(const u32x4*)(proj + (size_t)m * 6144 + c), wg = *(const u32x4*)(proj + (size_t)m * 6144 + 4096 + c);
            float o[8] = {bf_lo(wf.x) + bf_lo(wb.x), bf_hi(wf.x) + bf_hi(wb.x), bf_lo(wf.y) + bf_lo(wb.y), bf_hi(wf.y) + bf_hi(wb.y), bf_lo(wf.z) + bf_lo(wb.z), bf_hi(wf.z) + bf_hi(wb.z), bf_lo(wf.w) + bf_lo(wb.w), bf_hi(wf.w) + bf_hi(wb.w)};
            const float g[8] = {bf_lo(wg.x), bf_hi(wg.x), bf_lo(wg.y), bf_hi(wg.y), bf_lo(wg.z), bf_hi(wg.z), bf_lo(wg.w), bf_hi(wg.w)};
            float s = 0.f;
#pragma unroll
            for (int q = 0; q < 8; ++q) s += o[q] * o[q];
            const float rstd = __builtin_amdgcn_rsqf(wave_sum(s) * (1.f / 512.f) + NEPS);
#pragma unroll
            for (int q = 0; q < 8; ++q) o[q] = o[q] * rstd * g8[q] * silu_f(g[q]);
            u32x4 w; w.x = cvt_pk_bf16(o[0], o[1]); w.y = cvt_pk_bf16(o[2], o[3]); w.z = cvt_pk_bf16(o[4], o[5]); w.w = cvt_pk_bf16(o[6], o[7]);
            *(u32x4*)(hb + (size_t)m * 2048 + c) = w; }
    }
}

#define RLX_AGENT __ATOMIC_RELAXED, __HIP_MEMORY_SCOPE_AGENT
#define XB_TMO      128
#define XB_XCNT(j)  (256  + 64 * (j))
#define XB_XSUB(j)  (1280 + 64 * (j))
#define XB_XGEN(j)  (2304 + 64 * (j))
#define XB_TOP      3328
#define XB_TOPGEN   3392
#define XCD_BAR_WORDS 3456
#define XB_SPIN_CAP (1u << 18)

__device__ __forceinline__ unsigned xb_ld(unsigned* p)              { return __hip_atomic_load(p, __ATOMIC_RELAXED, __HIP_MEMORY_SCOPE_AGENT); }
__device__ __forceinline__ unsigned xb_add(unsigned* p, unsigned v) { return __hip_atomic_fetch_add(p, v, __ATOMIC_RELAXED, __HIP_MEMORY_SCOPE_AGENT); }
__device__ __forceinline__ unsigned xb_xcc_id() { return (unsigned)__builtin_amdgcn_s_getreg((3 << 11) | 20) & 0xFu; }
#define XB_SPIN(cond, bar) do { unsigned _sp = 0; while (cond) { __builtin_amdgcn_s_sleep(1); \
    if ((++_sp & 255u) == 0u) { if (xb_ld(&(bar)[XB_TMO])) break; if (_sp > XB_SPIN_CAP) { atomicAdd(&(bar)[XB_TMO], 1u); break; } } } } while (0)

struct XcdBarrier {
    unsigned* bar; unsigned x;
    volatile LAS unsigned* st;
};

__device__ __forceinline__ XcdBarrier xcd_barrier_post(unsigned* bar, volatile LAS unsigned* st) {
    XcdBarrier b; b.bar = bar; b.x = xb_xcc_id(); b.st = st;
    if (threadIdx.x == 0) (void)xb_add(&bar[XB_XCNT(b.x)], 1u);
    return b;
}
__device__ __forceinline__ void xcd_barrier_complete(unsigned* bar, unsigned x, unsigned& nloc, unsigned& nx) {
    const unsigned G = gridDim.x * gridDim.y * gridDim.z;
    unsigned sum, cnt, mine, sp = 0u;
    for (;;) {
        sum = 0u; cnt = 0u; mine = 0u;
#pragma unroll
        for (unsigned j = 0; j < 16; ++j) { const unsigned c = xb_ld(&bar[XB_XCNT(j)]); sum += c; cnt += (c > 0u) ? 1u : 0u; mine = (j == x) ? c : mine; }
        if (sum == G) break;
        __builtin_amdgcn_s_sleep(1);
        if ((++sp & 255u) == 0u) { if (xb_ld(&bar[XB_TMO])) break; if (sp > XB_SPIN_CAP) { atomicAdd(&bar[XB_TMO], 1u); break; } }
    }
    nloc = mine > 0u ? mine : 1u; nx = cnt > 0u ? cnt : 1u;
}

__device__ __forceinline__ void xcd_barrier(const XcdBarrier& b) {
    asm volatile("s_waitcnt vmcnt(0)" ::: "memory");
    __syncthreads();
    if (threadIdx.x == 0) {
        unsigned* bar = b.bar;
        __builtin_amdgcn_s_waitcnt(0);
        unsigned nloc = b.st[0], nx = b.st[1];
        if (nloc == 0u) { xcd_barrier_complete(bar, b.x, nloc, nx); b.st[0] = nloc; b.st[1] = nx; }
        const unsigned old = xb_add(&bar[XB_XSUB(b.x)], 1u);
        const unsigned gen = old / nloc;
        if (old + 1u == (gen + 1u) * nloc) {
            __builtin_amdgcn_fence(__ATOMIC_RELEASE, "agent");
            asm volatile("s_waitcnt vmcnt(0)" ::: "memory");
            const unsigned og = xb_add(&bar[XB_TOP], 1u);
            const unsigned tg = og / nx;
            if (og + 1u == (tg + 1u) * nx) xb_add(&bar[XB_TOPGEN], 1u);
            else XB_SPIN(xb_ld(&bar[XB_TOPGEN]) == tg, bar);
            __builtin_amdgcn_fence(__ATOMIC_ACQUIRE, "agent");
            xb_add(&bar[XB_XGEN(b.x)], 1u);
            asm volatile("s_waitcnt vmcnt(0)" ::: "memory");
        } else {
            XB_SPIN(xb_ld(&bar[XB_XGEN(b.x)]) == gen, bar);
            __builtin_amdgcn_fence(__ATOMIC_ACQUIRE, "agent");
            asm volatile("s_waitcnt vmcnt(0)" ::: "memory");
        }
    }
    __syncthreads();
}


constexpr int LDS_BYTES = 160 * 1024;
static_assert(SC_END <= LDS_BYTES - 64 && (int)attn::SHM_ATTN <= LDS_BYTES && pg8::STAGE_BYTES <= LDS_BYTES, "LDS map");

#define CG_SYNC() do { asm volatile("s_waitcnt vmcnt(0) lgkmcnt(0)" ::: "memory"); grid.sync(); __builtin_amdgcn_fence(__ATOMIC_ACQUIRE, "agent"); asm volatile("s_waitcnt vmcnt(0)" ::: "memory"); } while (0)
#define GRID_SYNC() xcd_barrier(xbar)
__global__ void __launch_bounds__(512, 2) fwd_megakernel(Args a) {
    extern __shared__ __attribute__((aligned(16))) unsigned char lds_raw[];
    LAS unsigned char* lds = (LAS unsigned char*)lds_raw;
    cg::grid_group grid = cg::this_grid();
    if (threadIdx.x < 16) ((LAS unsigned*)(lds + LDS_BYTES - 64))[threadIdx.x] = 0u;
    __syncthreads();
    XcdBarrier xbar = xcd_barrier_post((unsigned*)(a.ws + WS_BAR), (volatile LAS unsigned*)(lds + LDS_BYTES - 64));
    const int G = gridDim.x;
    float* mod = (float*)(a.ws + WS_MOD); float* rc = (float*)(a.ws + WS_ROPE); float* rs = rc + SEQ * 64;
    bf16_t* WB = (bf16_t*)(a.ws + WS_WB); bf16_t* WBG = (bf16_t*)(a.ws + WS_WB + 16 * MiB); bf16_t* WBO = (bf16_t*)(a.ws + WS_WB + 24 * MiB);
    bf16_t* HB = (bf16_t*)(a.ws + WS_HB); bf16_t* PROJ = (bf16_t*)(a.ws + WS_PROJ); bf16_t* YB = (bf16_t*)(a.ws + WS_QKK);

    phase_mod(a, lds, mod);
    __syncthreads();
    phase_rope_table(rc, rs);
    phase_weights(a, 0, lds);
    CG_SYNC();

#ifndef NLAYERS
#define NLAYERS 4
#endif
#ifndef REP_ATTN
#define REP_ATTN 1
#endif
#ifndef REP_SCAN
#define REP_SCAN 1
#endif
#ifndef REP_PREP
#define REP_PREP 1
#endif
#ifndef REP_GEMM0
#define REP_GEMM0 1
#endif
#ifndef REP_POOL
#define REP_POOL 1
#endif
#ifndef REP_SYNC
#define REP_SYNC 0
#endif
#ifndef REP_GRP
#define REP_GRP 1
#endif
#ifndef REP_OUT0
#define REP_OUT0 1
#endif
#ifndef REP_NORM
#define REP_NORM 1
#endif
    for (int rep = 0; rep < REP_SYNC; ++rep) GRID_SYNC();
    for (int L = 0; L < NLAYERS; ++L) {
        const int kind = L % 3, j = L / 3;
        const float* xin = (L == 0) ? a.x : a.out;
        const float* modL = mod + (size_t)L * 4 * 6144;
        if (L > 0) phase_weights(a, L, lds);
        for (int rep = 0; rep < REP_NORM; ++rep) {
        phase_norm_mod(xin, modL, HB);
        GRID_SYNC(); }
        if (kind == 0) {
            for (int rep = 0; rep < REP_GEMM0; ++rep) {
            { pg8::Gemm g{HB, WB, MTOK, 4096, 2048, 2048, 2048, 0}; pg8::StaticOrder S; S.init(MTOK, 4096, G, (int)blockIdx.x);
              pg8::EpiStore E{PROJ, 4096}; pg8::gemm_phase<pg8::EpiStore, pg8::StaticOrder>(lds, g, S, E); }
            GRID_SYNC(); }
            for (int rep = 0; rep < REP_POOL; ++rep) {
            phase_pool(PROJ, HB);
            GRID_SYNC(); }
            for (int rep = 0; rep < REP_GRP; ++rep) {
            { pg8::Gemm g{HB, WBG, MTOK, 2048, 512, 2048, 512, 1}; pg8::StaticOrder S; S.init(MTOK, 2048, G, (int)blockIdx.x);
              pg8::EpiPool E{YB, PROJ + 2048, 4096, a.pool_scale + (size_t)j * 2048}; pg8::gemm_phase<pg8::EpiPool, pg8::StaticOrder>(lds, g, S, E); }
            GRID_SYNC(); }
            for (int rep = 0; rep < (L == 0 ? REP_OUT0 : 1); ++rep) {
            { pg8::Gemm g{YB, WBO, MTOK, 2048, 2048, 2048, 2048, 0}; pg8::StaticOrder S; S.init(MTOK, 2048, G, (int)blockIdx.x);
              pg8::EpiRes E{xin, a.out, modL + 4096}; pg8::gemm_phase<pg8::EpiRes, pg8::StaticOrder>(lds, g, S, E); }
            GRID_SYNC(); }
        } else if (kind == 1) {
            phase_gla_lowrank(HB, (const bf16_t*)(a.ws + WS_W1T), (float*)(a.ws + WS_R));
            { pg8::Gemm g{HB, WB, MTOK, 6144, 2048, 2048, 2048, 0}; pg8::StaticOrder S; S.init(MTOK, 6144, G, (int)blockIdx.x);
              pg8::EpiStore E{PROJ, 6144}; pg8::gemm_phase<pg8::EpiStore, pg8::StaticOrder>(lds, g, S, E); }
            GRID_SYNC();
            for (int rep = 0; rep < REP_PREP; ++rep) {
            phase_gla_prep(a, lds);
            GRID_SYNC(); }
            for (int rep = 0; rep < REP_SCAN; ++rep) {
            phase_gla_scan(a, lds);
            GRID_SYNC(); }
            phase_gla_post(HB, PROJ, a.gla_norm_g);
            GRID_SYNC();
            { pg8::Gemm g{HB, WBO, MTOK, 2048, 2048, 2048, 2048, 0}; pg8::StaticOrder S; S.init(MTOK, 2048, G, (int)blockIdx.x);
              pg8::EpiRes E{xin, a.out, modL + 4096}; pg8::gemm_phase<pg8::EpiRes, pg8::StaticOrder>(lds, g, S, E); }
            GRID_SYNC();
        } else {
            { pg8::Gemm g{HB, WB, MTOK, 5120, 2048, 2048, 2048, 0}; pg8::StaticOrder S; S.init(MTOK, 5120, G, (int)blockIdx.x);
              pg8::EpiStore E{PROJ, 5120}; pg8::gemm_phase<pg8::EpiStore, pg8::StaticOrder>(lds, g, S, E); }
            GRID_SYNC();
            phase_qknorm_rope(PROJ, a.attn_qg, a.attn_kg, rc, rs);
            GRID_SYNC();
            for (int rep = 0; rep < REP_ATTN; ++rep) {
            for (int u = blockIdx.x; u < 2048; u += G) {
                const int bk = u >> 7, b = bk >> 2, kvh = bk & 3, hq = kvh * 4 + ((u >> 5) & 3), qb = u & 31;
                const size_t row0 = (size_t)b * SEQ + qb * 256;
                attn::attn_dense_body<attn::bf16>((const attn::bf16*)(PROJ + row0 * 5120 + hq * 128), (const attn::bf16*)(PROJ + (size_t)b * SEQ * 5120 + 2048 + kvh * 128),
                    (const attn::bf16*)(PROJ + (size_t)b * SEQ * 5120 + 2560 + kvh * 128), PROJ + row0 * 5120 + 3072 + hq * 128, YB + row0 * 2048 + hq * 128, SEQ, (char*)lds_raw);
                __syncthreads();
            }
            GRID_SYNC(); }
            { pg8::Gemm g{YB, WBO, MTOK, 2048, 2048, 2048, 2048, 0}; pg8::StaticOrder S; S.init(MTOK, 2048, G, (int)blockIdx.x);
              pg8::EpiRes E{xin, a.out, modL + 4096}; pg8::gemm_phase<pg8::EpiRes, pg8::StaticOrder>(lds, g, S, E); }
            GRID_SYNC();
        }
    }
    phase_final_norm(a.out, a.final_g);
}

extern "C" void kernel_launch(void* const* d_in, const int* in_sizes, int n_in, void* d_out, int out_size, void* d_ws, size_t ws_size, hipStream_t stream) {
    static int grid = 0;
    if (grid == 0) {
        if (n_in != 22 || in_sizes[0] != MTOK * DM || out_size != MTOK * DM || ws_size < WS_END) {
            fprintf(stderr, "kernel_launch: unexpected shapes: n_in %d in0 %d out %d ws %zu (need %zu)\n", n_in, n_in > 0 ? in_sizes[0] : -1, out_size, ws_size, (size_t)WS_END); grid = -1; return; }
        int dev = 0, cus = 0, per_cu = 0;
        hipGetDevice(&dev); hipDeviceGetAttribute(&cus, hipDeviceAttributeMultiprocessorCount, dev);
        if (hipFuncSetAttribute((const void*)fwd_megakernel, hipFuncAttributeMaxDynamicSharedMemorySize, LDS_BYTES) != hipSuccess) { fprintf(stderr, "kernel_launch: hipFuncSetAttribute failed\n"); grid = -1; return; }
        if (hipOccupancyMaxActiveBlocksPerMultiprocessor(&per_cu, (const void*)fwd_megakernel, 512, LDS_BYTES) != hipSuccess || per_cu < 1) { fprintf(stderr, "kernel_launch: occupancy query gave %d\n", per_cu); per_cu = 1; }
        (void)hipGetLastError();
        grid = cus;
        fprintf(stderr, "kernel_launch: cus %d per_cu %d grid %d\n", cus, per_cu, grid);
    }
    if (grid < 0) return;
    Args a{};
    const float** p = (const float**)&a;
    for (int i = 0; i < 22; ++i) p[i] = (const float*)d_in[i];
    a.out = (float*)d_out; a.ws = (unsigned char*)d_ws;
    if (hipMemsetAsync((char*)d_ws + WS_BAR, 0, 16384, stream) != hipSuccess) { fprintf(stderr, "kernel_launch: memset of the barrier words failed\n"); return; }
    void* args[] = {&a};
    hipError_t e = hipLaunchCooperativeKernel((const void*)fwd_megakernel, dim3(grid), dim3(512), args, LDS_BYTES, stream);
    if (e != hipSuccess) fprintf(stderr, "kernel_launch: cooperative launch failed: %s (grid %d)\n", hipGetErrorString(e), grid);
}
```

```cpp
#include <hip/hip_runtime.h>
#include <hip/hip_bf16.h>
#include <hip/hip_cooperative_groups.h>
#include <cstdio>
#include <cstdint>
#include <cmath>
namespace cg = cooperative_groups;

constexpr int NB = 4, SEQ = 8192, DM = 2048, MTOK = NB * SEQ;
constexpr float NEPS = 1e-6f;
constexpr size_t MiB = (size_t)1 << 20;
constexpr size_t WS_MOD = 0;
constexpr size_t WS_ROPE = 1 * MiB;
constexpr size_t WS_R = 5 * MiB;
constexpr size_t WS_DL = 9 * MiB;
constexpr size_t WS_W1T = 13 * MiB;
constexpr size_t WS_BAR = 15 * MiB;
constexpr size_t WS_WB = 16 * MiB;
constexpr size_t WS_HB = 52 * MiB;
constexpr size_t WS_PROJ = 180 * MiB;
constexpr size_t WS_QKK = 564 * MiB;
constexpr size_t WS_END = 948 * MiB;

typedef unsigned short bf16_t;
typedef short bf16x8 __attribute__((ext_vector_type(8)));
typedef float f32x4 __attribute__((ext_vector_type(4)));
typedef unsigned u32x4 __attribute__((ext_vector_type(4)));
typedef unsigned u32x2 __attribute__((ext_vector_type(2)));
#define LAS __attribute__((address_space(3)))

typedef float f32x2 __attribute__((ext_vector_type(2)));
typedef __bf16 bf16x2_t __attribute__((ext_vector_type(2)));
__device__ __forceinline__ unsigned cvt_pk_bf16(float lo, float hi) { f32x2 v = {lo, hi}; bf16x2_t b = __builtin_convertvector(v, bf16x2_t); return __builtin_bit_cast(unsigned, b); }
__device__ __forceinline__ float bf_lo(unsigned w) { return __uint_as_float(w << 16); }
__device__ __forceinline__ float bf_hi(unsigned w) { return __uint_as_float(w & 0xffff0000u); }
__device__ __forceinline__ float bf2f(bf16_t b) { return __uint_as_float(((unsigned)b) << 16); }
__device__ __forceinline__ bf16_t f2bf(float f) { unsigned u = __float_as_uint(f); u += 0x7fffu + ((u >> 16) & 1u); return (bf16_t)(u >> 16); }
__device__ __forceinline__ float silu_f(float v) { return v * __builtin_amdgcn_rcpf(1.f + __builtin_amdgcn_exp2f(-1.4426950408889634f * v)); }
__device__ __forceinline__ float wave_sum(float v) {
#pragma unroll
    for (int o = 1; o < 64; o <<= 1) v += __shfl_xor(v, o);
    return v;
}
__device__ __forceinline__ int opaque_tid() { int t; asm volatile("v_mov_b32 %0, %1" : "=v"(t) : "v"((int)threadIdx.x)); return t; }

namespace pg8 {
#define PG8_LAS __attribute__((address_space(3)))
constexpr int BM = 256, BK = 64, HALF = 128, HTB = HALF * BK * 2  , STAGE_BYTES = 8 * HTB, NXCD = 8, WGM = 8;
__host__ __device__ __forceinline__ int lds_byte(int r, int c) { const int st = (r >> 4) * 2 + (c >> 5), rr = r & 15, cc = c & 31, ob = rr * 64 + cc * 2; return st * 1024 + (ob ^ (((ob >> 9) & 1) << 5)); }
__host__ __device__ __forceinline__ void stage_rc(int b, int& R, int& C) { const int st = b / 1024, sb = b % 1024, swz = sb ^ (((sb >> 9) & 1) << 5); R = (st >> 1) * 16 + swz / 64; C = (st & 1) * 32 + (swz % 64) / 2; }
__host__ __device__ __forceinline__ int perm32(int rho) { const int n = rho >> 4, i = rho & 15; return 8 * (i >> 2) + 4 * n + (i & 3); }
struct Unit { int pm, pn; };
struct Gemm { const bf16_t* A; const bf16_t* Bt; int M, N, K, lda, ldb, grp;
    __device__ __forceinline__ const char* aptr(const Unit& u) const { return (const char*)(A + (size_t)u.pm * BM * lda + (grp ? (size_t)(u.pn >> 1) * K : (size_t)0)); }
    __device__ __forceinline__ const char* bptr(const Unit& u) const { return (const char*)(Bt + (size_t)u.pn * BM * ldb); } };
struct StaticOrder {
    int nM, nN, nwg, G, c;
    __host__ __device__ void init(int M, int N, int G_, int c_) { nM = M / BM; nN = N / BM; nwg = nM * nN; G = G_; c = c_; }
    __host__ __device__ bool next(int i, Unit& u) const {
        const long L = (long)i * G + c; if (L >= nwg) return false;
        int wgid = (int)L; { const int q = nwg / NXCD, r = nwg % NXCD, xcd = wgid % NXCD, off = wgid / NXCD; wgid = (xcd < r ? xcd * (q + 1) : r * (q + 1) + (xcd - r) * q) + off; }
        const int nig = WGM * nN, gid = wgid / nig, fm = gid * WGM, gsz = (nM - fm) < WGM ? (nM - fm) : WGM;
        u.pm = fm + ((wgid % nig) % gsz); u.pn = (wgid % nig) / gsz; return true;
    }
    __device__ __forceinline__ void a_ready(const Unit&) const {}
    __device__ __forceinline__ void done(const Unit&) const {}
};
struct EpiStore {
    static constexpr bool PERM = true, AFTER_DRAIN = false;
    bf16_t* O; int ldc;
    __device__ __forceinline__ void operator()(const f32x4 (&acc)[2][2][4][2], const Unit& u, int wr, int wc, int fr, int fq) const {
        const int row0 = u.pm * BM + wr * 64 + fr, col0 = u.pn * BM + wc * 32 + 8 * fq;
#pragma unroll
        for (int ai = 0; ai < 2; ++ai)
#pragma unroll
            for (int m = 0; m < 4; ++m) { bf16_t* rowp = O + (size_t)(row0 + ai * HALF + m * 16) * ldc + col0;
#pragma unroll
                for (int bj = 0; bj < 2; ++bj) { const f32x4 v0 = acc[ai][bj][m][0], v1 = acc[ai][bj][m][1];
                    u32x4 w; w.x = cvt_pk_bf16(v0[0], v0[1]); w.y = cvt_pk_bf16(v0[2], v0[3]); w.z = cvt_pk_bf16(v1[0], v1[1]); w.w = cvt_pk_bf16(v1[2], v1[3]);
                    *(u32x4*)(rowp + bj * HALF) = w; } }
    }
};
struct EpiPool {
    static constexpr bool PERM = true, AFTER_DRAIN = false;
    bf16_t* O; const bf16_t* G; int ldg; const float* scale;
    __device__ __forceinline__ void operator()(const f32x4 (&acc)[2][2][4][2], const Unit& u, int wr, int wc, int fr, int fq) const {
        const int row0 = u.pm * BM + wr * 64 + fr, col0 = u.pn * BM + wc * 32 + 8 * fq;
        f32x4 sv[2][2];
#pragma unroll
        for (int bj = 0; bj < 2; ++bj)
#pragma unroll
            for (int n = 0; n < 2; ++n) sv[bj][n] = *(const f32x4*)(scale + col0 + bj * HALF + 4 * n);
#pragma unroll
        for (int ai = 0; ai < 2; ++ai)
#pragma unroll
            for (int m = 0; m < 4; ++m) { const size_t row = (size_t)(row0 + ai * HALF + m * 16);
#pragma unroll
                for (int bj = 0; bj < 2; ++bj) { const u32x4 gw = *(const u32x4*)(G + row * ldg + col0 + bj * HALF);
                    const f32x4 v0 = acc[ai][bj][m][0] * sv[bj][0], v1 = acc[ai][bj][m][1] * sv[bj][1];
                    u32x4 w;
                    w.x = cvt_pk_bf16(v0[0] * silu_f(bf_lo(gw.x)), v0[1] * silu_f(bf_hi(gw.x))); w.y = cvt_pk_bf16(v0[2] * silu_f(bf_lo(gw.y)), v0[3] * silu_f(bf_hi(gw.y)));
                    w.z = cvt_pk_bf16(v1[0] * silu_f(bf_lo(gw.z)), v1[1] * silu_f(bf_hi(gw.z))); w.w = cvt_pk_bf16(v1[2] * silu_f(bf_lo(gw.w)), v1[3] * silu_f(bf_hi(gw.w)));
                    *(u32x4*)(O + row * 2048 + col0 + bj * HALF) = w; } }
    }
};
struct EpiRes {
    static constexpr bool PERM = false, AFTER_DRAIN = false;
    const float* xi; float* xo; const float* gate;
    __device__ __forceinline__ void operator()(const f32x4 (&acc)[2][2][4][2], const Unit& u, int wr, int wc, int fr, int fq) const {
        const int row0 = u.pm * BM + wr * 64 + fr, col0 = u.pn * BM + wc * 32 + 4 * fq;
        const float* gp = gate + (size_t)((u.pm * BM) / SEQ) * 6144 + col0;
        f32x4 gv[2][2];
#pragma unroll
        for (int bj = 0; bj < 2; ++bj)
#pragma unroll
            for (int n = 0; n < 2; ++n) gv[bj][n] = *(const f32x4*)(gp + bj * HALF + n * 16);
#pragma unroll
        for (int ai = 0; ai < 2; ++ai)
#pragma unroll
            for (int m = 0; m < 4; ++m) { const size_t off = (size_t)(row0 + ai * HALF + m * 16) * 2048 + col0;
#pragma unroll
                for (int bj = 0; bj < 2; ++bj)
#pragma unroll
                    for (int n = 0; n < 2; ++n) { const f32x4 xv = *(const f32x4*)(xi + off + bj * HALF + n * 16);
                        *(f32x4*)(xo + off + bj * HALF + n * 16) = xv + gv[bj][n] * acc[ai][bj][m][n]; }
                asm volatile("" ::: "memory"); }
    }
};
template <class Epi, class Sched>
__device__ __forceinline__ void gemm_phase(PG8_LAS unsigned char* lds, const Gemm g, const Sched& S, const Epi& E) {
    const int tid = opaque_tid(), wid = __builtin_amdgcn_readfirstlane(tid >> 6), lane = tid & 63, wr = wid >> 2, wc = wid & 3, fr = lane & 15, fq = lane >> 4;
    const int K = g.K, nt = K / BK;
    unsigned voffA[2], voffB[2];
#pragma unroll
    for (int i = 0; i < 2; ++i) { int R, C; stage_rc(tid * 16 + i * 8192, R, C); const int Rb = Epi::PERM ? ((R & ~31) + perm32(R & 31)) : R;
        voffA[i] = (unsigned)(R * g.lda + C) * 2u; voffB[i] = (unsigned)(Rb * g.ldb + C) * 2u; }
    const size_t kstep = (size_t)(BK * 2);
    const size_t hstepA = (size_t)HALF * g.lda * 2, hstepB = (size_t)HALF * g.ldb * 2;
    const unsigned ldsw = (unsigned)wid * 1024u;
    const int aoff = lds_byte(wr * 64 + fr, fq * 8), boff = lds_byte(wc * 32 + fr, fq * 8);
#define PG8_SA(b, h) (((b) * 2 + (h)) * HTB)
#define PG8_SB(b, h) ((4 + (b) * 2 + (h)) * HTB)
#define PG8_STAGE(bufoff, gbase, voff) do { _Pragma("unroll") for (int _i = 0; _i < 2; ++_i) \
        __builtin_amdgcn_global_load_lds((const unsigned*)((const char*)(gbase) + (voff)[_i]), (PG8_LAS unsigned*)(lds + (bufoff) + ldsw + _i * 8192), 16, 0, 0); } while (0)
#define PG8_LDA(dst, b, h) do { _Pragma("unroll") for (int m = 0; m < 4; ++m) _Pragma("unroll") for (int k = 0; k < 2; ++k) dst[m][k] = *(const PG8_LAS bf16x8*)(lds + PG8_SA(b, h) + aoff + m * 2048 + k * 1024); } while (0)
#define PG8_LDB(dst, b, h) do { _Pragma("unroll") for (int n = 0; n < 2; ++n) _Pragma("unroll") for (int k = 0; k < 2; ++k) dst[n][k] = *(const PG8_LAS bf16x8*)(lds + PG8_SB(b, h) + boff + n * 2048 + k * 1024); } while (0)
#define PG8_MMA(ai, bj, At, Bt) do { __builtin_amdgcn_s_setprio(1); _Pragma("unroll") for (int m = 0; m < 4; ++m) _Pragma("unroll") for (int n = 0; n < 2; ++n) _Pragma("unroll") for (int k = 0; k < 2; ++k) \
        acc[ai][bj][m][n] = __builtin_amdgcn_mfma_f32_16x16x32_bf16(Bt[n][k], At[m][k], acc[ai][bj][m][n], 0, 0, 0); __builtin_amdgcn_s_setprio(0); } while (0)
#define PG8_WAIT_V(n) asm volatile("s_waitcnt vmcnt(" #n ")" ::: "memory")
#define PG8_WAIT_L(n) asm volatile("s_waitcnt lgkmcnt(" #n ")" ::: "memory")
#define PG8_BAR __builtin_amdgcn_s_barrier()
#define PG8_SCHED __builtin_amdgcn_sched_barrier(0)
    Unit cur, nxt; int ui = 0;
    if (!S.next(0, cur)) return;
    f32x4 acc[2][2][4][2];
#pragma unroll
    for (int a = 0; a < 2; ++a)
#pragma unroll
        for (int b = 0; b < 2; ++b)
#pragma unroll
            for (int m = 0; m < 4; ++m)
#pragma unroll
                for (int n = 0; n < 2; ++n) acc[a][b][m][n] = (f32x4){0.f, 0.f, 0.f, 0.f};
    bf16x8 At[4][2], B0[2][2], B1[2][2];
    const char* cA = g.aptr(cur); const char* cB = g.bptr(cur);
    S.a_ready(cur);
    PG8_STAGE(PG8_SB(0, 0), cB, voffB); PG8_STAGE(PG8_SA(0, 0), cA, voffA); PG8_STAGE(PG8_SB(0, 1), cB + hstepB, voffB); PG8_STAGE(PG8_SA(0, 1), cA + hstepA, voffA);
    if (wr == 1) PG8_BAR;
    PG8_WAIT_V(4); PG8_BAR;
    PG8_STAGE(PG8_SB(1, 0), cB + kstep, voffB); PG8_STAGE(PG8_SA(1, 0), cA + kstep, voffA); PG8_STAGE(PG8_SB(1, 1), cB + hstepB + kstep, voffB);
    PG8_WAIT_V(6); PG8_BAR;
    for (;;) {
        const bool has_next = S.next(ui + 1, nxt);
        const char* nA = has_next ? g.aptr(nxt) : cA; const char* nB = has_next ? g.bptr(nxt) : cB;
        for (int t = 0; t < nt; t += 2) {
            const bool last = (t == nt - 2);
            const char* a1 = cA + (size_t)(t + 1) * kstep;
            const char* a2 = last ? nA : cA + (size_t)(t + 2) * kstep; const char* b2 = last ? nB : cB + (size_t)(t + 2) * kstep;
            const char* a3 = a2 + kstep; const char* b3 = b2 + kstep;
            if (last && has_next) S.a_ready(nxt);
            PG8_LDB(B0, 0, 0); PG8_SCHED; PG8_LDA(At, 0, 0); PG8_STAGE(PG8_SA(1, 1), a1 + hstepA, voffA);
            PG8_WAIT_L(8); PG8_BAR; PG8_WAIT_L(0); PG8_MMA(0, 0, At, B0); PG8_BAR; PG8_SCHED;
            PG8_LDB(B1, 0, 1); PG8_STAGE(PG8_SB(0, 0), b2, voffB);
            PG8_BAR; PG8_WAIT_L(0); PG8_MMA(0, 1, At, B1); PG8_BAR;
            PG8_LDA(At, 0, 1); PG8_STAGE(PG8_SA(0, 0), a2, voffA);
            PG8_BAR; PG8_WAIT_L(0); PG8_MMA(1, 0, At, B0); PG8_BAR; PG8_SCHED;
            PG8_STAGE(PG8_SB(0, 1), b2 + hstepB, voffB);
            PG8_WAIT_V(6); PG8_BAR; PG8_MMA(1, 1, At, B1); PG8_BAR;
            PG8_LDB(B0, 1, 0); PG8_SCHED; PG8_LDA(At, 1, 0); PG8_STAGE(PG8_SA(0, 1), a2 + hstepA, voffA);
            PG8_WAIT_L(8); PG8_BAR; PG8_WAIT_L(0); PG8_MMA(0, 0, At, B0); PG8_BAR; PG8_SCHED;
            PG8_LDB(B1, 1, 1); PG8_STAGE(PG8_SB(1, 0), b3, voffB);
            PG8_BAR; PG8_WAIT_L(0); PG8_MMA(0, 1, At, B1); PG8_BAR;
            PG8_LDA(At, 1, 1); PG8_STAGE(PG8_SA(1, 0), a3, voffA);
            PG8_BAR; PG8_WAIT_L(0); PG8_MMA(1, 0, At, B0); PG8_BAR; PG8_SCHED;
            PG8_STAGE(PG8_SB(1, 1), b3 + hstepB, voffB);
            PG8_WAIT_V(6); PG8_BAR; PG8_MMA(1, 1, At, B1); PG8_BAR;
        }
            if constexpr (!Epi::AFTER_DRAIN) { E(acc, cur, wr, wc, fr, fq); S.done(cur); }
            if (!has_next) break;
#pragma unroll
        for (int a = 0; a < 2; ++a)
#pragma unroll
            for (int b = 0; b < 2; ++b)
#pragma unroll
                for (int m = 0; m < 4; ++m)
#pragma unroll
                    for (int n = 0; n < 2; ++n) acc[a][b][m][n] = (f32x4){0.f, 0.f, 0.f, 0.f};
        cur = nxt; cA = nA; cB = nB; ++ui;
    }
    PG8_WAIT_V(0);
    if (wr == 0) PG8_BAR;
    PG8_BAR;
    if constexpr (Epi::AFTER_DRAIN) { E.fused(acc, cur, wr, wc, fr, fq, lds, wid, lane); S.done(cur); }
#undef PG8_SA
#undef PG8_SB
#undef PG8_STAGE
#undef PG8_LDA
#undef PG8_LDB
#undef PG8_MMA
#undef PG8_WAIT_V
#undef PG8_WAIT_L
#undef PG8_BAR
#undef PG8_SCHED
}
}


namespace attn {
using bf16 = __hip_bfloat16;
constexpr int   D = 128, NW = 8, QBLK = 32, KVBLK = 64;
constexpr float SCALE = 0.088388347648318440f;
constexpr float THR = 8.f;
constexpr int SDEPTH = 1;
constexpr int LDQ = 5120, LDK = 5120, LDO = 2048;
constexpr size_t SHM_V = KVBLK * D * 2, SHM_K = KVBLK * D * 2, SHM_ATTN = 2 * SHM_V + 2 * SHM_K + NW * 64 * 4;
using bf16x8 = __attribute__((ext_vector_type(8))) short;
using s16x4  = __attribute__((ext_vector_type(4))) short;
using f32x16 = __attribute__((ext_vector_type(16))) float;
using f32x8  = __attribute__((ext_vector_type(8))) float;
using u32x4  = __attribute__((ext_vector_type(4))) unsigned;
#define KSWZ(row, colB) ((row) * 256 + ((colB) ^ (((row) & 7) << 4)))
#define SBAR() __builtin_amdgcn_sched_barrier(0)
__device__ __forceinline__ int crow(int r, int hi) { return (r & 3) + 8 * (r >> 2) + 4 * hi; }
__device__ __forceinline__ unsigned cvtpk(float lo, float hi) {
  unsigned r; asm volatile("v_cvt_pk_bf16_f32 %0, %1, %2" : "=v"(r) : "v"(lo), "v"(hi)); return r;
}
template <typename TIn> struct Stage;
template <> struct Stage<bf16>  { using T = bf16x8;
  __device__ static __forceinline__ T ld8(const bf16* p) { return *reinterpret_cast<const bf16x8*>(p); }
  __device__ static __forceinline__ bf16x8 tobf(T x) { return x; } };
template <> struct Stage<float> { using T = f32x8;
  __device__ static __forceinline__ T ld8(const float* p) { return *reinterpret_cast<const f32x8*>(p); }
  __device__ static __forceinline__ bf16x8 tobf(T x) {
    u32x4 w = {cvtpk(x[0], x[1]), cvtpk(x[2], x[3]), cvtpk(x[4], x[5]), cvtpk(x[6], x[7])}; return *reinterpret_cast<bf16x8*>(&w); } };

__device__ __forceinline__ void partialSM(f32x16& p0, f32x16& p1, float& m_reg, float& mn, float& alpha) {
  constexpr float C = SCALE * 1.4426950408889634f;
  float pmax = p0[0]; for (int r = 1; r < 16; ++r) pmax = fmaxf(pmax, p0[r]); for (int r = 0; r < 16; ++r) pmax = fmaxf(pmax, p1[r]);
  { auto rr = __builtin_amdgcn_permlane32_swap(__float_as_uint(pmax), __float_as_uint(pmax), false, false);
    pmax = fmaxf(__uint_as_float(rr[0]), __uint_as_float(rr[1])); }
  if (__builtin_expect(__all(pmax - m_reg <= THR / SCALE), 1)) { mn = m_reg; alpha = 1.f; }
  else { mn = fmaxf(m_reg, pmax); alpha = __builtin_amdgcn_exp2f((m_reg - mn) * C); m_reg = mn; }
  float mnC = -mn * C;
  for (int r = 0; r < 16; ++r) p0[r] = fmaf(p0[r], C, mnC); for (int r = 0; r < 16; ++r) p1[r] = fmaf(p1[r], C, mnC);
  for (int r = 0; r < 16; ++r) p0[r] = __builtin_amdgcn_exp2f(p0[r]);
}
__device__ __forceinline__ void finishSM(f32x16& p0, f32x16& p1, float alpha, float& l_reg, bf16x8& pa0, bf16x8& pa1, bf16x8& pa2, bf16x8& pa3) {
  for (int r = 0; r < 16; ++r) p1[r] = __builtin_amdgcn_exp2f(p1[r]);
  float ps = 0; for (int r = 0; r < 16; ++r) ps += p0[r]; for (int r = 0; r < 16; ++r) ps += p1[r];
  { auto rr = __builtin_amdgcn_permlane32_swap(__float_as_uint(ps), __float_as_uint(ps), false, false);
    ps = __uint_as_float(rr[0]) + __uint_as_float(rr[1]); }
  l_reg = l_reg * alpha + ps;
#define PK4(P, BASE, OUT) do { unsigned a0 = cvtpk(P[BASE + 0], P[BASE + 1]), a1 = cvtpk(P[BASE + 2], P[BASE + 3]);   \
    unsigned b0 = cvtpk(P[BASE + 4], P[BASE + 5]), b1 = cvtpk(P[BASE + 6], P[BASE + 7]);                              \
    auto r0 = __builtin_amdgcn_permlane32_swap(a0, b0, false, false); auto r1 = __builtin_amdgcn_permlane32_swap(a1, b1, false, false); \
    u32x4 w = {r0[0], r1[0], r0[1], r1[1]}; OUT = *reinterpret_cast<bf16x8*>(&w); } while (0)
  PK4(p0, 0, pa0); PK4(p0, 8, pa1); PK4(p1, 0, pa2); PK4(p1, 8, pa3);
#undef PK4
}
__device__ __forceinline__ void qkt(f32x16& p0, f32x16& p1, const bf16* Ks, const bf16x8* qr, int r32, int hi) {
  p0 = f32x16{}; p1 = f32x16{};
  for (int d0 = 0; d0 < 8; ++d0) { int cb = (d0 * 16 + hi * 8) * 2;
    bf16x8 b0 = *reinterpret_cast<const bf16x8*>((const char*)Ks + KSWZ(r32, cb));
    bf16x8 b1 = *reinterpret_cast<const bf16x8*>((const char*)Ks + KSWZ(32 + r32, cb));
    p0 = __builtin_amdgcn_mfma_f32_32x32x16_bf16(b0, qr[d0], p0, 0, 0, 0);
    p1 = __builtin_amdgcn_mfma_f32_32x32x16_bf16(b1, qr[d0], p1, 0, 0, 0); }
}
__device__ __forceinline__ int v_st(int k, int c) { const int kk = (k & ~0xC) | ((k & 4) << 1) | ((k & 8) >> 1); return ((kk >> 3) * 4 + (c >> 5)) * 512 + ((kk & 7) * 32 + (c & 31)) * 2; }
__device__ __forceinline__ int v_rd_base(int lane) { return ((lane & 3) << 3) | (((lane >> 2) & 3) << 6) | (((lane >> 4) & 1) << 5) | (((lane >> 5) & 1) << 8); }
constexpr int v_rd_off(int d0, int ks, int half) { return d0 * 512 + ks * 4096 + half * 2048; }
template <int OFF> __device__ __forceinline__ s16x4 tr_read(int vb) {
  s16x4 r; asm volatile("ds_read_b64_tr_b16 %0, %1 offset:%2" : "=&v"(r) : "v"(vb), "i"(OFF) : "memory"); return r;
}
template <int D0> __device__ __forceinline__ void pv_one(f32x16& od, int vb, bf16x8 pa0, bf16x8 pa1, bf16x8 pa2, bf16x8 pa3) {
  const s16x4 l0 = tr_read<v_rd_off(D0, 0, 0)>(vb), h0 = tr_read<v_rd_off(D0, 0, 1)>(vb), l1 = tr_read<v_rd_off(D0, 1, 0)>(vb), h1 = tr_read<v_rd_off(D0, 1, 1)>(vb);
  const s16x4 l2 = tr_read<v_rd_off(D0, 2, 0)>(vb), h2 = tr_read<v_rd_off(D0, 2, 1)>(vb), l3 = tr_read<v_rd_off(D0, 3, 0)>(vb), h3 = tr_read<v_rd_off(D0, 3, 1)>(vb);
  asm volatile("s_waitcnt lgkmcnt(0)" ::: "memory"); SBAR();
#define PK(L, H) (bf16x8){L[0], L[1], L[2], L[3], H[0], H[1], H[2], H[3]}
  od = __builtin_amdgcn_mfma_f32_32x32x16_bf16(pa0, PK(l0, h0), od, 0, 0, 0);
  od = __builtin_amdgcn_mfma_f32_32x32x16_bf16(pa1, PK(l1, h1), od, 0, 0, 0);
  od = __builtin_amdgcn_mfma_f32_32x32x16_bf16(pa2, PK(l2, h2), od, 0, 0, 0);
  od = __builtin_amdgcn_mfma_f32_32x32x16_bf16(pa3, PK(l3, h3), od, 0, 0, 0);
#undef PK
}
__device__ __forceinline__ void pv_d0(f32x16* o, int vb, bf16x8 pa0, bf16x8 pa1, bf16x8 pa2, bf16x8 pa3) {
  pv_one<0>(o[0], vb, pa0, pa1, pa2, pa3); pv_one<1>(o[1], vb, pa0, pa1, pa2, pa3); pv_one<2>(o[2], vb, pa0, pa1, pa2, pa3); pv_one<3>(o[3], vb, pa0, pa1, pa2, pa3);
}

template <typename TQ>
__device__ __forceinline__ void attn_dense_body(const TQ* __restrict__ Qb, const bf16* __restrict__ Kh, const bf16* __restrict__ Vh,
                                                const unsigned short* __restrict__ Gb, unsigned short* __restrict__ Ob, int seq, char* lds) {
  using St = Stage<bf16>; using SQ = Stage<TQ>;
  const int tid = opaque_tid(), wid = tid >> 6, lane = tid & 63, r32 = lane & 31, hi = lane >> 5;
  bf16* V_lds = (bf16*)lds; bf16* K_lds = (bf16*)(lds + 2 * SHM_V);
  float* ws = (float*)(lds + 2 * SHM_V + 2 * SHM_K) + wid * 64; float* li_l = ws; float* al_l = ws + 32;
  float m_reg = -1e30f, l_reg = 0; f32x16 o[4] = {}; bf16x8 qr[8];
  const TQ* Qw = Qb + (long)(wid * QBLK + r32) * LDQ + hi * 8;
#pragma unroll
  for (int d0 = 0; d0 < 8; ++d0) qr[d0] = SQ::tobf(SQ::ld8(Qw + d0 * 16));
  const int sr = tid >> 4, sc = (tid & 15) * 8, vst0 = v_st(sr, sc), vst1 = v_st(32 + sr, sc);
  const int vb0 = (int)(uintptr_t)V_lds + v_rd_base(lane);
  struct { typename St::T vs0, vs1, ks0, ks1; } sr_[SDEPTH];
#define SLOAD(i, k0) do { sr_[i].vs0 = St::ld8(&Vh[(long)((k0) + sr) * LDK + sc]); sr_[i].vs1 = St::ld8(&Vh[(long)((k0) + 32 + sr) * LDK + sc]); \
    sr_[i].ks0 = St::ld8(&Kh[(long)((k0) + sr) * LDK + sc]); sr_[i].ks1 = St::ld8(&Kh[(long)((k0) + 32 + sr) * LDK + sc]); } while (0)
#define SWRITE(b, i) do { *(bf16x8*)((char*)V_lds + (b) * SHM_V + vst0) = St::tobf(sr_[i].vs0);          \
    *(bf16x8*)((char*)V_lds + (b) * SHM_V + vst1) = St::tobf(sr_[i].vs1); int kc = sc * 2;               \
    *(bf16x8*)((char*)K_lds + (b) * SHM_K + KSWZ(sr, kc)) = St::tobf(sr_[i].ks0);                       \
    *(bf16x8*)((char*)K_lds + (b) * SHM_K + KSWZ(32 + sr, kc)) = St::tobf(sr_[i].ks1); } while (0)
#define SWAIT() do { if constexpr (SDEPTH == 2) asm volatile("s_waitcnt vmcnt(4)" ::: "memory"); else asm volatile("s_waitcnt vmcnt(0)" ::: "memory"); } while (0)
#define RESC(a) do { if (__any((a) < 1.f)) { if (hi == 0) al_l[r32] = (a); asm volatile("s_waitcnt lgkmcnt(0)" ::: "memory"); \
    for (int d = 0; d < 4; ++d) for (int r = 0; r < 16; ++r) o[d][r] *= al_l[crow(r, hi)]; } } while (0)
  f32x16 pA0, pA1, pB0, pB1; float mnA, mnB, alA, alB; bf16x8 pa0, pa1, pa2, pa3; const int NT = seq / KVBLK;
  constexpr int SE = 0, SO = SDEPTH - 1;
  SLOAD(SE, 0); asm volatile("s_waitcnt vmcnt(0)" ::: "memory"); SWRITE(0, SE); __syncthreads();
  qkt(pA0, pA1, K_lds, qr, r32, hi); partialSM(pA0, pA1, m_reg, mnA, alA);
  SLOAD(SO, KVBLK); if constexpr (SDEPTH == 2) { if (2 < NT) SLOAD(SE, 2 * KVBLK); }
  SWAIT(); SWRITE(1, SO); __syncthreads();
  for (int j = 1; j + 1 < NT; j += 2) {
    SBAR(); qkt(pB0, pB1, (bf16*)((char*)K_lds + SHM_K), qr, r32, hi);
    finishSM(pA0, pA1, alA, l_reg, pa0, pa1, pa2, pa3); SBAR();
    SLOAD(SO, (j + SDEPTH) * KVBLK); SBAR();
    pv_d0(o, vb0, pa0, pa1, pa2, pa3); partialSM(pB0, pB1, m_reg, mnB, alB);
    __syncthreads(); SWAIT(); SWRITE(0, SE);
    RESC(alB); __syncthreads();
    SBAR(); qkt(pA0, pA1, K_lds, qr, r32, hi);
    finishSM(pB0, pB1, alB, l_reg, pa0, pa1, pa2, pa3); SBAR();
    if (SDEPTH == 1 || j + 3 < NT) SLOAD(SE, (j + 1 + SDEPTH) * KVBLK); SBAR();
    pv_d0(o, vb0 + (int)SHM_V, pa0, pa1, pa2, pa3); partialSM(pA0, pA1, m_reg, mnA, alA);
    __syncthreads(); SWAIT(); SWRITE(1, SO);
    RESC(alA); __syncthreads();
  }
  SBAR(); qkt(pB0, pB1, (bf16*)((char*)K_lds + SHM_K), qr, r32, hi);
  finishSM(pA0, pA1, alA, l_reg, pa0, pa1, pa2, pa3); SBAR();
  pv_d0(o, vb0, pa0, pa1, pa2, pa3); partialSM(pB0, pB1, m_reg, mnB, alB);
  __syncthreads(); RESC(alB);
  finishSM(pB0, pB1, alB, l_reg, pa0, pa1, pa2, pa3); SBAR();
  pv_d0(o, vb0 + (int)SHM_V, pa0, pa1, pa2, pa3);
  if (hi == 0) li_l[r32] = l_reg; asm volatile("s_waitcnt lgkmcnt(0)" ::: "memory");
  float rli[16];
#pragma unroll
  for (int r = 0; r < 16; ++r) rli[r] = __builtin_amdgcn_rcpf(li_l[crow(r, hi)]);
  unsigned short* Ow = Ob + (long)(wid * QBLK) * LDO + r32; const unsigned short* Gw = Gb + (long)(wid * QBLK) * LDQ + r32;
#pragma unroll
  for (int r = 0; r < 16; ++r) { const int orow = crow(r, hi);
    const unsigned short* gp = Gw + (long)orow * LDQ; unsigned short* op = Ow + (long)orow * LDO;
    float gv[4];
#pragma unroll
    for (int d0 = 0; d0 < 4; ++d0) gv[d0] = __uint_as_float(((unsigned)gp[d0 * 32]) << 16);
#pragma unroll
    for (int d0 = 0; d0 < 4; ++d0) {
      const float sg = gv[d0] * __builtin_amdgcn_rcpf(1.f + __builtin_amdgcn_exp2f(-1.4426950408889634f * gv[d0]));
      const float val = o[d0][r] * rli[r] * sg; unsigned u = __float_as_uint(val); u += 0x7fffu + ((u >> 16) & 1u);
      op[d0 * 32] = (unsigned short)(u >> 16); }
    asm volatile("" ::: "memory"); }
#undef SLOAD
#undef SWRITE
#undef SWAIT
#undef RESC
}
}

struct Args {
    const float *x, *c, *w_mod, *b_mod, *pool_w_in, *pool_w_grp, *pool_scale, *pool_w_out;
    const float *gla_w_in, *gla_fwd_w1, *gla_fwd_w2, *gla_fwd_b, *gla_bwd_w1, *gla_bwd_w2, *gla_bwd_b, *gla_norm_g, *gla_w_out;
    const float *attn_w_in, *attn_qg, *attn_kg, *attn_w_out, *final_g;
    float* out; unsigned char* ws;
};
#define LDS_WAIT() asm volatile("s_waitcnt lgkmcnt(0)" ::: "memory")

__device__ __forceinline__ void transpose_item(const float* W, int K, int N, bf16_t* WT, int row_off, LAS float* scr, int item, int lane) {
    const int nblk = N / 32, kb = item / nblk, nb = item % nblk, k0 = 64 * kb, n0 = 32 * nb;
#pragma unroll 8
    for (int i = 0; i < 32; ++i) { const int kk = 2 * i + (lane >> 5); scr[kk * 33 + (lane & 31)] = W[(size_t)(k0 + kk) * N + n0 + (lane & 31)]; }
    LDS_WAIT();
    const int c = lane & 7;
#pragma unroll
    for (int j = 0; j < 4; ++j) { const int n = (lane >> 3) + 8 * j; const LAS float* s = scr + (8 * c) * 33 + n;
        u32x4 o; o.x = cvt_pk_bf16(s[0 * 33], s[1 * 33]); o.y = cvt_pk_bf16(s[2 * 33], s[3 * 33]); o.z = cvt_pk_bf16(s[4 * 33], s[5 * 33]); o.w = cvt_pk_bf16(s[6 * 33], s[7 * 33]);
        *(u32x4*)(WT + (size_t)(row_off + n0 + n) * K + k0 + 8 * c) = o; }
    LDS_WAIT();
}
__device__ __forceinline__ void phase_weights(const Args& a, int L, LAS unsigned char* lds) {
    const int tid_ = opaque_tid(), lane = tid_ & 63, wave = __builtin_amdgcn_readfirstlane(tid_ >> 6), gw = blockIdx.x * 8 + wave, NGW = gridDim.x * 8; (void)wave; (void)gw; (void)NGW; (void)lane;
    LAS float* scr = (LAS float*)(lds + wave * 8704);
    bf16_t* WB = (bf16_t*)(a.ws + WS_WB); bf16_t* WBG = (bf16_t*)(a.ws + WS_WB + 16 * MiB); bf16_t* WBO = (bf16_t*)(a.ws + WS_WB + 24 * MiB);
    const int kind = L % 3, j = L / 3;
    if (kind == 0) {
        const float* win = a.pool_w_in + (size_t)j * 2048 * 4096; const float* wgrp = a.pool_w_grp + (size_t)j * 4 * 512 * 512; const float* wout = a.pool_w_out + (size_t)j * 2048 * 2048;
        constexpr int I_IN = 32 * 128, I_G = 8 * 16, I_OUT = 32 * 64;
        for (int it = gw; it < I_IN + 4 * I_G + I_OUT; it += NGW) {
            int r = it;
            if (r < I_IN) { transpose_item(win, 2048, 4096, WB, 0, scr, r, lane); continue; } r -= I_IN;
            if (r < 4 * I_G) { const int g = r / I_G; transpose_item(wgrp + (size_t)g * 512 * 512, 512, 512, WBG, g * 512, scr, r % I_G, lane); continue; } r -= 4 * I_G;
            transpose_item(wout, 2048, 2048, WBO, 0, scr, r, lane);
        }
    } else if (kind == 1) {
        constexpr int I_IN = 32 * 192, I_OUT = 32 * 64;
        for (int it = gw; it < I_IN + I_OUT; it += NGW) {
            int r = it;
            if (r < I_IN) { transpose_item(a.gla_w_in, 2048, 6144, WB, 0, scr, r, lane); continue; } r -= I_IN;
            transpose_item(a.gla_w_out, 2048, 2048, WBO, 0, scr, r, lane);
        }
        bf16_t* W1T = (bf16_t*)(a.ws + WS_W1T);
        for (int i = gw * 64 + lane; i < 32 * 2048; i += NGW * 64) { const int n = i >> 11, k = i & 2047;
            W1T[i] = f2bf(n < 16 ? a.gla_fwd_w1[k * 16 + n] : a.gla_bwd_w1[k * 16 + n - 16]); }
    } else {
        constexpr int I_IN = 32 * 160, I_OUT = 32 * 64;
        for (int it = gw; it < I_IN + I_OUT; it += NGW) {
            int r = it;
            if (r < I_IN) { transpose_item(a.attn_w_in, 2048, 5120, WB, 0, scr, r, lane); continue; } r -= I_IN;
            transpose_item(a.attn_w_out, 2048, 2048, WBO, 0, scr, r, lane);
        }
    }
}
__device__ __forceinline__ void phase_norm_mod(const float* x, const float* modL, bf16_t* hb) {
    const int tid_ = opaque_tid(), lane = tid_ & 63, wave = __builtin_amdgcn_readfirstlane(tid_ >> 6), gw = blockIdx.x * 8 + wave, NGW = gridDim.x * 8;
    for (int m = gw; m < MTOK; m += 2 * NGW) {
        f32x4 v[2][8]; float s[2];
#pragma unroll
        for (int r = 0; r < 2; ++r) { const f32x4* xr = (const f32x4*)(x + (size_t)(m + r * NGW) * DM) + lane;
#pragma unroll
            for (int j = 0; j < 8; ++j) v[r][j] = xr[64 * j]; }
#pragma unroll
        for (int r = 0; r < 2; ++r) { float t = 0.f;
#pragma unroll
            for (int j = 0; j < 8; ++j) t += (v[r][j].x * v[r][j].x + v[r][j].y * v[r][j].y) + (v[r][j].z * v[r][j].z + v[r][j].w * v[r][j].w);
            s[r] = t; }
#pragma unroll
        for (int r = 0; r < 2; ++r) { const int mm = m + r * NGW;
            const float rstd = __builtin_amdgcn_rsqf(wave_sum(s[r]) * (1.f / DM) + NEPS);
            const float* mp = modL + (size_t)(mm / SEQ) * 6144;
            u32x2* o8 = (u32x2*)(hb + (size_t)mm * DM) + lane;
#pragma unroll
            for (int j = 0; j < 8; ++j) { const f32x4 sh = *((const f32x4*)mp + lane + 64 * j), sc = *((const f32x4*)(mp + 2048) + lane + 64 * j);
                const f32x4 h = v[r][j] * rstd * (sc + 1.f) + sh; u32x2 w; w.x = cvt_pk_bf16(h.x, h.y); w.y = cvt_pk_bf16(h.z, h.w); o8[64 * j] = w; } }
    }
}
__device__ __forceinline__ void phase_final_norm(float* x, const float* g) {
    const int tid_ = opaque_tid(), lane = tid_ & 63, wave = __builtin_amdgcn_readfirstlane(tid_ >> 6), gw = blockIdx.x * 8 + wave, NGW = gridDim.x * 8;
    for (int m = gw; m < MTOK; m += 2 * NGW) {
        f32x4 v[2][8]; float s[2];
#pragma unroll
        for (int r = 0; r < 2; ++r) { const f32x4* xr = (const f32x4*)(x + (size_t)(m + r * NGW) * DM) + lane;
#pragma unroll
            for (int j = 0; j < 8; ++j) v[r][j] = xr[64 * j]; }
#pragma unroll
        for (int r = 0; r < 2; ++r) { float t = 0.f;
#pragma unroll
            for (int j = 0; j < 8; ++j) t += (v[r][j].x * v[r][j].x + v[r][j].y * v[r][j].y) + (v[r][j].z * v[r][j].z + v[r][j].w * v[r][j].w);
            s[r] = t; }
#pragma unroll
        for (int r = 0; r < 2; ++r) { f32x4* xr = (f32x4*)(x + (size_t)(m + r * NGW) * DM) + lane;
            const float rstd = __builtin_amdgcn_rsqf(wave_sum(s[r]) * (1.f / DM) + NEPS);
#pragma unroll
            for (int j = 0; j < 8; ++j) { const f32x4 gg = *((const f32x4*)g + lane + 64 * j); xr[64 * j] = v[r][j] * rstd * gg; } }
    }
}
__device__ __forceinline__ void phase_mod(const Args& a, LAS unsigned char* lds, float* mod) {
    LAS float* sc = (LAS float*)lds; LAS float* part = (LAS float*)(lds + 32768);
    const int tid = opaque_tid();
    if ((int)blockIdx.x >= 192) return;
    for (int i = tid; i < 8192; i += 512) sc[i] = silu_f(a.c[i]);
    __syncthreads();
    for (int item = blockIdx.x; item < 192; item += gridDim.x) {
        const int layer = item / 48, n0 = (item % 48) * 128, ks = tid >> 5, cq = tid & 31;
        f32x4 acc[4];
#pragma unroll
        for (int b = 0; b < 4; ++b) acc[b] = (f32x4){0.f, 0.f, 0.f, 0.f};
        const float* wp = a.w_mod + ((size_t)layer * 2048 + ks * 128) * 6144 + n0 + cq * 4;
#pragma unroll 8
        for (int k = 0; k < 128; ++k) { const f32x4 w = *(const f32x4*)(wp + (size_t)k * 6144); const int kk = ks * 128 + k;
#pragma unroll
            for (int b = 0; b < 4; ++b) acc[b] += w * sc[b * 2048 + kk]; }
#pragma unroll
        for (int b = 0; b < 4; ++b) *(LAS f32x4*)(part + (ks * 4 + b) * 128 + cq * 4) = acc[b];
        __syncthreads();
        { const int b = tid >> 7, col = tid & 127; float s = a.b_mod[layer * 6144 + n0 + col];
#pragma unroll
          for (int q = 0; q < 16; ++q) s += part[(q * 4 + b) * 128 + col];
          mod[(size_t)(layer * 4 + b) * 6144 + n0 + col] = s; }
        __syncthreads();
    }
}
__device__ __forceinline__ void phase_rope_table(float* rc, float* rs) {
    for (int idx = blockIdx.x * 512 + opaque_tid(); idx < SEQ * 64; idx += gridDim.x * 512) {
        const int t = idx >> 6, i = idx & 63;
        const float pos = (i < 32) ? (float)((t >> 6) - 64) : (float)((t & 63) - 32);
        const float inv = __builtin_amdgcn_exp2f(-(float)(i & 31) * 0.41524101186092029f);
        const float ang = pos * inv;
        const double xd = (double)ang; const double n = __builtin_rint(xd * 0.63661977236758134); const float rf = (float)(xd - n * 1.5707963267948966);
        const int q = ((int)n) & 3; const float r2 = rf * rf;
        const float sn = rf + rf * r2 * (-1.6666667e-1f + r2 * (8.3333333e-3f + r2 * (-1.9841270e-4f + r2 * 2.7557319e-6f)));
        const float cs = 1.f + r2 * (-0.5f + r2 * (4.1666667e-2f + r2 * (-1.3888889e-3f + r2 * (2.4801587e-5f + r2 * -2.7557319e-7f))));
        const float co = (q == 0) ? cs : (q == 1) ? -sn : (q == 2) ? -cs : sn;
        const float si = (q == 0) ? sn : (q == 1) ? cs : (q == 2) ? -sn : -cs;
        rc[idx] = co; rs[idx] = si;
    }
}
__device__ __forceinline__ void acc8(float (&s)[8], const u32x4 w, const float f) {
    s[0] += f * bf_lo(w.x); s[1] += f * bf_hi(w.x); s[2] += f * bf_lo(w.y); s[3] += f * bf_hi(w.y); s[4] += f * bf_lo(w.z); s[5] += f * bf_hi(w.z); s[6] += f * bf_lo(w.w); s[7] += f * bf_hi(w.w); }
__device__ __forceinline__ void phase_pool(const bf16_t* proj  , bf16_t* pooled) {
    const int tid_ = opaque_tid(), lane = tid_ & 63, wave = __builtin_amdgcn_readfirstlane(tid_ >> 6), gw = blockIdx.x * 8 + wave, NGW = gridDim.x * 8;
    for (int unit = gw; unit < (MTOK / 64) * 4; unit += NGW) {
        const int run = unit >> 2, j = unit & 3, half = 1 << j, m0 = run * 64, t0 = m0 & (SEQ - 1), c = (j * 64 + lane) * 8;
        const bf16_t* base = proj + (size_t)(m0 - t0) * 4096 + c; bf16_t* outp = pooled + (size_t)(m0 - t0) * 2048 + c;
        float S[8];
#pragma unroll
        for (int q = 0; q < 8; ++q) S[q] = 0.f;
        { const int lo = (t0 - half) > 0 ? (t0 - half) : 0, hi = (t0 + half) < SEQ ? (t0 + half) : SEQ;
          for (int r = lo; r < hi; ++r) acc8(S, *(const u32x4*)(base + (size_t)r * 4096), 1.f); }
#pragma unroll 4
        for (int tt = 0; tt < 64; ++tt) {
            const int t = t0 + tt, lo = (t - half) > 0 ? (t - half) : 0, hi = (t + half) < SEQ ? (t + half) : SEQ;
            const int ra = (t + half) < SEQ ? (t + half) : (SEQ - 1), rs = (t - half) > 0 ? (t - half) : 0;
            const float fa = (t + half) < SEQ ? 1.f : 0.f, fs = (t - half) >= 0 ? -1.f : 0.f;
            const u32x4 u = *(const u32x4*)(base + (size_t)t * 4096), wa = *(const u32x4*)(base + (size_t)ra * 4096), ws = *(const u32x4*)(base + (size_t)rs * 4096);
            const float ic = 1.f / (float)(hi - lo);
            u32x4 o; o.x = cvt_pk_bf16(S[0] * ic - bf_lo(u.x), S[1] * ic - bf_hi(u.x)); o.y = cvt_pk_bf16(S[2] * ic - bf_lo(u.y), S[3] * ic - bf_hi(u.y));
            o.z = cvt_pk_bf16(S[4] * ic - bf_lo(u.z), S[5] * ic - bf_hi(u.z)); o.w = cvt_pk_bf16(S[6] * ic - bf_lo(u.w), S[7] * ic - bf_hi(u.w));
            *(u32x4*)(outp + (size_t)t * 2048) = o;
            acc8(S, wa, fa); acc8(S, ws, fs);
        }
    }
}
__device__ __forceinline__ void phase_qknorm_rope(bf16_t* proj, const float* qg, const float* kg, const float* rc, const float* rs) {
    const int tid_ = opaque_tid(), lane = tid_ & 63, wave = __builtin_amdgcn_readfirstlane(tid_ >> 6), gw = blockIdx.x * 8 + wave, NGW = gridDim.x * 8;
    const float q0 = qg[2 * lane], q1 = qg[2 * lane + 1], k0 = kg[2 * lane], k1 = kg[2 * lane + 1];
    for (int m = gw; m < MTOK; m += 2 * NGW) {
        unsigned w[2][20]; float co[2], si[2];
#pragma unroll
        for (int r = 0; r < 2; ++r) { const int mm = m + r * NGW, t = mm & (SEQ - 1); co[r] = rc[t * 64 + lane]; si[r] = rs[t * 64 + lane];
            const unsigned* row = (const unsigned*)(proj + (size_t)mm * 5120) + lane;
#pragma unroll
            for (int h = 0; h < 20; ++h) w[r][h] = row[h * 64]; }
#pragma unroll
        for (int r = 0; r < 2; ++r) { unsigned* row = (unsigned*)(proj + (size_t)(m + r * NGW) * 5120) + lane;
#pragma unroll
            for (int h = 0; h < 20; ++h) {
                const float x0 = bf_lo(w[r][h]), x1 = bf_hi(w[r][h]);
                const float rstd = __builtin_amdgcn_rsqf(wave_sum(x0 * x0 + x1 * x1) * (1.f / 128.f) + NEPS);
                const float y0 = x0 * rstd * (h < 16 ? q0 : k0), y1 = x1 * rstd * (h < 16 ? q1 : k1);
                row[h * 64] = cvt_pk_bf16(y0 * co[r] - y1 * si[r], y0 * si[r] + y1 * co[r]);
            } }
    }
}

__device__ __forceinline__ f32x4 mfma16(bf16x8 x, bf16x8 y, f32x4 acc) { return __builtin_amdgcn_mfma_f32_16x16x32_bf16(x, y, acc, 0, 0, 0); }

__device__ __forceinline__ void phase_gla_lowrank(const bf16_t* hb, const bf16_t* w1t, float* R) {
    const int tid_ = opaque_tid(), lane = tid_ & 63, wave = __builtin_amdgcn_readfirstlane(tid_ >> 6), gw = blockIdx.x * 8 + wave, NGW = gridDim.x * 8; (void)wave; (void)gw; (void)NGW; (void)lane;
    const int fr = lane & 15, fq = lane >> 4;
    for (int u = gw; u < MTOK / 16; u += NGW) {
        const bf16_t* ap = hb + (size_t)(u * 16 + fr) * 2048 + fq * 8; const bf16_t* wp = w1t + (size_t)fr * 2048 + fq * 8;
        f32x4 acc0 = (f32x4){0.f, 0.f, 0.f, 0.f}, acc1 = acc0;
#pragma unroll 8
        for (int ks = 0; ks < 64; ++ks) { const bf16x8 av = *(const bf16x8*)(ap + ks * 32);
            acc0 = mfma16(*(const bf16x8*)(wp + ks * 32), av, acc0); acc1 = mfma16(*(const bf16x8*)(wp + 16 * 2048 + ks * 32), av, acc1); }
        float* rp = R + (size_t)(u * 16 + fr) * 32 + 4 * fq;
        *(f32x4*)rp = acc0; *(f32x4*)(rp + 16) = acc1;
    }
}
__device__ __forceinline__ bf16_t f2bf1(float v) { return (bf16_t)(cvt_pk_bf16(v, 0.f) & 0xffffu); }
template <int dir> __device__ __forceinline__ void gla_prep_body(const Args& a, LAS unsigned char* lds, const int tid) {
    constexpr int G1_QI = 8192, G1_KI = 8192 + 32768, G1_OUT = 8192 + 65536;
    LAS float* rl = (LAS float*)lds;
    const LAS bf16_t* qi = (const LAS bf16_t*)(lds + G1_QI); const LAS bf16_t* ki = (const LAS bf16_t*)(lds + G1_KI); LAS bf16_t* ob = (LAS bf16_t*)(lds + G1_OUT);
    const int d = tid & 255;
    const bf16_t* proj = (const bf16_t*)(a.ws + WS_PROJ); const float* R = (const float*)(a.ws + WS_R); float* DL = (float*)(a.ws + WS_DL);
    bf16_t* QT = (bf16_t*)(a.ws + WS_QKK); bf16_t* KT = (bf16_t*)(a.ws + WS_QKK + 128 * MiB); bf16_t* KH = (bf16_t*)(a.ws + WS_QKK + 256 * MiB);
    const float* w2 = dir ? a.gla_bwd_w2 : a.gla_fwd_w2; const float* bs = dir ? a.gla_bwd_b : a.gla_fwd_b;
    u32x4 pq[4], pk[4]; f32x4 pr;
    const unsigned ltoff = ((unsigned)(tid >> 5) * 6144u + (unsigned)(tid & 31) * 8u) * 2u, stoff = ((unsigned)(tid >> 5) * 1024u + (unsigned)(tid & 31) * 8u) * 2u;
#define G1_LOAD(u_) do { const int b_ = (u_) >> 9, cc_ = ((u_) >> 2) & 127, h_ = (u_) & 3; const size_t tok0_ = (size_t)b_ * SEQ + cc_ * 64; \
        _Pragma("unroll") for (int i_ = 0; i_ < 4; ++i_) { const char* p_ = (const char*)(proj + (tok0_ + 16 * i_) * 6144 + h_ * 256); pq[i_] = *(const u32x4*)(p_ + ltoff); pk[i_] = *(const u32x4*)(p_ + 2048 + ltoff); } \
        pr = *(const f32x4*)(R + tok0_ * 32 + tid * 4); } while (0)
    for (int u = blockIdx.x; u < 2048; u += gridDim.x) {
        G1_LOAD(u);
        const int b = u >> 9, cc = (u >> 2) & 127, h = u & 3, col = h * 256 + d; const size_t tok0 = (size_t)b * SEQ + cc * 64;
#pragma unroll
        for (int i = 0; i < 4; ++i) { const int idx = tid + 512 * i; *(LAS u32x4*)(lds + G1_QI + idx * 16) = pq[i]; *(LAS u32x4*)(lds + G1_KI + idx * 16) = pk[i]; }
        *(LAS f32x4*)(rl + tid * 4) = pr;
        float w2c[16];
#pragma unroll
        for (int c = 0; c < 16; ++c) w2c[c] = w2[c * 1024 + col];
        const float bias = bs[col];
        __syncthreads();
        float eb[64]; float run = 0.f;
#pragma unroll
        for (int i = 0; i < 64; ++i) { const int t = dir ? 63 - i : i; float z = bias;
#pragma unroll
            for (int c4 = 0; c4 < 4; ++c4) { const f32x4 rv = *(const LAS f32x4*)(rl + t * 32 + dir * 16 + c4 * 4);
                z += rv.x * w2c[c4 * 4] + rv.y * w2c[c4 * 4 + 1] + rv.z * w2c[c4 * 4 + 2] + rv.w * w2c[c4 * 4 + 3]; }
            const float ls = fminf(z, 0.f) - __logf(1.f + __expf(-fabsf(z)));
            run += ls * 0.0625f; eb[i] = __expf(run); if ((i & 3) == 3) asm volatile("" ::: "memory"); }
        const float ebl = eb[63];
#pragma unroll
        for (int i = 0; i < 64; ++i) { const int t = dir ? 63 - i : i; ob[(dir * 64 + t) * 256 + d] = f2bf1(bf2f(qi[t * 256 + d]) * 0.0625f * eb[i]); if ((i & 7) == 7) asm volatile("" ::: "memory"); }
        __syncthreads();
#pragma unroll
        for (int i = 0; i < 8; ++i) { char* p = (char*)(QT + (size_t)(i >> 2) * MTOK * 1024 + (tok0 + 16 * (i & 3)) * 1024 + h * 256);
            *(u32x4*)(p + stoff) = *(const LAS u32x4*)(lds + G1_OUT + (tid + 512 * i) * 16); }
        __syncthreads();
        bf16_t* khp = KH + ((((size_t)dir * 4 + b) * 128 + cc) * 4 + h) * (256 * 64) + (size_t)d * 64;
#pragma unroll
        for (int gi = 0; gi < 8; ++gi) {
            float kh[8];
#pragma unroll
            for (int q = 0; q < 8; ++q) { const int i = gi * 8 + q, t = dir ? 63 - i : i;
                const float ktv = bf2f(ki[t * 256 + d]) * __builtin_amdgcn_rcpf(eb[i]);
                ob[(dir * 64 + t) * 256 + d] = f2bf1(ktv); kh[q] = ktv * ebl; }
            u32x4 o;
            if (dir) { o.x = cvt_pk_bf16(kh[7], kh[6]); o.y = cvt_pk_bf16(kh[5], kh[4]); o.z = cvt_pk_bf16(kh[3], kh[2]); o.w = cvt_pk_bf16(kh[1], kh[0]); }
            else     { o.x = cvt_pk_bf16(kh[0], kh[1]); o.y = cvt_pk_bf16(kh[2], kh[3]); o.z = cvt_pk_bf16(kh[4], kh[5]); o.w = cvt_pk_bf16(kh[6], kh[7]); }
            *(u32x4*)(khp + (dir ? 56 - gi * 8 : gi * 8)) = o;
            asm volatile("" ::: "memory");
        }
        DL[(((size_t)dir * 4 + b) * 128 + cc) * 1024 + col] = ebl;
        __syncthreads();
#pragma unroll
        for (int i = 0; i < 8; ++i) { char* p = (char*)(KT + (size_t)(i >> 2) * MTOK * 1024 + (tok0 + 16 * (i & 3)) * 1024 + h * 256);
            *(u32x4*)(p + stoff) = *(const LAS u32x4*)(lds + G1_OUT + (tid + 512 * i) * 16); }
        __syncthreads();
    }
#undef G1_LOAD
}
__device__ __forceinline__ void phase_gla_prep(const Args& a, LAS unsigned char* lds) {
    const int tid = opaque_tid();
    if (__builtin_amdgcn_readfirstlane(tid >> 8)) gla_prep_body<1>(a, lds, tid); else gla_prep_body<0>(a, lds, tid);
}
constexpr int SC_PQ = 528, SC_PS = 144;
constexpr int SC_QT = 0, SC_KT = SC_QT + 64 * SC_PQ, SC_KH = SC_KT + 64 * SC_PQ, SC_VT = SC_KH + 256 * SC_PS, SC_ST = SC_VT + 64 * SC_PS, SC_AM = SC_ST + 64 * SC_PQ, SC_DL = SC_AM + 64 * SC_PS, SC_END = SC_DL + 1024;
__device__ __forceinline__ bf16x8 frag(const LAS unsigned char* base, int pitch, int row, int ks, int fq) { return *(const LAS bf16x8*)(base + row * pitch + ks * 64 + fq * 16); }
__device__ __forceinline__ void phase_gla_scan(const Args& a, LAS unsigned char* lds) {
    const int tid = opaque_tid(), wave = __builtin_amdgcn_readfirstlane(tid >> 6), lane = tid & 63, fr = lane & 15, fq = lane >> 4;
    const bf16_t* proj = (const bf16_t*)(a.ws + WS_PROJ); const float* DLg = (const float*)(a.ws + WS_DL);
    for (int item = blockIdx.x; item < 256; item += gridDim.x) {
        const int xcd = item & 7, jj = item >> 3, bhd = xcd * 4 + (jj >> 3), es = jj & 7, b = bhd >> 3, h = (bhd >> 1) & 3, dir = bhd & 1;
        const bf16_t* QT = (const bf16_t*)(a.ws + WS_QKK) + (size_t)dir * MTOK * 1024 + h * 256;
        const bf16_t* KT = (const bf16_t*)(a.ws + WS_QKK + 128 * MiB) + (size_t)dir * MTOK * 1024 + h * 256;
        const bf16_t* KH = (const bf16_t*)(a.ws + WS_QKK + 256 * MiB);
        const bf16_t* V = proj + 2048 + h * 512 + es * 64;
        bf16_t* O = dir ? ((bf16_t*)(a.ws + WS_PROJ) + h * 512 + es * 64) : ((bf16_t*)(a.ws + WS_HB) + h * 512 + es * 64); const int ldo = dir ? 6144 : 2048;
        for (int i = tid; i < 64 * SC_PQ / 16; i += 512) *(LAS u32x4*)(lds + SC_ST + i * 16) = (u32x4){0u, 0u, 0u, 0u};
        f32x4 S[2][4];
#pragma unroll
        for (int i = 0; i < 2; ++i)
#pragma unroll
            for (int j = 0; j < 4; ++j) S[i][j] = (f32x4){0.f, 0.f, 0.f, 0.f};
        u32x4 rq[4], rk[4], rkh[4], rv; f32x4 rdl = (f32x4){0.f, 0.f, 0.f, 0.f};
#define SC_LOAD(c) do { const int cc_ = dir ? 127 - (c) : (c); const size_t tok0_ = (size_t)b * SEQ + cc_ * 64; \
        _Pragma("unroll") for (int i_ = 0; i_ < 4; ++i_) { const int idx_ = tid + 512 * i_; rq[i_] = *(const u32x4*)(QT + (tok0_ + (idx_ >> 5)) * 1024 + (idx_ & 31) * 8); rk[i_] = *(const u32x4*)(KT + (tok0_ + (idx_ >> 5)) * 1024 + (idx_ & 31) * 8); } \
        const bf16_t* khc_ = KH + ((((size_t)dir * 4 + b) * 128 + cc_) * 4 + h) * (256 * 64); \
        _Pragma("unroll") for (int i_ = 0; i_ < 4; ++i_) rkh[i_] = *(const u32x4*)(khc_ + (size_t)(tid + 512 * i_) * 8); \
        rv = *(const u32x4*)(V + (tok0_ + (tid >> 3)) * 6144 + (tid & 7) * 8); \
        if (tid < 64) rdl = *(const f32x4*)(DLg + (((size_t)dir * 4 + b) * 128 + cc_) * 1024 + h * 256 + tid * 4); } while (0)
        SC_LOAD(0);
        for (int c = 0; c < 128; ++c) {
            const int cc = dir ? 127 - c : c; const size_t tok0 = (size_t)b * SEQ + cc * 64;
#pragma unroll
            for (int i = 0; i < 4; ++i) { const int idx = tid + 512 * i; *(LAS u32x4*)(lds + SC_QT + (idx >> 5) * SC_PQ + (idx & 31) * 16) = rq[i]; *(LAS u32x4*)(lds + SC_KT + (idx >> 5) * SC_PQ + (idx & 31) * 16) = rk[i];
                *(LAS u32x4*)(lds + SC_KH + (idx >> 3) * SC_PS + (idx & 7) * 16) = rkh[i]; }
            { LAS bf16_t* vt = (LAS bf16_t*)(lds + SC_VT) + ((tid & 7) * 8) * (SC_PS / 2) + (tid >> 3);
              vt[0 * (SC_PS / 2)] = (bf16_t)(rv.x & 0xffffu); vt[1 * (SC_PS / 2)] = (bf16_t)(rv.x >> 16); vt[2 * (SC_PS / 2)] = (bf16_t)(rv.y & 0xffffu); vt[3 * (SC_PS / 2)] = (bf16_t)(rv.y >> 16);
              vt[4 * (SC_PS / 2)] = (bf16_t)(rv.z & 0xffffu); vt[5 * (SC_PS / 2)] = (bf16_t)(rv.z >> 16); vt[6 * (SC_PS / 2)] = (bf16_t)(rv.w & 0xffffu); vt[7 * (SC_PS / 2)] = (bf16_t)(rv.w >> 16); }
            if (tid < 64) *(LAS f32x4*)(lds + SC_DL + tid * 16) = rdl;
            __syncthreads();
            if (c + 1 < 128) SC_LOAD(c + 1);
            const int it = wave >> 1, et0 = (wave & 1) * 2;
            f32x4 oacc[2], am[2];
#pragma unroll
            for (int n = 0; n < 2; ++n) { oacc[n] = (f32x4){0.f, 0.f, 0.f, 0.f}; am[n] = (f32x4){0.f, 0.f, 0.f, 0.f}; }
#pragma unroll
            for (int ks = 0; ks < 8; ++ks) { const bf16x8 fqt = frag(lds + SC_QT, SC_PQ, it * 16 + fr, ks, fq);
#pragma unroll
                for (int n = 0; n < 2; ++n) { oacc[n] = mfma16(frag(lds + SC_ST, SC_PQ, (et0 + n) * 16 + fr, ks, fq), fqt, oacc[n]);
                                              am[n] = mfma16(frag(lds + SC_KT, SC_PQ, (et0 + n) * 16 + fr, ks, fq), fqt, am[n]); } }
#pragma unroll
            for (int n = 0; n < 2; ++n) { const int i = it * 16 + fr, j0 = (et0 + n) * 16 + 4 * fq; float v[4];
#pragma unroll
                for (int r = 0; r < 4; ++r) { const int j = j0 + r; const bool keep = dir ? (j > i) : (j <= i); v[r] = keep ? am[n][r] : 0.f; }
                u32x2 w; w.x = cvt_pk_bf16(v[0], v[1]); w.y = cvt_pk_bf16(v[2], v[3]); *(LAS u32x2*)(lds + SC_AM + i * SC_PS + j0 * 2) = w; }
            __syncthreads();
#pragma unroll
            for (int ks = 0; ks < 2; ++ks) { const bf16x8 fa = frag(lds + SC_AM, SC_PS, it * 16 + fr, ks, fq);
#pragma unroll
                for (int n = 0; n < 2; ++n) oacc[n] = mfma16(frag(lds + SC_VT, SC_PS, (et0 + n) * 16 + fr, ks, fq), fa, oacc[n]); }
#pragma unroll
            for (int n = 0; n < 2; ++n) { u32x2 w; w.x = cvt_pk_bf16(oacc[n][0], oacc[n][1]); w.y = cvt_pk_bf16(oacc[n][2], oacc[n][3]);
                *(u32x2*)(O + (tok0 + it * 16 + fr) * ldo + (et0 + n) * 16 + 4 * fq) = w; }
#pragma unroll
            for (int i = 0; i < 2; ++i) { const f32x4 dl4 = *(const LAS f32x4*)(lds + SC_DL + ((wave * 2 + i) * 16 + 4 * fq) * 4);
#pragma unroll
                for (int j = 0; j < 4; ++j) S[i][j] *= dl4; }
#pragma unroll
            for (int ks = 0; ks < 2; ++ks) {
                bf16x8 fv[4];
#pragma unroll
                for (int j = 0; j < 4; ++j) fv[j] = frag(lds + SC_VT, SC_PS, j * 16 + fr, ks, fq);
#pragma unroll
                for (int i = 0; i < 2; ++i) { const bf16x8 fk = frag(lds + SC_KH, SC_PS, (wave * 2 + i) * 16 + fr, ks, fq);
#pragma unroll
                    for (int j = 0; j < 4; ++j) S[i][j] = mfma16(fk, fv[j], S[i][j]); } }
            __syncthreads();
#pragma unroll
            for (int i = 0; i < 2; ++i)
#pragma unroll
                for (int j = 0; j < 4; ++j) { u32x2 w; w.x = cvt_pk_bf16(S[i][j][0], S[i][j][1]); w.y = cvt_pk_bf16(S[i][j][2], S[i][j][3]);
                    *(LAS u32x2*)(lds + SC_ST + (j * 16 + fr) * SC_PQ + ((wave * 2 + i) * 16 + 4 * fq) * 2) = w; }
        }
        __syncthreads();
#undef SC_LOAD
    }
}
__device__ __forceinline__ void phase_gla_post(bf16_t* hb, const bf16_t* proj, const float* ng) {
    const int tid_ = opaque_tid(), lane = tid_ & 63, wave = __builtin_amdgcn_readfirstlane(tid_ >> 6), gw = blockIdx.x * 8 + wave, NGW = gridDim.x * 8;
    float g8[8];
#pragma unroll
    for (int q = 0; q < 8; ++q) g8[q] = ng[lane * 8 + q];
    for (int m = gw; m < MTOK; m += 2 * NGW) {
        u32x4 wf[2][4], wb[2][4], wg[2][4];
#pragma unroll
        for (int r = 0; r < 2; ++r) { const size_t mm = (size_t)(m + r * NGW);
#pragma unroll
            for (int hh = 0; hh < 4; ++hh) { const int c = hh * 512 + lane * 8;
                wf[r][hh] = *(const u32x4*)(hb + mm * 2048 + c); wb[r][hh] = *(const u32x4*)(proj + mm * 6144 + c); wg[r][hh] = *(const u32x4*)(proj + mm * 6144 + 4096 + c); } }
#pragma unroll
        for (int r = 0; r < 2; ++r) { const size_t mm = (size_t)(m + r * NGW);
#pragma unroll
            for (int hh = 0; hh < 4; ++hh) { const int c = hh * 512 + lane * 8; const u32x4 f = wf[r][hh], bk = wb[r][hh], gg = wg[r][hh];
                float o[8] = {bf_lo(f.x) + bf_lo(bk.x), bf_hi(f.x) + bf_hi(bk.x), bf_lo(f.y) + bf_lo(bk.y), bf_hi(f.y) + bf_hi(bk.y), bf_lo(f.z) + bf_lo(bk.z), bf_hi(f.z) + bf_hi(bk.z), bf_lo(f.w) + bf_lo(bk.w), bf_hi(f.w) + bf_hi(bk.w)};
                const float g[8] = {bf_lo(gg.x), bf_hi(gg.x), bf_lo(gg.y), bf_hi(gg.y), bf_lo(gg.z), bf_hi(gg.z), bf_lo(gg.w), bf_hi(gg.w)};
                float s = 0.f;
#pragma unroll
                for (int q = 0; q < 8; ++q) s += o[q] * o[q];
                const float rstd = __builtin_amdgcn_rsqf(wave_sum(s) * (1.f / 512.f) + NEPS);
#pragma unroll
                for (int q = 0; q < 8; ++q) o[q] = o[q] * rstd * g8[q] * silu_f(g[q]);
                u32x4 w; w.x = cvt_pk_bf16(o[0], o[1]); w.y = cvt_pk_bf16(o[2], o[3]); w.z = cvt_pk_bf16(o[4], o[5]); w.w = cvt_pk_bf16(o[6], o[7]);
                *(u32x4*)(hb + mm * 2048 + c) = w; } }
    }
}

#define RLX_AGENT __ATOMIC_RELAXED, __HIP_MEMORY_SCOPE_AGENT
#define XB_TMO      128
#define XB_XCNT(j)  (256  + 64 * (j))
#define XB_XSUB(j)  (1280 + 64 * (j))
#define XB_XGEN(j)  (2304 + 64 * (j))
#define XB_TOP      3328
#define XB_TOPGEN   3392
#define XCD_BAR_WORDS 3456
#define XB_SPIN_CAP (1u << 18)

__device__ __forceinline__ unsigned xb_ld(unsigned* p)              { return __hip_atomic_load(p, __ATOMIC_RELAXED, __HIP_MEMORY_SCOPE_AGENT); }
__device__ __forceinline__ unsigned xb_add(unsigned* p, unsigned v) { return __hip_atomic_fetch_add(p, v, __ATOMIC_RELAXED, __HIP_MEMORY_SCOPE_AGENT); }
__device__ __forceinline__ unsigned xb_xcc_id() { return (unsigned)__builtin_amdgcn_s_getreg((3 << 11) | 20) & 0xFu; }
#define XB_SPIN(cond, bar) do { unsigned _sp = 0; while (cond) { __builtin_amdgcn_s_sleep(1); \
    if ((++_sp & 255u) == 0u) { if (xb_ld(&(bar)[XB_TMO])) break; if (_sp > XB_SPIN_CAP) { atomicAdd(&(bar)[XB_TMO], 1u); break; } } } } while (0)

struct XcdBarrier {
    unsigned* bar; unsigned x;
    volatile LAS unsigned* st;
};

__device__ __forceinline__ XcdBarrier xcd_barrier_post(unsigned* bar, volatile LAS unsigned* st) {
    XcdBarrier b; b.bar = bar; b.x = xb_xcc_id(); b.st = st;
    if (threadIdx.x == 0) (void)xb_add(&bar[XB_XCNT(b.x)], 1u);
    return b;
}
__device__ __forceinline__ void xcd_barrier_complete(unsigned* bar, unsigned x, unsigned& nloc, unsigned& nx) {
    const unsigned G = gridDim.x * gridDim.y * gridDim.z;
    unsigned sum, cnt, mine, sp = 0u;
    for (;;) {
        sum = 0u; cnt = 0u; mine = 0u;
#pragma unroll
        for (unsigned j = 0; j < 16; ++j) { const unsigned c = xb_ld(&bar[XB_XCNT(j)]); sum += c; cnt += (c > 0u) ? 1u : 0u; mine = (j == x) ? c : mine; }
        if (sum == G) break;
        __builtin_amdgcn_s_sleep(1);
        if ((++sp & 255u) == 0u) { if (xb_ld(&bar[XB_TMO])) break; if (sp > XB_SPIN_CAP) { atomicAdd(&bar[XB_TMO], 1u); break; } }
    }
    nloc = mine > 0u ? mine : 1u; nx = cnt > 0u ? cnt : 1u;
}

__device__ __forceinline__ void xcd_barrier(const XcdBarrier& b) {
    asm volatile("s_waitcnt vmcnt(0)" ::: "memory");
    __syncthreads();
    if (threadIdx.x == 0) {
        unsigned* bar = b.bar;
        __builtin_amdgcn_s_waitcnt(0);
        unsigned nloc = b.st[0], nx = b.st[1];
        if (nloc == 0u) { xcd_barrier_complete(bar, b.x, nloc, nx); b.st[0] = nloc; b.st[1] = nx; }
        const unsigned old = xb_add(&bar[XB_XSUB(b.x)], 1u);
        const unsigned gen = old / nloc;
        if (old + 1u == (gen + 1u) * nloc) {
            __builtin_amdgcn_fence(__ATOMIC_RELEASE, "agent");
            asm volatile("s_waitcnt vmcnt(0)" ::: "memory");
            const unsigned og = xb_add(&bar[XB_TOP], 1u);
            const unsigned tg = og / nx;
            if (og + 1u == (tg + 1u) * nx) xb_add(&bar[XB_TOPGEN], 1u);
            else XB_SPIN(xb_ld(&bar[XB_TOPGEN]) == tg, bar);
            __builtin_amdgcn_fence(__ATOMIC_ACQUIRE, "agent");
            xb_add(&bar[XB_XGEN(b.x)], 1u);
            asm volatile("s_waitcnt vmcnt(0)" ::: "memory");
        } else {
            XB_SPIN(xb_ld(&bar[XB_XGEN(b.x)]) == gen, bar);
            __builtin_amdgcn_fence(__ATOMIC_ACQUIRE, "agent");
            asm volatile("s_waitcnt vmcnt(0)" ::: "memory");
        }
    }
    __syncthreads();
}


#ifndef NLAYERS
#define NLAYERS 4
#endif
#ifndef REP_ATTN
#define REP_ATTN 1
#endif
#ifndef REP_SCAN
#define REP_SCAN 1
#endif
#ifndef REP_PREP
#define REP_PREP 1
#endif
#ifndef REP_GEMM0
#define REP_GEMM0 1
#endif
#ifndef REP_POOL
#define REP_POOL 1
#endif
#ifndef REP_SYNC
#define REP_SYNC 0
#endif
#ifndef REP_GRP
#define REP_GRP 1
#endif
#ifndef REP_OUT0
#define REP_OUT0 1
#endif
#ifndef REP_PRO
#define REP_PRO 1
#endif
#ifndef REP_LOWRANK
#define REP_LOWRANK 1
#endif
#ifndef REP_NORM
#define REP_NORM 1
#endif
constexpr int LDS_BYTES = 160 * 1024;
static_assert(SC_END <= LDS_BYTES - 64 && (int)attn::SHM_ATTN <= LDS_BYTES && pg8::STAGE_BYTES <= LDS_BYTES, "LDS map");

#define CG_SYNC() do { asm volatile("s_waitcnt vmcnt(0) lgkmcnt(0)" ::: "memory"); grid.sync(); __builtin_amdgcn_fence(__ATOMIC_ACQUIRE, "agent"); asm volatile("s_waitcnt vmcnt(0)" ::: "memory"); } while (0)
#define GRID_SYNC() xcd_barrier(xbar)
__global__ void __launch_bounds__(512, 2) fwd_megakernel(Args a) {
    extern __shared__ __attribute__((aligned(16))) unsigned char lds_raw[];
    LAS unsigned char* lds = (LAS unsigned char*)lds_raw;
    cg::grid_group grid = cg::this_grid();
    if (threadIdx.x < 16) ((LAS unsigned*)(lds + LDS_BYTES - 64))[threadIdx.x] = 0u;
    __syncthreads();
    XcdBarrier xbar = xcd_barrier_post((unsigned*)(a.ws + WS_BAR), (volatile LAS unsigned*)(lds + LDS_BYTES - 64));
    const int G = gridDim.x;
    float* mod = (float*)(a.ws + WS_MOD); float* rc = (float*)(a.ws + WS_ROPE); float* rs = rc + SEQ * 64;
    bf16_t* WB = (bf16_t*)(a.ws + WS_WB); bf16_t* WBG = (bf16_t*)(a.ws + WS_WB + 16 * MiB); bf16_t* WBO = (bf16_t*)(a.ws + WS_WB + 24 * MiB);
    bf16_t* HB = (bf16_t*)(a.ws + WS_HB); bf16_t* PROJ = (bf16_t*)(a.ws + WS_PROJ); bf16_t* YB = (bf16_t*)(a.ws + WS_QKK);

    for (int rep = 0; rep < REP_PRO; ++rep) {
    phase_mod(a, lds, mod);
    __syncthreads();
    phase_rope_table(rc, rs);
    phase_weights(a, 0, lds);
    if (rep == 0) CG_SYNC(); else GRID_SYNC(); }

    for (int rep = 0; rep < REP_SYNC; ++rep) GRID_SYNC();
    for (int L = 0; L < NLAYERS; ++L) {
        const int kind = L % 3, j = L / 3;
        const float* xin = (L == 0) ? a.x : a.out;
        const float* modL = mod + (size_t)L * 4 * 6144;
        if (L > 0) for (int rep = 0; rep < REP_PRO; ++rep) { phase_weights(a, L, lds); if (rep) GRID_SYNC(); }
        for (int rep = 0; rep < REP_NORM; ++rep) {
        phase_norm_mod(xin, modL, HB);
        GRID_SYNC(); }
        if (kind == 0) {
            for (int rep = 0; rep < REP_GEMM0; ++rep) {
            { pg8::Gemm g{HB, WB, MTOK, 4096, 2048, 2048, 2048, 0}; pg8::StaticOrder S; S.init(MTOK, 4096, G, (int)blockIdx.x);
              pg8::EpiStore E{PROJ, 4096}; pg8::gemm_phase<pg8::EpiStore, pg8::StaticOrder>(lds, g, S, E); }
            GRID_SYNC(); }
            for (int rep = 0; rep < REP_POOL; ++rep) {
            phase_pool(PROJ, HB);
            GRID_SYNC(); }
            for (int rep = 0; rep < REP_GRP; ++rep) {
            { pg8::Gemm g{HB, WBG, MTOK, 2048, 512, 2048, 512, 1}; pg8::StaticOrder S; S.init(MTOK, 2048, G, (int)blockIdx.x);
              pg8::EpiPool E{YB, PROJ + 2048, 4096, a.pool_scale + (size_t)j * 2048}; pg8::gemm_phase<pg8::EpiPool, pg8::StaticOrder>(lds, g, S, E); }
            GRID_SYNC(); }
            for (int rep = 0; rep < (L == 0 ? REP_OUT0 : 1); ++rep) {
            { pg8::Gemm g{YB, WBO, MTOK, 2048, 2048, 2048, 2048, 0}; pg8::StaticOrder S; S.init(MTOK, 2048, G, (int)blockIdx.x);
              pg8::EpiRes E{xin, a.out, modL + 4096}; pg8::gemm_phase<pg8::EpiRes, pg8::StaticOrder>(lds, g, S, E); }
            GRID_SYNC(); }
        } else if (kind == 1) {
            for (int rep = 0; rep < REP_LOWRANK; ++rep) phase_gla_lowrank(HB, (const bf16_t*)(a.ws + WS_W1T), (float*)(a.ws + WS_R));
            { pg8::Gemm g{HB, WB, MTOK, 6144, 2048, 2048, 2048, 0}; pg8::StaticOrder S; S.init(MTOK, 6144, G, (int)blockIdx.x);
              pg8::EpiStore E{PROJ, 6144}; pg8::gemm_phase<pg8::EpiStore, pg8::StaticOrder>(lds, g, S, E); }
            GRID_SYNC();
            for (int rep = 0; rep < REP_PREP; ++rep) {
            phase_gla_prep(a, lds);
            GRID_SYNC(); }
            for (int rep = 0; rep < REP_SCAN; ++rep) {
            phase_gla_scan(a, lds);
            GRID_SYNC(); }
            phase_gla_post(HB, PROJ, a.gla_norm_g);
            GRID_SYNC();
            { pg8::Gemm g{HB, WBO, MTOK, 2048, 2048, 2048, 2048, 0}; pg8::StaticOrder S; S.init(MTOK, 2048, G, (int)blockIdx.x);
              pg8::EpiRes E{xin, a.out, modL + 4096}; pg8::gemm_phase<pg8::EpiRes, pg8::StaticOrder>(lds, g, S, E); }
            GRID_SYNC();
        } else {
            { pg8::Gemm g{HB, WB, MTOK, 5120, 2048, 2048, 2048, 0}; pg8::StaticOrder S; S.init(MTOK, 5120, G, (int)blockIdx.x);
              pg8::EpiStore E{PROJ, 5120}; pg8::gemm_phase<pg8::EpiStore, pg8::StaticOrder>(lds, g, S, E); }
            GRID_SYNC();
            phase_qknorm_rope(PROJ, a.attn_qg, a.attn_kg, rc, rs);
            GRID_SYNC();
            for (int rep = 0; rep < REP_ATTN; ++rep) {
            for (int u = blockIdx.x; u < 2048; u += G) {
                const int bk = u >> 7, b = bk >> 2, kvh = bk & 3, hq = kvh * 4 + ((u >> 5) & 3), qb = u & 31;
                const size_t row0 = (size_t)b * SEQ + qb * 256;
                attn::attn_dense_body<attn::bf16>((const attn::bf16*)(PROJ + row0 * 5120 + hq * 128), (const attn::bf16*)(PROJ + (size_t)b * SEQ * 5120 + 2048 + kvh * 128),
                    (const attn::bf16*)(PROJ + (size_t)b * SEQ * 5120 + 2560 + kvh * 128), PROJ + row0 * 5120 + 3072 + hq * 128, YB + row0 * 2048 + hq * 128, SEQ, (char*)lds_raw);
                __syncthreads();
            }
            GRID_SYNC(); }
            { pg8::Gemm g{YB, WBO, MTOK, 2048, 2048, 2048, 2048, 0}; pg8::StaticOrder S; S.init(MTOK, 2048, G, (int)blockIdx.x);
              pg8::EpiRes E{xin, a.out, modL + 4096}; pg8::gemm_phase<pg8::EpiRes, pg8::StaticOrder>(lds, g, S, E); }
            GRID_SYNC();
        }
    }
    phase_final_norm(a.out, a.final_g);
}

extern "C" void kernel_launch(void* const* d_in, const int* in_sizes, int n_in, void* d_out, int out_size, void* d_ws, size_t ws_size, hipStream_t stream) {
    static int grid = 0;
    if (grid == 0) {
        if (n_in != 22 || in_sizes[0] != MTOK * DM || out_size != MTOK * DM || ws_size < WS_END) {
            fprintf(stderr, "kernel_launch: unexpected shapes: n_in %d in0 %d out %d ws %zu (need %zu)\n", n_in, n_in > 0 ? in_sizes[0] : -1, out_size, ws_size, (size_t)WS_END); grid = -1; return; }
        int dev = 0, cus = 0, per_cu = 0;
        hipGetDevice(&dev); hipDeviceGetAttribute(&cus, hipDeviceAttributeMultiprocessorCount, dev);
        if (hipFuncSetAttribute((const void*)fwd_megakernel, hipFuncAttributeMaxDynamicSharedMemorySize, LDS_BYTES) != hipSuccess) { fprintf(stderr, "kernel_launch: hipFuncSetAttribute failed\n"); grid = -1; return; }
        if (hipOccupancyMaxActiveBlocksPerMultiprocessor(&per_cu, (const void*)fwd_megakernel, 512, LDS_BYTES) != hipSuccess || per_cu < 1) { fprintf(stderr, "kernel_launch: occupancy query gave %d\n", per_cu); per_cu = 1; }
        (void)hipGetLastError();
        grid = cus;
        fprintf(stderr, "kernel_launch: cus %d per_cu %d grid %d\n", cus, per_cu, grid);
    }
    if (grid < 0) return;
    Args a{};
    const float** p = (const float**)&a;
    for (int i = 0; i < 22; ++i) p[i] = (const float*)d_in[i];
    a.out = (float*)d_out; a.ws = (unsigned char*)d_ws;
    if (hipMemsetAsync((char*)d_ws + WS_BAR, 0, 16384, stream) != hipSuccess) { fprintf(stderr, "kernel_launch: memset of the barrier words failed\n"); return; }
    void* args[] = {&a};
    hipError_t e = hipLaunchCooperativeKernel((const void*)fwd_megakernel, dim3(grid), dim3(512), args, LDS_BYTES, stream);
    if (e != hipSuccess) fprintf(stderr, "kernel_launch: cooperative launch failed: %s (grid %d)\n", hipGetErrorString(e), grid);
}
```

```cpp
#include <hip/hip_runtime.h>
#include <hip/hip_bf16.h>
#include <hip/hip_cooperative_groups.h>
#include <cstdio>
#include <cstdint>
#include <cmath>
namespace cg = cooperative_groups;

constexpr int NB = 4, SEQ = 8192, DM = 2048, MTOK = NB * SEQ;
constexpr float NEPS = 1e-6f;
constexpr size_t MiB = (size_t)1 << 20;
constexpr size_t WS_MOD = 0;
constexpr size_t WS_ROPE = 1 * MiB;
constexpr size_t WS_R = 5 * MiB;
constexpr size_t WS_DL = 9 * MiB;
constexpr size_t WS_W1T = 13 * MiB;
constexpr size_t WS_BAR = 15 * MiB;
constexpr size_t WS_WB = 16 * MiB;
constexpr size_t WS_HB = 52 * MiB;
constexpr size_t WS_PROJ = 180 * MiB;
constexpr size_t WS_QKK = 564 * MiB;
constexpr size_t WS_END = 948 * MiB;

typedef unsigned short bf16_t;
typedef short bf16x8 __attribute__((ext_vector_type(8)));
typedef float f32x4 __attribute__((ext_vector_type(4)));
typedef unsigned u32x4 __attribute__((ext_vector_type(4)));
typedef unsigned u32x2 __attribute__((ext_vector_type(2)));
#define LAS __attribute__((address_space(3)))

typedef float f32x2 __attribute__((ext_vector_type(2)));
typedef __bf16 bf16x2_t __attribute__((ext_vector_type(2)));
__device__ __forceinline__ unsigned cvt_pk_bf16(float lo, float hi) { f32x2 v = {lo, hi}; bf16x2_t b = __builtin_convertvector(v, bf16x2_t); return __builtin_bit_cast(unsigned, b); }
__device__ __forceinline__ float bf_lo(unsigned w) { return __uint_as_float(w << 16); }
__device__ __forceinline__ float bf_hi(unsigned w) { return __uint_as_float(w & 0xffff0000u); }
__device__ __forceinline__ float bf2f(bf16_t b) { return __uint_as_float(((unsigned)b) << 16); }
__device__ __forceinline__ bf16_t f2bf(float f) { unsigned u = __float_as_uint(f); u += 0x7fffu + ((u >> 16) & 1u); return (bf16_t)(u >> 16); }
__device__ __forceinline__ float silu_f(float v) { return v * __builtin_amdgcn_rcpf(1.f + __builtin_amdgcn_exp2f(-1.4426950408889634f * v)); }
__device__ __forceinline__ float wave_sum(float v) {
#pragma unroll
    for (int o = 1; o < 64; o <<= 1) v += __shfl_xor(v, o);
    return v;
}
__device__ __forceinline__ int opaque_tid() { int t; asm volatile("v_mov_b32 %0, %1" : "=v"(t) : "v"((int)threadIdx.x)); return t; }

namespace pg8 {
#define PG8_LAS __attribute__((address_space(3)))
constexpr int BM = 256, BK = 64, HALF = 128, HTB = HALF * BK * 2  , STAGE_BYTES = 8 * HTB, NXCD = 8, WGM = 8;
__host__ __device__ __forceinline__ int lds_byte(int r, int c) { const int st = (r >> 4) * 2 + (c >> 5), rr = r & 15, cc = c & 31, ob = rr * 64 + cc * 2; return st * 1024 + (ob ^ (((ob >> 9) & 1) << 5)); }
__host__ __device__ __forceinline__ void stage_rc(int b, int& R, int& C) { const int st = b / 1024, sb = b % 1024, swz = sb ^ (((sb >> 9) & 1) << 5); R = (st >> 1) * 16 + swz / 64; C = (st & 1) * 32 + (swz % 64) / 2; }
__host__ __device__ __forceinline__ int perm32(int rho) { const int n = rho >> 4, i = rho & 15; return 8 * (i >> 2) + 4 * n + (i & 3); }
struct Unit { int pm, pn; };
struct Gemm { const bf16_t* A; const bf16_t* Bt; int M, N, K, lda, ldb, grp;
    __device__ __forceinline__ const char* aptr(const Unit& u) const { return (const char*)(A + (size_t)u.pm * BM * lda + (grp ? (size_t)(u.pn >> 1) * K : (size_t)0)); }
    __device__ __forceinline__ const char* bptr(const Unit& u) const { return (const char*)(Bt + (size_t)u.pn * BM * ldb); } };
struct StaticOrder {
    int nM, nN, nwg, G, c;
    __host__ __device__ void init(int M, int N, int G_, int c_) { nM = M / BM; nN = N / BM; nwg = nM * nN; G = G_; c = c_; }
    __host__ __device__ bool next(int i, Unit& u) const {
        const long L = (long)i * G + c; if (L >= nwg) return false;
        int wgid = (int)L; { const int q = nwg / NXCD, r = nwg % NXCD, xcd = wgid % NXCD, off = wgid / NXCD; wgid = (xcd < r ? xcd * (q + 1) : r * (q + 1) + (xcd - r) * q) + off; }
        const int nig = WGM * nN, gid = wgid / nig, fm = gid * WGM, gsz = (nM - fm) < WGM ? (nM - fm) : WGM;
        u.pm = fm + ((wgid % nig) % gsz); u.pn = (wgid % nig) / gsz; return true;
    }
    __device__ __forceinline__ void a_ready(const Unit&) const {}
    __device__ __forceinline__ void done(const Unit&) const {}
};
struct EpiStore {
    static constexpr bool PERM = true, AFTER_DRAIN = false; static constexpr int STAGGER_TICKS = 0;
    bf16_t* O; int ldc;
    __device__ __forceinline__ void operator()(const f32x4 (&acc)[2][2][4][2], const Unit& u, int wr, int wc, int fr, int fq) const {
        const int row0 = u.pm * BM + wr * 64 + fr, col0 = u.pn * BM + wc * 32 + 8 * fq;
#pragma unroll
        for (int ai = 0; ai < 2; ++ai)
#pragma unroll
            for (int m = 0; m < 4; ++m) { bf16_t* rowp = O + (size_t)(row0 + ai * HALF + m * 16) * ldc + col0;
#pragma unroll
                for (int bj = 0; bj < 2; ++bj) { const f32x4 v0 = acc[ai][bj][m][0], v1 = acc[ai][bj][m][1];
                    u32x4 w; w.x = cvt_pk_bf16(v0[0], v0[1]); w.y = cvt_pk_bf16(v0[2], v0[3]); w.z = cvt_pk_bf16(v1[0], v1[1]); w.w = cvt_pk_bf16(v1[2], v1[3]);
                    *(u32x4*)(rowp + bj * HALF) = w; } }
    }
};
struct EpiNull {
    static constexpr bool PERM = true, AFTER_DRAIN = false; static constexpr int STAGGER_TICKS = 0;
    bf16_t* O;
    __device__ __forceinline__ void operator()(const f32x4 (&acc)[2][2][4][2], const Unit& u, int wr, int wc, int fr, int fq) const {
        f32x4 s = (f32x4){0.f, 0.f, 0.f, 0.f};
#pragma unroll
        for (int ai = 0; ai < 2; ++ai)
#pragma unroll
            for (int bj = 0; bj < 2; ++bj)
#pragma unroll
                for (int m = 0; m < 4; ++m) { s += acc[ai][bj][m][0]; s += acc[ai][bj][m][1]; }
        if (s[0] + s[1] + s[2] + s[3] == 1234.5678f) O[0] = 0;
    }
};
struct EpiPool {
    static constexpr bool PERM = true, AFTER_DRAIN = false; static constexpr int STAGGER_TICKS = 0;
    bf16_t* O; const bf16_t* G; int ldg; const float* scale;
    __device__ __forceinline__ void operator()(const f32x4 (&acc)[2][2][4][2], const Unit& u, int wr, int wc, int fr, int fq) const {
        const int row0 = u.pm * BM + wr * 64 + fr, col0 = u.pn * BM + wc * 32 + 8 * fq;
        f32x4 sv[2][2];
#pragma unroll
        for (int bj = 0; bj < 2; ++bj)
#pragma unroll
            for (int n = 0; n < 2; ++n) sv[bj][n] = *(const f32x4*)(scale + col0 + bj * HALF + 4 * n);
#pragma unroll
        for (int ai = 0; ai < 2; ++ai) {
            u32x4 gwv[4][2];
#pragma unroll
            for (int m = 0; m < 4; ++m)
#pragma unroll
                for (int bj = 0; bj < 2; ++bj) gwv[m][bj] = *(const u32x4*)(G + (size_t)(row0 + ai * HALF + m * 16) * ldg + col0 + bj * HALF);
#pragma unroll
            for (int m = 0; m < 4; ++m) { const size_t row = (size_t)(row0 + ai * HALF + m * 16);
#pragma unroll
                for (int bj = 0; bj < 2; ++bj) { const u32x4 gw = gwv[m][bj];
                    const f32x4 v0 = acc[ai][bj][m][0] * sv[bj][0], v1 = acc[ai][bj][m][1] * sv[bj][1];
                    u32x4 w;
                    w.x = cvt_pk_bf16(v0[0] * silu_f(bf_lo(gw.x)), v0[1] * silu_f(bf_hi(gw.x))); w.y = cvt_pk_bf16(v0[2] * silu_f(bf_lo(gw.y)), v0[3] * silu_f(bf_hi(gw.y)));
                    w.z = cvt_pk_bf16(v1[0] * silu_f(bf_lo(gw.z)), v1[1] * silu_f(bf_hi(gw.z))); w.w = cvt_pk_bf16(v1[2] * silu_f(bf_lo(gw.w)), v1[3] * silu_f(bf_hi(gw.w)));
                    *(u32x4*)(O + row * 2048 + col0 + bj * HALF) = w; } }
            asm volatile("" ::: "memory"); }
    }
};
template <bool IN_BF16, bool OUT_BF16> struct EpiResT {
    static constexpr bool PERM = true, AFTER_DRAIN = false; static constexpr int STAGGER_TICKS = 0;
    const void* xi; void* xo; const float* gate;
    __device__ __forceinline__ void operator()(const f32x4 (&acc)[2][2][4][2], const Unit& u, int wr, int wc, int fr, int fq) const {
        const int row0 = u.pm * BM + wr * 64 + fr, col0 = u.pn * BM + wc * 32 + 8 * fq;
        const float* gp = gate + (size_t)((u.pm * BM) / SEQ) * 6144 + col0;
        f32x4 gv[2][2];
#pragma unroll
        for (int bj = 0; bj < 2; ++bj)
#pragma unroll
            for (int n = 0; n < 2; ++n) gv[bj][n] = *(const f32x4*)(gp + bj * HALF + 4 * n);
#pragma unroll
        for (int aim = 0; aim < (IN_BF16 ? 2 : 4); ++aim) {
            constexpr int MB = IN_BF16 ? 4 : 2; const int ai = IN_BF16 ? aim : (aim >> 1), mb0 = IN_BF16 ? 0 : (aim & 1) * 2;
            u32x4 raw[4][2][IN_BF16 ? 1 : 2];
#pragma unroll
            for (int m = mb0; m < mb0 + MB; ++m) { const size_t off = (size_t)(row0 + ai * HALF + m * 16) * 2048 + col0;
#pragma unroll
                for (int bj = 0; bj < 2; ++bj) {
                    if (IN_BF16) raw[m][bj][0] = *(const u32x4*)((const bf16_t*)xi + off + bj * HALF);
                    else { raw[m][bj][0] = *(const u32x4*)((const float*)xi + off + bj * HALF); raw[m][bj][IN_BF16 ? 0 : 1] = *(const u32x4*)((const float*)xi + off + bj * HALF + 4); } } }
#pragma unroll
            for (int m = mb0; m < mb0 + MB; ++m) { const size_t off = (size_t)(row0 + ai * HALF + m * 16) * 2048 + col0;
#pragma unroll
                for (int bj = 0; bj < 2; ++bj) { f32x4 x0, x1;
                    if (IN_BF16) { const u32x4 w = raw[m][bj][0]; x0 = (f32x4){bf_lo(w.x), bf_hi(w.x), bf_lo(w.y), bf_hi(w.y)}; x1 = (f32x4){bf_lo(w.z), bf_hi(w.z), bf_lo(w.w), bf_hi(w.w)}; }
                    else { x0 = __builtin_bit_cast(f32x4, raw[m][bj][0]); x1 = __builtin_bit_cast(f32x4, raw[m][bj][IN_BF16 ? 0 : 1]); }
                    const f32x4 v0 = x0 + gv[bj][0] * acc[ai][bj][m][0], v1 = x1 + gv[bj][1] * acc[ai][bj][m][1];
                    if (OUT_BF16) { u32x4 w; w.x = cvt_pk_bf16(v0[0], v0[1]); w.y = cvt_pk_bf16(v0[2], v0[3]); w.z = cvt_pk_bf16(v1[0], v1[1]); w.w = cvt_pk_bf16(v1[2], v1[3]);
                        *(u32x4*)((bf16_t*)xo + off + bj * HALF) = w; }
                    else { *(f32x4*)((float*)xo + off + bj * HALF) = v0; *(f32x4*)((float*)xo + off + bj * HALF + 4) = v1; } } }
            asm volatile("" ::: "memory"); }
    }
};
struct EpiRes {
#ifndef RES_STAGGER_TICKS
#define RES_STAGGER_TICKS 0
#endif
    static constexpr bool PERM = false, AFTER_DRAIN = false; static constexpr int STAGGER_TICKS = RES_STAGGER_TICKS;
    const float* xi; float* xo; const float* gate;
    __device__ __forceinline__ void operator()(const f32x4 (&acc)[2][2][4][2], const Unit& u, int wr, int wc, int fr, int fq) const {
        const int row0 = u.pm * BM + wr * 64 + fr, col0 = u.pn * BM + wc * 32 + 4 * fq;
        const float* gp = gate + (size_t)((u.pm * BM) / SEQ) * 6144 + col0;
        f32x4 gv[2][2];
#pragma unroll
        for (int bj = 0; bj < 2; ++bj)
#pragma unroll
            for (int n = 0; n < 2; ++n) gv[bj][n] = *(const f32x4*)(gp + bj * HALF + n * 16);
#pragma unroll
        for (int ai = 0; ai < 2; ++ai)
#pragma unroll
            for (int mp = 0; mp < 1; ++mp) {
                f32x4 xv[4][2][2];
#pragma unroll
                for (int mm = 0; mm < 4; ++mm) { const size_t off = (size_t)(row0 + ai * HALF + (4 * mp + mm) * 16) * 2048 + col0;
#pragma unroll
                    for (int bj = 0; bj < 2; ++bj)
#pragma unroll
                        for (int n = 0; n < 2; ++n) xv[mm][bj][n] = *(const f32x4*)(xi + off + bj * HALF + n * 16); }
#pragma unroll
                for (int mm = 0; mm < 4; ++mm) { const size_t off = (size_t)(row0 + ai * HALF + (4 * mp + mm) * 16) * 2048 + col0;
#pragma unroll
                    for (int bj = 0; bj < 2; ++bj)
#pragma unroll
                        for (int n = 0; n < 2; ++n) *(f32x4*)(xo + off + bj * HALF + n * 16) = xv[mm][bj][n] + gv[bj][n] * acc[ai][bj][4 * mp + mm][n]; }
                asm volatile("" ::: "memory"); }
    }
};
template <class Epi, class Sched>
__device__ __forceinline__ void gemm_phase(PG8_LAS unsigned char* lds, const Gemm g, const Sched& S, const Epi& E) {
    const int tid = opaque_tid(), wid = __builtin_amdgcn_readfirstlane(tid >> 6), lane = tid & 63, wr = wid >> 2, wc = wid & 3, fr = lane & 15, fq = lane >> 4;
    const int K = g.K, nt = K / BK;
    unsigned voffA[2], voffB[2];
#pragma unroll
    for (int i = 0; i < 2; ++i) { int R, C; stage_rc(tid * 16 + i * 8192, R, C); const int Rb = Epi::PERM ? ((R & ~31) + perm32(R & 31)) : R;
        voffA[i] = (unsigned)(R * g.lda + C) * 2u; voffB[i] = (unsigned)(Rb * g.ldb + C) * 2u; }
    const size_t kstep = (size_t)(BK * 2);
    const size_t hstepA = (size_t)HALF * g.lda * 2, hstepB = (size_t)HALF * g.ldb * 2;
    const unsigned ldsw = (unsigned)wid * 1024u;
    const int aoff = lds_byte(wr * 64 + fr, fq * 8), boff = lds_byte(wc * 32 + fr, fq * 8);
#define PG8_SA(b, h) (((b) * 2 + (h)) * HTB)
#define PG8_SB(b, h) ((4 + (b) * 2 + (h)) * HTB)
#define PG8_STAGE(bufoff, gbase, voff) do { _Pragma("unroll") for (int _i = 0; _i < 2; ++_i) \
        __builtin_amdgcn_global_load_lds((const unsigned*)((const char*)(gbase) + (voff)[_i]), (PG8_LAS unsigned*)(lds + (bufoff) + ldsw + _i * 8192), 16, 0, 0); } while (0)
#define PG8_LDA(dst, b, h) do { _Pragma("unroll") for (int m = 0; m < 4; ++m) _Pragma("unroll") for (int k = 0; k < 2; ++k) dst[m][k] = *(const PG8_LAS bf16x8*)(lds + PG8_SA(b, h) + aoff + m * 2048 + k * 1024); } while (0)
#define PG8_LDB(dst, b, h) do { _Pragma("unroll") for (int n = 0; n < 2; ++n) _Pragma("unroll") for (int k = 0; k < 2; ++k) dst[n][k] = *(const PG8_LAS bf16x8*)(lds + PG8_SB(b, h) + boff + n * 2048 + k * 1024); } while (0)
#define PG8_MMA(ai, bj, At, Bt) do { __builtin_amdgcn_s_setprio(1); _Pragma("unroll") for (int m = 0; m < 4; ++m) _Pragma("unroll") for (int n = 0; n < 2; ++n) _Pragma("unroll") for (int k = 0; k < 2; ++k) \
        acc[ai][bj][m][n] = __builtin_amdgcn_mfma_f32_16x16x32_bf16(Bt[n][k], At[m][k], acc[ai][bj][m][n], 0, 0, 0); __builtin_amdgcn_s_setprio(0); } while (0)
#define PG8_WAIT_V(n) asm volatile("s_waitcnt vmcnt(" #n ")" ::: "memory")
#define PG8_WAIT_L(n) asm volatile("s_waitcnt lgkmcnt(" #n ")" ::: "memory")
#define PG8_BAR __builtin_amdgcn_s_barrier()
#define PG8_SCHED __builtin_amdgcn_sched_barrier(0)
    Unit cur, nxt; int ui = 0;
    if (!S.next(0, cur)) return;
#ifndef GEMM_STAGGER_TICKS
#define GEMM_STAGGER_TICKS 0
#endif
    if (Epi::STAGGER_TICKS > 0) {
        const unsigned long long t0 = __builtin_amdgcn_s_memrealtime(), dl = (unsigned long long)((unsigned)blockIdx.x * (unsigned)Epi::STAGGER_TICKS / (unsigned)gridDim.x);
        while (__builtin_amdgcn_s_memrealtime() - t0 < dl) __builtin_amdgcn_s_sleep(8);
    }
    f32x4 acc[2][2][4][2];
#pragma unroll
    for (int a = 0; a < 2; ++a)
#pragma unroll
        for (int b = 0; b < 2; ++b)
#pragma unroll
            for (int m = 0; m < 4; ++m)
#pragma unroll
                for (int n = 0; n < 2; ++n) acc[a][b][m][n] = (f32x4){0.f, 0.f, 0.f, 0.f};
    bf16x8 At[4][2], B0[2][2], B1[2][2];
    const char* cA = g.aptr(cur); const char* cB = g.bptr(cur);
    S.a_ready(cur);
    PG8_STAGE(PG8_SB(0, 0), cB, voffB); PG8_STAGE(PG8_SA(0, 0), cA, voffA); PG8_STAGE(PG8_SB(0, 1), cB + hstepB, voffB); PG8_STAGE(PG8_SA(0, 1), cA + hstepA, voffA);
    if (wr == 1) PG8_BAR;
    PG8_WAIT_V(4); PG8_BAR;
    PG8_STAGE(PG8_SB(1, 0), cB + kstep, voffB); PG8_STAGE(PG8_SA(1, 0), cA + kstep, voffA); PG8_STAGE(PG8_SB(1, 1), cB + hstepB + kstep, voffB);
    PG8_WAIT_V(6); PG8_BAR;
    for (;;) {
        const bool has_next = S.next(ui + 1, nxt);
        const char* nA = has_next ? g.aptr(nxt) : cA; const char* nB = has_next ? g.bptr(nxt) : cB;
        for (int t = 0; t < nt; t += 2) {
            const bool last = (t == nt - 2);
            const char* a1 = cA + (size_t)(t + 1) * kstep;
            const char* a2 = last ? nA : cA + (size_t)(t + 2) * kstep; const char* b2 = last ? nB : cB + (size_t)(t + 2) * kstep;
            const char* a3 = a2 + kstep; const char* b3 = b2 + kstep;
            if (last && has_next) S.a_ready(nxt);
            PG8_LDB(B0, 0, 0); PG8_SCHED; PG8_LDA(At, 0, 0); PG8_STAGE(PG8_SA(1, 1), a1 + hstepA, voffA);
            PG8_WAIT_L(8); PG8_BAR; PG8_WAIT_L(0); PG8_MMA(0, 0, At, B0); PG8_BAR; PG8_SCHED;
            PG8_LDB(B1, 0, 1); PG8_STAGE(PG8_SB(0, 0), b2, voffB);
            PG8_BAR; PG8_WAIT_L(0); PG8_MMA(0, 1, At, B1); PG8_BAR;
            PG8_LDA(At, 0, 1); PG8_STAGE(PG8_SA(0, 0), a2, voffA);
            PG8_BAR; PG8_WAIT_L(0); PG8_MMA(1, 0, At, B0); PG8_BAR; PG8_SCHED;
            PG8_STAGE(PG8_SB(0, 1), b2 + hstepB, voffB);
            PG8_WAIT_V(6); PG8_BAR; PG8_MMA(1, 1, At, B1); PG8_BAR;
            PG8_LDB(B0, 1, 0); PG8_SCHED; PG8_LDA(At, 1, 0); PG8_STAGE(PG8_SA(0, 1), a2 + hstepA, voffA);
            PG8_WAIT_L(8); PG8_BAR; PG8_WAIT_L(0); PG8_MMA(0, 0, At, B0); PG8_BAR; PG8_SCHED;
            PG8_LDB(B1, 1, 1); PG8_STAGE(PG8_SB(1, 0), b3, voffB);
            PG8_BAR; PG8_WAIT_L(0); PG8_MMA(0, 1, At, B1); PG8_BAR;
            PG8_LDA(At, 1, 1); PG8_STAGE(PG8_SA(1, 0), a3, voffA);
            PG8_BAR; PG8_WAIT_L(0); PG8_MMA(1, 0, At, B0); PG8_BAR; PG8_SCHED;
            PG8_STAGE(PG8_SB(1, 1), b3 + hstepB, voffB);
            PG8_WAIT_V(6); PG8_BAR; PG8_MMA(1, 1, At, B1); PG8_BAR;
        }
            if constexpr (!Epi::AFTER_DRAIN) { E(acc, cur, wr, wc, fr, fq); S.done(cur); }
            if (!has_next) break;
#pragma unroll
        for (int a = 0; a < 2; ++a)
#pragma unroll
            for (int b = 0; b < 2; ++b)
#pragma unroll
                for (int m = 0; m < 4; ++m)
#pragma unroll
                    for (int n = 0; n < 2; ++n) acc[a][b][m][n] = (f32x4){0.f, 0.f, 0.f, 0.f};
        cur = nxt; cA = nA; cB = nB; ++ui;
    }
    PG8_WAIT_V(0);
    if (wr == 0) PG8_BAR;
    PG8_BAR;
    if constexpr (Epi::AFTER_DRAIN) { E.fused(acc, cur, wr, wc, fr, fq, lds, wid, lane); S.done(cur); }
#undef PG8_SA
#undef PG8_SB
#undef PG8_STAGE
#undef PG8_LDA
#undef PG8_LDB
#undef PG8_MMA
#undef PG8_WAIT_V
#undef PG8_WAIT_L
#undef PG8_BAR
#undef PG8_SCHED
}
}


namespace attn {
using bf16 = __hip_bfloat16;
constexpr int   D = 128, NW = 8, QBLK = 32, KVBLK = 64;
constexpr float SCALE = 0.088388347648318440f;
constexpr float THR = 8.f;
constexpr int SDEPTH = 1;
constexpr int LDQ = 5120, LDK = 5120, LDO = 2048;
constexpr size_t SHM_V = KVBLK * D * 2, SHM_K = KVBLK * D * 2, SHM_ATTN = 2 * SHM_V + 2 * SHM_K + NW * 64 * 4;
using bf16x8 = __attribute__((ext_vector_type(8))) short;
using s16x4  = __attribute__((ext_vector_type(4))) short;
using f32x16 = __attribute__((ext_vector_type(16))) float;
using f32x8  = __attribute__((ext_vector_type(8))) float;
using u32x4  = __attribute__((ext_vector_type(4))) unsigned;
#define KSWZ(row, colB) ((row) * 256 + ((colB) ^ (((row) & 7) << 4)))
#define SBAR() __builtin_amdgcn_sched_barrier(0)
__device__ __forceinline__ int crow(int r, int hi) { return (r & 3) + 8 * (r >> 2) + 4 * hi; }
__device__ __forceinline__ unsigned cvtpk(float lo, float hi) {
  unsigned r; asm volatile("v_cvt_pk_bf16_f32 %0, %1, %2" : "=v"(r) : "v"(lo), "v"(hi)); return r;
}
template <typename TIn> struct Stage;
template <> struct Stage<bf16>  { using T = bf16x8;
  __device__ static __forceinline__ T ld8(const bf16* p) { return *reinterpret_cast<const bf16x8*>(p); }
  __device__ static __forceinline__ bf16x8 tobf(T x) { return x; } };
template <> struct Stage<float> { using T = f32x8;
  __device__ static __forceinline__ T ld8(const float* p) { return *reinterpret_cast<const f32x8*>(p); }
  __device__ static __forceinline__ bf16x8 tobf(T x) {
    u32x4 w = {cvtpk(x[0], x[1]), cvtpk(x[2], x[3]), cvtpk(x[4], x[5]), cvtpk(x[6], x[7])}; return *reinterpret_cast<bf16x8*>(&w); } };

__device__ __forceinline__ void partialSM(f32x16& p0, f32x16& p1, float& m_reg, float& mn, float& alpha) {
  constexpr float C = SCALE * 1.4426950408889634f;
  float pmax = p0[0]; for (int r = 1; r < 16; ++r) pmax = fmaxf(pmax, p0[r]); for (int r = 0; r < 16; ++r) pmax = fmaxf(pmax, p1[r]);
  { auto rr = __builtin_amdgcn_permlane32_swap(__float_as_uint(pmax), __float_as_uint(pmax), false, false);
    pmax = fmaxf(__uint_as_float(rr[0]), __uint_as_float(rr[1])); }
  if (__builtin_expect(__all(pmax - m_reg <= THR / SCALE), 1)) { mn = m_reg; alpha = 1.f; }
  else { mn = fmaxf(m_reg, pmax); alpha = __builtin_amdgcn_exp2f((m_reg - mn) * C); m_reg = mn; }
  float mnC = -mn * C;
  for (int r = 0; r < 16; ++r) p0[r] = fmaf(p0[r], C, mnC); for (int r = 0; r < 16; ++r) p1[r] = fmaf(p1[r], C, mnC);
  for (int r = 0; r < 16; ++r) p0[r] = __builtin_amdgcn_exp2f(p0[r]);
}
__device__ __forceinline__ void finishSM(f32x16& p0, f32x16& p1, float alpha, float& l_reg, bf16x8& pa0, bf16x8& pa1, bf16x8& pa2, bf16x8& pa3) {
  for (int r = 0; r < 16; ++r) p1[r] = __builtin_amdgcn_exp2f(p1[r]);
  float ps = 0; for (int r = 0; r < 16; ++r) ps += p0[r]; for (int r = 0; r < 16; ++r) ps += p1[r];
  { auto rr = __builtin_amdgcn_permlane32_swap(__float_as_uint(ps), __float_as_uint(ps), false, false);
    ps = __uint_as_float(rr[0]) + __uint_as_float(rr[1]); }
  l_reg = l_reg * alpha + ps;
#define PK4(P, BASE, OUT) do { unsigned a0 = cvtpk(P[BASE + 0], P[BASE + 1]), a1 = cvtpk(P[BASE + 2], P[BASE + 3]);   \
    unsigned b0 = cvtpk(P[BASE + 4], P[BASE + 5]), b1 = cvtpk(P[BASE + 6], P[BASE + 7]);                              \
    auto r0 = __builtin_amdgcn_permlane32_swap(a0, b0, false, false); auto r1 = __builtin_amdgcn_permlane32_swap(a1, b1, false, false); \
    u32x4 w = {r0[0], r1[0], r0[1], r1[1]}; OUT = *reinterpret_cast<bf16x8*>(&w); } while (0)
  PK4(p0, 0, pa0); PK4(p0, 8, pa1); PK4(p1, 0, pa2); PK4(p1, 8, pa3);
#undef PK4
}
__device__ __forceinline__ void qkt(f32x16& p0, f32x16& p1, const bf16* Ks, const bf16x8* qr, int r32, int hi) {
  p0 = f32x16{}; p1 = f32x16{};
  for (int d0 = 0; d0 < 8; ++d0) { int cb = (d0 * 16 + hi * 8) * 2;
    bf16x8 b0 = *reinterpret_cast<const bf16x8*>((const char*)Ks + KSWZ(r32, cb));
    bf16x8 b1 = *reinterpret_cast<const bf16x8*>((const char*)Ks + KSWZ(32 + r32, cb));
    p0 = __builtin_amdgcn_mfma_f32_32x32x16_bf16(b0, qr[d0], p0, 0, 0, 0);
    p1 = __builtin_amdgcn_mfma_f32_32x32x16_bf16(b1, qr[d0], p1, 0, 0, 0); }
}
__device__ __forceinline__ int v_st(int k, int c) { const int kk = (k & ~0xC) | ((k & 4) << 1) | ((k & 8) >> 1); return ((kk >> 3) * 4 + (c >> 5)) * 512 + ((kk & 7) * 32 + (c & 31)) * 2; }
__device__ __forceinline__ int v_rd_base(int lane) { return ((lane & 3) << 3) | (((lane >> 2) & 3) << 6) | (((lane >> 4) & 1) << 5) | (((lane >> 5) & 1) << 8); }
constexpr int v_rd_off(int d0, int ks, int half) { return d0 * 512 + ks * 4096 + half * 2048; }
template <int OFF> __device__ __forceinline__ s16x4 tr_read(int vb) {
  s16x4 r; asm volatile("ds_read_b64_tr_b16 %0, %1 offset:%2" : "=&v"(r) : "v"(vb), "i"(OFF) : "memory"); return r;
}
template <int D0> __device__ __forceinline__ void pv_one(f32x16& od, int vb, bf16x8 pa0, bf16x8 pa1, bf16x8 pa2, bf16x8 pa3) {
  const s16x4 l0 = tr_read<v_rd_off(D0, 0, 0)>(vb), h0 = tr_read<v_rd_off(D0, 0, 1)>(vb), l1 = tr_read<v_rd_off(D0, 1, 0)>(vb), h1 = tr_read<v_rd_off(D0, 1, 1)>(vb);
  const s16x4 l2 = tr_read<v_rd_off(D0, 2, 0)>(vb), h2 = tr_read<v_rd_off(D0, 2, 1)>(vb), l3 = tr_read<v_rd_off(D0, 3, 0)>(vb), h3 = tr_read<v_rd_off(D0, 3, 1)>(vb);
  asm volatile("s_waitcnt lgkmcnt(0)" ::: "memory"); SBAR();
#define PK(L, H) (bf16x8){L[0], L[1], L[2], L[3], H[0], H[1], H[2], H[3]}
  od = __builtin_amdgcn_mfma_f32_32x32x16_bf16(pa0, PK(l0, h0), od, 0, 0, 0);
  od = __builtin_amdgcn_mfma_f32_32x32x16_bf16(pa1, PK(l1, h1), od, 0, 0, 0);
  od = __builtin_amdgcn_mfma_f32_32x32x16_bf16(pa2, PK(l2, h2), od, 0, 0, 0);
  od = __builtin_amdgcn_mfma_f32_32x32x16_bf16(pa3, PK(l3, h3), od, 0, 0, 0);
#undef PK
}
__device__ __forceinline__ void pv_d0(f32x16* o, int vb, bf16x8 pa0, bf16x8 pa1, bf16x8 pa2, bf16x8 pa3) {
  pv_one<0>(o[0], vb, pa0, pa1, pa2, pa3); pv_one<1>(o[1], vb, pa0, pa1, pa2, pa3); pv_one<2>(o[2], vb, pa0, pa1, pa2, pa3); pv_one<3>(o[3], vb, pa0, pa1, pa2, pa3);
}

template <typename TQ>
__device__ __forceinline__ void attn_dense_body(const TQ* __restrict__ Qb, const bf16* __restrict__ Kh, const bf16* __restrict__ Vh,
                                                const unsigned short* __restrict__ Gb, unsigned short* __restrict__ Ob, int seq, char* lds, int koff,
                                                const float* __restrict__ qgain, const float* __restrict__ rcos, const float* __restrict__ rsin, int tpos0) {
  using St = Stage<bf16>; using SQ = Stage<TQ>;
  const int tid = opaque_tid(), wid = tid >> 6, lane = tid & 63, r32 = lane & 31, hi = lane >> 5;
  bf16* V_lds = (bf16*)lds; bf16* K_lds = (bf16*)(lds + 2 * SHM_V);
  float* ws = (float*)(lds + 2 * SHM_V + 2 * SHM_K) + wid * 64; float* li_l = ws; float* al_l = ws + 32;
  float m_reg = -1e30f, l_reg = 0; f32x16 o[4] = {}; bf16x8 qr[8];
  const TQ* Qw = Qb + (long)(wid * QBLK + r32) * LDQ + hi * 8;
#pragma unroll
  for (int d0 = 0; d0 < 8; ++d0) qr[d0] = SQ::tobf(SQ::ld8(Qw + d0 * 16));
  {
    float ss = 0.f;
#pragma unroll
    for (int d0 = 0; d0 < 8; ++d0) { const u32x4 w = *reinterpret_cast<const u32x4*>(&qr[d0]);
      const float a0 = __uint_as_float(w.x << 16), a1 = __uint_as_float(w.x & 0xffff0000u), a2 = __uint_as_float(w.y << 16), a3 = __uint_as_float(w.y & 0xffff0000u);
      const float a4 = __uint_as_float(w.z << 16), a5 = __uint_as_float(w.z & 0xffff0000u), a6 = __uint_as_float(w.w << 16), a7 = __uint_as_float(w.w & 0xffff0000u);
      ss += (a0 * a0 + a1 * a1) + (a2 * a2 + a3 * a3) + (a4 * a4 + a5 * a5) + (a6 * a6 + a7 * a7); }
    ss += __shfl_xor(ss, 32);
    const float rstd = __builtin_amdgcn_rsqf(ss * (1.f / 128.f) + 1e-6f);
    const int tp = tpos0 + wid * QBLK + r32; const float* cp = rcos + (long)tp * 64 + hi * 4; const float* sp = rsin + (long)tp * 64 + hi * 4; const float* gp = qgain + hi * 8;
#pragma unroll
    for (int d0 = 0; d0 < 8; ++d0) { const u32x4 w = *reinterpret_cast<const u32x4*>(&qr[d0]);
      const float4 g0 = *reinterpret_cast<const float4*>(gp + d0 * 16), g1 = *reinterpret_cast<const float4*>(gp + d0 * 16 + 4), c4 = *reinterpret_cast<const float4*>(cp + d0 * 8), s4 = *reinterpret_cast<const float4*>(sp + d0 * 8);
      const float y0 = __uint_as_float(w.x << 16) * rstd * g0.x, y1 = __uint_as_float(w.x & 0xffff0000u) * rstd * g0.y, y2 = __uint_as_float(w.y << 16) * rstd * g0.z, y3 = __uint_as_float(w.y & 0xffff0000u) * rstd * g0.w;
      const float y4 = __uint_as_float(w.z << 16) * rstd * g1.x, y5 = __uint_as_float(w.z & 0xffff0000u) * rstd * g1.y, y6 = __uint_as_float(w.w << 16) * rstd * g1.z, y7 = __uint_as_float(w.w & 0xffff0000u) * rstd * g1.w;
      u32x4 o = {cvtpk(y0 * c4.x - y1 * s4.x, y0 * s4.x + y1 * c4.x), cvtpk(y2 * c4.y - y3 * s4.y, y2 * s4.y + y3 * c4.y), cvtpk(y4 * c4.z - y5 * s4.z, y4 * s4.z + y5 * c4.z), cvtpk(y6 * c4.w - y7 * s4.w, y6 * s4.w + y7 * c4.w)};
      qr[d0] = *reinterpret_cast<bf16x8*>(&o); }
  }
  const int sr = tid >> 4, sc = (tid & 15) * 8, vst0 = v_st(sr, sc), vst1 = v_st(32 + sr, sc);
  const int vb0 = (int)(uintptr_t)V_lds + v_rd_base(lane);
  struct { typename St::T vs0, vs1, ks0, ks1; } sr_[SDEPTH];
#define SLOAD(i, k0) do { const int kk_ = ((k0) + koff) & (seq - 1); sr_[i].vs0 = St::ld8(&Vh[(long)(kk_ + sr) * LDK + sc]); sr_[i].vs1 = St::ld8(&Vh[(long)(kk_ + 32 + sr) * LDK + sc]); \
    sr_[i].ks0 = St::ld8(&Kh[(long)(kk_ + sr) * LDK + sc]); sr_[i].ks1 = St::ld8(&Kh[(long)(kk_ + 32 + sr) * LDK + sc]); } while (0)
#define SWRITE(b, i) do { *(bf16x8*)((char*)V_lds + (b) * SHM_V + vst0) = St::tobf(sr_[i].vs0);          \
    *(bf16x8*)((char*)V_lds + (b) * SHM_V + vst1) = St::tobf(sr_[i].vs1); int kc = sc * 2;               \
    *(bf16x8*)((char*)K_lds + (b) * SHM_K + KSWZ(sr, kc)) = St::tobf(sr_[i].ks0);                       \
    *(bf16x8*)((char*)K_lds + (b) * SHM_K + KSWZ(32 + sr, kc)) = St::tobf(sr_[i].ks1); } while (0)
#define SWAIT() do { if constexpr (SDEPTH == 2) asm volatile("s_waitcnt vmcnt(4)" ::: "memory"); else asm volatile("s_waitcnt vmcnt(0)" ::: "memory"); } while (0)
#define RESC(a) do { if (__any((a) < 1.f)) { if (hi == 0) al_l[r32] = (a); asm volatile("s_waitcnt lgkmcnt(0)" ::: "memory"); \
    for (int d = 0; d < 4; ++d) for (int r = 0; r < 16; ++r) o[d][r] *= al_l[crow(r, hi)]; } } while (0)
  f32x16 pA0, pA1, pB0, pB1; float mnA, mnB, alA, alB; bf16x8 pa0, pa1, pa2, pa3; const int NT = seq / KVBLK;
  constexpr int SE = 0, SO = SDEPTH - 1;
  SLOAD(SE, 0); asm volatile("s_waitcnt vmcnt(0)" ::: "memory"); SWRITE(0, SE); __syncthreads();
  qkt(pA0, pA1, K_lds, qr, r32, hi); partialSM(pA0, pA1, m_reg, mnA, alA);
  SLOAD(SO, KVBLK); if constexpr (SDEPTH == 2) { if (2 < NT) SLOAD(SE, 2 * KVBLK); }
  SWAIT(); SWRITE(1, SO); __syncthreads();
  for (int j = 1; j + 1 < NT; j += 2) {
    SBAR(); qkt(pB0, pB1, (bf16*)((char*)K_lds + SHM_K), qr, r32, hi);
    finishSM(pA0, pA1, alA, l_reg, pa0, pa1, pa2, pa3); SBAR();
    SLOAD(SO, (j + SDEPTH) * KVBLK); SBAR();
    pv_d0(o, vb0, pa0, pa1, pa2, pa3); partialSM(pB0, pB1, m_reg, mnB, alB);
    __syncthreads(); SWAIT(); SWRITE(0, SE);
    RESC(alB); __syncthreads();
    SBAR(); qkt(pA0, pA1, K_lds, qr, r32, hi);
    finishSM(pB0, pB1, alB, l_reg, pa0, pa1, pa2, pa3); SBAR();
    if (SDEPTH == 1 || j + 3 < NT) SLOAD(SE, (j + 1 + SDEPTH) * KVBLK); SBAR();
    pv_d0(o, vb0 + (int)SHM_V, pa0, pa1, pa2, pa3); partialSM(pA0, pA1, m_reg, mnA, alA);
    __syncthreads(); SWAIT(); SWRITE(1, SO);
    RESC(alA); __syncthreads();
  }
  SBAR(); qkt(pB0, pB1, (bf16*)((char*)K_lds + SHM_K), qr, r32, hi);
  finishSM(pA0, pA1, alA, l_reg, pa0, pa1, pa2, pa3); SBAR();
  pv_d0(o, vb0, pa0, pa1, pa2, pa3); partialSM(pB0, pB1, m_reg, mnB, alB);
  __syncthreads(); RESC(alB);
  finishSM(pB0, pB1, alB, l_reg, pa0, pa1, pa2, pa3); SBAR();
  pv_d0(o, vb0 + (int)SHM_V, pa0, pa1, pa2, pa3);
  if (hi == 0) li_l[r32] = l_reg; asm volatile("s_waitcnt lgkmcnt(0)" ::: "memory");
  float rli[16];
#pragma unroll
  for (int r = 0; r < 16; ++r) rli[r] = __builtin_amdgcn_rcpf(li_l[crow(r, hi)]);
  unsigned short* Ow = Ob + (long)(wid * QBLK) * LDO + r32; const unsigned short* Gw = Gb + (long)(wid * QBLK) * LDQ + r32;
  unsigned short gq[16][4];
#pragma unroll
  for (int r = 0; r < 16; ++r) { const unsigned short* gp = Gw + (long)crow(r, hi) * LDQ;
#pragma unroll
    for (int d0 = 0; d0 < 4; ++d0) gq[r][d0] = gp[d0 * 32]; }
#pragma unroll
  for (int r = 0; r < 16; ++r) { unsigned short* op = Ow + (long)crow(r, hi) * LDO;
#pragma unroll
    for (int d0 = 0; d0 < 4; ++d0) { const float gv = __uint_as_float(((unsigned)gq[r][d0]) << 16);
      const float sg = gv * __builtin_amdgcn_rcpf(1.f + __builtin_amdgcn_exp2f(-1.4426950408889634f * gv));
      const float val = o[d0][r] * rli[r] * sg; unsigned u = __float_as_uint(val); u += 0x7fffu + ((u >> 16) & 1u);
      op[d0 * 32] = (unsigned short)(u >> 16); } }
#undef SLOAD
#undef SWRITE
#undef SWAIT
#undef RESC
}
}

struct Args {
    const float *x, *c, *w_mod, *b_mod, *pool_w_in, *pool_w_grp, *pool_scale, *pool_w_out;
    const float *gla_w_in, *gla_fwd_w1, *gla_fwd_w2, *gla_fwd_b, *gla_bwd_w1, *gla_bwd_w2, *gla_bwd_b, *gla_norm_g, *gla_w_out;
    const float *attn_w_in, *attn_qg, *attn_kg, *attn_w_out, *final_g;
    float* out; unsigned char* ws;
};
#define LDS_WAIT() asm volatile("s_waitcnt lgkmcnt(0)" ::: "memory")

__device__ __forceinline__ void transpose_item(const float* W, int K, int N, bf16_t* WT, int row_off, LAS float* scr, int item, int lane) {
    const int nblk = N / 32, kb = item / nblk, nb = item % nblk, k0 = 64 * kb, n0 = 32 * nb;
    float wv[32];
#pragma unroll
    for (int i = 0; i < 32; ++i) wv[i] = W[(size_t)(k0 + 2 * i + (lane >> 5)) * N + n0 + (lane & 31)];
#pragma unroll
    for (int i = 0; i < 32; ++i) scr[(2 * i + (lane >> 5)) * 33 + (lane & 31)] = wv[i];
    LDS_WAIT();
    const int c = lane & 7;
#pragma unroll
    for (int j = 0; j < 4; ++j) { const int n = (lane >> 3) + 8 * j; const LAS float* s = scr + (8 * c) * 33 + n;
        u32x4 o; o.x = cvt_pk_bf16(s[0 * 33], s[1 * 33]); o.y = cvt_pk_bf16(s[2 * 33], s[3 * 33]); o.z = cvt_pk_bf16(s[4 * 33], s[5 * 33]); o.w = cvt_pk_bf16(s[6 * 33], s[7 * 33]);
        *(u32x4*)(WT + (size_t)(row_off + n0 + n) * K + k0 + 8 * c) = o; }
    LDS_WAIT();
}
__device__ __forceinline__ void phase_weights(const Args& a, int L, LAS unsigned char* lds) {
    const int tid_ = opaque_tid(), lane = tid_ & 63, wave = __builtin_amdgcn_readfirstlane(tid_ >> 6), gw = blockIdx.x * 8 + wave, NGW = gridDim.x * 8; (void)wave; (void)gw; (void)NGW; (void)lane;
    LAS float* scr = (LAS float*)(lds + wave * 8704);
    bf16_t* WB = (bf16_t*)(a.ws + WS_WB); bf16_t* WBG = (bf16_t*)(a.ws + WS_WB + 16 * MiB); bf16_t* WBO = (bf16_t*)(a.ws + WS_WB + 24 * MiB);
    const int kind = L % 3, j = L / 3;
    if (kind == 0) {
        const float* win = a.pool_w_in + (size_t)j * 2048 * 4096; const float* wgrp = a.pool_w_grp + (size_t)j * 4 * 512 * 512; const float* wout = a.pool_w_out + (size_t)j * 2048 * 2048;
        constexpr int I_IN = 32 * 128, I_G = 8 * 16, I_OUT = 32 * 64;
        for (int it = gw; it < I_IN + 4 * I_G + I_OUT; it += NGW) {
            int r = it;
            if (r < I_IN) { transpose_item(win, 2048, 4096, WB, 0, scr, r, lane); continue; } r -= I_IN;
            if (r < 4 * I_G) { const int g = r / I_G; transpose_item(wgrp + (size_t)g * 512 * 512, 512, 512, WBG, g * 512, scr, r % I_G, lane); continue; } r -= 4 * I_G;
            transpose_item(wout, 2048, 2048, WBO, 0, scr, r, lane);
        }
    } else if (kind == 1) {
        constexpr int I_IN = 32 * 192, I_OUT = 32 * 64;
        for (int it = gw; it < I_IN + I_OUT; it += NGW) {
            int r = it;
            if (r < I_IN) { transpose_item(a.gla_w_in, 2048, 6144, WB, 0, scr, r, lane); continue; } r -= I_IN;
            transpose_item(a.gla_w_out, 2048, 2048, WBO, 0, scr, r, lane);
        }
        bf16_t* W1T = (bf16_t*)(a.ws + WS_W1T);
#pragma clang loop unroll(disable)
        for (int base = gw * 64; base < 32 * 2048; base += NGW * 64) { const int i = base + lane, n = i >> 11, k = i & 2047;
            W1T[i] = f2bf(n < 16 ? a.gla_fwd_w1[k * 16 + n] : a.gla_bwd_w1[k * 16 + n - 16]); }
    } else {
        constexpr int I_IN = 32 * 160, I_OUT = 32 * 64;
        for (int it = gw; it < I_IN + I_OUT; it += NGW) {
            int r = it;
            if (r < I_IN) { transpose_item(a.attn_w_in, 2048, 5120, WB, 0, scr, r, lane); continue; } r -= I_IN;
            transpose_item(a.attn_w_out, 2048, 2048, WBO, 0, scr, r, lane);
        }
    }
}
#define ROWS2_LOAD(V, xp, mm) do { _Pragma("unroll") for (int r_ = 0; r_ < 2; ++r_) { const f32x4* xr_ = (const f32x4*)((xp) + (size_t)((mm) + r_ * NGW) * DM) + lane; \
        _Pragma("unroll") for (int j_ = 0; j_ < 8; ++j_) V[r_][j_] = xr_[64 * j_]; } } while (0)
#define ROWS2_SS(V, s) do { _Pragma("unroll") for (int r_ = 0; r_ < 2; ++r_) { float t_ = 0.f; \
        _Pragma("unroll") for (int j_ = 0; j_ < 8; ++j_) t_ += (V[r_][j_].x * V[r_][j_].x + V[r_][j_].y * V[r_][j_].y) + (V[r_][j_].z * V[r_][j_].z + V[r_][j_].w * V[r_][j_].w); s[r_] = t_; } } while (0)
#define ROWS2C_LOAD(V, xp, mm) do { _Pragma("unroll") for (int r_ = 0; r_ < 2; ++r_) { const f32x4* xr_ = (const f32x4*)((xp) + (size_t)((mm) + r_) * DM) + lane; \
        _Pragma("unroll") for (int j_ = 0; j_ < 8; ++j_) V[r_][j_] = xr_[64 * j_]; } } while (0)
__device__ __forceinline__ void phase_norm_mod(const float* x, const float* modL, bf16_t* hb) {
    const int tid_ = opaque_tid(), lane = tid_ & 63, wave = __builtin_amdgcn_readfirstlane(tid_ >> 6), gw = blockIdx.x * 8 + wave, NGW = gridDim.x * 8;
#define NM_PROC(V, mm) do { float s_[2]; ROWS2_SS(V, s_); \
        _Pragma("unroll") for (int r = 0; r < 2; ++r) { const int mr = (mm) + r; const float rstd = __builtin_amdgcn_rsqf(wave_sum(s_[r]) * (1.f / DM) + NEPS); \
            u32x2* o8 = (u32x2*)(hb + (size_t)mr * DM) + lane; \
            _Pragma("unroll") for (int j = 0; j < 8; ++j) { const f32x4 h = V[r][j] * rstd * sc1[j] + sh[j]; u32x2 w; w.x = cvt_pk_bf16(h.x, h.y); w.y = cvt_pk_bf16(h.z, h.w); o8[64 * j] = w; } } } while (0)
    for (int g16 = gw; g16 < MTOK / 16; g16 += NGW) {
        const int m0 = g16 * 16; const float* mp = modL + (size_t)(m0 / SEQ) * 6144;
        f32x4 va[2][8], vb[2][8], sh[8], sc1[8];
        ROWS2C_LOAD(va, x, m0);
#pragma unroll
        for (int j = 0; j < 8; ++j) { sh[j] = *((const f32x4*)mp + lane + 64 * j); sc1[j] = *((const f32x4*)(mp + 2048) + lane + 64 * j) + 1.f; }
#pragma unroll 1
        for (int i = 0; i < 16; i += 4) {
            ROWS2C_LOAD(vb, x, m0 + i + 2);
            NM_PROC(va, m0 + i);
            if (i + 4 < 16) ROWS2C_LOAD(va, x, m0 + i + 4);
            NM_PROC(vb, m0 + i + 2);
        }
    }
#undef NM_PROC
}
__device__ __forceinline__ void phase_norm_mod_bf(const bf16_t* xb, const float* modL, bf16_t* hb) {
    const int tid_ = opaque_tid(), lane = tid_ & 63, wave = __builtin_amdgcn_readfirstlane(tid_ >> 6), gw = blockIdx.x * 8 + wave, NGW = gridDim.x * 8;
    for (int g16 = gw; g16 < MTOK / 16; g16 += NGW) {
        const int m0 = g16 * 16; const float* mp = modL + (size_t)(m0 / SEQ) * 6144;
        u32x4 va[2][4], vb[2][4]; f32x4 sh[4][2], sc1[4][2];
#define NB_LOAD(V, mm) do { _Pragma("unroll") for (int r_ = 0; r_ < 2; ++r_) { const u32x4* xr_ = (const u32x4*)(xb + (size_t)((mm) + r_) * DM) + lane; \
        _Pragma("unroll") for (int j_ = 0; j_ < 4; ++j_) V[r_][j_] = xr_[64 * j_]; } } while (0)
#define NB_PROC(V, mm) do { _Pragma("unroll") for (int r = 0; r < 2; ++r) { float f[4][8]; float s = 0.f; \
        _Pragma("unroll") for (int j = 0; j < 4; ++j) { const u32x4 w = V[r][j]; f[j][0] = bf_lo(w.x); f[j][1] = bf_hi(w.x); f[j][2] = bf_lo(w.y); f[j][3] = bf_hi(w.y); f[j][4] = bf_lo(w.z); f[j][5] = bf_hi(w.z); f[j][6] = bf_lo(w.w); f[j][7] = bf_hi(w.w); \
            _Pragma("unroll") for (int q = 0; q < 8; ++q) s += f[j][q] * f[j][q]; } \
        const float rstd = __builtin_amdgcn_rsqf(wave_sum(s) * (1.f / DM) + NEPS); u32x4* o16 = (u32x4*)(hb + (size_t)((mm) + r) * DM) + lane; \
        _Pragma("unroll") for (int j = 0; j < 4; ++j) { u32x4 w; \
            w.x = cvt_pk_bf16(f[j][0] * rstd * sc1[j][0][0] + sh[j][0][0], f[j][1] * rstd * sc1[j][0][1] + sh[j][0][1]); w.y = cvt_pk_bf16(f[j][2] * rstd * sc1[j][0][2] + sh[j][0][2], f[j][3] * rstd * sc1[j][0][3] + sh[j][0][3]); \
            w.z = cvt_pk_bf16(f[j][4] * rstd * sc1[j][1][0] + sh[j][1][0], f[j][5] * rstd * sc1[j][1][1] + sh[j][1][1]); w.w = cvt_pk_bf16(f[j][6] * rstd * sc1[j][1][2] + sh[j][1][2], f[j][7] * rstd * sc1[j][1][3] + sh[j][1][3]); \
            o16[64 * j] = w; } } } while (0)
        NB_LOAD(va, m0);
#pragma unroll
        for (int j = 0; j < 4; ++j)
#pragma unroll
            for (int q = 0; q < 2; ++q) { sh[j][q] = *(const f32x4*)(mp + (lane + 64 * j) * 8 + 4 * q); sc1[j][q] = *(const f32x4*)(mp + 2048 + (lane + 64 * j) * 8 + 4 * q) + 1.f; }
#pragma unroll 1
        for (int i = 0; i < 16; i += 4) {
            NB_LOAD(vb, m0 + i + 2);
            NB_PROC(va, m0 + i);
            if (i + 4 < 16) NB_LOAD(va, m0 + i + 4);
            NB_PROC(vb, m0 + i + 2);
        }
#undef NB_LOAD
#undef NB_PROC
    }
}
__device__ __forceinline__ void phase_final_norm(const float* x, const float* g, float* outp) {
    const int tid_ = opaque_tid(), lane = tid_ & 63, wave = __builtin_amdgcn_readfirstlane(tid_ >> 6), gw = blockIdx.x * 8 + wave, NGW = gridDim.x * 8;
    f32x4 gg[8];
#pragma unroll
    for (int j = 0; j < 8; ++j) gg[j] = *((const f32x4*)g + lane + 64 * j);
#define FN_PROC(V, mm) do { float s_[2]; ROWS2_SS(V, s_); \
        _Pragma("unroll") for (int r = 0; r < 2; ++r) { f32x4* xr = (f32x4*)(outp + (size_t)((mm) + r) * DM) + lane; const float rstd = __builtin_amdgcn_rsqf(wave_sum(s_[r]) * (1.f / DM) + NEPS); \
            _Pragma("unroll") for (int j = 0; j < 8; ++j) xr[64 * j] = V[r][j] * rstd * gg[j]; } } while (0)
    for (int g16 = gw; g16 < MTOK / 16; g16 += NGW) {
        const int m0 = g16 * 16;
        f32x4 va[2][8], vb[2][8];
        ROWS2C_LOAD(va, x, m0);
#pragma unroll 1
        for (int i = 0; i < 16; i += 4) {
            ROWS2C_LOAD(vb, x, m0 + i + 2);
            FN_PROC(va, m0 + i);
            if (i + 4 < 16) ROWS2C_LOAD(va, x, m0 + i + 4);
            FN_PROC(vb, m0 + i + 2);
        }
    }
#undef FN_PROC
}
__device__ __forceinline__ void phase_mod(const Args& a, LAS unsigned char* lds, float* mod) {
    LAS float* sc = (LAS float*)lds; LAS float* part = (LAS float*)(lds + 32768);
    const int tid = opaque_tid();
    if ((int)blockIdx.x >= 192) return;
    for (int i = tid; i < 8192; i += 512) sc[i] = silu_f(a.c[i]);
    __syncthreads();
    for (int item = blockIdx.x; item < 192; item += gridDim.x) {
        const int layer = item / 48, n0 = (item % 48) * 128, ks = tid >> 5, cq = tid & 31;
        f32x4 acc[4];
#pragma unroll
        for (int b = 0; b < 4; ++b) acc[b] = (f32x4){0.f, 0.f, 0.f, 0.f};
        const float* wp = a.w_mod + ((size_t)layer * 2048 + ks * 128) * 6144 + n0 + cq * 4;
#pragma unroll 16
        for (int k = 0; k < 128; ++k) { const f32x4 w = *(const f32x4*)(wp + (size_t)k * 6144); const int kk = ks * 128 + k;
#pragma unroll
            for (int b = 0; b < 4; ++b) acc[b] += w * sc[b * 2048 + kk]; }
#pragma unroll
        for (int b = 0; b < 4; ++b) *(LAS f32x4*)(part + (ks * 4 + b) * 128 + cq * 4) = acc[b];
        __syncthreads();
        { const int b = tid >> 7, col = tid & 127; float s = a.b_mod[layer * 6144 + n0 + col];
#pragma unroll
          for (int q = 0; q < 16; ++q) s += part[(q * 4 + b) * 128 + col];
          mod[(size_t)(layer * 4 + b) * 6144 + n0 + col] = s; }
        __syncthreads();
    }
}
__device__ __forceinline__ void phase_rope_table(float* rc, float* rs) {
#pragma clang loop unroll(disable)
    for (int idx = blockIdx.x * 512 + opaque_tid(); idx < SEQ * 64; idx += gridDim.x * 512) {
        const int t = idx >> 6, i = idx & 63;
        const float pos = (i < 32) ? (float)((t >> 6) - 64) : (float)((t & 63) - 32);
        const float inv = __builtin_amdgcn_exp2f(-(float)(i & 31) * 0.41524101186092029f);
        const float ang = pos * inv;
        const double xd = (double)ang; const double n = __builtin_rint(xd * 0.63661977236758134); const float rf = (float)(xd - n * 1.5707963267948966);
        const int q = ((int)n) & 3; const float r2 = rf * rf;
        const float sn = rf + rf * r2 * (-1.6666667e-1f + r2 * (8.3333333e-3f + r2 * (-1.9841270e-4f + r2 * 2.7557319e-6f)));
        const float cs = 1.f + r2 * (-0.5f + r2 * (4.1666667e-2f + r2 * (-1.3888889e-3f + r2 * (2.4801587e-5f + r2 * -2.7557319e-7f))));
        const float co = (q == 0) ? cs : (q == 1) ? -sn : (q == 2) ? -cs : sn;
        const float si = (q == 0) ? sn : (q == 1) ? cs : (q == 2) ? -sn : -cs;
        rc[idx] = co; rs[idx] = si;
    }
}
__device__ __forceinline__ void acc8(float (&s)[8], const u32x4 w, const float f) {
    s[0] += f * bf_lo(w.x); s[1] += f * bf_hi(w.x); s[2] += f * bf_lo(w.y); s[3] += f * bf_hi(w.y); s[4] += f * bf_lo(w.z); s[5] += f * bf_hi(w.z); s[6] += f * bf_lo(w.w); s[7] += f * bf_hi(w.w); }
__device__ __forceinline__ void phase_pool(const bf16_t* proj  , bf16_t* pooled) {
    const int tid_ = opaque_tid(), lane = tid_ & 63, wave = __builtin_amdgcn_readfirstlane(tid_ >> 6), gw = blockIdx.x * 8 + wave, NGW = gridDim.x * 8;
    for (int unit = gw; unit < (MTOK / 64) * 4; unit += NGW) {
        const int run = unit >> 2, j = unit & 3, half = 1 << j, m0 = run * 64, t0 = m0 & (SEQ - 1), c = (j * 64 + lane) * 8;
        const bf16_t* base = proj + (size_t)(m0 - t0) * 4096 + c; bf16_t* outp = pooled + (size_t)(m0 - t0) * 2048 + c;
        float S[8];
#pragma unroll
        for (int q = 0; q < 8; ++q) S[q] = 0.f;
        { u32x4 wi[16]; float fi[16];
#pragma unroll
          for (int q = 0; q < 16; ++q) { const int r = t0 - half + q, rc2 = r < 0 ? 0 : (r >= SEQ ? SEQ - 1 : r); fi[q] = (q < 2 * half && r >= 0 && r < SEQ) ? 1.f : 0.f; wi[q] = *(const u32x4*)(base + (size_t)rc2 * 4096); }
#pragma unroll
          for (int q = 0; q < 16; ++q) acc8(S, wi[q], fi[q]); }
#pragma unroll 8
        for (int tt = 0; tt < 64; ++tt) {
            const int t = t0 + tt, lo = (t - half) > 0 ? (t - half) : 0, hi = (t + half) < SEQ ? (t + half) : SEQ;
            const int ra = (t + half) < SEQ ? (t + half) : (SEQ - 1), rs = (t - half) > 0 ? (t - half) : 0;
            const float fa = (t + half) < SEQ ? 1.f : 0.f, fs = (t - half) >= 0 ? -1.f : 0.f;
            const u32x4 u = *(const u32x4*)(base + (size_t)t * 4096), wa = *(const u32x4*)(base + (size_t)ra * 4096), ws = *(const u32x4*)(base + (size_t)rs * 4096);
            const float ic = 1.f / (float)(hi - lo);
            u32x4 o; o.x = cvt_pk_bf16(S[0] * ic - bf_lo(u.x), S[1] * ic - bf_hi(u.x)); o.y = cvt_pk_bf16(S[2] * ic - bf_lo(u.y), S[3] * ic - bf_hi(u.y));
            o.z = cvt_pk_bf16(S[4] * ic - bf_lo(u.z), S[5] * ic - bf_hi(u.z)); o.w = cvt_pk_bf16(S[6] * ic - bf_lo(u.w), S[7] * ic - bf_hi(u.w));
            *(u32x4*)(outp + (size_t)t * 2048) = o;
            acc8(S, wa, fa); acc8(S, ws, fs);
        }
    }
}
__device__ __forceinline__ void phase_knorm_rope(bf16_t* proj, const float* kg, const float* rc, const float* rs) {
    const int tid_ = opaque_tid(), lane = tid_ & 63, wave = __builtin_amdgcn_readfirstlane(tid_ >> 6), gw = blockIdx.x * 8 + wave, NGW = gridDim.x * 8;
    const float k0 = kg[2 * lane], k1 = kg[2 * lane + 1];
    for (int m = gw; m < MTOK; m += 2 * NGW) {
        unsigned w[2][4]; float co[2], si[2];
#pragma unroll
        for (int r = 0; r < 2; ++r) { const int mm = m + r * NGW, t = mm & (SEQ - 1); co[r] = rc[t * 64 + lane]; si[r] = rs[t * 64 + lane];
            const unsigned* row = (const unsigned*)(proj + (size_t)mm * 5120 + 2048) + lane;
#pragma unroll
            for (int h = 0; h < 4; ++h) w[r][h] = row[h * 64]; }
#pragma unroll
        for (int r = 0; r < 2; ++r) { unsigned* row = (unsigned*)(proj + (size_t)(m + r * NGW) * 5120 + 2048) + lane;
#pragma unroll
            for (int h = 0; h < 4; ++h) {
                const float x0 = bf_lo(w[r][h]), x1 = bf_hi(w[r][h]);
                const float rstd = __builtin_amdgcn_rsqf(wave_sum(x0 * x0 + x1 * x1) * (1.f / 128.f) + NEPS);
                const float y0 = x0 * rstd * k0, y1 = x1 * rstd * k1;
                row[h * 64] = cvt_pk_bf16(y0 * co[r] - y1 * si[r], y0 * si[r] + y1 * co[r]);
            } }
    }
}

__device__ __forceinline__ f32x4 mfma16(bf16x8 x, bf16x8 y, f32x4 acc) { return __builtin_amdgcn_mfma_f32_16x16x32_bf16(x, y, acc, 0, 0, 0); }

__device__ __forceinline__ void phase_gla_lowrank(const bf16_t* hb, const bf16_t* w1t, float* R, LAS unsigned char* lds) {
    const int tid_ = opaque_tid(), lane = tid_ & 63, wave = __builtin_amdgcn_readfirstlane(tid_ >> 6), gw = blockIdx.x * 8 + wave, NGW = gridDim.x * 8;
    const int fr = lane & 15, fq = lane >> 4;
    for (int i = tid_; i < 32 * 256; i += 512) { const int n = i >> 8, c16 = i & 255; *(LAS u32x4*)(lds + n * 4112 + c16 * 16) = *(const u32x4*)(w1t + n * 2048 + c16 * 8); }
    __syncthreads();
    const LAS unsigned char* wl = lds + fr * 4112 + fq * 16;
    for (int u = gw; u < MTOK / 16; u += NGW) {
        const bf16_t* ap = hb + (size_t)(u * 16 + fr) * 2048 + fq * 8;
        f32x4 acc0 = (f32x4){0.f, 0.f, 0.f, 0.f}, acc1 = acc0;
#pragma unroll 16
        for (int ks = 0; ks < 64; ++ks) { const bf16x8 av = *(const bf16x8*)(ap + ks * 32);
            acc0 = mfma16(*(const LAS bf16x8*)(wl + ks * 64), av, acc0); acc1 = mfma16(*(const LAS bf16x8*)(wl + 16 * 4112 + ks * 64), av, acc1); }
        float* rp = R + (size_t)(u * 16 + fr) * 32 + 4 * fq;
        *(f32x4*)rp = acc0; *(f32x4*)(rp + 16) = acc1;
    }
    __syncthreads();
}
__device__ __forceinline__ bf16_t f2bf1(float v) { return (bf16_t)(cvt_pk_bf16(v, 0.f) & 0xffffu); }
constexpr int G1_QI = 8192, G1_KI = G1_QI + 32768, G1_QT = G1_KI + 32768, G1_KT = G1_QT + 64 * 528, G1_TOT = G1_KT + 64 * 528, G1_END = G1_TOT + 2048;
__device__ __forceinline__ bf16x8 frag(const LAS unsigned char* base, int pitch, int row, int ks, int fq) { return *(const LAS bf16x8*)(base + row * pitch + ks * 64 + fq * 16); }
template <int dir> __device__ __forceinline__ void gla_prep_dir(const Args& a, LAS unsigned char* lds, const int tid, const int b, const int cc, const int h, const size_t tok0) {
    const LAS float* rl = (const LAS float*)lds; const LAS bf16_t* qi = (const LAS bf16_t*)(lds + G1_QI); const LAS bf16_t* ki = (const LAS bf16_t*)(lds + G1_KI);
    LAS float* tot = (LAS float*)(lds + G1_TOT); LAS float* bl = tot + 256;
    const int d = tid & 255, half = __builtin_amdgcn_readfirstlane(tid >> 8), col = h * 256 + d;
    const int wave = __builtin_amdgcn_readfirstlane(tid >> 6), lane = tid & 63, fr = lane & 15, fq = lane >> 4;
    const float* w2 = dir ? a.gla_bwd_w2 : a.gla_fwd_w2; const float* bs = dir ? a.gla_bwd_b : a.gla_fwd_b;
    float w2c[16];
#pragma unroll
    for (int c = 0; c < 16; ++c) w2c[c] = w2[c * 1024 + col];
    const float bias = bs[col];
    float eb[32]; float run = 0.f;
#pragma unroll
    for (int i = 0; i < 32; ++i) { const int pi = half * 32 + i, t = dir ? 63 - pi : pi; float z = bias;
#pragma unroll
        for (int c4 = 0; c4 < 4; ++c4) { const f32x4 rv = *(const LAS f32x4*)(rl + t * 32 + dir * 16 + c4 * 4);
            z += rv.x * w2c[c4 * 4] + rv.y * w2c[c4 * 4 + 1] + rv.z * w2c[c4 * 4 + 2] + rv.w * w2c[c4 * 4 + 3]; }
        const float ls = fminf(z, 0.f) - __logf(1.f + __expf(-fabsf(z)));
        run += ls * 0.0625f; eb[i] = run; if ((i & 3) == 3) asm volatile("" ::: "memory"); }
    if (half == 0) tot[d] = run;
    __syncthreads();
    const float add = half ? tot[d] : 0.f;
    if (half == 1) bl[d] = run + add;
    __syncthreads();
    const float ebl = __expf(bl[d]);
    bf16_t* khp = (bf16_t*)(a.ws + WS_QKK + 256 * MiB) + ((((size_t)dir * 4 + b) * 128 + cc) * 4 + h) * (256 * 64) + (size_t)d * 64;
#pragma unroll
    for (int gi = 0; gi < 4; ++gi) {
        float kh[8];
#pragma unroll
        for (int q = 0; q < 8; ++q) { const int i = gi * 8 + q, pi = half * 32 + i, t = dir ? 63 - pi : pi;
            const float e = __expf(eb[i] + add);
            *(LAS bf16_t*)(lds + G1_QT + t * 528 + d * 2) = f2bf1(bf2f(qi[t * 256 + d]) * 0.0625f * e);
            const float ktv = bf2f(ki[t * 256 + d]) * __builtin_amdgcn_rcpf(e);
            *(LAS bf16_t*)(lds + G1_KT + t * 528 + d * 2) = f2bf1(ktv); kh[q] = ktv * ebl; }
        u32x4 o;
        if (dir) { o.x = cvt_pk_bf16(kh[7], kh[6]); o.y = cvt_pk_bf16(kh[5], kh[4]); o.z = cvt_pk_bf16(kh[3], kh[2]); o.w = cvt_pk_bf16(kh[1], kh[0]); }
        else     { o.x = cvt_pk_bf16(kh[0], kh[1]); o.y = cvt_pk_bf16(kh[2], kh[3]); o.z = cvt_pk_bf16(kh[4], kh[5]); o.w = cvt_pk_bf16(kh[6], kh[7]); }
        *(u32x4*)(khp + (dir ? 56 - half * 32 - gi * 8 : half * 32 + gi * 8)) = o;
        asm volatile("" ::: "memory");
    }
    if (half == 0) ((float*)(a.ws + WS_DL))[(((size_t)dir * 4 + b) * 128 + cc) * 1024 + col] = ebl;
    __syncthreads();
    { const int it = wave >> 1, jt0 = (wave & 1) * 2; f32x4 am[2] = {(f32x4){0.f, 0.f, 0.f, 0.f}, (f32x4){0.f, 0.f, 0.f, 0.f}};
#pragma unroll
      for (int ks = 0; ks < 8; ++ks) { const bf16x8 fqt = frag(lds + G1_QT, 528, it * 16 + fr, ks, fq);
#pragma unroll
          for (int n = 0; n < 2; ++n) am[n] = __builtin_amdgcn_mfma_f32_16x16x32_bf16(frag(lds + G1_KT, 528, (jt0 + n) * 16 + fr, ks, fq), fqt, am[n], 0, 0, 0); }
      bf16_t* amg = (bf16_t*)(a.ws + WS_QKK + 128 * MiB) + ((((size_t)dir * 4 + b) * 128 + cc) * 4 + h) * (64 * 64);
#pragma unroll
      for (int n = 0; n < 2; ++n) { const int i = it * 16 + fr, j0 = (jt0 + n) * 16 + 4 * fq; float v[4];
#pragma unroll
          for (int r = 0; r < 4; ++r) { const int j = j0 + r; const bool keep = dir ? (j > i) : (j <= i); v[r] = keep ? am[n][r] : 0.f; }
          u32x2 w; w.x = cvt_pk_bf16(v[0], v[1]); w.y = cvt_pk_bf16(v[2], v[3]); *(u32x2*)(amg + i * 64 + j0) = w; } }
    { bf16_t* QT = (bf16_t*)(a.ws + WS_QKK) + (size_t)dir * MTOK * 1024; const unsigned stoff = ((unsigned)(tid >> 5) * 1024u + (unsigned)(tid & 31) * 8u) * 2u;
#pragma unroll
      for (int i = 0; i < 4; ++i) { char* p = (char*)(QT + (tok0 + 16 * i) * 1024 + h * 256);
          *(u32x4*)(p + stoff) = *(const LAS u32x4*)(lds + G1_QT + ((tid >> 5) + 16 * i) * 528 + (tid & 31) * 16); } }
    __syncthreads();
}
__device__ __forceinline__ void phase_gla_prep(const Args& a, LAS unsigned char* lds) {
    const int tid = opaque_tid();
    const bf16_t* proj = (const bf16_t*)(a.ws + WS_PROJ); const float* R = (const float*)(a.ws + WS_R);
    const unsigned ltoff = ((unsigned)(tid >> 5) * 6144u + (unsigned)(tid & 31) * 8u) * 2u;
    for (int u = blockIdx.x; u < 2048; u += gridDim.x) {
        const int b = u >> 9, cc = (u >> 2) & 127, h = u & 3; const size_t tok0 = (size_t)b * SEQ + cc * 64;
#pragma unroll
        for (int i = 0; i < 4; ++i) { const char* p = (const char*)(proj + (tok0 + 16 * i) * 6144 + h * 256); const int idx = tid + 512 * i;
            *(LAS u32x4*)(lds + G1_QI + idx * 16) = *(const u32x4*)(p + ltoff); *(LAS u32x4*)(lds + G1_KI + idx * 16) = *(const u32x4*)(p + 2048 + ltoff); }
        *(LAS f32x4*)((LAS float*)lds + tid * 4) = *(const f32x4*)(R + tok0 * 32 + tid * 4);
        __syncthreads();
        gla_prep_dir<0>(a, lds, tid, b, cc, h, tok0);
        gla_prep_dir<1>(a, lds, tid, b, cc, h, tok0);
    }
}
constexpr int SC_PQ = 528, SC_PS = 144;
constexpr int SC_QT = 0, SC_KH = SC_QT + 64 * SC_PQ, SC_VT = SC_KH + 256 * SC_PS, SC_ST = SC_VT + 64 * SC_PS, SC_AM = SC_ST + 64 * SC_PQ, SC_DL = SC_AM + 64 * SC_PS, SC_END = SC_DL + 1024;
__device__ __forceinline__ void phase_gla_scan(const Args& a, LAS unsigned char* lds) {
    const int tid = opaque_tid(), wave = __builtin_amdgcn_readfirstlane(tid >> 6), lane = tid & 63, fr = lane & 15, fq = lane >> 4;
    const bf16_t* proj = (const bf16_t*)(a.ws + WS_PROJ); const float* DLg = (const float*)(a.ws + WS_DL);
    for (int item = blockIdx.x; item < 256; item += gridDim.x) {
        const int xcd = item & 7, jj = item >> 3, bhd = xcd * 4 + (jj >> 3), es = jj & 7, b = bhd >> 3, h = (bhd >> 1) & 3, dir = bhd & 1;
        const bf16_t* QT = (const bf16_t*)(a.ws + WS_QKK) + (size_t)dir * MTOK * 1024 + h * 256;
        const bf16_t* AMG = (const bf16_t*)(a.ws + WS_QKK + 128 * MiB);
        const bf16_t* KH = (const bf16_t*)(a.ws + WS_QKK + 256 * MiB);
        const bf16_t* V = proj + 2048 + h * 512 + es * 64;
        bf16_t* O = dir ? ((bf16_t*)(a.ws + WS_PROJ) + h * 512 + es * 64) : ((bf16_t*)(a.ws + WS_HB) + h * 512 + es * 64); const int ldo = dir ? 6144 : 2048;
        for (int i = tid; i < 64 * SC_PQ / 16; i += 512) *(LAS u32x4*)(lds + SC_ST + i * 16) = (u32x4){0u, 0u, 0u, 0u};
        f32x4 S[2][4];
#pragma unroll
        for (int i = 0; i < 2; ++i)
#pragma unroll
            for (int j = 0; j < 4; ++j) S[i][j] = (f32x4){0.f, 0.f, 0.f, 0.f};
        u32x4 rq[4], rkh[4], rv, ram; f32x4 rdl = (f32x4){0.f, 0.f, 0.f, 0.f};
#define SC_LOAD(c) do { const int cc_ = dir ? 127 - (c) : (c); const size_t tok0_ = (size_t)b * SEQ + cc_ * 64; const size_t ci_ = (((size_t)dir * 4 + b) * 128 + cc_) * 4 + h; \
        _Pragma("unroll") for (int i_ = 0; i_ < 4; ++i_) { const int idx_ = tid + 512 * i_; rq[i_] = *(const u32x4*)(QT + (tok0_ + (idx_ >> 5)) * 1024 + (idx_ & 31) * 8); } \
        const bf16_t* khc_ = KH + ci_ * (256 * 64); \
        _Pragma("unroll") for (int i_ = 0; i_ < 4; ++i_) rkh[i_] = *(const u32x4*)(khc_ + (size_t)(tid + 512 * i_) * 8); \
        ram = *(const u32x4*)(AMG + ci_ * (64 * 64) + (size_t)tid * 8); \
        rv = *(const u32x4*)(V + (tok0_ + (tid & 63)) * 6144 + (tid >> 6) * 8); \
        if (tid < 64) rdl = *(const f32x4*)(DLg + (((size_t)dir * 4 + b) * 128 + cc_) * 1024 + h * 256 + tid * 4); } while (0)
        SC_LOAD(0);
        for (int c = 0; c < 128; ++c) {
            const int cc = dir ? 127 - c : c; const size_t tok0 = (size_t)b * SEQ + cc * 64;
#pragma unroll
            for (int i = 0; i < 4; ++i) { const int idx = tid + 512 * i; *(LAS u32x4*)(lds + SC_QT + (idx >> 5) * SC_PQ + (idx & 31) * 16) = rq[i];
                *(LAS u32x4*)(lds + SC_KH + (idx >> 3) * SC_PS + (idx & 7) * 16) = rkh[i]; }
            *(LAS u32x4*)(lds + SC_AM + (tid >> 3) * SC_PS + (tid & 7) * 16) = ram;
            { LAS bf16_t* vt = (LAS bf16_t*)(lds + SC_VT) + ((tid >> 6) * 8) * (SC_PS / 2) + (tid & 63);
              vt[0 * (SC_PS / 2)] = (bf16_t)(rv.x & 0xffffu); vt[1 * (SC_PS / 2)] = (bf16_t)(rv.x >> 16); vt[2 * (SC_PS / 2)] = (bf16_t)(rv.y & 0xffffu); vt[3 * (SC_PS / 2)] = (bf16_t)(rv.y >> 16);
              vt[4 * (SC_PS / 2)] = (bf16_t)(rv.z & 0xffffu); vt[5 * (SC_PS / 2)] = (bf16_t)(rv.z >> 16); vt[6 * (SC_PS / 2)] = (bf16_t)(rv.w & 0xffffu); vt[7 * (SC_PS / 2)] = (bf16_t)(rv.w >> 16); }
            if (tid < 64) *(LAS f32x4*)(lds + SC_DL + tid * 16) = rdl;
            __syncthreads();
            if (c + 1 < 128) SC_LOAD(c + 1);
            const int it = wave >> 1, et0 = (wave & 1) * 2;
            f32x4 oacc[2];
#pragma unroll
            for (int n = 0; n < 2; ++n) oacc[n] = (f32x4){0.f, 0.f, 0.f, 0.f};
#pragma unroll
            for (int ks = 0; ks < 8; ++ks) { const bf16x8 fqt = frag(lds + SC_QT, SC_PQ, it * 16 + fr, ks, fq);
#pragma unroll
                for (int n = 0; n < 2; ++n) oacc[n] = mfma16(frag(lds + SC_ST, SC_PQ, (et0 + n) * 16 + fr, ks, fq), fqt, oacc[n]); }
#pragma unroll
            for (int ks = 0; ks < 2; ++ks) { const bf16x8 fa = frag(lds + SC_AM, SC_PS, it * 16 + fr, ks, fq);
#pragma unroll
                for (int n = 0; n < 2; ++n) oacc[n] = mfma16(frag(lds + SC_VT, SC_PS, (et0 + n) * 16 + fr, ks, fq), fa, oacc[n]); }
#pragma unroll
            for (int n = 0; n < 2; ++n) { u32x2 w; w.x = cvt_pk_bf16(oacc[n][0], oacc[n][1]); w.y = cvt_pk_bf16(oacc[n][2], oacc[n][3]);
                *(u32x2*)(O + (tok0 + it * 16 + fr) * ldo + (et0 + n) * 16 + 4 * fq) = w; }
#pragma unroll
            for (int i = 0; i < 2; ++i) { const f32x4 dl4 = *(const LAS f32x4*)(lds + SC_DL + ((wave * 2 + i) * 16 + 4 * fq) * 4);
#pragma unroll
                for (int j = 0; j < 4; ++j) S[i][j] *= dl4; }
#pragma unroll
            for (int ks = 0; ks < 2; ++ks) {
                bf16x8 fv[4];
#pragma unroll
                for (int j = 0; j < 4; ++j) fv[j] = frag(lds + SC_VT, SC_PS, j * 16 + fr, ks, fq);
#pragma unroll
                for (int i = 0; i < 2; ++i) { const bf16x8 fk = frag(lds + SC_KH, SC_PS, (wave * 2 + i) * 16 + fr, ks, fq);
#pragma unroll
                    for (int j = 0; j < 4; ++j) S[i][j] = mfma16(fk, fv[j], S[i][j]); } }
            __syncthreads();
#pragma unroll
            for (int i = 0; i < 2; ++i)
#pragma unroll
                for (int j = 0; j < 4; ++j) { u32x2 w; w.x = cvt_pk_bf16(S[i][j][0], S[i][j][1]); w.y = cvt_pk_bf16(S[i][j][2], S[i][j][3]);
                    *(LAS u32x2*)(lds + SC_ST + (j * 16 + fr) * SC_PQ + ((wave * 2 + i) * 16 + 4 * fq) * 2) = w; }
        }
        __syncthreads();
#undef SC_LOAD
    }
}
__device__ __forceinline__ void phase_gla_post(bf16_t* hb, const bf16_t* proj, const float* ng) {
    const int tid_ = opaque_tid(), lane = tid_ & 63, wave = __builtin_amdgcn_readfirstlane(tid_ >> 6), gw = blockIdx.x * 8 + wave, NGW = gridDim.x * 8;
    float g8[8];
#pragma unroll
    for (int q = 0; q < 8; ++q) g8[q] = ng[lane * 8 + q];
    for (int m = gw; m < MTOK; m += 2 * NGW) {
        u32x4 wf[2][4], wb[2][4], wg[2][4];
#pragma unroll
        for (int r = 0; r < 2; ++r) { const size_t mm = (size_t)(m + r * NGW);
#pragma unroll
            for (int hh = 0; hh < 4; ++hh) { const int c = hh * 512 + lane * 8;
                wf[r][hh] = *(const u32x4*)(hb + mm * 2048 + c); wb[r][hh] = *(const u32x4*)(proj + mm * 6144 + c); wg[r][hh] = *(const u32x4*)(proj + mm * 6144 + 4096 + c); } }
#pragma unroll
        for (int r = 0; r < 2; ++r) { const size_t mm = (size_t)(m + r * NGW);
#pragma unroll
            for (int hh = 0; hh < 4; ++hh) { const int c = hh * 512 + lane * 8; const u32x4 f = wf[r][hh], bk = wb[r][hh], gg = wg[r][hh];
                float o[8] = {bf_lo(f.x) + bf_lo(bk.x), bf_hi(f.x) + bf_hi(bk.x), bf_lo(f.y) + bf_lo(bk.y), bf_hi(f.y) + bf_hi(bk.y), bf_lo(f.z) + bf_lo(bk.z), bf_hi(f.z) + bf_hi(bk.z), bf_lo(f.w) + bf_lo(bk.w), bf_hi(f.w) + bf_hi(bk.w)};
                const float g[8] = {bf_lo(gg.x), bf_hi(gg.x), bf_lo(gg.y), bf_hi(gg.y), bf_lo(gg.z), bf_hi(gg.z), bf_lo(gg.w), bf_hi(gg.w)};
                float s = 0.f;
#pragma unroll
                for (int q = 0; q < 8; ++q) s += o[q] * o[q];
                const float rstd = __builtin_amdgcn_rsqf(wave_sum(s) * (1.f / 512.f) + NEPS);
#pragma unroll
                for (int q = 0; q < 8; ++q) o[q] = o[q] * rstd * g8[q] * silu_f(g[q]);
                u32x4 w; w.x = cvt_pk_bf16(o[0], o[1]); w.y = cvt_pk_bf16(o[2], o[3]); w.z = cvt_pk_bf16(o[4], o[5]); w.w = cvt_pk_bf16(o[6], o[7]);
                *(u32x4*)(hb + mm * 2048 + c) = w; } }
    }
}

#define RLX_AGENT __ATOMIC_RELAXED, __HIP_MEMORY_SCOPE_AGENT
#define XB_TMO      128
#define XB_XCNT(j)  (256  + 64 * (j))
#define XB_XSUB(j)  (1280 + 64 * (j))
#define XB_XGEN(j)  (2304 + 64 * (j))
#define XB_TOP      3328
#define XB_TOPGEN   3392
#define XCD_BAR_WORDS 3456
#define XB_SPIN_CAP (1u << 18)

__device__ __forceinline__ unsigned xb_ld(unsigned* p)              { return __hip_atomic_load(p, __ATOMIC_RELAXED, __HIP_MEMORY_SCOPE_AGENT); }
__device__ __forceinline__ unsigned xb_add(unsigned* p, unsigned v) { return __hip_atomic_fetch_add(p, v, __ATOMIC_RELAXED, __HIP_MEMORY_SCOPE_AGENT); }
__device__ __forceinline__ unsigned xb_xcc_id() { return (unsigned)__builtin_amdgcn_s_getreg((3 << 11) | 20) & 0xFu; }
#define XB_SPIN(cond, bar) do { unsigned _sp = 0; while (cond) { __builtin_amdgcn_s_sleep(1); \
    if ((++_sp & 255u) == 0u) { if (xb_ld(&(bar)[XB_TMO])) break; if (_sp > XB_SPIN_CAP) { atomicAdd(&(bar)[XB_TMO], 1u); break; } } } } while (0)

struct XcdBarrier {
    unsigned* bar; unsigned x;
    volatile LAS unsigned* st;
};

__device__ __forceinline__ XcdBarrier xcd_barrier_post(unsigned* bar, volatile LAS unsigned* st) {
    XcdBarrier b; b.bar = bar; b.x = xb_xcc_id(); b.st = st;
    if (threadIdx.x == 0) (void)xb_add(&bar[XB_XCNT(b.x)], 1u);
    return b;
}
__device__ __forceinline__ void xcd_barrier_complete(unsigned* bar, unsigned x, unsigned& nloc, unsigned& nx) {
    const unsigned G = gridDim.x * gridDim.y * gridDim.z;
    unsigned sum, cnt, mine, sp = 0u;
    for (;;) {
        sum = 0u; cnt = 0u; mine = 0u;
#pragma unroll
        for (unsigned j = 0; j < 16; ++j) { const unsigned c = xb_ld(&bar[XB_XCNT(j)]); sum += c; cnt += (c > 0u) ? 1u : 0u; mine = (j == x) ? c : mine; }
        if (sum == G) break;
        __builtin_amdgcn_s_sleep(1);
        if ((++sp & 255u) == 0u) { if (xb_ld(&bar[XB_TMO])) break; if (sp > XB_SPIN_CAP) { atomicAdd(&bar[XB_TMO], 1u); break; } }
    }
    nloc = mine > 0u ? mine : 1u; nx = cnt > 0u ? cnt : 1u;
}

__device__ __forceinline__ void xcd_barrier(const XcdBarrier& b) {
    asm volatile("s_waitcnt vmcnt(0)" ::: "memory");
    __syncthreads();
    if (threadIdx.x == 0) {
        unsigned* bar = b.bar;
        __builtin_amdgcn_s_waitcnt(0);
        unsigned nloc = b.st[0], nx = b.st[1];
        if (nloc == 0u) { xcd_barrier_complete(bar, b.x, nloc, nx); b.st[0] = nloc; b.st[1] = nx; }
        const unsigned old = xb_add(&bar[XB_XSUB(b.x)], 1u);
        const unsigned gen = old / nloc;
        if (old + 1u == (gen + 1u) * nloc) {
            __builtin_amdgcn_fence(__ATOMIC_RELEASE, "agent");
            asm volatile("s_waitcnt vmcnt(0)" ::: "memory");
            const unsigned og = xb_add(&bar[XB_TOP], 1u);
            const unsigned tg = og / nx;
            if (og + 1u == (tg + 1u) * nx) xb_add(&bar[XB_TOPGEN], 1u);
            else XB_SPIN(xb_ld(&bar[XB_TOPGEN]) == tg, bar);
            __builtin_amdgcn_fence(__ATOMIC_ACQUIRE, "agent");
            xb_add(&bar[XB_XGEN(b.x)], 1u);
            asm volatile("s_waitcnt vmcnt(0)" ::: "memory");
        } else {
            XB_SPIN(xb_ld(&bar[XB_XGEN(b.x)]) == gen, bar);
            __builtin_amdgcn_fence(__ATOMIC_ACQUIRE, "agent");
            asm volatile("s_waitcnt vmcnt(0)" ::: "memory");
        }
    }
    __syncthreads();
}


#ifndef NLAYERS
#define NLAYERS 4
#endif
#ifndef REP_ATTN
#define REP_ATTN 1
#endif
#ifndef REP_SCAN
#define REP_SCAN 1
#endif
#ifndef REP_PREP
#define REP_PREP 1
#endif
#ifndef REP_GEMM0
#define REP_GEMM0 1
#endif
#ifndef REP_POOL
#define REP_POOL 1
#endif
#ifndef REP_SYNC
#define REP_SYNC 0
#endif
#ifndef REP_GRP
#define REP_GRP 1
#endif
#ifndef REP_OUT0
#define REP_OUT0 1
#endif
#ifndef REP_PRO
#define REP_PRO 1
#endif
#ifndef REP_LOWRANK
#define REP_LOWRANK 1
#endif
#ifndef REP_NORM
#define REP_NORM 1
#endif
constexpr int LDS_BYTES = 160 * 1024;
static_assert(SC_END <= LDS_BYTES - 64 && (int)attn::SHM_ATTN <= LDS_BYTES && pg8::STAGE_BYTES <= LDS_BYTES, "LDS map");

#define CG_SYNC() do { asm volatile("s_waitcnt vmcnt(0) lgkmcnt(0)" ::: "memory"); grid.sync(); __builtin_amdgcn_fence(__ATOMIC_ACQUIRE, "agent"); asm volatile("s_waitcnt vmcnt(0)" ::: "memory"); } while (0)
#define GRID_SYNC() xcd_barrier(xbar)
__global__ void __launch_bounds__(512, 2) fwd_megakernel(Args a) {
    extern __shared__ __attribute__((aligned(16))) unsigned char lds_raw[];
    LAS unsigned char* lds = (LAS unsigned char*)lds_raw;
    cg::grid_group grid = cg::this_grid();
    if (threadIdx.x < 16) ((LAS unsigned*)(lds + LDS_BYTES - 64))[threadIdx.x] = 0u;
    __syncthreads();
    XcdBarrier xbar = xcd_barrier_post((unsigned*)(a.ws + WS_BAR), (volatile LAS unsigned*)(lds + LDS_BYTES - 64));
    const int G = gridDim.x;
    float* mod = (float*)(a.ws + WS_MOD); float* rc = (float*)(a.ws + WS_ROPE); float* rs = rc + SEQ * 64;
    bf16_t* WB = (bf16_t*)(a.ws + WS_WB); bf16_t* WBG = (bf16_t*)(a.ws + WS_WB + 16 * MiB); bf16_t* WBO = (bf16_t*)(a.ws + WS_WB + 24 * MiB);
    bf16_t* HB = (bf16_t*)(a.ws + WS_HB); bf16_t* PROJ = (bf16_t*)(a.ws + WS_PROJ); bf16_t* YB = (bf16_t*)(a.ws + WS_QKK);

    for (int rep = 0; rep < REP_PRO; ++rep) {
    phase_mod(a, lds, mod);
    __syncthreads();
    phase_rope_table(rc, rs);
    phase_weights(a, 0, lds);
    GRID_SYNC(); }
    if (a.ws == nullptr) CG_SYNC();

    bf16_t* XB = (bf16_t*)a.out;
    float* XF = (float*)(a.ws + WS_QKK + 128 * MiB);
    for (int L = 0; L < NLAYERS; ++L) {
        const int kind = L % 3, j = L / 3, N = (kind == 0) ? 4096 : (kind == 1) ? 6144 : 5120;
        const float* modL = mod + (size_t)L * 4 * 6144;
        if (L > 0) phase_weights(a, L, lds);
        if (L == 0) phase_norm_mod(a.x, modL, HB); else phase_norm_mod_bf(XB, modL, HB);
        GRID_SYNC();
        if (kind == 1) for (int rep = 0; rep < REP_LOWRANK; ++rep) phase_gla_lowrank(HB, (const bf16_t*)(a.ws + WS_W1T), (float*)(a.ws + WS_R), lds);
        for (int rep = 0; rep < REP_GEMM0; ++rep) {
        { pg8::Gemm g{HB, WB, MTOK, N, 2048, 2048, 2048, 0}; pg8::StaticOrder S; S.init(MTOK, N, G, (int)blockIdx.x);
          pg8::EpiStore E{PROJ, N}; pg8::gemm_phase<pg8::EpiStore, pg8::StaticOrder>(lds, g, S, E); }
        GRID_SYNC(); }
        if (kind == 0) {
            for (int rep = 0; rep < REP_POOL; ++rep) {
            phase_pool(PROJ, HB);
            GRID_SYNC(); }
            for (int rep = 0; rep < REP_GRP; ++rep) {
            { pg8::Gemm g{HB, WBG, MTOK, 2048, 512, 2048, 512, 1}; pg8::StaticOrder S; S.init(MTOK, 2048, G, (int)blockIdx.x);
              pg8::EpiPool E{YB, PROJ + 2048, 4096, a.pool_scale + (size_t)j * 2048}; pg8::gemm_phase<pg8::EpiPool, pg8::StaticOrder>(lds, g, S, E); }
            GRID_SYNC(); }
        } else if (kind == 1) {
            for (int rep = 0; rep < REP_PREP; ++rep) {
            phase_gla_prep(a, lds);
            GRID_SYNC(); }
            for (int rep = 0; rep < REP_SCAN; ++rep) {
            phase_gla_scan(a, lds);
            GRID_SYNC(); }
            phase_gla_post(HB, PROJ, a.gla_norm_g);
            GRID_SYNC();
        } else {
            phase_knorm_rope(PROJ, a.attn_kg, rc, rs);
            GRID_SYNC();
            for (int rep = 0; rep < REP_ATTN; ++rep) {
            for (int u = blockIdx.x; u < 2048; u += G) {
                const int bk = u >> 7, b = bk >> 2, kvh = bk & 3, hq = kvh * 4 + ((u >> 5) & 3), qb = u & 31;
                const size_t row0 = (size_t)b * SEQ + qb * 256;
                attn::attn_dense_body<attn::bf16>((const attn::bf16*)(PROJ + row0 * 5120 + hq * 128), (const attn::bf16*)(PROJ + (size_t)b * SEQ * 5120 + 2048 + kvh * 128),
                    (const attn::bf16*)(PROJ + (size_t)b * SEQ * 5120 + 2560 + kvh * 128), PROJ + row0 * 5120 + 3072 + hq * 128, YB + row0 * 2048 + hq * 128, SEQ, (char*)lds_raw, 0, a.attn_qg, rc, rs, qb * 256);
                __syncthreads();
            }
            GRID_SYNC(); }
        }
        { pg8::Gemm g{kind == 1 ? HB : YB, WBO, MTOK, 2048, 2048, 2048, 2048, 0}; pg8::StaticOrder S; S.init(MTOK, 2048, G, (int)blockIdx.x);
          if (L == 0) { pg8::EpiResT<false, true> E{a.x, XB, modL + 4096}; pg8::gemm_phase<pg8::EpiResT<false, true>, pg8::StaticOrder>(lds, g, S, E); }
          else if (L < 3) { pg8::EpiResT<true, true> E{XB, XB, modL + 4096}; pg8::gemm_phase<pg8::EpiResT<true, true>, pg8::StaticOrder>(lds, g, S, E); }
          else { pg8::EpiResT<true, false> E{XB, XF, modL + 4096}; pg8::gemm_phase<pg8::EpiResT<true, false>, pg8::StaticOrder>(lds, g, S, E); } }
        GRID_SYNC();
    }
    phase_final_norm(XF, a.final_g, a.out);
}

extern "C" void kernel_launch(void* const* d_in, const int* in_sizes, int n_in, void* d_out, int out_size, void* d_ws, size_t ws_size, hipStream_t stream) {
    static int grid = 0;
    if (grid == 0) {
        if (n_in != 22 || in_sizes[0] != MTOK * DM || out_size != MTOK * DM || ws_size < WS_END) {
            fprintf(stderr, "kernel_launch: unexpected shapes: n_in %d in0 %d out %d ws %zu (need %zu)\n", n_in, n_in > 0 ? in_sizes[0] : -1, out_size, ws_size, (size_t)WS_END); grid = -1; return; }
        int dev = 0, cus = 0, per_cu = 0;
        hipGetDevice(&dev); hipDeviceGetAttribute(&cus, hipDeviceAttributeMultiprocessorCount, dev);
        if (hipFuncSetAttribute((const void*)fwd_megakernel, hipFuncAttributeMaxDynamicSharedMemorySize, LDS_BYTES) != hipSuccess) { fprintf(stderr, "kernel_launch: hipFuncSetAttribute failed\n"); grid = -1; return; }
        if (hipOccupancyMaxActiveBlocksPerMultiprocessor(&per_cu, (const void*)fwd_megakernel, 512, LDS_BYTES) != hipSuccess || per_cu < 1) { fprintf(stderr, "kernel_launch: occupancy query gave %d\n", per_cu); per_cu = 1; }
        (void)hipGetLastError();
        grid = cus;
        fprintf(stderr, "kernel_launch: cus %d per_cu %d grid %d\n", cus, per_cu, grid);
    }
    if (grid < 0) return;
    Args a{};
    const float** p = (const float**)&a;
    for (int i = 0; i < 22; ++i) p[i] = (const float*)d_in[i];
    a.out = (float*)d_out; a.ws = (unsigned char*)d_ws;
    if (hipMemsetAsync((char*)d_ws + WS_BAR, 0, 16384, stream) != hipSuccess) { fprintf(stderr, "kernel_launch: memset of the barrier words failed\n"); return; }
    void* args[] = {&a};
    hipError_t e = hipLaunchCooperativeKernel((const void*)fwd_megakernel, dim3(grid), dim3(512), args, LDS_BYTES, stream);
    if (e != hipSuccess) fprintf(stderr, "kernel_launch: cooperative launch failed: %s (grid %d)\n", hipGetErrorString(e), grid);
}
```

```cpp
#include <hip/hip_runtime.h>
#include <hip/hip_bf16.h>
#include <hip/hip_cooperative_groups.h>
#include <cstdio>
#include <cstdint>
#include <cmath>
namespace cg = cooperative_groups;

constexpr int NB = 4, SEQ = 8192, DM = 2048, MTOK = NB * SEQ;
constexpr float NEPS = 1e-6f;
constexpr size_t MiB = (size_t)1 << 20;
constexpr size_t WS_MOD = 0;
constexpr size_t WS_ROPE = 1 * MiB;
constexpr size_t WS_R = 5 * MiB;
constexpr size_t WS_DL = 9 * MiB;
constexpr size_t WS_W1T = 13 * MiB;
constexpr size_t WS_BAR = 15 * MiB;
constexpr size_t WS_WB = 16 * MiB;
constexpr size_t WS_HB = 52 * MiB;
constexpr size_t WS_PROJ = 180 * MiB;
constexpr size_t WS_QKK = 564 * MiB;
constexpr size_t WS_END = 948 * MiB;

typedef unsigned short bf16_t;
typedef short bf16x8 __attribute__((ext_vector_type(8)));
typedef float f32x4 __attribute__((ext_vector_type(4)));
typedef unsigned u32x4 __attribute__((ext_vector_type(4)));
typedef unsigned u32x2 __attribute__((ext_vector_type(2)));
#define LAS __attribute__((address_space(3)))

typedef float f32x2 __attribute__((ext_vector_type(2)));
typedef __bf16 bf16x2_t __attribute__((ext_vector_type(2)));
__device__ __forceinline__ unsigned cvt_pk_bf16(float lo, float hi) { f32x2 v = {lo, hi}; bf16x2_t b = __builtin_convertvector(v, bf16x2_t); return __builtin_bit_cast(unsigned, b); }
__device__ __forceinline__ float bf_lo(unsigned w) { return __uint_as_float(w << 16); }
__device__ __forceinline__ float bf_hi(unsigned w) { return __uint_as_float(w & 0xffff0000u); }
__device__ __forceinline__ float bf2f(bf16_t b) { return __uint_as_float(((unsigned)b) << 16); }
__device__ __forceinline__ bf16_t f2bf(float f) { unsigned u = __float_as_uint(f); u += 0x7fffu + ((u >> 16) & 1u); return (bf16_t)(u >> 16); }
__device__ __forceinline__ float silu_f(float v) { return v * __builtin_amdgcn_rcpf(1.f + __builtin_amdgcn_exp2f(-1.4426950408889634f * v)); }
__device__ __forceinline__ float wave_sum(float v) {
#pragma unroll
    for (int o = 1; o < 64; o <<= 1) v += __shfl_xor(v, o);
    return v;
}
__device__ __forceinline__ int opaque_tid() { int t; asm volatile("v_mov_b32 %0, %1" : "=v"(t) : "v"((int)threadIdx.x)); return t; }

namespace pg8 {
#define PG8_LAS __attribute__((address_space(3)))
constexpr int BM = 256, BK = 64, HALF = 128, HTB = HALF * BK * 2  , STAGE_BYTES = 8 * HTB, NXCD = 8, WGM = 4;
__host__ __device__ __forceinline__ int lds_byte(int r, int c) { const int st = (r >> 4) * 2 + (c >> 5), rr = r & 15, cc = c & 31, ob = rr * 64 + cc * 2; return st * 1024 + (ob ^ (((ob >> 9) & 1) << 5)); }
__host__ __device__ __forceinline__ void stage_rc(int b, int& R, int& C) { const int st = b / 1024, sb = b % 1024, swz = sb ^ (((sb >> 9) & 1) << 5); R = (st >> 1) * 16 + swz / 64; C = (st & 1) * 32 + (swz % 64) / 2; }
__host__ __device__ __forceinline__ int perm32(int rho) { const int n = rho >> 4, i = rho & 15; return 8 * (i >> 2) + 4 * n + (i & 3); }
struct Unit { int pm, pn; };
struct Gemm { const bf16_t* A; const bf16_t* Bt; int M, N, K, lda, ldb, grp;
    __device__ __forceinline__ const char* aptr(const Unit& u) const { return (const char*)(A + (size_t)u.pm * BM * lda + (grp ? (size_t)(u.pn >> 1) * K : (size_t)0)); }
    __device__ __forceinline__ const char* bptr(const Unit& u) const { return (const char*)(Bt + (size_t)u.pn * BM * ldb); } };
struct StaticOrder {
    int nM, nN, nwg, G, c;
    __host__ __device__ void init(int M, int N, int G_, int c_) { nM = M / BM; nN = N / BM; nwg = nM * nN; G = G_; c = c_; }
    __host__ __device__ bool next(int i, Unit& u) const {
        const long L = (long)i * G + c; if (L >= nwg) return false;
        int wgid = (int)L; { const int q = nwg / NXCD, r = nwg % NXCD, xcd = wgid % NXCD, off = wgid / NXCD; wgid = (xcd < r ? xcd * (q + 1) : r * (q + 1) + (xcd - r) * q) + off; }
        const int nig = WGM * nN, gid = wgid / nig, fm = gid * WGM, gsz = (nM - fm) < WGM ? (nM - fm) : WGM;
        u.pm = fm + ((wgid % nig) % gsz); u.pn = (wgid % nig) / gsz; return true;
    }
    __device__ __forceinline__ void a_ready(const Unit&) const {}
    __device__ __forceinline__ void done(const Unit&) const {}
};
struct EpiStore {
    static constexpr bool PERM = true, AFTER_DRAIN = false; static constexpr int STAGGER_TICKS = 0;
    bf16_t* O; int ldc;
    __device__ __forceinline__ void operator()(const f32x4 (&acc)[2][2][4][2], const Unit& u, int wr, int wc, int fr, int fq) const {
        const int row0 = u.pm * BM + wr * 64 + fr, col0 = u.pn * BM + wc * 32 + 8 * fq;
#pragma unroll
        for (int ai = 0; ai < 2; ++ai)
#pragma unroll
            for (int m = 0; m < 4; ++m) { bf16_t* rowp = O + (size_t)(row0 + ai * HALF + m * 16) * ldc + col0;
#pragma unroll
                for (int bj = 0; bj < 2; ++bj) { const f32x4 v0 = acc[ai][bj][m][0], v1 = acc[ai][bj][m][1];
                    u32x4 w; w.x = cvt_pk_bf16(v0[0], v0[1]); w.y = cvt_pk_bf16(v0[2], v0[3]); w.z = cvt_pk_bf16(v1[0], v1[1]); w.w = cvt_pk_bf16(v1[2], v1[3]);
                    *(u32x4*)(rowp + bj * HALF) = w; } }
    }
};
struct EpiNull {
    static constexpr bool PERM = true, AFTER_DRAIN = false; static constexpr int STAGGER_TICKS = 0;
    bf16_t* O;
    __device__ __forceinline__ void operator()(const f32x4 (&acc)[2][2][4][2], const Unit& u, int wr, int wc, int fr, int fq) const {
        f32x4 s = (f32x4){0.f, 0.f, 0.f, 0.f};
#pragma unroll
        for (int ai = 0; ai < 2; ++ai)
#pragma unroll
            for (int bj = 0; bj < 2; ++bj)
#pragma unroll
                for (int m = 0; m < 4; ++m) { s += acc[ai][bj][m][0]; s += acc[ai][bj][m][1]; }
        if (s[0] + s[1] + s[2] + s[3] == 1234.5678f) O[0] = 0;
    }
};
struct EpiPool {
    static constexpr bool PERM = true, AFTER_DRAIN = false; static constexpr int STAGGER_TICKS = 0;
    bf16_t* O; const bf16_t* G; int ldg; const float* scale;
    __device__ __forceinline__ void operator()(const f32x4 (&acc)[2][2][4][2], const Unit& u, int wr, int wc, int fr, int fq) const {
        const int row0 = u.pm * BM + wr * 64 + fr, col0 = u.pn * BM + wc * 32 + 8 * fq;
        f32x4 sv[2][2];
#pragma unroll
        for (int bj = 0; bj < 2; ++bj)
#pragma unroll
            for (int n = 0; n < 2; ++n) sv[bj][n] = *(const f32x4*)(scale + col0 + bj * HALF + 4 * n);
#pragma unroll
        for (int ai = 0; ai < 2; ++ai) {
            u32x4 gwv[4][2];
#pragma unroll
            for (int m = 0; m < 4; ++m)
#pragma unroll
                for (int bj = 0; bj < 2; ++bj) gwv[m][bj] = *(const u32x4*)(G + (size_t)(row0 + ai * HALF + m * 16) * ldg + col0 + bj * HALF);
#pragma unroll
            for (int m = 0; m < 4; ++m) { const size_t row = (size_t)(row0 + ai * HALF + m * 16);
#pragma unroll
                for (int bj = 0; bj < 2; ++bj) { const u32x4 gw = gwv[m][bj];
                    const f32x4 v0 = acc[ai][bj][m][0] * sv[bj][0], v1 = acc[ai][bj][m][1] * sv[bj][1];
                    u32x4 w;
                    w.x = cvt_pk_bf16(v0[0] * silu_f(bf_lo(gw.x)), v0[1] * silu_f(bf_hi(gw.x))); w.y = cvt_pk_bf16(v0[2] * silu_f(bf_lo(gw.y)), v0[3] * silu_f(bf_hi(gw.y)));
                    w.z = cvt_pk_bf16(v1[0] * silu_f(bf_lo(gw.z)), v1[1] * silu_f(bf_hi(gw.z))); w.w = cvt_pk_bf16(v1[2] * silu_f(bf_lo(gw.w)), v1[3] * silu_f(bf_hi(gw.w)));
                    *(u32x4*)(O + row * 2048 + col0 + bj * HALF) = w; } }
            asm volatile("" ::: "memory"); }
    }
};
template <bool IN_BF16, bool OUT_BF16> struct EpiResT {
    static constexpr bool PERM = true, AFTER_DRAIN = false; static constexpr int STAGGER_TICKS = 0;
    const void* xi; void* xo; const float* gate;
    __device__ __forceinline__ void operator()(const f32x4 (&acc)[2][2][4][2], const Unit& u, int wr, int wc, int fr, int fq) const {
        const int row0 = u.pm * BM + wr * 64 + fr, col0 = u.pn * BM + wc * 32 + 8 * fq;
        const float* gp = gate + (size_t)((u.pm * BM) / SEQ) * 6144 + col0;
        f32x4 gv[2][2];
#pragma unroll
        for (int bj = 0; bj < 2; ++bj)
#pragma unroll
            for (int n = 0; n < 2; ++n) gv[bj][n] = *(const f32x4*)(gp + bj * HALF + 4 * n);
#pragma unroll
        for (int aim = 0; aim < (IN_BF16 ? 2 : 4); ++aim) {
            constexpr int MB = IN_BF16 ? 4 : 2; const int ai = IN_BF16 ? aim : (aim >> 1), mb0 = IN_BF16 ? 0 : (aim & 1) * 2;
            u32x4 raw[4][2][IN_BF16 ? 1 : 2];
#pragma unroll
            for (int m = mb0; m < mb0 + MB; ++m) { const size_t off = (size_t)(row0 + ai * HALF + m * 16) * 2048 + col0;
#pragma unroll
                for (int bj = 0; bj < 2; ++bj) {
                    if (IN_BF16) raw[m][bj][0] = *(const u32x4*)((const bf16_t*)xi + off + bj * HALF);
                    else { raw[m][bj][0] = *(const u32x4*)((const float*)xi + off + bj * HALF); raw[m][bj][IN_BF16 ? 0 : 1] = *(const u32x4*)((const float*)xi + off + bj * HALF + 4); } } }
#pragma unroll
            for (int m = mb0; m < mb0 + MB; ++m) { const size_t off = (size_t)(row0 + ai * HALF + m * 16) * 2048 + col0;
#pragma unroll
                for (int bj = 0; bj < 2; ++bj) { f32x4 x0, x1;
                    if (IN_BF16) { const u32x4 w = raw[m][bj][0]; x0 = (f32x4){bf_lo(w.x), bf_hi(w.x), bf_lo(w.y), bf_hi(w.y)}; x1 = (f32x4){bf_lo(w.z), bf_hi(w.z), bf_lo(w.w), bf_hi(w.w)}; }
                    else { x0 = __builtin_bit_cast(f32x4, raw[m][bj][0]); x1 = __builtin_bit_cast(f32x4, raw[m][bj][IN_BF16 ? 0 : 1]); }
                    const f32x4 v0 = x0 + gv[bj][0] * acc[ai][bj][m][0], v1 = x1 + gv[bj][1] * acc[ai][bj][m][1];
                    if (OUT_BF16) { u32x4 w; w.x = cvt_pk_bf16(v0[0], v0[1]); w.y = cvt_pk_bf16(v0[2], v0[3]); w.z = cvt_pk_bf16(v1[0], v1[1]); w.w = cvt_pk_bf16(v1[2], v1[3]);
                        *(u32x4*)((bf16_t*)xo + off + bj * HALF) = w; }
                    else { *(f32x4*)((float*)xo + off + bj * HALF) = v0; *(f32x4*)((float*)xo + off + bj * HALF + 4) = v1; } } }
            asm volatile("" ::: "memory"); }
    }
};
struct EpiRes {
#ifndef RES_STAGGER_TICKS
#define RES_STAGGER_TICKS 0
#endif
    static constexpr bool PERM = false, AFTER_DRAIN = false; static constexpr int STAGGER_TICKS = RES_STAGGER_TICKS;
    const float* xi; float* xo; const float* gate;
    __device__ __forceinline__ void operator()(const f32x4 (&acc)[2][2][4][2], const Unit& u, int wr, int wc, int fr, int fq) const {
        const int row0 = u.pm * BM + wr * 64 + fr, col0 = u.pn * BM + wc * 32 + 4 * fq;
        const float* gp = gate + (size_t)((u.pm * BM) / SEQ) * 6144 + col0;
        f32x4 gv[2][2];
#pragma unroll
        for (int bj = 0; bj < 2; ++bj)
#pragma unroll
            for (int n = 0; n < 2; ++n) gv[bj][n] = *(const f32x4*)(gp + bj * HALF + n * 16);
#pragma unroll
        for (int ai = 0; ai < 2; ++ai)
#pragma unroll
            for (int mp = 0; mp < 1; ++mp) {
                f32x4 xv[4][2][2];
#pragma unroll
                for (int mm = 0; mm < 4; ++mm) { const size_t off = (size_t)(row0 + ai * HALF + (4 * mp + mm) * 16) * 2048 + col0;
#pragma unroll
                    for (int bj = 0; bj < 2; ++bj)
#pragma unroll
                        for (int n = 0; n < 2; ++n) xv[mm][bj][n] = *(const f32x4*)(xi + off + bj * HALF + n * 16); }
#pragma unroll
                for (int mm = 0; mm < 4; ++mm) { const size_t off = (size_t)(row0 + ai * HALF + (4 * mp + mm) * 16) * 2048 + col0;
#pragma unroll
                    for (int bj = 0; bj < 2; ++bj)
#pragma unroll
                        for (int n = 0; n < 2; ++n) *(f32x4*)(xo + off + bj * HALF + n * 16) = xv[mm][bj][n] + gv[bj][n] * acc[ai][bj][4 * mp + mm][n]; }
                asm volatile("" ::: "memory"); }
    }
};
template <class Epi, class Sched>
__device__ __forceinline__ void gemm_phase(PG8_LAS unsigned char* lds, const Gemm g, const Sched& S, const Epi& E) {
    const int tid = opaque_tid(), wid = __builtin_amdgcn_readfirstlane(tid >> 6), lane = tid & 63, wr = wid >> 2, wc = wid & 3, fr = lane & 15, fq = lane >> 4;
    const int K = g.K, nt = K / BK;
    unsigned voffA[2], voffB[2];
#pragma unroll
    for (int i = 0; i < 2; ++i) { int R, C; stage_rc(tid * 16 + i * 8192, R, C); const int Rb = Epi::PERM ? ((R & ~31) + perm32(R & 31)) : R;
        voffA[i] = (unsigned)(R * g.lda + C) * 2u; voffB[i] = (unsigned)(Rb * g.ldb + C) * 2u; }
    const size_t kstep = (size_t)(BK * 2);
    const size_t hstepA = (size_t)HALF * g.lda * 2, hstepB = (size_t)HALF * g.ldb * 2;
    const unsigned ldsw = (unsigned)wid * 1024u;
    const int aoff = lds_byte(wr * 64 + fr, fq * 8), boff = lds_byte(wc * 32 + fr, fq * 8);
#define PG8_SA(b, h) (((b) * 2 + (h)) * HTB)
#define PG8_SB(b, h) ((4 + (b) * 2 + (h)) * HTB)
#define PG8_STAGE(bufoff, gbase, voff) do { _Pragma("unroll") for (int _i = 0; _i < 2; ++_i) \
        __builtin_amdgcn_global_load_lds((const unsigned*)((const char*)(gbase) + (voff)[_i]), (PG8_LAS unsigned*)(lds + (bufoff) + ldsw + _i * 8192), 16, 0, 0); } while (0)
#define PG8_LDA(dst, b, h) do { _Pragma("unroll") for (int m = 0; m < 4; ++m) _Pragma("unroll") for (int k = 0; k < 2; ++k) dst[m][k] = *(const PG8_LAS bf16x8*)(lds + PG8_SA(b, h) + aoff + m * 2048 + k * 1024); } while (0)
#define PG8_LDB(dst, b, h) do { _Pragma("unroll") for (int n = 0; n < 2; ++n) _Pragma("unroll") for (int k = 0; k < 2; ++k) dst[n][k] = *(const PG8_LAS bf16x8*)(lds + PG8_SB(b, h) + boff + n * 2048 + k * 1024); } while (0)
#define PG8_MMA(ai, bj, At, Bt) do { __builtin_amdgcn_s_setprio(1); _Pragma("unroll") for (int m = 0; m < 4; ++m) _Pragma("unroll") for (int n = 0; n < 2; ++n) _Pragma("unroll") for (int k = 0; k < 2; ++k) \
        acc[ai][bj][m][n] = __builtin_amdgcn_mfma_f32_16x16x32_bf16(Bt[n][k], At[m][k], acc[ai][bj][m][n], 0, 0, 0); __builtin_amdgcn_s_setprio(0); } while (0)
#define PG8_WAIT_V(n) asm volatile("s_waitcnt vmcnt(" #n ")" ::: "memory")
#define PG8_WAIT_L(n) asm volatile("s_waitcnt lgkmcnt(" #n ")" ::: "memory")
#define PG8_BAR __builtin_amdgcn_s_barrier()
#define PG8_SCHED __builtin_amdgcn_sched_barrier(0)
    Unit cur, nxt; int ui = 0;
    if (!S.next(0, cur)) return;
#ifndef GEMM_STAGGER_TICKS
#define GEMM_STAGGER_TICKS 0
#endif
    if (Epi::STAGGER_TICKS > 0) {
        const unsigned long long t0 = __builtin_amdgcn_s_memrealtime(), dl = (unsigned long long)((unsigned)blockIdx.x * (unsigned)Epi::STAGGER_TICKS / (unsigned)gridDim.x);
        while (__builtin_amdgcn_s_memrealtime() - t0 < dl) __builtin_amdgcn_s_sleep(8);
    }
    f32x4 acc[2][2][4][2];
#pragma unroll
    for (int a = 0; a < 2; ++a)
#pragma unroll
        for (int b = 0; b < 2; ++b)
#pragma unroll
            for (int m = 0; m < 4; ++m)
#pragma unroll
                for (int n = 0; n < 2; ++n) acc[a][b][m][n] = (f32x4){0.f, 0.f, 0.f, 0.f};
    bf16x8 At[4][2], B0[2][2], B1[2][2];
    const char* cA = g.aptr(cur); const char* cB = g.bptr(cur);
    S.a_ready(cur);
    PG8_STAGE(PG8_SB(0, 0), cB, voffB); PG8_STAGE(PG8_SA(0, 0), cA, voffA); PG8_STAGE(PG8_SB(0, 1), cB + hstepB, voffB); PG8_STAGE(PG8_SA(0, 1), cA + hstepA, voffA);
    if (wr == 1) PG8_BAR;
    PG8_WAIT_V(4); PG8_BAR;
    PG8_STAGE(PG8_SB(1, 0), cB + kstep, voffB); PG8_STAGE(PG8_SA(1, 0), cA + kstep, voffA); PG8_STAGE(PG8_SB(1, 1), cB + hstepB + kstep, voffB);
    PG8_WAIT_V(6); PG8_BAR;
    for (;;) {
        const bool has_next = S.next(ui + 1, nxt);
        const char* nA = has_next ? g.aptr(nxt) : cA; const char* nB = has_next ? g.bptr(nxt) : cB;
        for (int t = 0; t < nt; t += 2) {
            const bool last = (t == nt - 2);
            const char* a1 = cA + (size_t)(t + 1) * kstep;
            const char* a2 = last ? nA : cA + (size_t)(t + 2) * kstep; const char* b2 = last ? nB : cB + (size_t)(t + 2) * kstep;
            const char* a3 = a2 + kstep; const char* b3 = b2 + kstep;
            if (last && has_next) S.a_ready(nxt);
            PG8_LDB(B0, 0, 0); PG8_SCHED; PG8_LDA(At, 0, 0); PG8_STAGE(PG8_SA(1, 1), a1 + hstepA, voffA);
            PG8_WAIT_L(8); PG8_BAR; PG8_WAIT_L(0); PG8_MMA(0, 0, At, B0); PG8_BAR; PG8_SCHED;
            PG8_LDB(B1, 0, 1); PG8_STAGE(PG8_SB(0, 0), b2, voffB);
            PG8_BAR; PG8_WAIT_L(0); PG8_MMA(0, 1, At, B1); PG8_BAR;
            PG8_LDA(At, 0, 1); PG8_STAGE(PG8_SA(0, 0), a2, voffA);
            PG8_BAR; PG8_WAIT_L(0); PG8_MMA(1, 0, At, B0); PG8_BAR; PG8_SCHED;
            PG8_STAGE(PG8_SB(0, 1), b2 + hstepB, voffB);
            PG8_WAIT_V(6); PG8_BAR; PG8_MMA(1, 1, At, B1); PG8_BAR;
            PG8_LDB(B0, 1, 0); PG8_SCHED; PG8_LDA(At, 1, 0); PG8_STAGE(PG8_SA(0, 1), a2 + hstepA, voffA);
            PG8_WAIT_L(8); PG8_BAR; PG8_WAIT_L(0); PG8_MMA(0, 0, At, B0); PG8_BAR; PG8_SCHED;
            PG8_LDB(B1, 1, 1); PG8_STAGE(PG8_SB(1, 0), b3, voffB);
            PG8_BAR; PG8_WAIT_L(0); PG8_MMA(0, 1, At, B1); PG8_BAR;
            PG8_LDA(At, 1, 1); PG8_STAGE(PG8_SA(1, 0), a3, voffA);
            PG8_BAR; PG8_WAIT_L(0); PG8_MMA(1, 0, At, B0); PG8_BAR; PG8_SCHED;
            PG8_STAGE(PG8_SB(1, 1), b3 + hstepB, voffB);
            PG8_WAIT_V(6); PG8_BAR; PG8_MMA(1, 1, At, B1); PG8_BAR;
        }
            if constexpr (!Epi::AFTER_DRAIN) { E(acc, cur, wr, wc, fr, fq); S.done(cur); }
            if (!has_next) break;
#pragma unroll
        for (int a = 0; a < 2; ++a)
#pragma unroll
            for (int b = 0; b < 2; ++b)
#pragma unroll
                for (int m = 0; m < 4; ++m)
#pragma unroll
                    for (int n = 0; n < 2; ++n) acc[a][b][m][n] = (f32x4){0.f, 0.f, 0.f, 0.f};
        cur = nxt; cA = nA; cB = nB; ++ui;
    }
    PG8_WAIT_V(0);
    if (wr == 0) PG8_BAR;
    PG8_BAR;
    if constexpr (Epi::AFTER_DRAIN) { E.fused(acc, cur, wr, wc, fr, fq, lds, wid, lane); S.done(cur); }
#undef PG8_SA
#undef PG8_SB
#undef PG8_STAGE
#undef PG8_LDA
#undef PG8_LDB
#undef PG8_MMA
#undef PG8_WAIT_V
#undef PG8_WAIT_L
#undef PG8_BAR
#undef PG8_SCHED
}
}


namespace attn {
using bf16 = __hip_bfloat16;
constexpr int   D = 128, NW = 8, QBLK = 32, KVBLK = 64;
constexpr float SCALE = 0.088388347648318440f;
constexpr float THR = 8.f;
constexpr int SDEPTH = 1;
constexpr int LDQ = 5120, LDK = 5120, LDO = 2048;
constexpr size_t SHM_V = KVBLK * D * 2, SHM_K = KVBLK * D * 2, SHM_ATTN = 2 * SHM_V + 2 * SHM_K + NW * 64 * 4;
using bf16x8 = __attribute__((ext_vector_type(8))) short;
using s16x4  = __attribute__((ext_vector_type(4))) short;
using f32x16 = __attribute__((ext_vector_type(16))) float;
using f32x8  = __attribute__((ext_vector_type(8))) float;
using u32x4  = __attribute__((ext_vector_type(4))) unsigned;
#define KSWZ(row, colB) ((row) * 256 + ((colB) ^ (((row) & 7) << 4)))
#define SBAR() __builtin_amdgcn_sched_barrier(0)
__device__ __forceinline__ int crow(int r, int hi) { return (r & 3) + 8 * (r >> 2) + 4 * hi; }
__device__ __forceinline__ unsigned cvtpk(float lo, float hi) {
  unsigned r; asm volatile("v_cvt_pk_bf16_f32 %0, %1, %2" : "=v"(r) : "v"(lo), "v"(hi)); return r;
}
template <typename TIn> struct Stage;
template <> struct Stage<bf16>  { using T = bf16x8;
  __device__ static __forceinline__ T ld8(const bf16* p) { return *reinterpret_cast<const bf16x8*>(p); }
  __device__ static __forceinline__ bf16x8 tobf(T x) { return x; } };
template <> struct Stage<float> { using T = f32x8;
  __device__ static __forceinline__ T ld8(const float* p) { return *reinterpret_cast<const f32x8*>(p); }
  __device__ static __forceinline__ bf16x8 tobf(T x) {
    u32x4 w = {cvtpk(x[0], x[1]), cvtpk(x[2], x[3]), cvtpk(x[4], x[5]), cvtpk(x[6], x[7])}; return *reinterpret_cast<bf16x8*>(&w); } };

__device__ __forceinline__ void partialSM(f32x16& p0, f32x16& p1, float& m_reg, float& mn, float& alpha) {
  constexpr float C = SCALE * 1.4426950408889634f;
  float pmax = p0[0]; for (int r = 1; r < 16; ++r) pmax = fmaxf(pmax, p0[r]); for (int r = 0; r < 16; ++r) pmax = fmaxf(pmax, p1[r]);
  { auto rr = __builtin_amdgcn_permlane32_swap(__float_as_uint(pmax), __float_as_uint(pmax), false, false);
    pmax = fmaxf(__uint_as_float(rr[0]), __uint_as_float(rr[1])); }
  if (__builtin_expect(__all(pmax - m_reg <= THR / SCALE), 1)) { mn = m_reg; alpha = 1.f; }
  else { mn = fmaxf(m_reg, pmax); alpha = __builtin_amdgcn_exp2f((m_reg - mn) * C); m_reg = mn; }
  float mnC = -mn * C;
  for (int r = 0; r < 16; ++r) p0[r] = fmaf(p0[r], C, mnC); for (int r = 0; r < 16; ++r) p1[r] = fmaf(p1[r], C, mnC);
  for (int r = 0; r < 16; ++r) p0[r] = __builtin_amdgcn_exp2f(p0[r]);
}
__device__ __forceinline__ void finishSM(f32x16& p0, f32x16& p1, float alpha, float& l_reg, bf16x8& pa0, bf16x8& pa1, bf16x8& pa2, bf16x8& pa3) {
  for (int r = 0; r < 16; ++r) p1[r] = __builtin_amdgcn_exp2f(p1[r]);
  float ps = 0; for (int r = 0; r < 16; ++r) ps += p0[r]; for (int r = 0; r < 16; ++r) ps += p1[r];
  { auto rr = __builtin_amdgcn_permlane32_swap(__float_as_uint(ps), __float_as_uint(ps), false, false);
    ps = __uint_as_float(rr[0]) + __uint_as_float(rr[1]); }
  l_reg = l_reg * alpha + ps;
#define PK4(P, BASE, OUT) do { unsigned a0 = cvtpk(P[BASE + 0], P[BASE + 1]), a1 = cvtpk(P[BASE + 2], P[BASE + 3]);   \
    unsigned b0 = cvtpk(P[BASE + 4], P[BASE + 5]), b1 = cvtpk(P[BASE + 6], P[BASE + 7]);                              \
    auto r0 = __builtin_amdgcn_permlane32_swap(a0, b0, false, false); auto r1 = __builtin_amdgcn_permlane32_swap(a1, b1, false, false); \
    u32x4 w = {r0[0], r1[0], r0[1], r1[1]}; OUT = *reinterpret_cast<bf16x8*>(&w); } while (0)
  PK4(p0, 0, pa0); PK4(p0, 8, pa1); PK4(p1, 0, pa2); PK4(p1, 8, pa3);
#undef PK4
}
__device__ __forceinline__ void qkt(f32x16& p0, f32x16& p1, const bf16* Ks, const bf16x8* qr, int r32, int hi) {
  p0 = f32x16{}; p1 = f32x16{};
  for (int d0 = 0; d0 < 8; ++d0) { int cb = (d0 * 16 + hi * 8) * 2;
    bf16x8 b0 = *reinterpret_cast<const bf16x8*>((const char*)Ks + KSWZ(r32, cb));
    bf16x8 b1 = *reinterpret_cast<const bf16x8*>((const char*)Ks + KSWZ(32 + r32, cb));
    p0 = __builtin_amdgcn_mfma_f32_32x32x16_bf16(b0, qr[d0], p0, 0, 0, 0);
    p1 = __builtin_amdgcn_mfma_f32_32x32x16_bf16(b1, qr[d0], p1, 0, 0, 0); }
}
__device__ __forceinline__ int v_st(int k, int c) { const int kk = (k & ~0xC) | ((k & 4) << 1) | ((k & 8) >> 1); return ((kk >> 3) * 4 + (c >> 5)) * 512 + ((kk & 7) * 32 + (c & 31)) * 2; }
__device__ __forceinline__ int v_rd_base(int lane) { return ((lane & 3) << 3) | (((lane >> 2) & 3) << 6) | (((lane >> 4) & 1) << 5) | (((lane >> 5) & 1) << 8); }
constexpr int v_rd_off(int d0, int ks, int half) { return d0 * 512 + ks * 4096 + half * 2048; }
template <int OFF> __device__ __forceinline__ s16x4 tr_read(int vb) {
  s16x4 r; asm volatile("ds_read_b64_tr_b16 %0, %1 offset:%2" : "=&v"(r) : "v"(vb), "i"(OFF) : "memory"); return r;
}
template <int D0> __device__ __forceinline__ void pv_one(f32x16& od, int vb, bf16x8 pa0, bf16x8 pa1, bf16x8 pa2, bf16x8 pa3) {
  const s16x4 l0 = tr_read<v_rd_off(D0, 0, 0)>(vb), h0 = tr_read<v_rd_off(D0, 0, 1)>(vb), l1 = tr_read<v_rd_off(D0, 1, 0)>(vb), h1 = tr_read<v_rd_off(D0, 1, 1)>(vb);
  const s16x4 l2 = tr_read<v_rd_off(D0, 2, 0)>(vb), h2 = tr_read<v_rd_off(D0, 2, 1)>(vb), l3 = tr_read<v_rd_off(D0, 3, 0)>(vb), h3 = tr_read<v_rd_off(D0, 3, 1)>(vb);
  asm volatile("s_waitcnt lgkmcnt(0)" ::: "memory"); SBAR();
#define PK(L, H) (bf16x8){L[0], L[1], L[2], L[3], H[0], H[1], H[2], H[3]}
  od = __builtin_amdgcn_mfma_f32_32x32x16_bf16(pa0, PK(l0, h0), od, 0, 0, 0);
  od = __builtin_amdgcn_mfma_f32_32x32x16_bf16(pa1, PK(l1, h1), od, 0, 0, 0);
  od = __builtin_amdgcn_mfma_f32_32x32x16_bf16(pa2, PK(l2, h2), od, 0, 0, 0);
  od = __builtin_amdgcn_mfma_f32_32x32x16_bf16(pa3, PK(l3, h3), od, 0, 0, 0);
#undef PK
}
__device__ __forceinline__ void pv_d0(f32x16* o, int vb, bf16x8 pa0, bf16x8 pa1, bf16x8 pa2, bf16x8 pa3) {
  pv_one<0>(o[0], vb, pa0, pa1, pa2, pa3); pv_one<1>(o[1], vb, pa0, pa1, pa2, pa3); pv_one<2>(o[2], vb, pa0, pa1, pa2, pa3); pv_one<3>(o[3], vb, pa0, pa1, pa2, pa3);
}

template <typename TQ>
__device__ __forceinline__ void attn_dense_body(const TQ* __restrict__ Qb, const bf16* __restrict__ Kh, const bf16* __restrict__ Vh,
                                                const unsigned short* __restrict__ Gb, unsigned short* __restrict__ Ob, int seq, char* lds, int koff,
                                                const float* __restrict__ qgain, const float* __restrict__ rcos, const float* __restrict__ rsin, int tpos0) {
  using St = Stage<bf16>; using SQ = Stage<TQ>;
  const int tid = opaque_tid(), wid = tid >> 6, lane = tid & 63, r32 = lane & 31, hi = lane >> 5;
  bf16* V_lds = (bf16*)lds; bf16* K_lds = (bf16*)(lds + 2 * SHM_V);
  float* ws = (float*)(lds + 2 * SHM_V + 2 * SHM_K) + wid * 64; float* li_l = ws; float* al_l = ws + 32;
  float m_reg = -1e30f, l_reg = 0; f32x16 o[4] = {}; bf16x8 qr[8];
  const TQ* Qw = Qb + (long)(wid * QBLK + r32) * LDQ + hi * 8;
#pragma unroll
  for (int d0 = 0; d0 < 8; ++d0) qr[d0] = SQ::tobf(SQ::ld8(Qw + d0 * 16));
  {
    float ss = 0.f;
#pragma unroll
    for (int d0 = 0; d0 < 8; ++d0) { const u32x4 w = *reinterpret_cast<const u32x4*>(&qr[d0]);
      const float a0 = __uint_as_float(w.x << 16), a1 = __uint_as_float(w.x & 0xffff0000u), a2 = __uint_as_float(w.y << 16), a3 = __uint_as_float(w.y & 0xffff0000u);
      const float a4 = __uint_as_float(w.z << 16), a5 = __uint_as_float(w.z & 0xffff0000u), a6 = __uint_as_float(w.w << 16), a7 = __uint_as_float(w.w & 0xffff0000u);
      ss += (a0 * a0 + a1 * a1) + (a2 * a2 + a3 * a3) + (a4 * a4 + a5 * a5) + (a6 * a6 + a7 * a7); }
    ss += __shfl_xor(ss, 32);
    const float rstd = __builtin_amdgcn_rsqf(ss * (1.f / 128.f) + 1e-6f);
    const int tp = tpos0 + wid * QBLK + r32; const float* cp = rcos + (long)tp * 64 + hi * 4; const float* sp = rsin + (long)tp * 64 + hi * 4; const float* gp = qgain + hi * 8;
#pragma unroll
    for (int d0 = 0; d0 < 8; ++d0) { const u32x4 w = *reinterpret_cast<const u32x4*>(&qr[d0]);
      const float4 g0 = *reinterpret_cast<const float4*>(gp + d0 * 16), g1 = *reinterpret_cast<const float4*>(gp + d0 * 16 + 4), c4 = *reinterpret_cast<const float4*>(cp + d0 * 8), s4 = *reinterpret_cast<const float4*>(sp + d0 * 8);
      const float y0 = __uint_as_float(w.x << 16) * rstd * g0.x, y1 = __uint_as_float(w.x & 0xffff0000u) * rstd * g0.y, y2 = __uint_as_float(w.y << 16) * rstd * g0.z, y3 = __uint_as_float(w.y & 0xffff0000u) * rstd * g0.w;
      const float y4 = __uint_as_float(w.z << 16) * rstd * g1.x, y5 = __uint_as_float(w.z & 0xffff0000u) * rstd * g1.y, y6 = __uint_as_float(w.w << 16) * rstd * g1.z, y7 = __uint_as_float(w.w & 0xffff0000u) * rstd * g1.w;
      u32x4 o = {cvtpk(y0 * c4.x - y1 * s4.x, y0 * s4.x + y1 * c4.x), cvtpk(y2 * c4.y - y3 * s4.y, y2 * s4.y + y3 * c4.y), cvtpk(y4 * c4.z - y5 * s4.z, y4 * s4.z + y5 * c4.z), cvtpk(y6 * c4.w - y7 * s4.w, y6 * s4.w + y7 * c4.w)};
      qr[d0] = *reinterpret_cast<bf16x8*>(&o); }
  }
  const int sr = tid >> 4, sc = (tid & 15) * 8, vst0 = v_st(sr, sc), vst1 = v_st(32 + sr, sc);
  const int vb0 = (int)(uintptr_t)V_lds + v_rd_base(lane);
  struct { typename St::T vs0, vs1, ks0, ks1; } sr_[SDEPTH];
#define SLOAD(i, k0) do { const int kk_ = ((k0) + koff) & (seq - 1); sr_[i].vs0 = St::ld8(&Vh[(long)(kk_ + sr) * LDK + sc]); sr_[i].vs1 = St::ld8(&Vh[(long)(kk_ + 32 + sr) * LDK + sc]); \
    sr_[i].ks0 = St::ld8(&Kh[(long)(kk_ + sr) * LDK + sc]); sr_[i].ks1 = St::ld8(&Kh[(long)(kk_ + 32 + sr) * LDK + sc]); } while (0)
#define SWRITE(b, i) do { *(bf16x8*)((char*)V_lds + (b) * SHM_V + vst0) = St::tobf(sr_[i].vs0);          \
    *(bf16x8*)((char*)V_lds + (b) * SHM_V + vst1) = St::tobf(sr_[i].vs1); int kc = sc * 2;               \
    *(bf16x8*)((char*)K_lds + (b) * SHM_K + KSWZ(sr, kc)) = St::tobf(sr_[i].ks0);                       \
    *(bf16x8*)((char*)K_lds + (b) * SHM_K + KSWZ(32 + sr, kc)) = St::tobf(sr_[i].ks1); } while (0)
#define SWAIT() do { if constexpr (SDEPTH == 2) asm volatile("s_waitcnt vmcnt(4)" ::: "memory"); else asm volatile("s_waitcnt vmcnt(0)" ::: "memory"); } while (0)
#define RESC(a) do { if (__any((a) < 1.f)) { if (hi == 0) al_l[r32] = (a); asm volatile("s_waitcnt lgkmcnt(0)" ::: "memory"); \
    for (int d = 0; d < 4; ++d) for (int r = 0; r < 16; ++r) o[d][r] *= al_l[crow(r, hi)]; } } while (0)
  f32x16 pA0, pA1, pB0, pB1; float mnA, mnB, alA, alB; bf16x8 pa0, pa1, pa2, pa3; const int NT = seq / KVBLK;
  constexpr int SE = 0, SO = SDEPTH - 1;
  SLOAD(SE, 0); asm volatile("s_waitcnt vmcnt(0)" ::: "memory"); SWRITE(0, SE); __syncthreads();
  qkt(pA0, pA1, K_lds, qr, r32, hi); partialSM(pA0, pA1, m_reg, mnA, alA);
  SLOAD(SO, KVBLK); if constexpr (SDEPTH == 2) { if (2 < NT) SLOAD(SE, 2 * KVBLK); }
  SWAIT(); SWRITE(1, SO); __syncthreads();
  for (int j = 1; j + 1 < NT; j += 2) {
    SBAR(); qkt(pB0, pB1, (bf16*)((char*)K_lds + SHM_K), qr, r32, hi);
    finishSM(pA0, pA1, alA, l_reg, pa0, pa1, pa2, pa3); SBAR();
    SLOAD(SO, (j + SDEPTH) * KVBLK); SBAR();
    pv_d0(o, vb0, pa0, pa1, pa2, pa3); partialSM(pB0, pB1, m_reg, mnB, alB);
    __syncthreads(); SWAIT(); SWRITE(0, SE);
    RESC(alB); __syncthreads();
    SBAR(); qkt(pA0, pA1, K_lds, qr, r32, hi);
    finishSM(pB0, pB1, alB, l_reg, pa0, pa1, pa2, pa3); SBAR();
    if (SDEPTH == 1 || j + 3 < NT) SLOAD(SE, (j + 1 + SDEPTH) * KVBLK); SBAR();
    pv_d0(o, vb0 + (int)SHM_V, pa0, pa1, pa2, pa3); partialSM(pA0, pA1, m_reg, mnA, alA);
    __syncthreads(); SWAIT(); SWRITE(1, SO);
    RESC(alA); __syncthreads();
  }
  SBAR(); qkt(pB0, pB1, (bf16*)((char*)K_lds + SHM_K), qr, r32, hi);
  finishSM(pA0, pA1, alA, l_reg, pa0, pa1, pa2, pa3); SBAR();
  pv_d0(o, vb0, pa0, pa1, pa2, pa3); partialSM(pB0, pB1, m_reg, mnB, alB);
  __syncthreads(); RESC(alB);
  finishSM(pB0, pB1, alB, l_reg, pa0, pa1, pa2, pa3); SBAR();
  pv_d0(o, vb0 + (int)SHM_V, pa0, pa1, pa2, pa3);
  if (hi == 0) li_l[r32] = l_reg; asm volatile("s_waitcnt lgkmcnt(0)" ::: "memory");
  float rli[16];
#pragma unroll
  for (int r = 0; r < 16; ++r) rli[r] = __builtin_amdgcn_rcpf(li_l[crow(r, hi)]);
  unsigned short* Ow = Ob + (long)(wid * QBLK) * LDO + r32; const unsigned short* Gw = Gb + (long)(wid * QBLK) * LDQ + r32;
  unsigned short gq[16][4];
#pragma unroll
  for (int r = 0; r < 16; ++r) { const unsigned short* gp = Gw + (long)crow(r, hi) * LDQ;
#pragma unroll
    for (int d0 = 0; d0 < 4; ++d0) gq[r][d0] = gp[d0 * 32]; }
#pragma unroll
  for (int r = 0; r < 16; ++r) { unsigned short* op = Ow + (long)crow(r, hi) * LDO;
#pragma unroll
    for (int d0 = 0; d0 < 4; ++d0) { const float gv = __uint_as_float(((unsigned)gq[r][d0]) << 16);
      const float sg = gv * __builtin_amdgcn_rcpf(1.f + __builtin_amdgcn_exp2f(-1.4426950408889634f * gv));
      const float val = o[d0][r] * rli[r] * sg; unsigned u = __float_as_uint(val); u += 0x7fffu + ((u >> 16) & 1u);
      op[d0 * 32] = (unsigned short)(u >> 16); } }
#undef SLOAD
#undef SWRITE
#undef SWAIT
#undef RESC
}
}

struct Args {
    const float *x, *c, *w_mod, *b_mod, *pool_w_in, *pool_w_grp, *pool_scale, *pool_w_out;
    const float *gla_w_in, *gla_fwd_w1, *gla_fwd_w2, *gla_fwd_b, *gla_bwd_w1, *gla_bwd_w2, *gla_bwd_b, *gla_norm_g, *gla_w_out;
    const float *attn_w_in, *attn_qg, *attn_kg, *attn_w_out, *final_g;
    float* out; unsigned char* ws;
};
#define LDS_WAIT() asm volatile("s_waitcnt lgkmcnt(0)" ::: "memory")

__device__ __forceinline__ void transpose_item(const float* W, int K, int N, bf16_t* WT, int row_off, LAS float* scr, int item, int lane) {
    const int nblk = N / 32, kb = item / nblk, nb = item % nblk, k0 = 64 * kb, n0 = 32 * nb;
    float wv[32];
#pragma unroll
    for (int i = 0; i < 32; ++i) wv[i] = W[(size_t)(k0 + 2 * i + (lane >> 5)) * N + n0 + (lane & 31)];
#pragma unroll
    for (int i = 0; i < 32; ++i) scr[(2 * i + (lane >> 5)) * 33 + (lane & 31)] = wv[i];
    LDS_WAIT();
    const int c = lane & 7;
#pragma unroll
    for (int j = 0; j < 4; ++j) { const int n = (lane >> 3) + 8 * j; const LAS float* s = scr + (8 * c) * 33 + n;
        u32x4 o; o.x = cvt_pk_bf16(s[0 * 33], s[1 * 33]); o.y = cvt_pk_bf16(s[2 * 33], s[3 * 33]); o.z = cvt_pk_bf16(s[4 * 33], s[5 * 33]); o.w = cvt_pk_bf16(s[6 * 33], s[7 * 33]);
        *(u32x4*)(WT + (size_t)(row_off + n0 + n) * K + k0 + 8 * c) = o; }
    LDS_WAIT();
}
__device__ __forceinline__ void phase_weights(const Args& a, int L, LAS unsigned char* lds) {
    const int tid_ = opaque_tid(), lane = tid_ & 63, wave = __builtin_amdgcn_readfirstlane(tid_ >> 6), gw = blockIdx.x * 8 + wave, NGW = gridDim.x * 8; (void)wave; (void)gw; (void)NGW; (void)lane;
    LAS float* scr = (LAS float*)(lds + wave * 8704);
    bf16_t* WB = (bf16_t*)(a.ws + WS_WB); bf16_t* WBG = (bf16_t*)(a.ws + WS_WB + 16 * MiB); bf16_t* WBO = (bf16_t*)(a.ws + WS_WB + 24 * MiB);
    const int kind = L % 3, j = L / 3;
    if (kind == 0) {
        const float* win = a.pool_w_in + (size_t)j * 2048 * 4096; const float* wgrp = a.pool_w_grp + (size_t)j * 4 * 512 * 512; const float* wout = a.pool_w_out + (size_t)j * 2048 * 2048;
        constexpr int I_IN = 32 * 128, I_G = 8 * 16, I_OUT = 32 * 64;
        for (int it = gw; it < I_IN + 4 * I_G + I_OUT; it += NGW) {
            int r = it;
            if (r < I_IN) { transpose_item(win, 2048, 4096, WB, 0, scr, r, lane); continue; } r -= I_IN;
            if (r < 4 * I_G) { const int g = r / I_G; transpose_item(wgrp + (size_t)g * 512 * 512, 512, 512, WBG, g * 512, scr, r % I_G, lane); continue; } r -= 4 * I_G;
            transpose_item(wout, 2048, 2048, WBO, 0, scr, r, lane);
        }
    } else if (kind == 1) {
        constexpr int I_IN = 32 * 192, I_OUT = 32 * 64;
        for (int it = gw; it < I_IN + I_OUT; it += NGW) {
            int r = it;
            if (r < I_IN) { transpose_item(a.gla_w_in, 2048, 6144, WB, 0, scr, r, lane); continue; } r -= I_IN;
            transpose_item(a.gla_w_out, 2048, 2048, WBO, 0, scr, r, lane);
        }
        bf16_t* W1T = (bf16_t*)(a.ws + WS_W1T);
#pragma clang loop unroll(disable)
        for (int base = gw * 64; base < 32 * 2048; base += NGW * 64) { const int i = base + lane, n = i >> 11, k = i & 2047;
            W1T[i] = f2bf(n < 16 ? a.gla_fwd_w1[k * 16 + n] : a.gla_bwd_w1[k * 16 + n - 16]); }
    } else {
        constexpr int I_IN = 32 * 160, I_OUT = 32 * 64;
        for (int it = gw; it < I_IN + I_OUT; it += NGW) {
            int r = it;
            if (r < I_IN) { transpose_item(a.attn_w_in, 2048, 5120, WB, 0, scr, r, lane); continue; } r -= I_IN;
            transpose_item(a.attn_w_out, 2048, 2048, WBO, 0, scr, r, lane);
        }
    }
}
#define ROWS2_LOAD(V, xp, mm) do { _Pragma("unroll") for (int r_ = 0; r_ < 2; ++r_) { const f32x4* xr_ = (const f32x4*)((xp) + (size_t)((mm) + r_ * NGW) * DM) + lane; \
        _Pragma("unroll") for (int j_ = 0; j_ < 8; ++j_) V[r_][j_] = xr_[64 * j_]; } } while (0)
#define ROWS2_SS(V, s) do { _Pragma("unroll") for (int r_ = 0; r_ < 2; ++r_) { float t_ = 0.f; \
        _Pragma("unroll") for (int j_ = 0; j_ < 8; ++j_) t_ += (V[r_][j_].x * V[r_][j_].x + V[r_][j_].y * V[r_][j_].y) + (V[r_][j_].z * V[r_][j_].z + V[r_][j_].w * V[r_][j_].w); s[r_] = t_; } } while (0)
#define ROWS2C_LOAD(V, xp, mm) do { _Pragma("unroll") for (int r_ = 0; r_ < 2; ++r_) { const f32x4* xr_ = (const f32x4*)((xp) + (size_t)((mm) + r_) * DM) + lane; \
        _Pragma("unroll") for (int j_ = 0; j_ < 8; ++j_) V[r_][j_] = xr_[64 * j_]; } } while (0)
__device__ __forceinline__ void phase_norm_mod(const float* x, const float* modL, bf16_t* hb) {
    const int tid_ = opaque_tid(), lane = tid_ & 63, wave = __builtin_amdgcn_readfirstlane(tid_ >> 6), gw = blockIdx.x * 8 + wave, NGW = gridDim.x * 8;
#define NM_PROC(V, mm) do { float s_[2]; ROWS2_SS(V, s_); \
        _Pragma("unroll") for (int r = 0; r < 2; ++r) { const int mr = (mm) + r; const float rstd = __builtin_amdgcn_rsqf(wave_sum(s_[r]) * (1.f / DM) + NEPS); \
            u32x2* o8 = (u32x2*)(hb + (size_t)mr * DM) + lane; \
            _Pragma("unroll") for (int j = 0; j < 8; ++j) { const f32x4 h = V[r][j] * rstd * sc1[j] + sh[j]; u32x2 w; w.x = cvt_pk_bf16(h.x, h.y); w.y = cvt_pk_bf16(h.z, h.w); o8[64 * j] = w; } } } while (0)
    for (int g16 = gw; g16 < MTOK / 16; g16 += NGW) {
        const int m0 = g16 * 16; const float* mp = modL + (size_t)(m0 / SEQ) * 6144;
        f32x4 va[2][8], vb[2][8], sh[8], sc1[8];
        ROWS2C_LOAD(va, x, m0);
#pragma unroll
        for (int j = 0; j < 8; ++j) { sh[j] = *((const f32x4*)mp + lane + 64 * j); sc1[j] = *((const f32x4*)(mp + 2048) + lane + 64 * j) + 1.f; }
#pragma unroll 1
        for (int i = 0; i < 16; i += 4) {
            ROWS2C_LOAD(vb, x, m0 + i + 2);
            NM_PROC(va, m0 + i);
            if (i + 4 < 16) ROWS2C_LOAD(va, x, m0 + i + 4);
            NM_PROC(vb, m0 + i + 2);
        }
    }
#undef NM_PROC
}
__device__ __forceinline__ void phase_norm_mod_bf(const bf16_t* xb, const float* modL, bf16_t* hb) {
    const int tid_ = opaque_tid(), lane = tid_ & 63, wave = __builtin_amdgcn_readfirstlane(tid_ >> 6), gw = blockIdx.x * 8 + wave, NGW = gridDim.x * 8;
    for (int g16 = gw; g16 < MTOK / 16; g16 += NGW) {
        const int m0 = g16 * 16; const float* mp = modL + (size_t)(m0 / SEQ) * 6144;
        u32x4 va[2][4], vb[2][4]; f32x4 sh[4][2], sc1[4][2];
#define NB_LOAD(V, mm) do { _Pragma("unroll") for (int r_ = 0; r_ < 2; ++r_) { const u32x4* xr_ = (const u32x4*)(xb + (size_t)((mm) + r_) * DM) + lane; \
        _Pragma("unroll") for (int j_ = 0; j_ < 4; ++j_) V[r_][j_] = xr_[64 * j_]; } } while (0)
#define NB_PROC(V, mm) do { _Pragma("unroll") for (int r = 0; r < 2; ++r) { float f[4][8]; float s = 0.f; \
        _Pragma("unroll") for (int j = 0; j < 4; ++j) { const u32x4 w = V[r][j]; f[j][0] = bf_lo(w.x); f[j][1] = bf_hi(w.x); f[j][2] = bf_lo(w.y); f[j][3] = bf_hi(w.y); f[j][4] = bf_lo(w.z); f[j][5] = bf_hi(w.z); f[j][6] = bf_lo(w.w); f[j][7] = bf_hi(w.w); \
            _Pragma("unroll") for (int q = 0; q < 8; ++q) s += f[j][q] * f[j][q]; } \
        const float rstd = __builtin_amdgcn_rsqf(wave_sum(s) * (1.f / DM) + NEPS); u32x4* o16 = (u32x4*)(hb + (size_t)((mm) + r) * DM) + lane; \
        _Pragma("unroll") for (int j = 0; j < 4; ++j) { u32x4 w; \
            w.x = cvt_pk_bf16(f[j][0] * rstd * sc1[j][0][0] + sh[j][0][0], f[j][1] * rstd * sc1[j][0][1] + sh[j][0][1]); w.y = cvt_pk_bf16(f[j][2] * rstd * sc1[j][0][2] + sh[j][0][2], f[j][3] * rstd * sc1[j][0][3] + sh[j][0][3]); \
            w.z = cvt_pk_bf16(f[j][4] * rstd * sc1[j][1][0] + sh[j][1][0], f[j][5] * rstd * sc1[j][1][1] + sh[j][1][1]); w.w = cvt_pk_bf16(f[j][6] * rstd * sc1[j][1][2] + sh[j][1][2], f[j][7] * rstd * sc1[j][1][3] + sh[j][1][3]); \
            o16[64 * j] = w; } } } while (0)
        NB_LOAD(va, m0);
#pragma unroll
        for (int j = 0; j < 4; ++j)
#pragma unroll
            for (int q = 0; q < 2; ++q) { sh[j][q] = *(const f32x4*)(mp + (lane + 64 * j) * 8 + 4 * q); sc1[j][q] = *(const f32x4*)(mp + 2048 + (lane + 64 * j) * 8 + 4 * q) + 1.f; }
#pragma unroll 1
        for (int i = 0; i < 16; i += 4) {
            NB_LOAD(vb, m0 + i + 2);
            NB_PROC(va, m0 + i);
            if (i + 4 < 16) NB_LOAD(va, m0 + i + 4);
            NB_PROC(vb, m0 + i + 2);
        }
#undef NB_LOAD
#undef NB_PROC
    }
}
__device__ __forceinline__ void phase_final_norm(const float* x, const float* g, float* outp) {
    const int tid_ = opaque_tid(), lane = tid_ & 63, wave = __builtin_amdgcn_readfirstlane(tid_ >> 6), gw = blockIdx.x * 8 + wave, NGW = gridDim.x * 8;
    f32x4 gg[8];
#pragma unroll
    for (int j = 0; j < 8; ++j) gg[j] = *((const f32x4*)g + lane + 64 * j);
#define FN_PROC(V, mm) do { float s_[2]; ROWS2_SS(V, s_); \
        _Pragma("unroll") for (int r = 0; r < 2; ++r) { f32x4* xr = (f32x4*)(outp + (size_t)((mm) + r) * DM) + lane; const float rstd = __builtin_amdgcn_rsqf(wave_sum(s_[r]) * (1.f / DM) + NEPS); \
            _Pragma("unroll") for (int j = 0; j < 8; ++j) xr[64 * j] = V[r][j] * rstd * gg[j]; } } while (0)
    for (int g16 = gw; g16 < MTOK / 16; g16 += NGW) {
        const int m0 = g16 * 16;
        f32x4 va[2][8], vb[2][8];
        ROWS2C_LOAD(va, x, m0);
#pragma unroll 1
        for (int i = 0; i < 16; i += 4) {
            ROWS2C_LOAD(vb, x, m0 + i + 2);
            FN_PROC(va, m0 + i);
            if (i + 4 < 16) ROWS2C_LOAD(va, x, m0 + i + 4);
            FN_PROC(vb, m0 + i + 2);
        }
    }
#undef FN_PROC
}
__device__ __forceinline__ void phase_mod(const Args& a, LAS unsigned char* lds, float* mod) {
    LAS float* sc = (LAS float*)lds; LAS float* part = (LAS float*)(lds + 32768);
    const int tid = opaque_tid();
    if ((int)blockIdx.x >= 192) return;
    for (int i = tid; i < 8192; i += 512) sc[i] = silu_f(a.c[i]);
    __syncthreads();
    for (int item = blockIdx.x; item < 192; item += gridDim.x) {
        const int layer = item / 48, n0 = (item % 48) * 128, ks = tid >> 5, cq = tid & 31;
        f32x4 acc[4];
#pragma unroll
        for (int b = 0; b < 4; ++b) acc[b] = (f32x4){0.f, 0.f, 0.f, 0.f};
        const float* wp = a.w_mod + ((size_t)layer * 2048 + ks * 128) * 6144 + n0 + cq * 4;
#pragma unroll 16
        for (int k = 0; k < 128; ++k) { const f32x4 w = *(const f32x4*)(wp + (size_t)k * 6144); const int kk = ks * 128 + k;
#pragma unroll
            for (int b = 0; b < 4; ++b) acc[b] += w * sc[b * 2048 + kk]; }
#pragma unroll
        for (int b = 0; b < 4; ++b) *(LAS f32x4*)(part + (ks * 4 + b) * 128 + cq * 4) = acc[b];
        __syncthreads();
        { const int b = tid >> 7, col = tid & 127; float s = a.b_mod[layer * 6144 + n0 + col];
#pragma unroll
          for (int q = 0; q < 16; ++q) s += part[(q * 4 + b) * 128 + col];
          mod[(size_t)(layer * 4 + b) * 6144 + n0 + col] = s; }
        __syncthreads();
    }
}
__device__ __forceinline__ void phase_rope_table(float* rc, float* rs) {
#pragma clang loop unroll(disable)
    for (int idx = blockIdx.x * 512 + opaque_tid(); idx < SEQ * 64; idx += gridDim.x * 512) {
        const int t = idx >> 6, i = idx & 63;
        const float pos = (i < 32) ? (float)((t >> 6) - 64) : (float)((t & 63) - 32);
        const float inv = __builtin_amdgcn_exp2f(-(float)(i & 31) * 0.41524101186092029f);
        const float ang = pos * inv;
        const double xd = (double)ang; const double n = __builtin_rint(xd * 0.63661977236758134); const float rf = (float)(xd - n * 1.5707963267948966);
        const int q = ((int)n) & 3; const float r2 = rf * rf;
        const float sn = rf + rf * r2 * (-1.6666667e-1f + r2 * (8.3333333e-3f + r2 * (-1.9841270e-4f + r2 * 2.7557319e-6f)));
        const float cs = 1.f + r2 * (-0.5f + r2 * (4.1666667e-2f + r2 * (-1.3888889e-3f + r2 * (2.4801587e-5f + r2 * -2.7557319e-7f))));
        const float co = (q == 0) ? cs : (q == 1) ? -sn : (q == 2) ? -cs : sn;
        const float si = (q == 0) ? sn : (q == 1) ? cs : (q == 2) ? -sn : -cs;
        rc[idx] = co; rs[idx] = si;
    }
}
__device__ __forceinline__ void acc8(float (&s)[8], const u32x4 w, const float f) {
    s[0] += f * bf_lo(w.x); s[1] += f * bf_hi(w.x); s[2] += f * bf_lo(w.y); s[3] += f * bf_hi(w.y); s[4] += f * bf_lo(w.z); s[5] += f * bf_hi(w.z); s[6] += f * bf_lo(w.w); s[7] += f * bf_hi(w.w); }
__device__ __forceinline__ void phase_pool(const bf16_t* proj  , bf16_t* pooled) {
    const int tid_ = opaque_tid(), lane = tid_ & 63, wave = __builtin_amdgcn_readfirstlane(tid_ >> 6), gw = blockIdx.x * 8 + wave, NGW = gridDim.x * 8;
    for (int unit = gw; unit < (MTOK / 64) * 4; unit += NGW) {
        const int run = unit >> 2, j = unit & 3, half = 1 << j, m0 = run * 64, t0 = m0 & (SEQ - 1), c = (j * 64 + lane) * 8;
        const bf16_t* base = proj + (size_t)(m0 - t0) * 4096 + c; bf16_t* outp = pooled + (size_t)(m0 - t0) * 2048 + c;
        float S[8];
#pragma unroll
        for (int q = 0; q < 8; ++q) S[q] = 0.f;
        { u32x4 wi[16]; float fi[16];
#pragma unroll
          for (int q = 0; q < 16; ++q) { const int r = t0 - half + q, rc2 = r < 0 ? 0 : (r >= SEQ ? SEQ - 1 : r); fi[q] = (q < 2 * half && r >= 0 && r < SEQ) ? 1.f : 0.f; wi[q] = *(const u32x4*)(base + (size_t)rc2 * 4096); }
#pragma unroll
          for (int q = 0; q < 16; ++q) acc8(S, wi[q], fi[q]); }
#pragma unroll 8
        for (int tt = 0; tt < 64; ++tt) {
            const int t = t0 + tt, lo = (t - half) > 0 ? (t - half) : 0, hi = (t + half) < SEQ ? (t + half) : SEQ;
            const int ra = (t + half) < SEQ ? (t + half) : (SEQ - 1), rs = (t - half) > 0 ? (t - half) : 0;
            const float fa = (t + half) < SEQ ? 1.f : 0.f, fs = (t - half) >= 0 ? -1.f : 0.f;
            const u32x4 u = *(const u32x4*)(base + (size_t)t * 4096), wa = *(const u32x4*)(base + (size_t)ra * 4096), ws = *(const u32x4*)(base + (size_t)rs * 4096);
            const float ic = 1.f / (float)(hi - lo);
            u32x4 o; o.x = cvt_pk_bf16(S[0] * ic - bf_lo(u.x), S[1] * ic - bf_hi(u.x)); o.y = cvt_pk_bf16(S[2] * ic - bf_lo(u.y), S[3] * ic - bf_hi(u.y));
            o.z = cvt_pk_bf16(S[4] * ic - bf_lo(u.z), S[5] * ic - bf_hi(u.z)); o.w = cvt_pk_bf16(S[6] * ic - bf_lo(u.w), S[7] * ic - bf_hi(u.w));
            *(u32x4*)(outp + (size_t)t * 2048) = o;
            acc8(S, wa, fa); acc8(S, ws, fs);
        }
    }
}
__device__ __forceinline__ void phase_knorm_rope(bf16_t* proj, const float* kg, const float* rc, const float* rs) {
    const int tid_ = opaque_tid(), lane = tid_ & 63, wave = __builtin_amdgcn_readfirstlane(tid_ >> 6), gw = blockIdx.x * 8 + wave, NGW = gridDim.x * 8;
    const float k0 = kg[2 * lane], k1 = kg[2 * lane + 1];
    for (int m = gw; m < MTOK; m += 2 * NGW) {
        unsigned w[2][4]; float co[2], si[2];
#pragma unroll
        for (int r = 0; r < 2; ++r) { const int mm = m + r * NGW, t = mm & (SEQ - 1); co[r] = rc[t * 64 + lane]; si[r] = rs[t * 64 + lane];
            const unsigned* row = (const unsigned*)(proj + (size_t)mm * 5120 + 2048) + lane;
#pragma unroll
            for (int h = 0; h < 4; ++h) w[r][h] = row[h * 64]; }
#pragma unroll
        for (int r = 0; r < 2; ++r) { unsigned* row = (unsigned*)(proj + (size_t)(m + r * NGW) * 5120 + 2048) + lane;
#pragma unroll
            for (int h = 0; h < 4; ++h) {
                const float x0 = bf_lo(w[r][h]), x1 = bf_hi(w[r][h]);
                const float rstd = __builtin_amdgcn_rsqf(wave_sum(x0 * x0 + x1 * x1) * (1.f / 128.f) + NEPS);
                const float y0 = x0 * rstd * k0, y1 = x1 * rstd * k1;
                row[h * 64] = cvt_pk_bf16(y0 * co[r] - y1 * si[r], y0 * si[r] + y1 * co[r]);
            } }
    }
}

__device__ __forceinline__ f32x4 mfma16(bf16x8 x, bf16x8 y, f32x4 acc) { return __builtin_amdgcn_mfma_f32_16x16x32_bf16(x, y, acc, 0, 0, 0); }

__device__ __forceinline__ void phase_gla_lowrank(const bf16_t* hb, const bf16_t* w1t, float* R, LAS unsigned char* lds) {
    const int tid_ = opaque_tid(), lane = tid_ & 63, wave = __builtin_amdgcn_readfirstlane(tid_ >> 6), gw = blockIdx.x * 8 + wave, NGW = gridDim.x * 8;
    const int fr = lane & 15, fq = lane >> 4;
    for (int i = tid_; i < 32 * 256; i += 512) { const int n = i >> 8, c16 = i & 255; *(LAS u32x4*)(lds + n * 4112 + c16 * 16) = *(const u32x4*)(w1t + n * 2048 + c16 * 8); }
    __syncthreads();
    const LAS unsigned char* wl = lds + fr * 4112 + fq * 16;
    for (int u = gw; u < MTOK / 16; u += NGW) {
        const bf16_t* ap = hb + (size_t)(u * 16 + fr) * 2048 + fq * 8;
        f32x4 acc0 = (f32x4){0.f, 0.f, 0.f, 0.f}, acc1 = acc0;
#pragma unroll 16
        for (int ks = 0; ks < 64; ++ks) { const bf16x8 av = *(const bf16x8*)(ap + ks * 32);
            acc0 = mfma16(*(const LAS bf16x8*)(wl + ks * 64), av, acc0); acc1 = mfma16(*(const LAS bf16x8*)(wl + 16 * 4112 + ks * 64), av, acc1); }
        float* rp = R + (size_t)(u * 16 + fr) * 32 + 4 * fq;
        *(f32x4*)rp = acc0; *(f32x4*)(rp + 16) = acc1;
    }
    __syncthreads();
}
__device__ __forceinline__ bf16_t f2bf1(float v) { return (bf16_t)(cvt_pk_bf16(v, 0.f) & 0xffffu); }
constexpr int G1_QI = 8192, G1_KI = G1_QI + 32768, G1_QT = G1_KI + 32768, G1_KT = G1_QT + 64 * 528, G1_TOT = G1_KT + 64 * 528, G1_END = G1_TOT + 2048;
__device__ __forceinline__ bf16x8 frag(const LAS unsigned char* base, int pitch, int row, int ks, int fq) { return *(const LAS bf16x8*)(base + row * pitch + ks * 64 + fq * 16); }
template <int dir> __device__ __forceinline__ void gla_prep_dir(const Args& a, LAS unsigned char* lds, const int tid, const int b, const int cc, const int h, const size_t tok0) {
    const LAS float* rl = (const LAS float*)lds; const LAS bf16_t* qi = (const LAS bf16_t*)(lds + G1_QI); const LAS bf16_t* ki = (const LAS bf16_t*)(lds + G1_KI);
    LAS float* tot = (LAS float*)(lds + G1_TOT); LAS float* bl = tot + 256;
    const int d = tid & 255, half = __builtin_amdgcn_readfirstlane(tid >> 8), col = h * 256 + d;
    const int wave = __builtin_amdgcn_readfirstlane(tid >> 6), lane = tid & 63, fr = lane & 15, fq = lane >> 4;
    const float* w2 = dir ? a.gla_bwd_w2 : a.gla_fwd_w2; const float* bs = dir ? a.gla_bwd_b : a.gla_fwd_b;
    float w2c[16];
#pragma unroll
    for (int c = 0; c < 16; ++c) w2c[c] = w2[c * 1024 + col];
    const float bias = bs[col];
    float eb[32]; float run = 0.f;
#pragma unroll
    for (int i = 0; i < 32; ++i) { const int pi = half * 32 + i, t = dir ? 63 - pi : pi; float z = bias;
#pragma unroll
        for (int c4 = 0; c4 < 4; ++c4) { const f32x4 rv = *(const LAS f32x4*)(rl + t * 32 + dir * 16 + c4 * 4);
            z += rv.x * w2c[c4 * 4] + rv.y * w2c[c4 * 4 + 1] + rv.z * w2c[c4 * 4 + 2] + rv.w * w2c[c4 * 4 + 3]; }
        const float ls = fminf(z, 0.f) - __logf(1.f + __expf(-fabsf(z)));
        run += ls * 0.0625f; eb[i] = run; if ((i & 3) == 3) asm volatile("" ::: "memory"); }
    if (half == 0) tot[d] = run;
    __syncthreads();
    const float add = half ? tot[d] : 0.f;
    if (half == 1) bl[d] = run + add;
    __syncthreads();
    const float ebl = __expf(bl[d]);
    bf16_t* khp = (bf16_t*)(a.ws + WS_QKK + 256 * MiB) + ((((size_t)dir * 4 + b) * 128 + cc) * 4 + h) * (256 * 64) + (size_t)d * 64;
#pragma unroll
    for (int gi = 0; gi < 4; ++gi) {
        float kh[8];
#pragma unroll
        for (int q = 0; q < 8; ++q) { const int i = gi * 8 + q, pi = half * 32 + i, t = dir ? 63 - pi : pi;
            const float e = __expf(eb[i] + add);
            *(LAS bf16_t*)(lds + G1_QT + t * 528 + d * 2) = f2bf1(bf2f(qi[t * 256 + d]) * 0.0625f * e);
            const float ktv = bf2f(ki[t * 256 + d]) * __builtin_amdgcn_rcpf(e);
            *(LAS bf16_t*)(lds + G1_KT + t * 528 + d * 2) = f2bf1(ktv); kh[q] = ktv * ebl; }
        u32x4 o;
        if (dir) { o.x = cvt_pk_bf16(kh[7], kh[6]); o.y = cvt_pk_bf16(kh[5], kh[4]); o.z = cvt_pk_bf16(kh[3], kh[2]); o.w = cvt_pk_bf16(kh[1], kh[0]); }
        else     { o.x = cvt_pk_bf16(kh[0], kh[1]); o.y = cvt_pk_bf16(kh[2], kh[3]); o.z = cvt_pk_bf16(kh[4], kh[5]); o.w = cvt_pk_bf16(kh[6], kh[7]); }
        *(u32x4*)(khp + (dir ? 56 - half * 32 - gi * 8 : half * 32 + gi * 8)) = o;
        asm volatile("" ::: "memory");
    }
    if (half == 0) ((float*)(a.ws + WS_DL))[(((size_t)dir * 4 + b) * 128 + cc) * 1024 + col] = ebl;
    __syncthreads();
    { const int it = wave >> 1, jt0 = (wave & 1) * 2; f32x4 am[2] = {(f32x4){0.f, 0.f, 0.f, 0.f}, (f32x4){0.f, 0.f, 0.f, 0.f}};
#pragma unroll
      for (int ks = 0; ks < 8; ++ks) { const bf16x8 fqt = frag(lds + G1_QT, 528, it * 16 + fr, ks, fq);
#pragma unroll
          for (int n = 0; n < 2; ++n) am[n] = __builtin_amdgcn_mfma_f32_16x16x32_bf16(frag(lds + G1_KT, 528, (jt0 + n) * 16 + fr, ks, fq), fqt, am[n], 0, 0, 0); }
      bf16_t* amg = (bf16_t*)(a.ws + WS_QKK + 128 * MiB) + ((((size_t)dir * 4 + b) * 128 + cc) * 4 + h) * (64 * 64);
#pragma unroll
      for (int n = 0; n < 2; ++n) { const int i = it * 16 + fr, j0 = (jt0 + n) * 16 + 4 * fq; float v[4];
#pragma unroll
          for (int r = 0; r < 4; ++r) { const int j = j0 + r; const bool keep = dir ? (j > i) : (j <= i); v[r] = keep ? am[n][r] : 0.f; }
          u32x2 w; w.x = cvt_pk_bf16(v[0], v[1]); w.y = cvt_pk_bf16(v[2], v[3]); *(u32x2*)(amg + i * 64 + j0) = w; } }
    { bf16_t* QT = (bf16_t*)(a.ws + WS_QKK) + (size_t)dir * MTOK * 1024; const unsigned stoff = ((unsigned)(tid >> 5) * 1024u + (unsigned)(tid & 31) * 8u) * 2u;
#pragma unroll
      for (int i = 0; i < 4; ++i) { char* p = (char*)(QT + (tok0 + 16 * i) * 1024 + h * 256);
          *(u32x4*)(p + stoff) = *(const LAS u32x4*)(lds + G1_QT + ((tid >> 5) + 16 * i) * 528 + (tid & 31) * 16); } }
    __syncthreads();
}
__device__ __forceinline__ void phase_gla_prep(const Args& a, LAS unsigned char* lds) {
    const int tid = opaque_tid();
    const bf16_t* proj = (const bf16_t*)(a.ws + WS_PROJ); const float* R = (const float*)(a.ws + WS_R);
    const unsigned ltoff = ((unsigned)(tid >> 5) * 6144u + (unsigned)(tid & 31) * 8u) * 2u;
    for (int u = blockIdx.x; u < 2048; u += gridDim.x) {
        const int b = u >> 9, cc = (u >> 2) & 127, h = u & 3; const size_t tok0 = (size_t)b * SEQ + cc * 64;
#pragma unroll
        for (int i = 0; i < 4; ++i) { const char* p = (const char*)(proj + (tok0 + 16 * i) * 6144 + h * 256); const int idx = tid + 512 * i;
            *(LAS u32x4*)(lds + G1_QI + idx * 16) = *(const u32x4*)(p + ltoff); *(LAS u32x4*)(lds + G1_KI + idx * 16) = *(const u32x4*)(p + 2048 + ltoff); }
        *(LAS f32x4*)((LAS float*)lds + tid * 4) = *(const f32x4*)(R + tok0 * 32 + tid * 4);
        __syncthreads();
        gla_prep_dir<0>(a, lds, tid, b, cc, h, tok0);
        gla_prep_dir<1>(a, lds, tid, b, cc, h, tok0);
    }
}
constexpr int SC_PQ = 528, SC_PS = 144;
constexpr int SC_QT = 0, SC_KH = SC_QT + 64 * SC_PQ, SC_VT = SC_KH + 256 * SC_PS, SC_ST = SC_VT + 64 * SC_PS, SC_AM = SC_ST + 64 * SC_PQ, SC_DL = SC_AM + 64 * SC_PS, SC_END = SC_DL + 1024;
__device__ __forceinline__ void phase_gla_scan(const Args& a, LAS unsigned char* lds) {
    const int tid = opaque_tid(), wave = __builtin_amdgcn_readfirstlane(tid >> 6), lane = tid & 63, fr = lane & 15, fq = lane >> 4;
    const bf16_t* proj = (const bf16_t*)(a.ws + WS_PROJ); const float* DLg = (const float*)(a.ws + WS_DL);
    for (int item = blockIdx.x; item < 256; item += gridDim.x) {
        const int xcd = item & 7, jj = item >> 3, bhd = xcd * 4 + (jj >> 3), es = jj & 7, b = bhd >> 3, h = (bhd >> 1) & 3, dir = bhd & 1;
        const bf16_t* QT = (const bf16_t*)(a.ws + WS_QKK) + (size_t)dir * MTOK * 1024 + h * 256;
        const bf16_t* AMG = (const bf16_t*)(a.ws + WS_QKK + 128 * MiB);
        const bf16_t* KH = (const bf16_t*)(a.ws + WS_QKK + 256 * MiB);
        const bf16_t* V = proj + 2048 + h * 512 + es * 64;
        bf16_t* O = dir ? ((bf16_t*)(a.ws + WS_PROJ) + h * 512 + es * 64) : ((bf16_t*)(a.ws + WS_HB) + h * 512 + es * 64); const int ldo = dir ? 6144 : 2048;
        for (int i = tid; i < 64 * SC_PQ / 16; i += 512) *(LAS u32x4*)(lds + SC_ST + i * 16) = (u32x4){0u, 0u, 0u, 0u};
        f32x4 S[2][4];
#pragma unroll
        for (int i = 0; i < 2; ++i)
#pragma unroll
            for (int j = 0; j < 4; ++j) S[i][j] = (f32x4){0.f, 0.f, 0.f, 0.f};
        u32x4 rq[4], rkh[4], rv, ram; f32x4 rdl = (f32x4){0.f, 0.f, 0.f, 0.f};
#define SC_LOAD(c) do { const int cc_ = dir ? 127 - (c) : (c); const size_t tok0_ = (size_t)b * SEQ + cc_ * 64; const size_t ci_ = (((size_t)dir * 4 + b) * 128 + cc_) * 4 + h; \
        _Pragma("unroll") for (int i_ = 0; i_ < 4; ++i_) { const int idx_ = tid + 512 * i_; rq[i_] = *(const u32x4*)(QT + (tok0_ + (idx_ >> 5)) * 1024 + (idx_ & 31) * 8); } \
        const bf16_t* khc_ = KH + ci_ * (256 * 64); \
        _Pragma("unroll") for (int i_ = 0; i_ < 4; ++i_) rkh[i_] = *(const u32x4*)(khc_ + (size_t)(tid + 512 * i_) * 8); \
        ram = *(const u32x4*)(AMG + ci_ * (64 * 64) + (size_t)tid * 8); \
        rv = *(const u32x4*)(V + (tok0_ + (tid & 63)) * 6144 + (tid >> 6) * 8); \
        if (tid < 64) rdl = *(const f32x4*)(DLg + (((size_t)dir * 4 + b) * 128 + cc_) * 1024 + h * 256 + tid * 4); } while (0)
        SC_LOAD(0);
        for (int c = 0; c < 128; ++c) {
            const int cc = dir ? 127 - c : c; const size_t tok0 = (size_t)b * SEQ + cc * 64;
#pragma unroll
            for (int i = 0; i < 4; ++i) { const int idx = tid + 512 * i; *(LAS u32x4*)(lds + SC_QT + (idx >> 5) * SC_PQ + (idx & 31) * 16) = rq[i];
                *(LAS u32x4*)(lds + SC_KH + (idx >> 3) * SC_PS + (idx & 7) * 16) = rkh[i]; }
            *(LAS u32x4*)(lds + SC_AM + (tid >> 3) * SC_PS + (tid & 7) * 16) = ram;
            { LAS bf16_t* vt = (LAS bf16_t*)(lds + SC_VT) + ((tid >> 6) * 8) * (SC_PS / 2) + (tid & 63);
              vt[0 * (SC_PS / 2)] = (bf16_t)(rv.x & 0xffffu); vt[1 * (SC_PS / 2)] = (bf16_t)(rv.x >> 16); vt[2 * (SC_PS / 2)] = (bf16_t)(rv.y & 0xffffu); vt[3 * (SC_PS / 2)] = (bf16_t)(rv.y >> 16);
              vt[4 * (SC_PS / 2)] = (bf16_t)(rv.z & 0xffffu); vt[5 * (SC_PS / 2)] = (bf16_t)(rv.z >> 16); vt[6 * (SC_PS / 2)] = (bf16_t)(rv.w & 0xffffu); vt[7 * (SC_PS / 2)] = (bf16_t)(rv.w >> 16); }
            if (tid < 64) *(LAS f32x4*)(lds + SC_DL + tid * 16) = rdl;
            __syncthreads();
            if (c + 1 < 128) SC_LOAD(c + 1);
            const int it = wave >> 1, et0 = (wave & 1) * 2;
            f32x4 oacc[2];
#pragma unroll
            for (int n = 0; n < 2; ++n) oacc[n] = (f32x4){0.f, 0.f, 0.f, 0.f};
#pragma unroll
            for (int ks = 0; ks < 8; ++ks) { const bf16x8 fqt = frag(lds + SC_QT, SC_PQ, it * 16 + fr, ks, fq);
#pragma unroll
                for (int n = 0; n < 2; ++n) oacc[n] = mfma16(frag(lds + SC_ST, SC_PQ, (et0 + n) * 16 + fr, ks, fq), fqt, oacc[n]); }
#pragma unroll
            for (int ks = 0; ks < 2; ++ks) { const bf16x8 fa = frag(lds + SC_AM, SC_PS, it * 16 + fr, ks, fq);
#pragma unroll
                for (int n = 0; n < 2; ++n) oacc[n] = mfma16(frag(lds + SC_VT, SC_PS, (et0 + n) * 16 + fr, ks, fq), fa, oacc[n]); }
#pragma unroll
            for (int n = 0; n < 2; ++n) { u32x2 w; w.x = cvt_pk_bf16(oacc[n][0], oacc[n][1]); w.y = cvt_pk_bf16(oacc[n][2], oacc[n][3]);
                *(u32x2*)(O + (tok0 + it * 16 + fr) * ldo + (et0 + n) * 16 + 4 * fq) = w; }
#pragma unroll
            for (int i = 0; i < 2; ++i) { const f32x4 dl4 = *(const LAS f32x4*)(lds + SC_DL + ((wave * 2 + i) * 16 + 4 * fq) * 4);
#pragma unroll
                for (int j = 0; j < 4; ++j) S[i][j] *= dl4; }
#pragma unroll
            for (int ks = 0; ks < 2; ++ks) {
                bf16x8 fv[4];
#pragma unroll
                for (int j = 0; j < 4; ++j) fv[j] = frag(lds + SC_VT, SC_PS, j * 16 + fr, ks, fq);
#pragma unroll
                for (int i = 0; i < 2; ++i) { const bf16x8 fk = frag(lds + SC_KH, SC_PS, (wave * 2 + i) * 16 + fr, ks, fq);
#pragma unroll
                    for (int j = 0; j < 4; ++j) S[i][j] = mfma16(fk, fv[j], S[i][j]); } }
            __syncthreads();
#pragma unroll
            for (int i = 0; i < 2; ++i)
#pragma unroll
                for (int j = 0; j < 4; ++j) { u32x2 w; w.x = cvt_pk_bf16(S[i][j][0], S[i][j][1]); w.y = cvt_pk_bf16(S[i][j][2], S[i][j][3]);
                    *(LAS u32x2*)(lds + SC_ST + (j * 16 + fr) * SC_PQ + ((wave * 2 + i) * 16 + 4 * fq) * 2) = w; }
        }
        __syncthreads();
#undef SC_LOAD
    }
}
__device__ __forceinline__ void phase_gla_post(bf16_t* hb, const bf16_t* proj, const float* ng) {
    const int tid_ = opaque_tid(), lane = tid_ & 63, wave = __builtin_amdgcn_readfirstlane(tid_ >> 6), gw = blockIdx.x * 8 + wave, NGW = gridDim.x * 8;
    float g8[8];
#pragma unroll
    for (int q = 0; q < 8; ++q) g8[q] = ng[lane * 8 + q];
    for (int m = gw; m < MTOK; m += 2 * NGW) {
        u32x4 wf[2][4], wb[2][4], wg[2][4];
#pragma unroll
        for (int r = 0; r < 2; ++r) { const size_t mm = (size_t)(m + r * NGW);
#pragma unroll
            for (int hh = 0; hh < 4; ++hh) { const int c = hh * 512 + lane * 8;
                wf[r][hh] = *(const u32x4*)(hb + mm * 2048 + c); wb[r][hh] = *(const u32x4*)(proj + mm * 6144 + c); wg[r][hh] = *(const u32x4*)(proj + mm * 6144 + 4096 + c); } }
#pragma unroll
        for (int r = 0; r < 2; ++r) { const size_t mm = (size_t)(m + r * NGW);
#pragma unroll
            for (int hh = 0; hh < 4; ++hh) { const int c = hh * 512 + lane * 8; const u32x4 f = wf[r][hh], bk = wb[r][hh], gg = wg[r][hh];
                float o[8] = {bf_lo(f.x) + bf_lo(bk.x), bf_hi(f.x) + bf_hi(bk.x), bf_lo(f.y) + bf_lo(bk.y), bf_hi(f.y) + bf_hi(bk.y), bf_lo(f.z) + bf_lo(bk.z), bf_hi(f.z) + bf_hi(bk.z), bf_lo(f.w) + bf_lo(bk.w), bf_hi(f.w) + bf_hi(bk.w)};
                const float g[8] = {bf_lo(gg.x), bf_hi(gg.x), bf_lo(gg.y), bf_hi(gg.y), bf_lo(gg.z), bf_hi(gg.z), bf_lo(gg.w), bf_hi(gg.w)};
                float s = 0.f;
#pragma unroll
                for (int q = 0; q < 8; ++q) s += o[q] * o[q];
                const float rstd = __builtin_amdgcn_rsqf(wave_sum(s) * (1.f / 512.f) + NEPS);
#pragma unroll
                for (int q = 0; q < 8; ++q) o[q] = o[q] * rstd * g8[q] * silu_f(g[q]);
                u32x4 w; w.x = cvt_pk_bf16(o[0], o[1]); w.y = cvt_pk_bf16(o[2], o[3]); w.z = cvt_pk_bf16(o[4], o[5]); w.w = cvt_pk_bf16(o[6], o[7]);
                *(u32x4*)(hb + mm * 2048 + c) = w; } }
    }
}

#define RLX_AGENT __ATOMIC_RELAXED, __HIP_MEMORY_SCOPE_AGENT
#define XB_TMO      128
#define XB_XCNT(j)  (256  + 64 * (j))
#define XB_XSUB(j)  (1280 + 64 * (j))
#define XB_XGEN(j)  (2304 + 64 * (j))
#define XB_TOP      3328
#define XB_TOPGEN   3392
#define XCD_BAR_WORDS 3456
#define XB_SPIN_CAP (1u << 18)

__device__ __forceinline__ unsigned xb_ld(unsigned* p)              { return __hip_atomic_load(p, __ATOMIC_RELAXED, __HIP_MEMORY_SCOPE_AGENT); }
__device__ __forceinline__ unsigned xb_add(unsigned* p, unsigned v) { return __hip_atomic_fetch_add(p, v, __ATOMIC_RELAXED, __HIP_MEMORY_SCOPE_AGENT); }
__device__ __forceinline__ unsigned xb_xcc_id() { return (unsigned)__builtin_amdgcn_s_getreg((3 << 11) | 20) & 0xFu; }
#define XB_SPIN(cond, bar) do { unsigned _sp = 0; while (cond) { __builtin_amdgcn_s_sleep(1); \
    if ((++_sp & 255u) == 0u) { if (xb_ld(&(bar)[XB_TMO])) break; if (_sp > XB_SPIN_CAP) { atomicAdd(&(bar)[XB_TMO], 1u); break; } } } } while (0)

struct XcdBarrier {
    unsigned* bar; unsigned x;
    volatile LAS unsigned* st;
};

__device__ __forceinline__ XcdBarrier xcd_barrier_post(unsigned* bar, volatile LAS unsigned* st) {
    XcdBarrier b; b.bar = bar; b.x = xb_xcc_id(); b.st = st;
    if (threadIdx.x == 0) (void)xb_add(&bar[XB_XCNT(b.x)], 1u);
    return b;
}
__device__ __forceinline__ void xcd_barrier_complete(unsigned* bar, unsigned x, unsigned& nloc, unsigned& nx) {
    const unsigned G = gridDim.x * gridDim.y * gridDim.z;
    unsigned sum, cnt, mine, sp = 0u;
    for (;;) {
        sum = 0u; cnt = 0u; mine = 0u;
#pragma unroll
        for (unsigned j = 0; j < 16; ++j) { const unsigned c = xb_ld(&bar[XB_XCNT(j)]); sum += c; cnt += (c > 0u) ? 1u : 0u; mine = (j == x) ? c : mine; }
        if (sum == G) break;
        __builtin_amdgcn_s_sleep(1);
        if ((++sp & 255u) == 0u) { if (xb_ld(&bar[XB_TMO])) break; if (sp > XB_SPIN_CAP) { atomicAdd(&bar[XB_TMO], 1u); break; } }
    }
    nloc = mine > 0u ? mine : 1u; nx = cnt > 0u ? cnt : 1u;
}

__device__ __forceinline__ void xcd_barrier(const XcdBarrier& b) {
    asm volatile("s_waitcnt vmcnt(0)" ::: "memory");
    __syncthreads();
    if (threadIdx.x == 0) {
        unsigned* bar = b.bar;
        __builtin_amdgcn_s_waitcnt(0);
        unsigned nloc = b.st[0], nx = b.st[1];
        if (nloc == 0u) { xcd_barrier_complete(bar, b.x, nloc, nx); b.st[0] = nloc; b.st[1] = nx; }
        const unsigned old = xb_add(&bar[XB_XSUB(b.x)], 1u);
        const unsigned gen = old / nloc;
        if (old + 1u == (gen + 1u) * nloc) {
            __builtin_amdgcn_fence(__ATOMIC_RELEASE, "agent");
            asm volatile("s_waitcnt vmcnt(0)" ::: "memory");
            const unsigned og = xb_add(&bar[XB_TOP], 1u);
            const unsigned tg = og / nx;
            if (og + 1u == (tg + 1u) * nx) xb_add(&bar[XB_TOPGEN], 1u);
            else XB_SPIN(xb_ld(&bar[XB_TOPGEN]) == tg, bar);
            __builtin_amdgcn_fence(__ATOMIC_ACQUIRE, "agent");
            xb_add(&bar[XB_XGEN(b.x)], 1u);
            asm volatile("s_waitcnt vmcnt(0)" ::: "memory");
        } else {
            XB_SPIN(xb_ld(&bar[XB_XGEN(b.x)]) == gen, bar);
            __builtin_amdgcn_fence(__ATOMIC_ACQUIRE, "agent");
            asm volatile("s_waitcnt vmcnt(0)" ::: "memory");
        }
    }
    __syncthreads();
}


#ifndef NLAYERS
#define NLAYERS 4
#endif
#ifndef REP_ATTN
#define REP_ATTN 1
#endif
#ifndef REP_SCAN
#define REP_SCAN 1
#endif
#ifndef REP_PREP
#define REP_PREP 1
#endif
#ifndef REP_GEMM0
#define REP_GEMM0 1
#endif
#ifndef REP_POOL
#define REP_POOL 1
#endif
#ifndef REP_SYNC
#define REP_SYNC 0
#endif
#ifndef REP_GRP
#define REP_GRP 1
#endif
#ifndef REP_OUT0
#define REP_OUT0 1
#endif
#ifndef REP_PRO
#define REP_PRO 1
#endif
#ifndef REP_LOWRANK
#define REP_LOWRANK 1
#endif
#ifndef REP_NORM
#define REP_NORM 1
#endif
constexpr int LDS_BYTES = 160 * 1024;
static_assert(SC_END <= LDS_BYTES - 64 && (int)attn::SHM_ATTN <= LDS_BYTES && pg8::STAGE_BYTES <= LDS_BYTES, "LDS map");

#define CG_SYNC() do { asm volatile("s_waitcnt vmcnt(0) lgkmcnt(0)" ::: "memory"); grid.sync(); __builtin_amdgcn_fence(__ATOMIC_ACQUIRE, "agent"); asm volatile("s_waitcnt vmcnt(0)" ::: "memory"); } while (0)
#define GRID_SYNC() xcd_barrier(xbar)
__global__ void __launch_bounds__(512, 2) fwd_megakernel(Args a) {
    extern __shared__ __attribute__((aligned(16))) unsigned char lds_raw[];
    LAS unsigned char* lds = (LAS unsigned char*)lds_raw;
    cg::grid_group grid = cg::this_grid();
    if (threadIdx.x < 16) ((LAS unsigned*)(lds + LDS_BYTES - 64))[threadIdx.x] = 0u;
    __syncthreads();
    XcdBarrier xbar = xcd_barrier_post((unsigned*)(a.ws + WS_BAR), (volatile LAS unsigned*)(lds + LDS_BYTES - 64));
    const int G = gridDim.x;
    float* mod = (float*)(a.ws + WS_MOD); float* rc = (float*)(a.ws + WS_ROPE); float* rs = rc + SEQ * 64;
    bf16_t* WB = (bf16_t*)(a.ws + WS_WB); bf16_t* WBG = (bf16_t*)(a.ws + WS_WB + 16 * MiB); bf16_t* WBO = (bf16_t*)(a.ws + WS_WB + 24 * MiB);
    bf16_t* HB = (bf16_t*)(a.ws + WS_HB); bf16_t* PROJ = (bf16_t*)(a.ws + WS_PROJ); bf16_t* YB = (bf16_t*)(a.ws + WS_QKK);

    for (int rep = 0; rep < REP_PRO; ++rep) {
    phase_mod(a, lds, mod);
    __syncthreads();
    phase_rope_table(rc, rs);
    phase_weights(a, 0, lds);
    GRID_SYNC(); }
    if (a.ws == nullptr) CG_SYNC();

    bf16_t* XB = (bf16_t*)a.out;
    float* XF = (float*)(a.ws + WS_QKK + 128 * MiB);
    for (int L = 0; L < NLAYERS; ++L) {
        const int kind = L % 3, j = L / 3, N = (kind == 0) ? 4096 : (kind == 1) ? 6144 : 5120;
        const float* modL = mod + (size_t)L * 4 * 6144;
        if (L > 0) phase_weights(a, L, lds);
        if (L == 0) phase_norm_mod(a.x, modL, HB); else phase_norm_mod_bf(XB, modL, HB);
        GRID_SYNC();
        if (kind == 1) for (int rep = 0; rep < REP_LOWRANK; ++rep) phase_gla_lowrank(HB, (const bf16_t*)(a.ws + WS_W1T), (float*)(a.ws + WS_R), lds);
        for (int rep = 0; rep < REP_GEMM0; ++rep) {
        { pg8::Gemm g{HB, WB, MTOK, N, 2048, 2048, 2048, 0}; pg8::StaticOrder S; S.init(MTOK, N, G, (int)blockIdx.x);
          pg8::EpiStore E{PROJ, N}; pg8::gemm_phase<pg8::EpiStore, pg8::StaticOrder>(lds, g, S, E); }
        GRID_SYNC(); }
        if (kind == 0) {
            for (int rep = 0; rep < REP_POOL; ++rep) {
            phase_pool(PROJ, HB);
            GRID_SYNC(); }
            for (int rep = 0; rep < REP_GRP; ++rep) {
            { pg8::Gemm g{HB, WBG, MTOK, 2048, 512, 2048, 512, 1}; pg8::StaticOrder S; S.init(MTOK, 2048, G, (int)blockIdx.x);
              pg8::EpiPool E{YB, PROJ + 2048, 4096, a.pool_scale + (size_t)j * 2048}; pg8::gemm_phase<pg8::EpiPool, pg8::StaticOrder>(lds, g, S, E); }
            GRID_SYNC(); }
        } else if (kind == 1) {
            for (int rep = 0; rep < REP_PREP; ++rep) {
            phase_gla_prep(a, lds);
            GRID_SYNC(); }
            for (int rep = 0; rep < REP_SCAN; ++rep) {
            phase_gla_scan(a, lds);
            GRID_SYNC(); }
            phase_gla_post(HB, PROJ, a.gla_norm_g);
            GRID_SYNC();
        } else {
            phase_knorm_rope(PROJ, a.attn_kg, rc, rs);
            GRID_SYNC();
            for (int rep = 0; rep < REP_ATTN; ++rep) {
            for (int u = blockIdx.x; u < 2048; u += G) {
                const int bk = u >> 7, b = bk >> 2, kvh = bk & 3, hq = kvh * 4 + ((u >> 5) & 3), qb = u & 31;
                const size_t row0 = (size_t)b * SEQ + qb * 256;
                attn::attn_dense_body<attn::bf16>((const attn::bf16*)(PROJ + row0 * 5120 + hq * 128), (const attn::bf16*)(PROJ + (size_t)b * SEQ * 5120 + 2048 + kvh * 128),
                    (const attn::bf16*)(PROJ + (size_t)b * SEQ * 5120 + 2560 + kvh * 128), PROJ + row0 * 5120 + 3072 + hq * 128, YB + row0 * 2048 + hq * 128, SEQ, (char*)lds_raw, 0, a.attn_qg, rc, rs, qb * 256);
                __syncthreads();
            }
            GRID_SYNC(); }
        }
        { pg8::Gemm g{kind == 1 ? HB : YB, WBO, MTOK, 2048, 2048, 2048, 2048, 0}; pg8::StaticOrder S; S.init(MTOK, 2048, G, (int)blockIdx.x);
          if (L == 0) { pg8::EpiResT<false, true> E{a.x, XB, modL + 4096}; pg8::gemm_phase<pg8::EpiResT<false, true>, pg8::StaticOrder>(lds, g, S, E); }
          else if (L < 3) { pg8::EpiResT<true, true> E{XB, XB, modL + 4096}; pg8::gemm_phase<pg8::EpiResT<true, true>, pg8::StaticOrder>(lds, g, S, E); }
          else { pg8::EpiResT<true, false> E{XB, XF, modL + 4096}; pg8::gemm_phase<pg8::EpiResT<true, false>, pg8::StaticOrder>(lds, g, S, E); } }
        GRID_SYNC();
    }
    phase_final_norm(XF, a.final_g, a.out);
}

extern "C" void kernel_launch(void* const* d_in, const int* in_sizes, int n_in, void* d_out, int out_size, void* d_ws, size_t ws_size, hipStream_t stream) {
    static int grid = 0;
    if (grid == 0) {
        if (n_in != 22 || in_sizes[0] != MTOK * DM || out_size != MTOK * DM || ws_size < WS_END) {
            fprintf(stderr, "kernel_launch: unexpected shapes: n_in %d in0 %d out %d ws %zu (need %zu)\n", n_in, n_in > 0 ? in_sizes[0] : -1, out_size, ws_size, (size_t)WS_END); grid = -1; return; }
        int dev = 0, cus = 0, per_cu = 0;
        hipGetDevice(&dev); hipDeviceGetAttribute(&cus, hipDeviceAttributeMultiprocessorCount, dev);
        if (hipFuncSetAttribute((const void*)fwd_megakernel, hipFuncAttributeMaxDynamicSharedMemorySize, LDS_BYTES) != hipSuccess) { fprintf(stderr, "kernel_launch: hipFuncSetAttribute failed\n"); grid = -1; return; }
        if (hipOccupancyMaxActiveBlocksPerMultiprocessor(&per_cu, (const void*)fwd_megakernel, 512, LDS_BYTES) != hipSuccess || per_cu < 1) { fprintf(stderr, "kernel_launch: occupancy query gave %d\n", per_cu); per_cu = 1; }
        (void)hipGetLastError();
        grid = cus;
        fprintf(stderr, "kernel_launch: cus %d per_cu %d grid %d\n", cus, per_cu, grid);
    }
    if (grid < 0) return;
    Args a{};
    const float** p = (const float**)&a;
    for (int i = 0; i < 22; ++i) p[i] = (const float*)d_in[i];
    a.out = (float*)d_out; a.ws = (unsigned char*)d_ws;
    if (hipMemsetAsync((char*)d_ws + WS_BAR, 0, 16384, stream) != hipSuccess) { fprintf(stderr, "kernel_launch: memset of the barrier words failed\n"); return; }
    void* args[] = {&a};
    hipError_t e = hipLaunchCooperativeKernel((const void*)fwd_megakernel, dim3(grid), dim3(512), args, LDS_BYTES, stream);
    if (e != hipSuccess) fprintf(stderr, "kernel_launch: cooperative launch failed: %s (grid %d)\n", hipGetErrorString(e), grid);
}
```

```cpp
#include <hip/hip_runtime.h>
#include <hip/hip_bf16.h>
#include <hip/hip_cooperative_groups.h>
#include <cstdio>
#include <cstdint>
#include <cmath>
namespace cg = cooperative_groups;

constexpr int NB = 4, SEQ = 8192, DM = 2048, MTOK = NB * SEQ;
constexpr float NEPS = 1e-6f;
constexpr size_t MiB = (size_t)1 << 20;
constexpr size_t WS_MOD = 0;
constexpr size_t WS_ROPE = 1 * MiB;
constexpr size_t WS_R = 5 * MiB;
constexpr size_t WS_DL = 9 * MiB;
constexpr size_t WS_W1T = 13 * MiB;
constexpr size_t WS_BAR = 15 * MiB;
constexpr size_t WS_WB = 16 * MiB;
constexpr size_t WS_HB = 52 * MiB;
constexpr size_t WS_PROJ = 180 * MiB;
constexpr size_t WS_QKK = 564 * MiB;
constexpr size_t WS_END = 948 * MiB;

typedef unsigned short bf16_t;
typedef short bf16x8 __attribute__((ext_vector_type(8)));
typedef float f32x4 __attribute__((ext_vector_type(4)));
typedef unsigned u32x4 __attribute__((ext_vector_type(4)));
typedef unsigned u32x2 __attribute__((ext_vector_type(2)));
#define LAS __attribute__((address_space(3)))

typedef float f32x2 __attribute__((ext_vector_type(2)));
typedef __bf16 bf16x2_t __attribute__((ext_vector_type(2)));
__device__ __forceinline__ unsigned cvt_pk_bf16(float lo, float hi) { f32x2 v = {lo, hi}; bf16x2_t b = __builtin_convertvector(v, bf16x2_t); return __builtin_bit_cast(unsigned, b); }
__device__ __forceinline__ float bf_lo(unsigned w) { return __uint_as_float(w << 16); }
__device__ __forceinline__ float bf_hi(unsigned w) { return __uint_as_float(w & 0xffff0000u); }
__device__ __forceinline__ float bf2f(bf16_t b) { return __uint_as_float(((unsigned)b) << 16); }
__device__ __forceinline__ bf16_t f2bf(float f) { unsigned u = __float_as_uint(f); u += 0x7fffu + ((u >> 16) & 1u); return (bf16_t)(u >> 16); }
__device__ __forceinline__ float silu_f(float v) { return v * __builtin_amdgcn_rcpf(1.f + __builtin_amdgcn_exp2f(-1.4426950408889634f * v)); }
__device__ __forceinline__ float wave_sum(float v) {
#pragma unroll
    for (int o = 1; o < 64; o <<= 1) v += __shfl_xor(v, o);
    return v;
}
__device__ __forceinline__ int opaque_tid() { int t; asm volatile("v_mov_b32 %0, %1" : "=v"(t) : "v"((int)threadIdx.x)); return t; }

namespace pg8 {
#define PG8_LAS __attribute__((address_space(3)))
constexpr int BM = 256, BK = 64, HALF = 128, HTB = HALF * BK * 2  , STAGE_BYTES = 8 * HTB, NXCD = 8, WGM = 4;
__host__ __device__ __forceinline__ int lds_byte(int r, int c) { const int st = (r >> 4) * 2 + (c >> 5), rr = r & 15, cc = c & 31, ob = rr * 64 + cc * 2; return st * 1024 + (ob ^ (((ob >> 9) & 1) << 5)); }
__host__ __device__ __forceinline__ void stage_rc(int b, int& R, int& C) { const int st = b / 1024, sb = b % 1024, swz = sb ^ (((sb >> 9) & 1) << 5); R = (st >> 1) * 16 + swz / 64; C = (st & 1) * 32 + (swz % 64) / 2; }
__host__ __device__ __forceinline__ int perm32(int rho) { const int n = rho >> 4, i = rho & 15; return 8 * (i >> 2) + 4 * n + (i & 3); }
struct Unit { int pm, pn; };
struct Gemm { const bf16_t* A; const bf16_t* Bt; int M, N, K, lda, ldb, grp;
    __device__ __forceinline__ const char* aptr(const Unit& u) const { return (const char*)(A + (size_t)u.pm * BM * lda + (grp == 1 ? (size_t)(u.pn >> 1) * K : (size_t)0)); }
    __device__ __forceinline__ const char* bptr(const Unit& u) const { return (const char*)(Bt + (size_t)u.pn * BM * ldb + (grp == 2 ? (size_t)(u.pm >> 1) * K : (size_t)0)); } };
struct StaticOrder {
    int nM, nN, nwg, G, c;
    __host__ __device__ void init(int M, int N, int G_, int c_) { nM = M / BM; nN = N / BM; nwg = nM * nN; G = G_; c = c_; }
    __host__ __device__ bool next(int i, Unit& u) const {
        const long L = (long)i * G + c; if (L >= nwg) return false;
        int wgid = (int)L; { const int q = nwg / NXCD, r = nwg % NXCD, xcd = wgid % NXCD, off = wgid / NXCD; wgid = (xcd < r ? xcd * (q + 1) : r * (q + 1) + (xcd - r) * q) + off; }
        const int nig = WGM * nN, gid = wgid / nig, fm = gid * WGM, gsz = (nM - fm) < WGM ? (nM - fm) : WGM;
        u.pm = fm + ((wgid % nig) % gsz); u.pn = (wgid % nig) / gsz; return true;
    }
    __device__ __forceinline__ void a_ready(const Unit&) const {}
    __device__ __forceinline__ void done(const Unit&) const {}
};
struct EpiStore {
    static constexpr bool PERM = true, AFTER_DRAIN = false; static constexpr int STAGGER_TICKS = 0;
    bf16_t* O; int ldc;
    __device__ __forceinline__ void operator()(const f32x4 (&acc)[2][2][4][2], const Unit& u, int wr, int wc, int fr, int fq) const {
        const int row0 = u.pm * BM + wr * 64 + fr, col0 = u.pn * BM + wc * 32 + 8 * fq;
#pragma unroll
        for (int ai = 0; ai < 2; ++ai)
#pragma unroll
            for (int m = 0; m < 4; ++m) { bf16_t* rowp = O + (size_t)(row0 + ai * HALF + m * 16) * ldc + col0;
#pragma unroll
                for (int bj = 0; bj < 2; ++bj) { const f32x4 v0 = acc[ai][bj][m][0], v1 = acc[ai][bj][m][1];
                    u32x4 w; w.x = cvt_pk_bf16(v0[0], v0[1]); w.y = cvt_pk_bf16(v0[2], v0[3]); w.z = cvt_pk_bf16(v1[0], v1[1]); w.w = cvt_pk_bf16(v1[2], v1[3]);
                    *(u32x4*)(rowp + bj * HALF) = w; } }
    }
};
struct EpiNull {
    static constexpr bool PERM = true, AFTER_DRAIN = false; static constexpr int STAGGER_TICKS = 0;
    bf16_t* O;
    __device__ __forceinline__ void operator()(const f32x4 (&acc)[2][2][4][2], const Unit& u, int wr, int wc, int fr, int fq) const {
        f32x4 s = (f32x4){0.f, 0.f, 0.f, 0.f};
#pragma unroll
        for (int ai = 0; ai < 2; ++ai)
#pragma unroll
            for (int bj = 0; bj < 2; ++bj)
#pragma unroll
                for (int m = 0; m < 4; ++m) { s += acc[ai][bj][m][0]; s += acc[ai][bj][m][1]; }
        if (s[0] + s[1] + s[2] + s[3] == 1234.5678f) O[0] = 0;
    }
};
struct EpiPool {
    static constexpr bool PERM = true, AFTER_DRAIN = false; static constexpr int STAGGER_TICKS = 0;
    bf16_t* O; const bf16_t* G; int ldg; const float* scale;
    __device__ __forceinline__ void operator()(const f32x4 (&acc)[2][2][4][2], const Unit& u, int wr, int wc, int fr, int fq) const {
        const int row0 = u.pm * BM + wr * 64 + fr, col0 = u.pn * BM + wc * 32 + 8 * fq;
        f32x4 sv[2][2];
#pragma unroll
        for (int bj = 0; bj < 2; ++bj)
#pragma unroll
            for (int n = 0; n < 2; ++n) sv[bj][n] = *(const f32x4*)(scale + col0 + bj * HALF + 4 * n);
#pragma unroll
        for (int ai = 0; ai < 2; ++ai) {
            u32x4 gwv[4][2];
#pragma unroll
            for (int m = 0; m < 4; ++m)
#pragma unroll
                for (int bj = 0; bj < 2; ++bj) gwv[m][bj] = *(const u32x4*)(G + (size_t)(row0 + ai * HALF + m * 16) * ldg + col0 + bj * HALF);
#pragma unroll
            for (int m = 0; m < 4; ++m) { const size_t row = (size_t)(row0 + ai * HALF + m * 16);
#pragma unroll
                for (int bj = 0; bj < 2; ++bj) { const u32x4 gw = gwv[m][bj];
                    const f32x4 v0 = acc[ai][bj][m][0] * sv[bj][0], v1 = acc[ai][bj][m][1] * sv[bj][1];
                    u32x4 w;
                    w.x = cvt_pk_bf16(v0[0] * silu_f(bf_lo(gw.x)), v0[1] * silu_f(bf_hi(gw.x))); w.y = cvt_pk_bf16(v0[2] * silu_f(bf_lo(gw.y)), v0[3] * silu_f(bf_hi(gw.y)));
                    w.z = cvt_pk_bf16(v1[0] * silu_f(bf_lo(gw.z)), v1[1] * silu_f(bf_hi(gw.z))); w.w = cvt_pk_bf16(v1[2] * silu_f(bf_lo(gw.w)), v1[3] * silu_f(bf_hi(gw.w)));
                    *(u32x4*)(O + row * 2048 + col0 + bj * HALF) = w; } }
            asm volatile("" ::: "memory"); }
    }
};
template <bool IN_BF16, bool OUT_BF16> struct EpiResT {
    static constexpr bool PERM = true, AFTER_DRAIN = false; static constexpr int STAGGER_TICKS = 0;
    const void* xi; void* xo; const float* gate;
    __device__ __forceinline__ void operator()(const f32x4 (&acc)[2][2][4][2], const Unit& u, int wr, int wc, int fr, int fq) const {
        const int row0 = u.pm * BM + wr * 64 + fr, col0 = u.pn * BM + wc * 32 + 8 * fq;
        const float* gp = gate + (size_t)((u.pm * BM) / SEQ) * 6144 + col0;
        f32x4 gv[2][2];
#pragma unroll
        for (int bj = 0; bj < 2; ++bj)
#pragma unroll
            for (int n = 0; n < 2; ++n) gv[bj][n] = *(const f32x4*)(gp + bj * HALF + 4 * n);
#pragma unroll
        for (int aim = 0; aim < (IN_BF16 ? 2 : 4); ++aim) {
            constexpr int MB = IN_BF16 ? 4 : 2; const int ai = IN_BF16 ? aim : (aim >> 1), mb0 = IN_BF16 ? 0 : (aim & 1) * 2;
            u32x4 raw[4][2][IN_BF16 ? 1 : 2];
#pragma unroll
            for (int m = mb0; m < mb0 + MB; ++m) { const size_t off = (size_t)(row0 + ai * HALF + m * 16) * 2048 + col0;
#pragma unroll
                for (int bj = 0; bj < 2; ++bj) {
                    if (IN_BF16) raw[m][bj][0] = *(const u32x4*)((const bf16_t*)xi + off + bj * HALF);
                    else { raw[m][bj][0] = *(const u32x4*)((const float*)xi + off + bj * HALF); raw[m][bj][IN_BF16 ? 0 : 1] = *(const u32x4*)((const float*)xi + off + bj * HALF + 4); } } }
#pragma unroll
            for (int m = mb0; m < mb0 + MB; ++m) { const size_t off = (size_t)(row0 + ai * HALF + m * 16) * 2048 + col0;
#pragma unroll
                for (int bj = 0; bj < 2; ++bj) { f32x4 x0, x1;
                    if (IN_BF16) { const u32x4 w = raw[m][bj][0]; x0 = (f32x4){bf_lo(w.x), bf_hi(w.x), bf_lo(w.y), bf_hi(w.y)}; x1 = (f32x4){bf_lo(w.z), bf_hi(w.z), bf_lo(w.w), bf_hi(w.w)}; }
                    else { x0 = __builtin_bit_cast(f32x4, raw[m][bj][0]); x1 = __builtin_bit_cast(f32x4, raw[m][bj][IN_BF16 ? 0 : 1]); }
                    const f32x4 v0 = x0 + gv[bj][0] * acc[ai][bj][m][0], v1 = x1 + gv[bj][1] * acc[ai][bj][m][1];
                    if (OUT_BF16) { u32x4 w; w.x = cvt_pk_bf16(v0[0], v0[1]); w.y = cvt_pk_bf16(v0[2], v0[3]); w.z = cvt_pk_bf16(v1[0], v1[1]); w.w = cvt_pk_bf16(v1[2], v1[3]);
                        *(u32x4*)((bf16_t*)xo + off + bj * HALF) = w; }
                    else { *(f32x4*)((float*)xo + off + bj * HALF) = v0; *(f32x4*)((float*)xo + off + bj * HALF + 4) = v1; } } }
            asm volatile("" ::: "memory"); }
    }
};
struct EpiRes {
#ifndef RES_STAGGER_TICKS
#define RES_STAGGER_TICKS 0
#endif
    static constexpr bool PERM = false, AFTER_DRAIN = false; static constexpr int STAGGER_TICKS = RES_STAGGER_TICKS;
    const float* xi; float* xo; const float* gate;
    __device__ __forceinline__ void operator()(const f32x4 (&acc)[2][2][4][2], const Unit& u, int wr, int wc, int fr, int fq) const {
        const int row0 = u.pm * BM + wr * 64 + fr, col0 = u.pn * BM + wc * 32 + 4 * fq;
        const float* gp = gate + (size_t)((u.pm * BM) / SEQ) * 6144 + col0;
        f32x4 gv[2][2];
#pragma unroll
        for (int bj = 0; bj < 2; ++bj)
#pragma unroll
            for (int n = 0; n < 2; ++n) gv[bj][n] = *(const f32x4*)(gp + bj * HALF + n * 16);
#pragma unroll
        for (int ai = 0; ai < 2; ++ai)
#pragma unroll
            for (int mp = 0; mp < 1; ++mp) {
                f32x4 xv[4][2][2];
#pragma unroll
                for (int mm = 0; mm < 4; ++mm) { const size_t off = (size_t)(row0 + ai * HALF + (4 * mp + mm) * 16) * 2048 + col0;
#pragma unroll
                    for (int bj = 0; bj < 2; ++bj)
#pragma unroll
                        for (int n = 0; n < 2; ++n) xv[mm][bj][n] = *(const f32x4*)(xi + off + bj * HALF + n * 16); }
#pragma unroll
                for (int mm = 0; mm < 4; ++mm) { const size_t off = (size_t)(row0 + ai * HALF + (4 * mp + mm) * 16) * 2048 + col0;
#pragma unroll
                    for (int bj = 0; bj < 2; ++bj)
#pragma unroll
                        for (int n = 0; n < 2; ++n) *(f32x4*)(xo + off + bj * HALF + n * 16) = xv[mm][bj][n] + gv[bj][n] * acc[ai][bj][4 * mp + mm][n]; }
                asm volatile("" ::: "memory"); }
    }
};
template <class Epi, class Sched>
__device__ __forceinline__ void gemm_phase(PG8_LAS unsigned char* lds, const Gemm g, const Sched& S, const Epi& E) {
    const int tid = opaque_tid(), wid = __builtin_amdgcn_readfirstlane(tid >> 6), lane = tid & 63, wr = wid >> 2, wc = wid & 3, fr = lane & 15, fq = lane >> 4;
    const int K = g.K, nt = K / BK;
    unsigned voffA[2], voffB[2];
#pragma unroll
    for (int i = 0; i < 2; ++i) { int R, C; stage_rc(tid * 16 + i * 8192, R, C); const int Rb = Epi::PERM ? ((R & ~31) + perm32(R & 31)) : R;
        voffA[i] = (unsigned)(R * g.lda + C) * 2u; voffB[i] = (unsigned)(Rb * g.ldb + C) * 2u; }
    const size_t kstep = (size_t)(BK * 2);
    const size_t hstepA = (size_t)HALF * g.lda * 2, hstepB = (size_t)HALF * g.ldb * 2;
    const unsigned ldsw = (unsigned)wid * 1024u;
    const int aoff = lds_byte(wr * 64 + fr, fq * 8), boff = lds_byte(wc * 32 + fr, fq * 8);
#define PG8_SA(b, h) (((b) * 2 + (h)) * HTB)
#define PG8_SB(b, h) ((4 + (b) * 2 + (h)) * HTB)
#define PG8_STAGE(bufoff, gbase, voff) do { _Pragma("unroll") for (int _i = 0; _i < 2; ++_i) \
        __builtin_amdgcn_global_load_lds((const unsigned*)((const char*)(gbase) + (voff)[_i]), (PG8_LAS unsigned*)(lds + (bufoff) + ldsw + _i * 8192), 16, 0, 0); } while (0)
#define PG8_LDA(dst, b, h) do { _Pragma("unroll") for (int m = 0; m < 4; ++m) _Pragma("unroll") for (int k = 0; k < 2; ++k) dst[m][k] = *(const PG8_LAS bf16x8*)(lds + PG8_SA(b, h) + aoff + m * 2048 + k * 1024); } while (0)
#define PG8_LDB(dst, b, h) do { _Pragma("unroll") for (int n = 0; n < 2; ++n) _Pragma("unroll") for (int k = 0; k < 2; ++k) dst[n][k] = *(const PG8_LAS bf16x8*)(lds + PG8_SB(b, h) + boff + n * 2048 + k * 1024); } while (0)
#define PG8_MMA(ai, bj, At, Bt) do { __builtin_amdgcn_s_setprio(1); _Pragma("unroll") for (int m = 0; m < 4; ++m) _Pragma("unroll") for (int n = 0; n < 2; ++n) _Pragma("unroll") for (int k = 0; k < 2; ++k) \
        acc[ai][bj][m][n] = __builtin_amdgcn_mfma_f32_16x16x32_bf16(Bt[n][k], At[m][k], acc[ai][bj][m][n], 0, 0, 0); __builtin_amdgcn_s_setprio(0); } while (0)
#define PG8_WAIT_V(n) asm volatile("s_waitcnt vmcnt(" #n ")" ::: "memory")
#define PG8_WAIT_L(n) asm volatile("s_waitcnt lgkmcnt(" #n ")" ::: "memory")
#define PG8_BAR __builtin_amdgcn_s_barrier()
#define PG8_SCHED __builtin_amdgcn_sched_barrier(0)
    Unit cur, nxt; int ui = 0;
    if (!S.next(0, cur)) return;
#ifndef GEMM_STAGGER_TICKS
#define GEMM_STAGGER_TICKS 0
#endif
    if (Epi::STAGGER_TICKS > 0) {
        const unsigned long long t0 = __builtin_amdgcn_s_memrealtime(), dl = (unsigned long long)((unsigned)blockIdx.x * (unsigned)Epi::STAGGER_TICKS / (unsigned)gridDim.x);
        while (__builtin_amdgcn_s_memrealtime() - t0 < dl) __builtin_amdgcn_s_sleep(8);
    }
    f32x4 acc[2][2][4][2];
#pragma unroll
    for (int a = 0; a < 2; ++a)
#pragma unroll
        for (int b = 0; b < 2; ++b)
#pragma unroll
            for (int m = 0; m < 4; ++m)
#pragma unroll
                for (int n = 0; n < 2; ++n) acc[a][b][m][n] = (f32x4){0.f, 0.f, 0.f, 0.f};
    bf16x8 At[4][2], B0[2][2], B1[2][2];
    const char* cA = g.aptr(cur); const char* cB = g.bptr(cur);
    S.a_ready(cur);
    PG8_STAGE(PG8_SB(0, 0), cB, voffB); PG8_STAGE(PG8_SA(0, 0), cA, voffA); PG8_STAGE(PG8_SB(0, 1), cB + hstepB, voffB); PG8_STAGE(PG8_SA(0, 1), cA + hstepA, voffA);
    if (wr == 1) PG8_BAR;
    PG8_WAIT_V(4); PG8_BAR;
    PG8_STAGE(PG8_SB(1, 0), cB + kstep, voffB); PG8_STAGE(PG8_SA(1, 0), cA + kstep, voffA); PG8_STAGE(PG8_SB(1, 1), cB + hstepB + kstep, voffB);
    PG8_WAIT_V(6); PG8_BAR;
    for (;;) {
        const bool has_next = S.next(ui + 1, nxt);
        const char* nA = has_next ? g.aptr(nxt) : cA; const char* nB = has_next ? g.bptr(nxt) : cB;
        for (int t = 0; t < nt; t += 2) {
            const bool last = (t == nt - 2);
            const char* a1 = cA + (size_t)(t + 1) * kstep;
            const char* a2 = last ? nA : cA + (size_t)(t + 2) * kstep; const char* b2 = last ? nB : cB + (size_t)(t + 2) * kstep;
            const char* a3 = a2 + kstep; const char* b3 = b2 + kstep;
            if (last && has_next) S.a_ready(nxt);
            PG8_LDB(B0, 0, 0); PG8_SCHED; PG8_LDA(At, 0, 0); PG8_STAGE(PG8_SA(1, 1), a1 + hstepA, voffA);
            PG8_WAIT_L(8); PG8_BAR; PG8_WAIT_L(0); PG8_MMA(0, 0, At, B0); PG8_BAR; PG8_SCHED;
            PG8_LDB(B1, 0, 1); PG8_STAGE(PG8_SB(0, 0), b2, voffB);
            PG8_BAR; PG8_WAIT_L(0); PG8_MMA(0, 1, At, B1); PG8_BAR;
            PG8_LDA(At, 0, 1); PG8_STAGE(PG8_SA(0, 0), a2, voffA);
            PG8_BAR; PG8_WAIT_L(0); PG8_MMA(1, 0, At, B0); PG8_BAR; PG8_SCHED;
            PG8_STAGE(PG8_SB(0, 1), b2 + hstepB, voffB);
            PG8_WAIT_V(6); PG8_BAR; PG8_MMA(1, 1, At, B1); PG8_BAR;
            PG8_LDB(B0, 1, 0); PG8_SCHED; PG8_LDA(At, 1, 0); PG8_STAGE(PG8_SA(0, 1), a2 + hstepA, voffA);
            PG8_WAIT_L(8); PG8_BAR; PG8_WAIT_L(0); PG8_MMA(0, 0, At, B0); PG8_BAR; PG8_SCHED;
            PG8_LDB(B1, 1, 1); PG8_STAGE(PG8_SB(1, 0), b3, voffB);
            PG8_BAR; PG8_WAIT_L(0); PG8_MMA(0, 1, At, B1); PG8_BAR;
            PG8_LDA(At, 1, 1); PG8_STAGE(PG8_SA(1, 0), a3, voffA);
            PG8_BAR; PG8_WAIT_L(0); PG8_MMA(1, 0, At, B0); PG8_BAR; PG8_SCHED;
            PG8_STAGE(PG8_SB(1, 1), b3 + hstepB, voffB);
            PG8_WAIT_V(6); PG8_BAR; PG8_MMA(1, 1, At, B1); PG8_BAR;
        }
            if constexpr (!Epi::AFTER_DRAIN) { E(acc, cur, wr, wc, fr, fq); S.done(cur); }
            if (!has_next) break;
#pragma unroll
        for (int a = 0; a < 2; ++a)
#pragma unroll
            for (int b = 0; b < 2; ++b)
#pragma unroll
                for (int m = 0; m < 4; ++m)
#pragma unroll
                    for (int n = 0; n < 2; ++n) acc[a][b][m][n] = (f32x4){0.f, 0.f, 0.f, 0.f};
        cur = nxt; cA = nA; cB = nB; ++ui;
    }
    PG8_WAIT_V(0);
    if (wr == 0) PG8_BAR;
    PG8_BAR;
    if constexpr (Epi::AFTER_DRAIN) { E.fused(acc, cur, wr, wc, fr, fq, lds, wid, lane); S.done(cur); }
#undef PG8_SA
#undef PG8_SB
#undef PG8_STAGE
#undef PG8_LDA
#undef PG8_LDB
#undef PG8_MMA
#undef PG8_WAIT_V
#undef PG8_WAIT_L
#undef PG8_BAR
#undef PG8_SCHED
}
}


namespace attn {
using bf16 = __hip_bfloat16;
constexpr int   D = 128, NW = 8, QBLK = 32, KVBLK = 64;
constexpr float SCALE = 0.088388347648318440f;
constexpr float THR = 8.f;
constexpr int SDEPTH = 1;
constexpr int LDQ = 5120, LDK = 5120, LDO = 2048;
constexpr size_t SHM_V = KVBLK * D * 2, SHM_K = KVBLK * D * 2, SHM_ATTN = 2 * SHM_V + 2 * SHM_K + NW * 64 * 4;
using bf16x8 = __attribute__((ext_vector_type(8))) short;
using s16x4  = __attribute__((ext_vector_type(4))) short;
using f32x16 = __attribute__((ext_vector_type(16))) float;
using f32x8  = __attribute__((ext_vector_type(8))) float;
using u32x4  = __attribute__((ext_vector_type(4))) unsigned;
#define KSWZ(row, colB) ((row) * 256 + ((colB) ^ (((row) & 7) << 4)))
#define SBAR() __builtin_amdgcn_sched_barrier(0)
__device__ __forceinline__ int crow(int r, int hi) { return (r & 3) + 8 * (r >> 2) + 4 * hi; }
__device__ __forceinline__ unsigned cvtpk(float lo, float hi) {
  unsigned r; asm volatile("v_cvt_pk_bf16_f32 %0, %1, %2" : "=v"(r) : "v"(lo), "v"(hi)); return r;
}
template <typename TIn> struct Stage;
template <> struct Stage<bf16>  { using T = bf16x8;
  __device__ static __forceinline__ T ld8(const bf16* p) { return *reinterpret_cast<const bf16x8*>(p); }
  __device__ static __forceinline__ bf16x8 tobf(T x) { return x; } };
template <> struct Stage<float> { using T = f32x8;
  __device__ static __forceinline__ T ld8(const float* p) { return *reinterpret_cast<const f32x8*>(p); }
  __device__ static __forceinline__ bf16x8 tobf(T x) {
    u32x4 w = {cvtpk(x[0], x[1]), cvtpk(x[2], x[3]), cvtpk(x[4], x[5]), cvtpk(x[6], x[7])}; return *reinterpret_cast<bf16x8*>(&w); } };

__device__ __forceinline__ void partialSM(f32x16& p0, f32x16& p1, float& m_reg, float& mn, float& alpha) {
  constexpr float C = SCALE * 1.4426950408889634f;
  float pmax = p0[0]; for (int r = 1; r < 16; ++r) pmax = fmaxf(pmax, p0[r]); for (int r = 0; r < 16; ++r) pmax = fmaxf(pmax, p1[r]);
  { auto rr = __builtin_amdgcn_permlane32_swap(__float_as_uint(pmax), __float_as_uint(pmax), false, false);
    pmax = fmaxf(__uint_as_float(rr[0]), __uint_as_float(rr[1])); }
  if (__builtin_expect(__all(pmax - m_reg <= THR / SCALE), 1)) { mn = m_reg; alpha = 1.f; }
  else { mn = fmaxf(m_reg, pmax); alpha = __builtin_amdgcn_exp2f((m_reg - mn) * C); m_reg = mn; }
  float mnC = -mn * C;
  for (int r = 0; r < 16; ++r) p0[r] = fmaf(p0[r], C, mnC); for (int r = 0; r < 16; ++r) p1[r] = fmaf(p1[r], C, mnC);
  for (int r = 0; r < 16; ++r) p0[r] = __builtin_amdgcn_exp2f(p0[r]);
}
__device__ __forceinline__ void finishSM(f32x16& p0, f32x16& p1, float alpha, float& l_reg, bf16x8& pa0, bf16x8& pa1, bf16x8& pa2, bf16x8& pa3) {
  for (int r = 0; r < 16; ++r) p1[r] = __builtin_amdgcn_exp2f(p1[r]);
  float ps = 0; for (int r = 0; r < 16; ++r) ps += p0[r]; for (int r = 0; r < 16; ++r) ps += p1[r];
  { auto rr = __builtin_amdgcn_permlane32_swap(__float_as_uint(ps), __float_as_uint(ps), false, false);
    ps = __uint_as_float(rr[0]) + __uint_as_float(rr[1]); }
  l_reg = l_reg * alpha + ps;
#define PK4(P, BASE, OUT) do { unsigned a0 = cvtpk(P[BASE + 0], P[BASE + 1]), a1 = cvtpk(P[BASE + 2], P[BASE + 3]);   \
    unsigned b0 = cvtpk(P[BASE + 4], P[BASE + 5]), b1 = cvtpk(P[BASE + 6], P[BASE + 7]);                              \
    auto r0 = __builtin_amdgcn_permlane32_swap(a0, b0, false, false); auto r1 = __builtin_amdgcn_permlane32_swap(a1, b1, false, false); \
    u32x4 w = {r0[0], r1[0], r0[1], r1[1]}; OUT = *reinterpret_cast<bf16x8*>(&w); } while (0)
  PK4(p0, 0, pa0); PK4(p0, 8, pa1); PK4(p1, 0, pa2); PK4(p1, 8, pa3);
#undef PK4
}
__device__ __forceinline__ void qkt(f32x16& p0, f32x16& p1, const bf16* Ks, const bf16x8* qr, int r32, int hi) {
  p0 = f32x16{}; p1 = f32x16{};
  for (int d0 = 0; d0 < 8; ++d0) { int cb = (d0 * 16 + hi * 8) * 2;
    bf16x8 b0 = *reinterpret_cast<const bf16x8*>((const char*)Ks + KSWZ(r32, cb));
    bf16x8 b1 = *reinterpret_cast<const bf16x8*>((const char*)Ks + KSWZ(32 + r32, cb));
    p0 = __builtin_amdgcn_mfma_f32_32x32x16_bf16(b0, qr[d0], p0, 0, 0, 0);
    p1 = __builtin_amdgcn_mfma_f32_32x32x16_bf16(b1, qr[d0], p1, 0, 0, 0); }
}
__device__ __forceinline__ int v_st(int k, int c) { const int kk = (k & ~0xC) | ((k & 4) << 1) | ((k & 8) >> 1); return ((kk >> 3) * 4 + (c >> 5)) * 512 + ((kk & 7) * 32 + (c & 31)) * 2; }
__device__ __forceinline__ int v_rd_base(int lane) { return ((lane & 3) << 3) | (((lane >> 2) & 3) << 6) | (((lane >> 4) & 1) << 5) | (((lane >> 5) & 1) << 8); }
constexpr int v_rd_off(int d0, int ks, int half) { return d0 * 512 + ks * 4096 + half * 2048; }
template <int OFF> __device__ __forceinline__ s16x4 tr_read(int vb) {
  s16x4 r; asm volatile("ds_read_b64_tr_b16 %0, %1 offset:%2" : "=&v"(r) : "v"(vb), "i"(OFF) : "memory"); return r;
}
template <int D0> __device__ __forceinline__ void pv_one(f32x16& od, int vb, bf16x8 pa0, bf16x8 pa1, bf16x8 pa2, bf16x8 pa3) {
  const s16x4 l0 = tr_read<v_rd_off(D0, 0, 0)>(vb), h0 = tr_read<v_rd_off(D0, 0, 1)>(vb), l1 = tr_read<v_rd_off(D0, 1, 0)>(vb), h1 = tr_read<v_rd_off(D0, 1, 1)>(vb);
  const s16x4 l2 = tr_read<v_rd_off(D0, 2, 0)>(vb), h2 = tr_read<v_rd_off(D0, 2, 1)>(vb), l3 = tr_read<v_rd_off(D0, 3, 0)>(vb), h3 = tr_read<v_rd_off(D0, 3, 1)>(vb);
  asm volatile("s_waitcnt lgkmcnt(0)" ::: "memory"); SBAR();
#define PK(L, H) (bf16x8){L[0], L[1], L[2], L[3], H[0], H[1], H[2], H[3]}
  od = __builtin_amdgcn_mfma_f32_32x32x16_bf16(pa0, PK(l0, h0), od, 0, 0, 0);
  od = __builtin_amdgcn_mfma_f32_32x32x16_bf16(pa1, PK(l1, h1), od, 0, 0, 0);
  od = __builtin_amdgcn_mfma_f32_32x32x16_bf16(pa2, PK(l2, h2), od, 0, 0, 0);
  od = __builtin_amdgcn_mfma_f32_32x32x16_bf16(pa3, PK(l3, h3), od, 0, 0, 0);
#undef PK
}
__device__ __forceinline__ void pv_d0(f32x16* o, int vb, bf16x8 pa0, bf16x8 pa1, bf16x8 pa2, bf16x8 pa3) {
  pv_one<0>(o[0], vb, pa0, pa1, pa2, pa3); pv_one<1>(o[1], vb, pa0, pa1, pa2, pa3); pv_one<2>(o[2], vb, pa0, pa1, pa2, pa3); pv_one<3>(o[3], vb, pa0, pa1, pa2, pa3);
}

template <typename TQ>
__device__ __forceinline__ void attn_dense_body(const TQ* __restrict__ Qb, const bf16* __restrict__ Kh, const bf16* __restrict__ Vh,
                                                const unsigned short* __restrict__ Gb, unsigned short* __restrict__ Ob, int seq, char* lds, int koff,
                                                const float* __restrict__ qgain, const float* __restrict__ rcos, const float* __restrict__ rsin, int tpos0) {
  using St = Stage<bf16>; using SQ = Stage<TQ>;
  const int tid = opaque_tid(), wid = tid >> 6, lane = tid & 63, r32 = lane & 31, hi = lane >> 5;
  bf16* V_lds = (bf16*)lds; bf16* K_lds = (bf16*)(lds + 2 * SHM_V);
  float* ws = (float*)(lds + 2 * SHM_V + 2 * SHM_K) + wid * 64; float* li_l = ws; float* al_l = ws + 32;
  float m_reg = -1e30f, l_reg = 0; f32x16 o[4] = {}; bf16x8 qr[8];
  const TQ* Qw = Qb + (long)(wid * QBLK + r32) * LDQ + hi * 8;
#pragma unroll
  for (int d0 = 0; d0 < 8; ++d0) qr[d0] = SQ::tobf(SQ::ld8(Qw + d0 * 16));
  {
    float ss = 0.f;
#pragma unroll
    for (int d0 = 0; d0 < 8; ++d0) { const u32x4 w = *reinterpret_cast<const u32x4*>(&qr[d0]);
      const float a0 = __uint_as_float(w.x << 16), a1 = __uint_as_float(w.x & 0xffff0000u), a2 = __uint_as_float(w.y << 16), a3 = __uint_as_float(w.y & 0xffff0000u);
      const float a4 = __uint_as_float(w.z << 16), a5 = __uint_as_float(w.z & 0xffff0000u), a6 = __uint_as_float(w.w << 16), a7 = __uint_as_float(w.w & 0xffff0000u);
      ss += (a0 * a0 + a1 * a1) + (a2 * a2 + a3 * a3) + (a4 * a4 + a5 * a5) + (a6 * a6 + a7 * a7); }
    ss += __shfl_xor(ss, 32);
    const float rstd = __builtin_amdgcn_rsqf(ss * (1.f / 128.f) + 1e-6f);
    const int tp = tpos0 + wid * QBLK + r32; const float* cp = rcos + (long)tp * 64 + hi * 4; const float* sp = rsin + (long)tp * 64 + hi * 4; const float* gp = qgain + hi * 8;
#pragma unroll
    for (int d0 = 0; d0 < 8; ++d0) { const u32x4 w = *reinterpret_cast<const u32x4*>(&qr[d0]);
      const float4 g0 = *reinterpret_cast<const float4*>(gp + d0 * 16), g1 = *reinterpret_cast<const float4*>(gp + d0 * 16 + 4), c4 = *reinterpret_cast<const float4*>(cp + d0 * 8), s4 = *reinterpret_cast<const float4*>(sp + d0 * 8);
      const float y0 = __uint_as_float(w.x << 16) * rstd * g0.x, y1 = __uint_as_float(w.x & 0xffff0000u) * rstd * g0.y, y2 = __uint_as_float(w.y << 16) * rstd * g0.z, y3 = __uint_as_float(w.y & 0xffff0000u) * rstd * g0.w;
      const float y4 = __uint_as_float(w.z << 16) * rstd * g1.x, y5 = __uint_as_float(w.z & 0xffff0000u) * rstd * g1.y, y6 = __uint_as_float(w.w << 16) * rstd * g1.z, y7 = __uint_as_float(w.w & 0xffff0000u) * rstd * g1.w;
      u32x4 o = {cvtpk(y0 * c4.x - y1 * s4.x, y0 * s4.x + y1 * c4.x), cvtpk(y2 * c4.y - y3 * s4.y, y2 * s4.y + y3 * c4.y), cvtpk(y4 * c4.z - y5 * s4.z, y4 * s4.z + y5 * c4.z), cvtpk(y6 * c4.w - y7 * s4.w, y6 * s4.w + y7 * c4.w)};
      qr[d0] = *reinterpret_cast<bf16x8*>(&o); }
  }
  const int sr = tid >> 4, sc = (tid & 15) * 8, vst0 = v_st(sr, sc), vst1 = v_st(32 + sr, sc);
  const int vb0 = (int)(uintptr_t)V_lds + v_rd_base(lane);
  struct { typename St::T vs0, vs1, ks0, ks1; } sr_[SDEPTH];
#define SLOAD(i, k0) do { const int kk_ = ((k0) + koff) & (seq - 1); sr_[i].vs0 = St::ld8(&Vh[(long)(kk_ + sr) * LDK + sc]); sr_[i].vs1 = St::ld8(&Vh[(long)(kk_ + 32 + sr) * LDK + sc]); \
    sr_[i].ks0 = St::ld8(&Kh[(long)(kk_ + sr) * LDK + sc]); sr_[i].ks1 = St::ld8(&Kh[(long)(kk_ + 32 + sr) * LDK + sc]); } while (0)
#define SWRITE(b, i) do { *(bf16x8*)((char*)V_lds + (b) * SHM_V + vst0) = St::tobf(sr_[i].vs0);          \
    *(bf16x8*)((char*)V_lds + (b) * SHM_V + vst1) = St::tobf(sr_[i].vs1); int kc = sc * 2;               \
    *(bf16x8*)((char*)K_lds + (b) * SHM_K + KSWZ(sr, kc)) = St::tobf(sr_[i].ks0);                       \
    *(bf16x8*)((char*)K_lds + (b) * SHM_K + KSWZ(32 + sr, kc)) = St::tobf(sr_[i].ks1); } while (0)
#define SWAIT() do { if constexpr (SDEPTH == 2) asm volatile("s_waitcnt vmcnt(4)" ::: "memory"); else asm volatile("s_waitcnt vmcnt(0)" ::: "memory"); } while (0)
#define RESC(a) do { if (__any((a) < 1.f)) { if (hi == 0) al_l[r32] = (a); asm volatile("s_waitcnt lgkmcnt(0)" ::: "memory"); \
    for (int d = 0; d < 4; ++d) for (int r = 0; r < 16; ++r) o[d][r] *= al_l[crow(r, hi)]; } } while (0)
  f32x16 pA0, pA1, pB0, pB1; float mnA, mnB, alA, alB; bf16x8 pa0, pa1, pa2, pa3; const int NT = seq / KVBLK;
  constexpr int SE = 0, SO = SDEPTH - 1;
  SLOAD(SE, 0); asm volatile("s_waitcnt vmcnt(0)" ::: "memory"); SWRITE(0, SE); __syncthreads();
  qkt(pA0, pA1, K_lds, qr, r32, hi); partialSM(pA0, pA1, m_reg, mnA, alA);
  SLOAD(SO, KVBLK); if constexpr (SDEPTH == 2) { if (2 < NT) SLOAD(SE, 2 * KVBLK); }
  SWAIT(); SWRITE(1, SO); __syncthreads();
  for (int j = 1; j + 1 < NT; j += 2) {
    SBAR(); qkt(pB0, pB1, (bf16*)((char*)K_lds + SHM_K), qr, r32, hi);
    finishSM(pA0, pA1, alA, l_reg, pa0, pa1, pa2, pa3); SBAR();
    SLOAD(SO, (j + SDEPTH) * KVBLK); SBAR();
    pv_d0(o, vb0, pa0, pa1, pa2, pa3); partialSM(pB0, pB1, m_reg, mnB, alB);
    __syncthreads(); SWAIT(); SWRITE(0, SE);
    RESC(alB); __syncthreads();
    SBAR(); qkt(pA0, pA1, K_lds, qr, r32, hi);
    finishSM(pB0, pB1, alB, l_reg, pa0, pa1, pa2, pa3); SBAR();
    if (SDEPTH == 1 || j + 3 < NT) SLOAD(SE, (j + 1 + SDEPTH) * KVBLK); SBAR();
    pv_d0(o, vb0 + (int)SHM_V, pa0, pa1, pa2, pa3); partialSM(pA0, pA1, m_reg, mnA, alA);
    __syncthreads(); SWAIT(); SWRITE(1, SO);
    RESC(alA); __syncthreads();
  }
  SBAR(); qkt(pB0, pB1, (bf16*)((char*)K_lds + SHM_K), qr, r32, hi);
  finishSM(pA0, pA1, alA, l_reg, pa0, pa1, pa2, pa3); SBAR();
  pv_d0(o, vb0, pa0, pa1, pa2, pa3); partialSM(pB0, pB1, m_reg, mnB, alB);
  __syncthreads(); RESC(alB);
  finishSM(pB0, pB1, alB, l_reg, pa0, pa1, pa2, pa3); SBAR();
  pv_d0(o, vb0 + (int)SHM_V, pa0, pa1, pa2, pa3);
  if (hi == 0) li_l[r32] = l_reg; asm volatile("s_waitcnt lgkmcnt(0)" ::: "memory");
  float rli[16];
#pragma unroll
  for (int r = 0; r < 16; ++r) rli[r] = __builtin_amdgcn_rcpf(li_l[crow(r, hi)]);
  unsigned short* Ow = Ob + (long)(wid * QBLK) * LDO + r32; const unsigned short* Gw = Gb + (long)(wid * QBLK) * LDQ + r32;
  unsigned short gq[16][4];
#pragma unroll
  for (int r = 0; r < 16; ++r) { const unsigned short* gp = Gw + (long)crow(r, hi) * LDQ;
#pragma unroll
    for (int d0 = 0; d0 < 4; ++d0) gq[r][d0] = gp[d0 * 32]; }
#pragma unroll
  for (int r = 0; r < 16; ++r) { unsigned short* op = Ow + (long)crow(r, hi) * LDO;
#pragma unroll
    for (int d0 = 0; d0 < 4; ++d0) { const float gv = __uint_as_float(((unsigned)gq[r][d0]) << 16);
      const float sg = gv * __builtin_amdgcn_rcpf(1.f + __builtin_amdgcn_exp2f(-1.4426950408889634f * gv));
      const float val = o[d0][r] * rli[r] * sg; unsigned u = __float_as_uint(val); u += 0x7fffu + ((u >> 16) & 1u);
      op[d0 * 32] = (unsigned short)(u >> 16); } }
#undef SLOAD
#undef SWRITE
#undef SWAIT
#undef RESC
}
}

struct Args {
    const float *x, *c, *w_mod, *b_mod, *pool_w_in, *pool_w_grp, *pool_scale, *pool_w_out;
    const float *gla_w_in, *gla_fwd_w1, *gla_fwd_w2, *gla_fwd_b, *gla_bwd_w1, *gla_bwd_w2, *gla_bwd_b, *gla_norm_g, *gla_w_out;
    const float *attn_w_in, *attn_qg, *attn_kg, *attn_w_out, *final_g;
    float* out; unsigned char* ws;
};
#define LDS_WAIT() asm volatile("s_waitcnt lgkmcnt(0)" ::: "memory")

__device__ __forceinline__ void transpose_item(const float* W, int K, int N, bf16_t* WT, int row_off, LAS float* scr, int item, int lane, int ldw = 0) {
    const int nblk = N / 32, kb = item / nblk, nb = item % nblk, k0 = 64 * kb, n0 = 32 * nb; if (ldw == 0) ldw = N;
    float wv[32];
#pragma unroll
    for (int i = 0; i < 32; ++i) wv[i] = W[(size_t)(k0 + 2 * i + (lane >> 5)) * ldw + n0 + (lane & 31)];
#pragma unroll
    for (int i = 0; i < 32; ++i) scr[(2 * i + (lane >> 5)) * 33 + (lane & 31)] = wv[i];
    LDS_WAIT();
    const int c = lane & 7;
#pragma unroll
    for (int j = 0; j < 4; ++j) { const int n = (lane >> 3) + 8 * j; const LAS float* s = scr + (8 * c) * 33 + n;
        u32x4 o; o.x = cvt_pk_bf16(s[0 * 33], s[1 * 33]); o.y = cvt_pk_bf16(s[2 * 33], s[3 * 33]); o.z = cvt_pk_bf16(s[4 * 33], s[5 * 33]); o.w = cvt_pk_bf16(s[6 * 33], s[7 * 33]);
        *(u32x4*)(WT + (size_t)(row_off + n0 + n) * K + k0 + 8 * c) = o; }
    LDS_WAIT();
}
__device__ __forceinline__ void phase_weights(const Args& a, int L, LAS unsigned char* lds) {
    const int tid_ = opaque_tid(), lane = tid_ & 63, wave = __builtin_amdgcn_readfirstlane(tid_ >> 6), gw = blockIdx.x * 8 + wave, NGW = gridDim.x * 8; (void)wave; (void)gw; (void)NGW; (void)lane;
    LAS float* scr = (LAS float*)(lds + wave * 8704);
    bf16_t* WB = (bf16_t*)(a.ws + WS_WB); bf16_t* WBG = (bf16_t*)(a.ws + WS_WB + 16 * MiB); bf16_t* WBO = (bf16_t*)(a.ws + WS_WB + 24 * MiB);
    const int kind = L % 3, j = L / 3;
    if (kind == 0) {
        const float* win = a.pool_w_in + (size_t)j * 2048 * 4096; const float* wgrp = a.pool_w_grp + (size_t)j * 4 * 512 * 512; const float* wout = a.pool_w_out + (size_t)j * 2048 * 2048;
        constexpr int I_IN = 32 * 64, I_G = 8 * 16, I_OUT = 32 * 64;
        { bf16_t* WBU = (bf16_t*)(a.ws + WS_QKK + 300 * MiB);
#pragma clang loop unroll(disable)
          for (int base = gw * 64; base < 2048 * 256; base += NGW * 64) { const int i = base + lane, k = i >> 8, c8 = (i & 255) * 8;
              const f32x4 v0 = *(const f32x4*)(win + (size_t)k * 4096 + c8), v1 = *(const f32x4*)(win + (size_t)k * 4096 + c8 + 4);
              u32x4 o; o.x = cvt_pk_bf16(v0[0], v0[1]); o.y = cvt_pk_bf16(v0[2], v0[3]); o.z = cvt_pk_bf16(v1[0], v1[1]); o.w = cvt_pk_bf16(v1[2], v1[3]);
              *(u32x4*)(WBU + (size_t)k * 2048 + c8) = o; } }
        for (int it = gw; it < I_IN + 4 * I_G + I_OUT; it += NGW) {
            int r = it;
            if (r < I_IN) { transpose_item(win + 2048, 2048, 2048, WB, 2048, scr, r, lane, 4096); continue; } r -= I_IN;
            if (r < 4 * I_G) { const int g = r / I_G; transpose_item(wgrp + (size_t)g * 512 * 512, 512, 512, WBG, g * 512, scr, r % I_G, lane); continue; } r -= 4 * I_G;
            transpose_item(wout, 2048, 2048, WBO, 0, scr, r, lane);
        }
    } else if (kind == 1) {
        constexpr int I_IN = 32 * 192, I_OUT = 32 * 64;
        for (int it = gw; it < I_IN + I_OUT; it += NGW) {
            int r = it;
            if (r < I_IN) { transpose_item(a.gla_w_in, 2048, 6144, WB, 0, scr, r, lane); continue; } r -= I_IN;
            transpose_item(a.gla_w_out, 2048, 2048, WBO, 0, scr, r, lane);
        }
        bf16_t* W1T = (bf16_t*)(a.ws + WS_W1T);
#pragma clang loop unroll(disable)
        for (int base = gw * 64; base < 32 * 2048; base += NGW * 64) { const int i = base + lane, n = i >> 11, k = i & 2047;
            W1T[i] = f2bf(n < 16 ? a.gla_fwd_w1[k * 16 + n] : a.gla_bwd_w1[k * 16 + n - 16]); }
    } else {
        constexpr int I_IN = 32 * 160, I_OUT = 32 * 64;
        for (int it = gw; it < I_IN + I_OUT; it += NGW) {
            int r = it;
            if (r < I_IN) { transpose_item(a.attn_w_in, 2048, 5120, WB, 0, scr, r, lane); continue; } r -= I_IN;
            transpose_item(a.attn_w_out, 2048, 2048, WBO, 0, scr, r, lane);
        }
    }
}
#define ROWS2_LOAD(V, xp, mm) do { _Pragma("unroll") for (int r_ = 0; r_ < 2; ++r_) { const f32x4* xr_ = (const f32x4*)((xp) + (size_t)((mm) + r_ * NGW) * DM) + lane; \
        _Pragma("unroll") for (int j_ = 0; j_ < 8; ++j_) V[r_][j_] = xr_[64 * j_]; } } while (0)
#define ROWS2_SS(V, s) do { _Pragma("unroll") for (int r_ = 0; r_ < 2; ++r_) { float t_ = 0.f; \
        _Pragma("unroll") for (int j_ = 0; j_ < 8; ++j_) t_ += (V[r_][j_].x * V[r_][j_].x + V[r_][j_].y * V[r_][j_].y) + (V[r_][j_].z * V[r_][j_].z + V[r_][j_].w * V[r_][j_].w); s[r_] = t_; } } while (0)
#define ROWS2C_LOAD(V, xp, mm) do { _Pragma("unroll") for (int r_ = 0; r_ < 2; ++r_) { const f32x4* xr_ = (const f32x4*)((xp) + (size_t)((mm) + r_) * DM) + lane; \
        _Pragma("unroll") for (int j_ = 0; j_ < 8; ++j_) V[r_][j_] = xr_[64 * j_]; } } while (0)
__device__ __forceinline__ void phase_norm_mod(const float* x, const float* modL, bf16_t* hb) {
    const int tid_ = opaque_tid(), lane = tid_ & 63, wave = __builtin_amdgcn_readfirstlane(tid_ >> 6), gw = blockIdx.x * 8 + wave, NGW = gridDim.x * 8;
#define NM_PROC(V, mm) do { float s_[2]; ROWS2_SS(V, s_); \
        _Pragma("unroll") for (int r = 0; r < 2; ++r) { const int mr = (mm) + r; const float rstd = __builtin_amdgcn_rsqf(wave_sum(s_[r]) * (1.f / DM) + NEPS); \
            u32x2* o8 = (u32x2*)(hb + (size_t)mr * DM) + lane; \
            _Pragma("unroll") for (int j = 0; j < 8; ++j) { const f32x4 h = V[r][j] * rstd * sc1[j] + sh[j]; u32x2 w; w.x = cvt_pk_bf16(h.x, h.y); w.y = cvt_pk_bf16(h.z, h.w); o8[64 * j] = w; } } } while (0)
    for (int g16 = gw; g16 < MTOK / 16; g16 += NGW) {
        const int m0 = g16 * 16; const float* mp = modL + (size_t)(m0 / SEQ) * 6144;
        f32x4 va[2][8], vb[2][8], sh[8], sc1[8];
        ROWS2C_LOAD(va, x, m0);
#pragma unroll
        for (int j = 0; j < 8; ++j) { sh[j] = *((const f32x4*)mp + lane + 64 * j); sc1[j] = *((const f32x4*)(mp + 2048) + lane + 64 * j) + 1.f; }
#pragma unroll 1
        for (int i = 0; i < 16; i += 4) {
            ROWS2C_LOAD(vb, x, m0 + i + 2);
            NM_PROC(va, m0 + i);
            if (i + 4 < 16) ROWS2C_LOAD(va, x, m0 + i + 4);
            NM_PROC(vb, m0 + i + 2);
        }
    }
#undef NM_PROC
}
__device__ __forceinline__ void phase_norm_mod_bf(const bf16_t* xb, const float* modL, bf16_t* hb) {
    const int tid_ = opaque_tid(), lane = tid_ & 63, wave = __builtin_amdgcn_readfirstlane(tid_ >> 6), gw = blockIdx.x * 8 + wave, NGW = gridDim.x * 8;
    for (int g16 = gw; g16 < MTOK / 16; g16 += NGW) {
        const int m0 = g16 * 16; const float* mp = modL + (size_t)(m0 / SEQ) * 6144;
        u32x4 va[2][4], vb[2][4]; f32x4 sh[4][2], sc1[4][2];
#define NB_LOAD(V, mm) do { _Pragma("unroll") for (int r_ = 0; r_ < 2; ++r_) { const u32x4* xr_ = (const u32x4*)(xb + (size_t)((mm) + r_) * DM) + lane; \
        _Pragma("unroll") for (int j_ = 0; j_ < 4; ++j_) V[r_][j_] = xr_[64 * j_]; } } while (0)
#define NB_PROC(V, mm) do { _Pragma("unroll") for (int r = 0; r < 2; ++r) { float f[4][8]; float s = 0.f; \
        _Pragma("unroll") for (int j = 0; j < 4; ++j) { const u32x4 w = V[r][j]; f[j][0] = bf_lo(w.x); f[j][1] = bf_hi(w.x); f[j][2] = bf_lo(w.y); f[j][3] = bf_hi(w.y); f[j][4] = bf_lo(w.z); f[j][5] = bf_hi(w.z); f[j][6] = bf_lo(w.w); f[j][7] = bf_hi(w.w); \
            _Pragma("unroll") for (int q = 0; q < 8; ++q) s += f[j][q] * f[j][q]; } \
        const float rstd = __builtin_amdgcn_rsqf(wave_sum(s) * (1.f / DM) + NEPS); u32x4* o16 = (u32x4*)(hb + (size_t)((mm) + r) * DM) + lane; \
        _Pragma("unroll") for (int j = 0; j < 4; ++j) { u32x4 w; \
            w.x = cvt_pk_bf16(f[j][0] * rstd * sc1[j][0][0] + sh[j][0][0], f[j][1] * rstd * sc1[j][0][1] + sh[j][0][1]); w.y = cvt_pk_bf16(f[j][2] * rstd * sc1[j][0][2] + sh[j][0][2], f[j][3] * rstd * sc1[j][0][3] + sh[j][0][3]); \
            w.z = cvt_pk_bf16(f[j][4] * rstd * sc1[j][1][0] + sh[j][1][0], f[j][5] * rstd * sc1[j][1][1] + sh[j][1][1]); w.w = cvt_pk_bf16(f[j][6] * rstd * sc1[j][1][2] + sh[j][1][2], f[j][7] * rstd * sc1[j][1][3] + sh[j][1][3]); \
            o16[64 * j] = w; } } } while (0)
        NB_LOAD(va, m0);
#pragma unroll
        for (int j = 0; j < 4; ++j)
#pragma unroll
            for (int q = 0; q < 2; ++q) { sh[j][q] = *(const f32x4*)(mp + (lane + 64 * j) * 8 + 4 * q); sc1[j][q] = *(const f32x4*)(mp + 2048 + (lane + 64 * j) * 8 + 4 * q) + 1.f; }
#pragma unroll 1
        for (int i = 0; i < 16; i += 4) {
            NB_LOAD(vb, m0 + i + 2);
            NB_PROC(va, m0 + i);
            if (i + 4 < 16) NB_LOAD(va, m0 + i + 4);
            NB_PROC(vb, m0 + i + 2);
        }
#undef NB_LOAD
#undef NB_PROC
    }
}
__device__ __forceinline__ void phase_final_norm(const float* x, const float* g, float* outp) {
    const int tid_ = opaque_tid(), lane = tid_ & 63, wave = __builtin_amdgcn_readfirstlane(tid_ >> 6), gw = blockIdx.x * 8 + wave, NGW = gridDim.x * 8;
    f32x4 gg[8];
#pragma unroll
    for (int j = 0; j < 8; ++j) gg[j] = *((const f32x4*)g + lane + 64 * j);
#define FN_PROC(V, mm) do { float s_[2]; ROWS2_SS(V, s_); \
        _Pragma("unroll") for (int r = 0; r < 2; ++r) { f32x4* xr = (f32x4*)(outp + (size_t)((mm) + r) * DM) + lane; const float rstd = __builtin_amdgcn_rsqf(wave_sum(s_[r]) * (1.f / DM) + NEPS); \
            _Pragma("unroll") for (int j = 0; j < 8; ++j) xr[64 * j] = V[r][j] * rstd * gg[j]; } } while (0)
    for (int g16 = gw; g16 < MTOK / 16; g16 += NGW) {
        const int m0 = g16 * 16;
        f32x4 va[2][8], vb[2][8];
        ROWS2C_LOAD(va, x, m0);
#pragma unroll 1
        for (int i = 0; i < 16; i += 4) {
            ROWS2C_LOAD(vb, x, m0 + i + 2);
            FN_PROC(va, m0 + i);
            if (i + 4 < 16) ROWS2C_LOAD(va, x, m0 + i + 4);
            FN_PROC(vb, m0 + i + 2);
        }
    }
#undef FN_PROC
}
__device__ __forceinline__ void phase_mod(const Args& a, LAS unsigned char* lds, float* mod) {
    LAS float* sc = (LAS float*)lds; LAS float* part = (LAS float*)(lds + 32768);
    const int tid = opaque_tid();
    if ((int)blockIdx.x >= 192) return;
    for (int i = tid; i < 8192; i += 512) sc[i] = silu_f(a.c[i]);
    __syncthreads();
    for (int item = blockIdx.x; item < 192; item += gridDim.x) {
        const int layer = item / 48, n0 = (item % 48) * 128, ks = tid >> 5, cq = tid & 31;
        f32x4 acc[4];
#pragma unroll
        for (int b = 0; b < 4; ++b) acc[b] = (f32x4){0.f, 0.f, 0.f, 0.f};
        const float* wp = a.w_mod + ((size_t)layer * 2048 + ks * 128) * 6144 + n0 + cq * 4;
#pragma unroll 16
        for (int k = 0; k < 128; ++k) { const f32x4 w = *(const f32x4*)(wp + (size_t)k * 6144); const int kk = ks * 128 + k;
#pragma unroll
            for (int b = 0; b < 4; ++b) acc[b] += w * sc[b * 2048 + kk]; }
#pragma unroll
        for (int b = 0; b < 4; ++b) *(LAS f32x4*)(part + (ks * 4 + b) * 128 + cq * 4) = acc[b];
        __syncthreads();
        { const int b = tid >> 7, col = tid & 127; float s = a.b_mod[layer * 6144 + n0 + col];
#pragma unroll
          for (int q = 0; q < 16; ++q) s += part[(q * 4 + b) * 128 + col];
          mod[(size_t)(layer * 4 + b) * 6144 + n0 + col] = s; }
        __syncthreads();
    }
}
__device__ __forceinline__ void phase_rope_table(float* rc, float* rs) {
#pragma clang loop unroll(disable)
    for (int idx = blockIdx.x * 512 + opaque_tid(); idx < SEQ * 64; idx += gridDim.x * 512) {
        const int t = idx >> 6, i = idx & 63;
        const float pos = (i < 32) ? (float)((t >> 6) - 64) : (float)((t & 63) - 32);
        const float inv = __builtin_amdgcn_exp2f(-(float)(i & 31) * 0.41524101186092029f);
        const float ang = pos * inv;
        const double xd = (double)ang; const double n = __builtin_rint(xd * 0.63661977236758134); const float rf = (float)(xd - n * 1.5707963267948966);
        const int q = ((int)n) & 3; const float r2 = rf * rf;
        const float sn = rf + rf * r2 * (-1.6666667e-1f + r2 * (8.3333333e-3f + r2 * (-1.9841270e-4f + r2 * 2.7557319e-6f)));
        const float cs = 1.f + r2 * (-0.5f + r2 * (4.1666667e-2f + r2 * (-1.3888889e-3f + r2 * (2.4801587e-5f + r2 * -2.7557319e-7f))));
        const float co = (q == 0) ? cs : (q == 1) ? -sn : (q == 2) ? -cs : sn;
        const float si = (q == 0) ? sn : (q == 1) ? cs : (q == 2) ? -sn : -cs;
        rc[idx] = co; rs[idx] = si;
    }
}
__device__ __forceinline__ void acc8(float (&s)[8], const u32x4 w, const float f) {
    s[0] += f * bf_lo(w.x); s[1] += f * bf_hi(w.x); s[2] += f * bf_lo(w.y); s[3] += f * bf_hi(w.y); s[4] += f * bf_lo(w.z); s[5] += f * bf_hi(w.z); s[6] += f * bf_lo(w.w); s[7] += f * bf_hi(w.w); }
__device__ __forceinline__ void phase_pool(const bf16_t* proj  , bf16_t* yout, const float* scale) {
    const int tid_ = opaque_tid(), lane = tid_ & 63, wave = __builtin_amdgcn_readfirstlane(tid_ >> 6), gw = blockIdx.x * 8 + wave, NGW = gridDim.x * 8;
    for (int unit = gw; unit < (MTOK / 64) * 4; unit += NGW) {
        const int run = unit >> 2, j = unit & 3, half = 1 << j, m0 = run * 64, t0 = m0 & (SEQ - 1), c = (j * 64 + lane) * 8;
        const bf16_t* base = proj + (size_t)(m0 - t0) * 4096 + c; bf16_t* outp = yout + (size_t)(m0 - t0) * 2048 + c;
        const f32x4 sc0 = *(const f32x4*)(scale + c), sc1 = *(const f32x4*)(scale + c + 4);
        float S[8];
#pragma unroll
        for (int q = 0; q < 8; ++q) S[q] = 0.f;
        { u32x4 wi[16]; float fi[16];
#pragma unroll
          for (int q = 0; q < 16; ++q) { const int r = t0 - half + q, rc2 = r < 0 ? 0 : (r >= SEQ ? SEQ - 1 : r); fi[q] = (q < 2 * half && r >= 0 && r < SEQ) ? 1.f : 0.f; wi[q] = *(const u32x4*)(base + (size_t)rc2 * 4096); }
#pragma unroll
          for (int q = 0; q < 16; ++q) acc8(S, wi[q], fi[q]); }
#pragma unroll 8
        for (int tt = 0; tt < 64; ++tt) {
            const int t = t0 + tt, lo = (t - half) > 0 ? (t - half) : 0, hi = (t + half) < SEQ ? (t + half) : SEQ;
            const int ra = (t + half) < SEQ ? (t + half) : (SEQ - 1), rs = (t - half) > 0 ? (t - half) : 0;
            const float fa = (t + half) < SEQ ? 1.f : 0.f, fs = (t - half) >= 0 ? -1.f : 0.f;
            const u32x4 u = *(const u32x4*)(base + (size_t)t * 4096), wa = *(const u32x4*)(base + (size_t)ra * 4096), ws = *(const u32x4*)(base + (size_t)rs * 4096), g = *(const u32x4*)(base + (size_t)t * 4096 + 2048);
            const float ic = 1.f / (float)(hi - lo);
            u32x4 o; o.x = cvt_pk_bf16((S[0] * ic - bf_lo(u.x)) * sc0[0] * silu_f(bf_lo(g.x)), (S[1] * ic - bf_hi(u.x)) * sc0[1] * silu_f(bf_hi(g.x)));
            o.y = cvt_pk_bf16((S[2] * ic - bf_lo(u.y)) * sc0[2] * silu_f(bf_lo(g.y)), (S[3] * ic - bf_hi(u.y)) * sc0[3] * silu_f(bf_hi(g.y)));
            o.z = cvt_pk_bf16((S[4] * ic - bf_lo(u.z)) * sc1[0] * silu_f(bf_lo(g.z)), (S[5] * ic - bf_hi(u.z)) * sc1[1] * silu_f(bf_hi(g.z)));
            o.w = cvt_pk_bf16((S[6] * ic - bf_lo(u.w)) * sc1[2] * silu_f(bf_lo(g.w)), (S[7] * ic - bf_hi(u.w)) * sc1[3] * silu_f(bf_hi(g.w)));
            *(u32x4*)(outp + (size_t)t * 2048) = o;
            acc8(S, wa, fa); acc8(S, ws, fs);
        }
    }
}
__device__ __forceinline__ void phase_knorm_rope(bf16_t* proj, const float* kg, const float* rc, const float* rs) {
    const int tid_ = opaque_tid(), lane = tid_ & 63, wave = __builtin_amdgcn_readfirstlane(tid_ >> 6), gw = blockIdx.x * 8 + wave, NGW = gridDim.x * 8;
    const float k0 = kg[2 * lane], k1 = kg[2 * lane + 1];
    for (int m = gw; m < MTOK; m += 2 * NGW) {
        unsigned w[2][4]; float co[2], si[2];
#pragma unroll
        for (int r = 0; r < 2; ++r) { const int mm = m + r * NGW, t = mm & (SEQ - 1); co[r] = rc[t * 64 + lane]; si[r] = rs[t * 64 + lane];
            const unsigned* row = (const unsigned*)(proj + (size_t)mm * 5120 + 2048) + lane;
#pragma unroll
            for (int h = 0; h < 4; ++h) w[r][h] = row[h * 64]; }
#pragma unroll
        for (int r = 0; r < 2; ++r) { unsigned* row = (unsigned*)(proj + (size_t)(m + r * NGW) * 5120 + 2048) + lane;
#pragma unroll
            for (int h = 0; h < 4; ++h) {
                const float x0 = bf_lo(w[r][h]), x1 = bf_hi(w[r][h]);
                const float rstd = __builtin_amdgcn_rsqf(wave_sum(x0 * x0 + x1 * x1) * (1.f / 128.f) + NEPS);
                const float y0 = x0 * rstd * k0, y1 = x1 * rstd * k1;
                row[h * 64] = cvt_pk_bf16(y0 * co[r] - y1 * si[r], y0 * si[r] + y1 * co[r]);
            } }
    }
}

__device__ __forceinline__ f32x4 mfma16(bf16x8 x, bf16x8 y, f32x4 acc) { return __builtin_amdgcn_mfma_f32_16x16x32_bf16(x, y, acc, 0, 0, 0); }

__device__ __forceinline__ void phase_gla_lowrank(const bf16_t* hb, const bf16_t* w1t, float* R, LAS unsigned char* lds) {
    const int tid_ = opaque_tid(), lane = tid_ & 63, wave = __builtin_amdgcn_readfirstlane(tid_ >> 6), gw = blockIdx.x * 8 + wave, NGW = gridDim.x * 8;
    const int fr = lane & 15, fq = lane >> 4;
    for (int i = tid_; i < 32 * 256; i += 512) { const int n = i >> 8, c16 = i & 255; *(LAS u32x4*)(lds + n * 4112 + c16 * 16) = *(const u32x4*)(w1t + n * 2048 + c16 * 8); }
    __syncthreads();
    const LAS unsigned char* wl = lds + fr * 4112 + fq * 16;
    for (int u = gw; u < MTOK / 16; u += NGW) {
        const bf16_t* ap = hb + (size_t)(u * 16 + fr) * 2048 + fq * 8;
        f32x4 acc0 = (f32x4){0.f, 0.f, 0.f, 0.f}, acc1 = acc0;
#pragma unroll 16
        for (int ks = 0; ks < 64; ++ks) { const bf16x8 av = *(const bf16x8*)(ap + ks * 32);
            acc0 = mfma16(*(const LAS bf16x8*)(wl + ks * 64), av, acc0); acc1 = mfma16(*(const LAS bf16x8*)(wl + 16 * 4112 + ks * 64), av, acc1); }
        float* rp = R + (size_t)(u * 16 + fr) * 32 + 4 * fq;
        *(f32x4*)rp = acc0; *(f32x4*)(rp + 16) = acc1;
    }
    __syncthreads();
}
__device__ __forceinline__ bf16_t f2bf1(float v) { return (bf16_t)(cvt_pk_bf16(v, 0.f) & 0xffffu); }
constexpr int G1_QI = 8192, G1_KI = G1_QI + 32768, G1_QT = G1_KI + 32768, G1_KT = G1_QT + 64 * 528, G1_TOT = G1_KT + 64 * 528, G1_END = G1_TOT + 2048;
__device__ __forceinline__ bf16x8 frag(const LAS unsigned char* base, int pitch, int row, int ks, int fq) { return *(const LAS bf16x8*)(base + row * pitch + ks * 64 + fq * 16); }
template <int dir> __device__ __forceinline__ void gla_prep_dir(const Args& a, LAS unsigned char* lds, const int tid, const int b, const int cc, const int h, const size_t tok0) {
    const LAS float* rl = (const LAS float*)lds; const LAS bf16_t* qi = (const LAS bf16_t*)(lds + G1_QI); const LAS bf16_t* ki = (const LAS bf16_t*)(lds + G1_KI);
    LAS float* tot = (LAS float*)(lds + G1_TOT); LAS float* bl = tot + 256;
    const int d = tid & 255, half = __builtin_amdgcn_readfirstlane(tid >> 8), col = h * 256 + d;
    const int wave = __builtin_amdgcn_readfirstlane(tid >> 6), lane = tid & 63, fr = lane & 15, fq = lane >> 4;
    const float* w2 = dir ? a.gla_bwd_w2 : a.gla_fwd_w2; const float* bs = dir ? a.gla_bwd_b : a.gla_fwd_b;
    float w2c[16];
#pragma unroll
    for (int c = 0; c < 16; ++c) w2c[c] = w2[c * 1024 + col];
    const float bias = bs[col];
    float eb[32]; float run = 0.f;
#pragma unroll
    for (int i = 0; i < 32; ++i) { const int pi = half * 32 + i, t = dir ? 63 - pi : pi; float z = bias;
#pragma unroll
        for (int c4 = 0; c4 < 4; ++c4) { const f32x4 rv = *(const LAS f32x4*)(rl + t * 32 + dir * 16 + c4 * 4);
            z += rv.x * w2c[c4 * 4] + rv.y * w2c[c4 * 4 + 1] + rv.z * w2c[c4 * 4 + 2] + rv.w * w2c[c4 * 4 + 3]; }
        const float ls = fminf(z, 0.f) - __logf(1.f + __expf(-fabsf(z)));
        run += ls * 0.0625f; eb[i] = run; if ((i & 3) == 3) asm volatile("" ::: "memory"); }
    if (half == 0) tot[d] = run;
    __syncthreads();
    const float add = half ? tot[d] : 0.f;
    if (half == 1) bl[d] = run + add;
    __syncthreads();
    const float ebl = __expf(bl[d]);
    bf16_t* khp = (bf16_t*)(a.ws + WS_QKK + 256 * MiB) + ((((size_t)dir * 4 + b) * 128 + cc) * 4 + h) * (256 * 64) + (size_t)d * 64;
#pragma unroll
    for (int gi = 0; gi < 4; ++gi) {
        float kh[8];
#pragma unroll
        for (int q = 0; q < 8; ++q) { const int i = gi * 8 + q, pi = half * 32 + i, t = dir ? 63 - pi : pi;
            const float e = __expf(eb[i] + add);
            *(LAS bf16_t*)(lds + G1_QT + t * 528 + d * 2) = f2bf1(bf2f(qi[t * 256 + d]) * 0.0625f * e);
            const float ktv = bf2f(ki[t * 256 + d]) * __builtin_amdgcn_rcpf(e);
            *(LAS bf16_t*)(lds + G1_KT + t * 528 + d * 2) = f2bf1(ktv); kh[q] = ktv * ebl; }
        u32x4 o;
        if (dir) { o.x = cvt_pk_bf16(kh[7], kh[6]); o.y = cvt_pk_bf16(kh[5], kh[4]); o.z = cvt_pk_bf16(kh[3], kh[2]); o.w = cvt_pk_bf16(kh[1], kh[0]); }
        else     { o.x = cvt_pk_bf16(kh[0], kh[1]); o.y = cvt_pk_bf16(kh[2], kh[3]); o.z = cvt_pk_bf16(kh[4], kh[5]); o.w = cvt_pk_bf16(kh[6], kh[7]); }
        *(u32x4*)(khp + (dir ? 56 - half * 32 - gi * 8 : half * 32 + gi * 8)) = o;
        asm volatile("" ::: "memory");
    }
    if (half == 0) ((float*)(a.ws + WS_DL))[(((size_t)dir * 4 + b) * 128 + cc) * 1024 + col] = ebl;
    __syncthreads();
    { const int it = wave >> 1, jt0 = (wave & 1) * 2; f32x4 am[2] = {(f32x4){0.f, 0.f, 0.f, 0.f}, (f32x4){0.f, 0.f, 0.f, 0.f}};
#pragma unroll
      for (int ks = 0; ks < 8; ++ks) { const bf16x8 fqt = frag(lds + G1_QT, 528, it * 16 + fr, ks, fq);
#pragma unroll
          for (int n = 0; n < 2; ++n) am[n] = __builtin_amdgcn_mfma_f32_16x16x32_bf16(frag(lds + G1_KT, 528, (jt0 + n) * 16 + fr, ks, fq), fqt, am[n], 0, 0, 0); }
      bf16_t* amg = (bf16_t*)(a.ws + WS_QKK + 128 * MiB) + ((((size_t)dir * 4 + b) * 128 + cc) * 4 + h) * (64 * 64);
#pragma unroll
      for (int n = 0; n < 2; ++n) { const int i = it * 16 + fr, j0 = (jt0 + n) * 16 + 4 * fq; float v[4];
#pragma unroll
          for (int r = 0; r < 4; ++r) { const int j = j0 + r; const bool keep = dir ? (j > i) : (j <= i); v[r] = keep ? am[n][r] : 0.f; }
          u32x2 w; w.x = cvt_pk_bf16(v[0], v[1]); w.y = cvt_pk_bf16(v[2], v[3]); *(u32x2*)(amg + i * 64 + j0) = w; } }
    { bf16_t* QT = (bf16_t*)(a.ws + WS_QKK) + (size_t)dir * MTOK * 1024; const unsigned stoff = ((unsigned)(tid >> 5) * 1024u + (unsigned)(tid & 31) * 8u) * 2u;
#pragma unroll
      for (int i = 0; i < 4; ++i) { char* p = (char*)(QT + (tok0 + 16 * i) * 1024 + h * 256);
          *(u32x4*)(p + stoff) = *(const LAS u32x4*)(lds + G1_QT + ((tid >> 5) + 16 * i) * 528 + (tid & 31) * 16); } }
    __syncthreads();
}
__device__ __forceinline__ void phase_gla_prep(const Args& a, LAS unsigned char* lds) {
    const int tid = opaque_tid();
    const bf16_t* proj = (const bf16_t*)(a.ws + WS_PROJ); const float* R = (const float*)(a.ws + WS_R);
    const unsigned ltoff = ((unsigned)(tid >> 5) * 6144u + (unsigned)(tid & 31) * 8u) * 2u;
    for (int u = blockIdx.x; u < 2048; u += gridDim.x) {
        const int b = u >> 9, cc = (u >> 2) & 127, h = u & 3; const size_t tok0 = (size_t)b * SEQ + cc * 64;
#pragma unroll
        for (int i = 0; i < 4; ++i) { const char* p = (const char*)(proj + (tok0 + 16 * i) * 6144 + h * 256); const int idx = tid + 512 * i;
            *(LAS u32x4*)(lds + G1_QI + idx * 16) = *(const u32x4*)(p + ltoff); *(LAS u32x4*)(lds + G1_KI + idx * 16) = *(const u32x4*)(p + 2048 + ltoff); }
        *(LAS f32x4*)((LAS float*)lds + tid * 4) = *(const f32x4*)(R + tok0 * 32 + tid * 4);
        __syncthreads();
        gla_prep_dir<0>(a, lds, tid, b, cc, h, tok0);
        gla_prep_dir<1>(a, lds, tid, b, cc, h, tok0);
    }
}
constexpr int SC_PQ = 528, SC_PS = 144;
constexpr int SC_QT = 0, SC_KH = SC_QT + 64 * SC_PQ, SC_VT = SC_KH + 256 * SC_PS, SC_ST = SC_VT + 64 * SC_PS, SC_AM = SC_ST + 64 * SC_PQ, SC_DL = SC_AM + 64 * SC_PS, SC_END = SC_DL + 1024;
__device__ __forceinline__ void phase_gla_scan(const Args& a, LAS unsigned char* lds) {
    const int tid = opaque_tid(), wave = __builtin_amdgcn_readfirstlane(tid >> 6), lane = tid & 63, fr = lane & 15, fq = lane >> 4;
    const bf16_t* proj = (const bf16_t*)(a.ws + WS_PROJ); const float* DLg = (const float*)(a.ws + WS_DL);
    for (int item = blockIdx.x; item < 256; item += gridDim.x) {
        const int xcd = item & 7, jj = item >> 3, bhd = xcd * 4 + (jj >> 3), es = jj & 7, b = bhd >> 3, h = (bhd >> 1) & 3, dir = bhd & 1;
        const bf16_t* QT = (const bf16_t*)(a.ws + WS_QKK) + (size_t)dir * MTOK * 1024 + h * 256;
        const bf16_t* AMG = (const bf16_t*)(a.ws + WS_QKK + 128 * MiB);
        const bf16_t* KH = (const bf16_t*)(a.ws + WS_QKK + 256 * MiB);
        const bf16_t* V = proj + 2048 + h * 512 + es * 64;
        bf16_t* O = dir ? ((bf16_t*)(a.ws + WS_PROJ) + h * 512 + es * 64) : ((bf16_t*)(a.ws + WS_HB) + h * 512 + es * 64); const int ldo = dir ? 6144 : 2048;
        for (int i = tid; i < 64 * SC_PQ / 16; i += 512) *(LAS u32x4*)(lds + SC_ST + i * 16) = (u32x4){0u, 0u, 0u, 0u};
        f32x4 S[2][4];
#pragma unroll
        for (int i = 0; i < 2; ++i)
#pragma unroll
            for (int j = 0; j < 4; ++j) S[i][j] = (f32x4){0.f, 0.f, 0.f, 0.f};
        u32x4 rq[4], rkh[4], rv, ram; f32x4 rdl = (f32x4){0.f, 0.f, 0.f, 0.f};
#define SC_LOAD(c) do { const int cc_ = dir ? 127 - (c) : (c); const size_t tok0_ = (size_t)b * SEQ + cc_ * 64; const size_t ci_ = (((size_t)dir * 4 + b) * 128 + cc_) * 4 + h; \
        _Pragma("unroll") for (int i_ = 0; i_ < 4; ++i_) { const int idx_ = tid + 512 * i_; rq[i_] = *(const u32x4*)(QT + (tok0_ + (idx_ >> 5)) * 1024 + (idx_ & 31) * 8); } \
        const bf16_t* khc_ = KH + ci_ * (256 * 64); \
        _Pragma("unroll") for (int i_ = 0; i_ < 4; ++i_) rkh[i_] = *(const u32x4*)(khc_ + (size_t)(tid + 512 * i_) * 8); \
        ram = *(const u32x4*)(AMG + ci_ * (64 * 64) + (size_t)tid * 8); \
        rv = *(const u32x4*)(V + (tok0_ + (tid & 63)) * 6144 + (tid >> 6) * 8); \
        if (tid < 64) rdl = *(const f32x4*)(DLg + (((size_t)dir * 4 + b) * 128 + cc_) * 1024 + h * 256 + tid * 4); } while (0)
        SC_LOAD(0);
        for (int c = 0; c < 128; ++c) {
            const int cc = dir ? 127 - c : c; const size_t tok0 = (size_t)b * SEQ + cc * 64;
#pragma unroll
            for (int i = 0; i < 4; ++i) { const int idx = tid + 512 * i; *(LAS u32x4*)(lds + SC_QT + (idx >> 5) * SC_PQ + (idx & 31) * 16) = rq[i];
                *(LAS u32x4*)(lds + SC_KH + (idx >> 3) * SC_PS + (idx & 7) * 16) = rkh[i]; }
            *(LAS u32x4*)(lds + SC_AM + (tid >> 3) * SC_PS + (tid & 7) * 16) = ram;
            { LAS bf16_t* vt = (LAS bf16_t*)(lds + SC_VT) + ((tid >> 6) * 8) * (SC_PS / 2) + (tid & 63);
              vt[0 * (SC_PS / 2)] = (bf16_t)(rv.x & 0xffffu); vt[1 * (SC_PS / 2)] = (bf16_t)(rv.x >> 16); vt[2 * (SC_PS / 2)] = (bf16_t)(rv.y & 0xffffu); vt[3 * (SC_PS / 2)] = (bf16_t)(rv.y >> 16);
              vt[4 * (SC_PS / 2)] = (bf16_t)(rv.z & 0xffffu); vt[5 * (SC_PS / 2)] = (bf16_t)(rv.z >> 16); vt[6 * (SC_PS / 2)] = (bf16_t)(rv.w & 0xffffu); vt[7 * (SC_PS / 2)] = (bf16_t)(rv.w >> 16); }
            if (tid < 64) *(LAS f32x4*)(lds + SC_DL + tid * 16) = rdl;
            __syncthreads();
            if (c + 1 < 128) SC_LOAD(c + 1);
            const int it = wave >> 1, et0 = (wave & 1) * 2;
            f32x4 oacc[2];
#pragma unroll
            for (int n = 0; n < 2; ++n) oacc[n] = (f32x4){0.f, 0.f, 0.f, 0.f};
#pragma unroll
            for (int ks = 0; ks < 8; ++ks) { const bf16x8 fqt = frag(lds + SC_QT, SC_PQ, it * 16 + fr, ks, fq);
#pragma unroll
                for (int n = 0; n < 2; ++n) oacc[n] = mfma16(frag(lds + SC_ST, SC_PQ, (et0 + n) * 16 + fr, ks, fq), fqt, oacc[n]); }
#pragma unroll
            for (int ks = 0; ks < 2; ++ks) { const bf16x8 fa = frag(lds + SC_AM, SC_PS, it * 16 + fr, ks, fq);
#pragma unroll
                for (int n = 0; n < 2; ++n) oacc[n] = mfma16(frag(lds + SC_VT, SC_PS, (et0 + n) * 16 + fr, ks, fq), fa, oacc[n]); }
#pragma unroll
            for (int n = 0; n < 2; ++n) { u32x2 w; w.x = cvt_pk_bf16(oacc[n][0], oacc[n][1]); w.y = cvt_pk_bf16(oacc[n][2], oacc[n][3]);
                *(u32x2*)(O + (tok0 + it * 16 + fr) * ldo + (et0 + n) * 16 + 4 * fq) = w; }
#pragma unroll
            for (int i = 0; i < 2; ++i) { const f32x4 dl4 = *(const LAS f32x4*)(lds + SC_DL + ((wave * 2 + i) * 16 + 4 * fq) * 4);
#pragma unroll
                for (int j = 0; j < 4; ++j) S[i][j] *= dl4; }
#pragma unroll
            for (int ks = 0; ks < 2; ++ks) {
                bf16x8 fv[4];
#pragma unroll
                for (int j = 0; j < 4; ++j) fv[j] = frag(lds + SC_VT, SC_PS, j * 16 + fr, ks, fq);
#pragma unroll
                for (int i = 0; i < 2; ++i) { const bf16x8 fk = frag(lds + SC_KH, SC_PS, (wave * 2 + i) * 16 + fr, ks, fq);
#pragma unroll
                    for (int j = 0; j < 4; ++j) S[i][j] = mfma16(fk, fv[j], S[i][j]); } }
            __syncthreads();
#pragma unroll
            for (int i = 0; i < 2; ++i)
#pragma unroll
                for (int j = 0; j < 4; ++j) { u32x2 w; w.x = cvt_pk_bf16(S[i][j][0], S[i][j][1]); w.y = cvt_pk_bf16(S[i][j][2], S[i][j][3]);
                    *(LAS u32x2*)(lds + SC_ST + (j * 16 + fr) * SC_PQ + ((wave * 2 + i) * 16 + 4 * fq) * 2) = w; }
        }
        __syncthreads();
#undef SC_LOAD
    }
}
__device__ __forceinline__ void phase_gla_post(bf16_t* hb, const bf16_t* proj, const float* ng) {
    const int tid_ = opaque_tid(), lane = tid_ & 63, wave = __builtin_amdgcn_readfirstlane(tid_ >> 6), gw = blockIdx.x * 8 + wave, NGW = gridDim.x * 8;
    float g8[8];
#pragma unroll
    for (int q = 0; q < 8; ++q) g8[q] = ng[lane * 8 + q];
    for (int m = gw; m < MTOK; m += 2 * NGW) {
        u32x4 wf[2][4], wb[2][4], wg[2][4];
#pragma unroll
        for (int r = 0; r < 2; ++r) { const size_t mm = (size_t)(m + r * NGW);
#pragma unroll
            for (int hh = 0; hh < 4; ++hh) { const int c = hh * 512 + lane * 8;
                wf[r][hh] = *(const u32x4*)(hb + mm * 2048 + c); wb[r][hh] = *(const u32x4*)(proj + mm * 6144 + c); wg[r][hh] = *(const u32x4*)(proj + mm * 6144 + 4096 + c); } }
#pragma unroll
        for (int r = 0; r < 2; ++r) { const size_t mm = (size_t)(m + r * NGW);
#pragma unroll
            for (int hh = 0; hh < 4; ++hh) { const int c = hh * 512 + lane * 8; const u32x4 f = wf[r][hh], bk = wb[r][hh], gg = wg[r][hh];
                float o[8] = {bf_lo(f.x) + bf_lo(bk.x), bf_hi(f.x) + bf_hi(bk.x), bf_lo(f.y) + bf_lo(bk.y), bf_hi(f.y) + bf_hi(bk.y), bf_lo(f.z) + bf_lo(bk.z), bf_hi(f.z) + bf_hi(bk.z), bf_lo(f.w) + bf_lo(bk.w), bf_hi(f.w) + bf_hi(bk.w)};
                const float g[8] = {bf_lo(gg.x), bf_hi(gg.x), bf_lo(gg.y), bf_hi(gg.y), bf_lo(gg.z), bf_hi(gg.z), bf_lo(gg.w), bf_hi(gg.w)};
                float s = 0.f;
#pragma unroll
                for (int q = 0; q < 8; ++q) s += o[q] * o[q];
                const float rstd = __builtin_amdgcn_rsqf(wave_sum(s) * (1.f / 512.f) + NEPS);
#pragma unroll
                for (int q = 0; q < 8; ++q) o[q] = o[q] * rstd * g8[q] * silu_f(g[q]);
                u32x4 w; w.x = cvt_pk_bf16(o[0], o[1]); w.y = cvt_pk_bf16(o[2], o[3]); w.z = cvt_pk_bf16(o[4], o[5]); w.w = cvt_pk_bf16(o[6], o[7]);
                *(u32x4*)(hb + mm * 2048 + c) = w; } }
    }
}

#define RLX_AGENT __ATOMIC_RELAXED, __HIP_MEMORY_SCOPE_AGENT
#define XB_TMO      128
#define XB_XCNT(j)  (256  + 64 * (j))
#define XB_XSUB(j)  (1280 + 64 * (j))
#define XB_XGEN(j)  (2304 + 64 * (j))
#define XB_TOP      3328
#define XB_TOPGEN   3392
#define XCD_BAR_WORDS 3456
#define XB_SPIN_CAP (1u << 18)

__device__ __forceinline__ unsigned xb_ld(unsigned* p)              { return __hip_atomic_load(p, __ATOMIC_RELAXED, __HIP_MEMORY_SCOPE_AGENT); }
__device__ __forceinline__ unsigned xb_add(unsigned* p, unsigned v) { return __hip_atomic_fetch_add(p, v, __ATOMIC_RELAXED, __HIP_MEMORY_SCOPE_AGENT); }
__device__ __forceinline__ unsigned xb_xcc_id() { return (unsigned)__builtin_amdgcn_s_getreg((3 << 11) | 20) & 0xFu; }
#define XB_SPIN(cond, bar) do { unsigned _sp = 0; while (cond) { __builtin_amdgcn_s_sleep(1); \
    if ((++_sp & 255u) == 0u) { if (xb_ld(&(bar)[XB_TMO])) break; if (_sp > XB_SPIN_CAP) { atomicAdd(&(bar)[XB_TMO], 1u); break; } } } } while (0)

struct XcdBarrier {
    unsigned* bar; unsigned x;
    volatile LAS unsigned* st;
};

__device__ __forceinline__ XcdBarrier xcd_barrier_post(unsigned* bar, volatile LAS unsigned* st) {
    XcdBarrier b; b.bar = bar; b.x = xb_xcc_id(); b.st = st;
    if (threadIdx.x == 0) (void)xb_add(&bar[XB_XCNT(b.x)], 1u);
    return b;
}
__device__ __forceinline__ void xcd_barrier_complete(unsigned* bar, unsigned x, unsigned& nloc, unsigned& nx) {
    const unsigned G = gridDim.x * gridDim.y * gridDim.z;
    unsigned sum, cnt, mine, sp = 0u;
    for (;;) {
        sum = 0u; cnt = 0u; mine = 0u;
#pragma unroll
        for (unsigned j = 0; j < 16; ++j) { const unsigned c = xb_ld(&bar[XB_XCNT(j)]); sum += c; cnt += (c > 0u) ? 1u : 0u; mine = (j == x) ? c : mine; }
        if (sum == G) break;
        __builtin_amdgcn_s_sleep(1);
        if ((++sp & 255u) == 0u) { if (xb_ld(&bar[XB_TMO])) break; if (sp > XB_SPIN_CAP) { atomicAdd(&bar[XB_TMO], 1u); break; } }
    }
    nloc = mine > 0u ? mine : 1u; nx = cnt > 0u ? cnt : 1u;
}

__device__ __forceinline__ void xcd_barrier(const XcdBarrier& b) {
    asm volatile("s_waitcnt vmcnt(0)" ::: "memory");
    __syncthreads();
    if (threadIdx.x == 0) {
        unsigned* bar = b.bar;
        __builtin_amdgcn_s_waitcnt(0);
        unsigned nloc = b.st[0], nx = b.st[1];
        if (nloc == 0u) { xcd_barrier_complete(bar, b.x, nloc, nx); b.st[0] = nloc; b.st[1] = nx; }
        const unsigned old = xb_add(&bar[XB_XSUB(b.x)], 1u);
        const unsigned gen = old / nloc;
        if (old + 1u == (gen + 1u) * nloc) {
            __builtin_amdgcn_fence(__ATOMIC_RELEASE, "agent");
            asm volatile("s_waitcnt vmcnt(0)" ::: "memory");
            const unsigned og = xb_add(&bar[XB_TOP], 1u);
            const unsigned tg = og / nx;
            if (og + 1u == (tg + 1u) * nx) xb_add(&bar[XB_TOPGEN], 1u);
            else XB_SPIN(xb_ld(&bar[XB_TOPGEN]) == tg, bar);
            __builtin_amdgcn_fence(__ATOMIC_ACQUIRE, "agent");
            xb_add(&bar[XB_XGEN(b.x)], 1u);
            asm volatile("s_waitcnt vmcnt(0)" ::: "memory");
        } else {
            XB_SPIN(xb_ld(&bar[XB_XGEN(b.x)]) == gen, bar);
            __builtin_amdgcn_fence(__ATOMIC_ACQUIRE, "agent");
            asm volatile("s_waitcnt vmcnt(0)" ::: "memory");
        }
    }
    __syncthreads();
}


#ifndef NLAYERS
#define NLAYERS 4
#endif
#ifndef REP_ATTN
#define REP_ATTN 1
#endif
#ifndef REP_SCAN
#define REP_SCAN 1
#endif
#ifndef REP_PREP
#define REP_PREP 1
#endif
#ifndef REP_GEMM0
#define REP_GEMM0 1
#endif
#ifndef REP_POOL
#define REP_POOL 1
#endif
#ifndef REP_SYNC
#define REP_SYNC 0
#endif
#ifndef REP_GRP
#define REP_GRP 1
#endif
#ifndef REP_OUT0
#define REP_OUT0 1
#endif
#ifndef REP_PRO
#define REP_PRO 1
#endif
#ifndef REP_LOWRANK
#define REP_LOWRANK 1
#endif
#ifndef REP_NORM
#define REP_NORM 1
#endif
constexpr int LDS_BYTES = 160 * 1024;
static_assert(SC_END <= LDS_BYTES - 64 && (int)attn::SHM_ATTN <= LDS_BYTES && pg8::STAGE_BYTES <= LDS_BYTES, "LDS map");

#define CG_SYNC() do { asm volatile("s_waitcnt vmcnt(0) lgkmcnt(0)" ::: "memory"); grid.sync(); __builtin_amdgcn_fence(__ATOMIC_ACQUIRE, "agent"); asm volatile("s_waitcnt vmcnt(0)" ::: "memory"); } while (0)
#define GRID_SYNC() xcd_barrier(xbar)
__global__ void __launch_bounds__(512, 2) fwd_megakernel(Args a) {
    extern __shared__ __attribute__((aligned(16))) unsigned char lds_raw[];
    LAS unsigned char* lds = (LAS unsigned char*)lds_raw;
    cg::grid_group grid = cg::this_grid();
    if (threadIdx.x < 16) ((LAS unsigned*)(lds + LDS_BYTES - 64))[threadIdx.x] = 0u;
    __syncthreads();
    XcdBarrier xbar = xcd_barrier_post((unsigned*)(a.ws + WS_BAR), (volatile LAS unsigned*)(lds + LDS_BYTES - 64));
    const int G = gridDim.x;
    float* mod = (float*)(a.ws + WS_MOD); float* rc = (float*)(a.ws + WS_ROPE); float* rs = rc + SEQ * 64;
    bf16_t* WB = (bf16_t*)(a.ws + WS_WB); bf16_t* WBG = (bf16_t*)(a.ws + WS_WB + 16 * MiB); bf16_t* WBO = (bf16_t*)(a.ws + WS_WB + 24 * MiB);
    bf16_t* HB = (bf16_t*)(a.ws + WS_HB); bf16_t* PROJ = (bf16_t*)(a.ws + WS_PROJ); bf16_t* YB = (bf16_t*)(a.ws + WS_QKK);

    for (int rep = 0; rep < REP_PRO; ++rep) {
    phase_mod(a, lds, mod);
    __syncthreads();
    phase_rope_table(rc, rs);
    phase_weights(a, 0, lds);
    GRID_SYNC(); }
    if (a.ws == nullptr) CG_SYNC();

    bf16_t* XB = (bf16_t*)a.out;
    float* XF = (float*)(a.ws + WS_QKK + 128 * MiB);
    for (int L = 0; L < NLAYERS; ++L) {
        const int kind = L % 3, j = L / 3, N = (kind == 0) ? 4096 : (kind == 1) ? 6144 : 5120;
        const float* modL = mod + (size_t)L * 4 * 6144;
        if (L > 0) phase_weights(a, L, lds);
        if (L == 0) phase_norm_mod(a.x, modL, HB); else phase_norm_mod_bf(XB, modL, HB);
        GRID_SYNC();
        if (kind == 0) {
            { pg8::Gemm g{WBG, (const bf16_t*)(a.ws + WS_QKK + 300 * MiB), 2048, 2048, 512, 512, 2048, 2}; pg8::StaticOrder S; S.init(2048, 2048, G, (int)blockIdx.x);
              pg8::EpiStore E{WB, 2048}; pg8::gemm_phase<pg8::EpiStore, pg8::StaticOrder>(lds, g, S, E); }
            GRID_SYNC();
        }
        if (kind == 1) for (int rep = 0; rep < REP_LOWRANK; ++rep) phase_gla_lowrank(HB, (const bf16_t*)(a.ws + WS_W1T), (float*)(a.ws + WS_R), lds);
        for (int rep = 0; rep < REP_GEMM0; ++rep) {
        { pg8::Gemm g{HB, WB, MTOK, N, 2048, 2048, 2048, 0}; pg8::StaticOrder S; S.init(MTOK, N, G, (int)blockIdx.x);
          pg8::EpiStore E{PROJ, N}; pg8::gemm_phase<pg8::EpiStore, pg8::StaticOrder>(lds, g, S, E); }
        GRID_SYNC(); }
        if (kind == 0) {
            for (int rep = 0; rep < REP_POOL; ++rep) {
            phase_pool(PROJ, YB, a.pool_scale + (size_t)j * 2048);
            GRID_SYNC(); }
        } else if (kind == 1) {
            for (int rep = 0; rep < REP_PREP; ++rep) {
            phase_gla_prep(a, lds);
            GRID_SYNC(); }
            for (int rep = 0; rep < REP_SCAN; ++rep) {
            phase_gla_scan(a, lds);
            GRID_SYNC(); }
            phase_gla_post(HB, PROJ, a.gla_norm_g);
            GRID_SYNC();
        } else {
            phase_knorm_rope(PROJ, a.attn_kg, rc, rs);
            GRID_SYNC();
            for (int rep = 0; rep < REP_ATTN; ++rep) {
            for (int u = blockIdx.x; u < 2048; u += G) {
                const int bk = u >> 7, b = bk >> 2, kvh = bk & 3, hq = kvh * 4 + ((u >> 5) & 3), qb = u & 31;
                const size_t row0 = (size_t)b * SEQ + qb * 256;
                attn::attn_dense_body<attn::bf16>((const attn::bf16*)(PROJ + row0 * 5120 + hq * 128), (const attn::bf16*)(PROJ + (size_t)b * SEQ * 5120 + 2048 + kvh * 128),
                    (const attn::bf16*)(PROJ + (size_t)b * SEQ * 5120 + 2560 + kvh * 128), PROJ + row0 * 5120 + 3072 + hq * 128, YB + row0 * 2048 + hq * 128, SEQ, (char*)lds_raw, 0, a.attn_qg, rc, rs, qb * 256);
                __syncthreads();
            }
            GRID_SYNC(); }
        }
        { pg8::Gemm g{kind == 1 ? HB : YB, WBO, MTOK, 2048, 2048, 2048, 2048, 0}; pg8::StaticOrder S; S.init(MTOK, 2048, G, (int)blockIdx.x);
          if (L == 0) { pg8::EpiResT<false, true> E{a.x, XB, modL + 4096}; pg8::gemm_phase<pg8::EpiResT<false, true>, pg8::StaticOrder>(lds, g, S, E); }
          else if (L < 3) { pg8::EpiResT<true, true> E{XB, XB, modL + 4096}; pg8::gemm_phase<pg8::EpiResT<true, true>, pg8::StaticOrder>(lds, g, S, E); }
          else { pg8::EpiResT<true, false> E{XB, XF, modL + 4096}; pg8::gemm_phase<pg8::EpiResT<true, false>, pg8::StaticOrder>(lds, g, S, E); } }
        GRID_SYNC();
    }
    phase_final_norm(XF, a.final_g, a.out);
}

extern "C" void kernel_launch(void* const* d_in, const int* in_sizes, int n_in, void* d_out, int out_size, void* d_ws, size_t ws_size, hipStream_t stream) {
    static int grid = 0;
    if (grid == 0) {
        if (n_in != 22 || in_sizes[0] != MTOK * DM || out_size != MTOK * DM || ws_size < WS_END) {
            fprintf(stderr, "kernel_launch: unexpected shapes: n_in %d in0 %d out %d ws %zu (need %zu)\n", n_in, n_in > 0 ? in_sizes[0] : -1, out_size, ws_size, (size_t)WS_END); grid = -1; return; }
        int dev = 0, cus = 0, per_cu = 0;
        hipGetDevice(&dev); hipDeviceGetAttribute(&cus, hipDeviceAttributeMultiprocessorCount, dev);
        if (hipFuncSetAttribute((const void*)fwd_megakernel, hipFuncAttributeMaxDynamicSharedMemorySize, LDS_BYTES) != hipSuccess) { fprintf(stderr, "kernel_launch: hipFuncSetAttribute failed\n"); grid = -1; return; }
        if (hipOccupancyMaxActiveBlocksPerMultiprocessor(&per_cu, (const void*)fwd_megakernel, 512, LDS_BYTES) != hipSuccess || per_cu < 1) { fprintf(stderr, "kernel_launch: occupancy query gave %d\n", per_cu); per_cu = 1; }
        (void)hipGetLastError();
        grid = cus;
        fprintf(stderr, "kernel_launch: cus %d per_cu %d grid %d\n", cus, per_cu, grid);
    }
    if (grid < 0) return;
    Args a{};
    const float** p = (const float**)&a;
    for (int i = 0; i < 22; ++i) p[i] = (const float*)d_in[i];
    a.out = (float*)d_out; a.ws = (unsigned char*)d_ws;
    if (hipMemsetAsync((char*)d_ws + WS_BAR, 0, 16384, stream) != hipSuccess) { fprintf(stderr, "kernel_launch: memset of the barrier words failed\n"); return; }
    void* args[] = {&a};
    hipError_t e = hipLaunchCooperativeKernel((const void*)fwd_megakernel, dim3(grid), dim3(512), args, LDS_BYTES, stream);
    if (e != hipSuccess) fprintf(stderr, "kernel_launch: cooperative launch failed: %s (grid %d)\n", hipGetErrorString(e), grid);
}
```

```cpp
#include <hip/hip_runtime.h>
#include <hip/hip_bf16.h>
#include <hip/hip_cooperative_groups.h>
#include <cstdio>
#include <cstdint>
#include <cmath>
namespace cg = cooperative_groups;

constexpr int NB = 4, SEQ = 8192, DM = 2048, MTOK = NB * SEQ;
constexpr float NEPS = 1e-6f;
constexpr size_t MiB = (size_t)1 << 20;
constexpr size_t WS_MOD = 0;
constexpr size_t WS_ROPE = 1 * MiB;
constexpr size_t WS_R = 5 * MiB;
constexpr size_t WS_DL = 9 * MiB;
constexpr size_t WS_W1T = 13 * MiB;
constexpr size_t WS_BAR = 15 * MiB;
constexpr size_t WS_WB = 16 * MiB;
constexpr size_t WS_HB = 52 * MiB;
constexpr size_t WS_PROJ = 180 * MiB;
constexpr size_t WS_QKK = 564 * MiB;
constexpr size_t WS_END = 948 * MiB;

typedef unsigned short bf16_t;
typedef short bf16x8 __attribute__((ext_vector_type(8)));
typedef float f32x4 __attribute__((ext_vector_type(4)));
typedef unsigned u32x4 __attribute__((ext_vector_type(4)));
typedef unsigned u32x2 __attribute__((ext_vector_type(2)));
#define LAS __attribute__((address_space(3)))

typedef float f32x2 __attribute__((ext_vector_type(2)));
typedef __bf16 bf16x2_t __attribute__((ext_vector_type(2)));
__device__ __forceinline__ unsigned cvt_pk_bf16(float lo, float hi) { f32x2 v = {lo, hi}; bf16x2_t b = __builtin_convertvector(v, bf16x2_t); return __builtin_bit_cast(unsigned, b); }
__device__ __forceinline__ float bf_lo(unsigned w) { return __uint_as_float(w << 16); }
__device__ __forceinline__ float bf_hi(unsigned w) { return __uint_as_float(w & 0xffff0000u); }
__device__ __forceinline__ float bf2f(bf16_t b) { return __uint_as_float(((unsigned)b) << 16); }
__device__ __forceinline__ bf16_t f2bf(float f) { unsigned u = __float_as_uint(f); u += 0x7fffu + ((u >> 16) & 1u); return (bf16_t)(u >> 16); }
__device__ __forceinline__ float silu_f(float v) { return v * __builtin_amdgcn_rcpf(1.f + __builtin_amdgcn_exp2f(-1.4426950408889634f * v)); }
__device__ __forceinline__ float wave_sum(float v) {
#pragma unroll
    for (int o = 1; o < 64; o <<= 1) v += __shfl_xor(v, o);
    return v;
}
__device__ __forceinline__ int opaque_tid() { int t; asm volatile("v_mov_b32 %0, %1" : "=v"(t) : "v"((int)threadIdx.x)); return t; }

namespace pg8 {
#define PG8_LAS __attribute__((address_space(3)))
constexpr int BM = 256, BK = 64, HALF = 128, HTB = HALF * BK * 2  , STAGE_BYTES = 8 * HTB, NXCD = 8, WGM = 4;
__host__ __device__ __forceinline__ int lds_byte(int r, int c) { const int st = (r >> 4) * 2 + (c >> 5), rr = r & 15, cc = c & 31, ob = rr * 64 + cc * 2; return st * 1024 + (ob ^ (((ob >> 9) & 1) << 5)); }
__host__ __device__ __forceinline__ void stage_rc(int b, int& R, int& C) { const int st = b / 1024, sb = b % 1024, swz = sb ^ (((sb >> 9) & 1) << 5); R = (st >> 1) * 16 + swz / 64; C = (st & 1) * 32 + (swz % 64) / 2; }
__host__ __device__ __forceinline__ int perm32(int rho) { const int n = rho >> 4, i = rho & 15; return 8 * (i >> 2) + 4 * n + (i & 3); }
struct Unit { int pm, pn; };
struct Gemm { const bf16_t* A; const bf16_t* Bt; int M, N, K, lda, ldb, grp;
    __device__ __forceinline__ const char* aptr(const Unit& u) const { return (const char*)(A + (size_t)u.pm * BM * lda + (grp == 1 ? (size_t)(u.pn >> 1) * K : (size_t)0)); }
    __device__ __forceinline__ const char* bptr(const Unit& u) const { return (const char*)(Bt + (size_t)u.pn * BM * ldb + (grp == 2 ? (size_t)(u.pm >> 1) * K : (size_t)0)); } };
struct StaticOrder {
    int nM, nN, nwg, G, c;
    __host__ __device__ void init(int M, int N, int G_, int c_) { nM = M / BM; nN = N / BM; nwg = nM * nN; G = G_; c = c_; }
    __host__ __device__ bool next(int i, Unit& u) const {
        const long L = (long)i * G + c; if (L >= nwg) return false;
        int wgid = (int)L; { const int q = nwg / NXCD, r = nwg % NXCD, xcd = wgid % NXCD, off = wgid / NXCD; wgid = (xcd < r ? xcd * (q + 1) : r * (q + 1) + (xcd - r) * q) + off; }
        const int nig = WGM * nN, gid = wgid / nig, fm = gid * WGM, gsz = (nM - fm) < WGM ? (nM - fm) : WGM;
        u.pm = fm + ((wgid % nig) % gsz); u.pn = (wgid % nig) / gsz; return true;
    }
    __device__ __forceinline__ void a_ready(const Unit&) const {}
    __device__ __forceinline__ void done(const Unit&) const {}
};
struct EpiStore {
    static constexpr bool PERM = true, AFTER_DRAIN = false; static constexpr int STAGGER_TICKS = 0;
    bf16_t* O; int ldc;
    __device__ __forceinline__ void operator()(const f32x4 (&acc)[2][2][4][2], const Unit& u, int wr, int wc, int fr, int fq) const {
        const int row0 = u.pm * BM + wr * 64 + fr, col0 = u.pn * BM + wc * 32 + 8 * fq;
#pragma unroll
        for (int ai = 0; ai < 2; ++ai)
#pragma unroll
            for (int m = 0; m < 4; ++m) { bf16_t* rowp = O + (size_t)(row0 + ai * HALF + m * 16) * ldc + col0;
#pragma unroll
                for (int bj = 0; bj < 2; ++bj) { const f32x4 v0 = acc[ai][bj][m][0], v1 = acc[ai][bj][m][1];
                    u32x4 w; w.x = cvt_pk_bf16(v0[0], v0[1]); w.y = cvt_pk_bf16(v0[2], v0[3]); w.z = cvt_pk_bf16(v1[0], v1[1]); w.w = cvt_pk_bf16(v1[2], v1[3]);
                    *(u32x4*)(rowp + bj * HALF) = w; } }
    }
};
struct EpiNull {
    static constexpr bool PERM = true, AFTER_DRAIN = false; static constexpr int STAGGER_TICKS = 0;
    bf16_t* O;
    __device__ __forceinline__ void operator()(const f32x4 (&acc)[2][2][4][2], const Unit& u, int wr, int wc, int fr, int fq) const {
        f32x4 s = (f32x4){0.f, 0.f, 0.f, 0.f};
#pragma unroll
        for (int ai = 0; ai < 2; ++ai)
#pragma unroll
            for (int bj = 0; bj < 2; ++bj)
#pragma unroll
                for (int m = 0; m < 4; ++m) { s += acc[ai][bj][m][0]; s += acc[ai][bj][m][1]; }
        if (s[0] + s[1] + s[2] + s[3] == 1234.5678f) O[0] = 0;
    }
};
struct EpiPool {
    static constexpr bool PERM = true, AFTER_DRAIN = false; static constexpr int STAGGER_TICKS = 0;
    bf16_t* O; const bf16_t* G; int ldg; const float* scale;
    __device__ __forceinline__ void operator()(const f32x4 (&acc)[2][2][4][2], const Unit& u, int wr, int wc, int fr, int fq) const {
        const int row0 = u.pm * BM + wr * 64 + fr, col0 = u.pn * BM + wc * 32 + 8 * fq;
        f32x4 sv[2][2];
#pragma unroll
        for (int bj = 0; bj < 2; ++bj)
#pragma unroll
            for (int n = 0; n < 2; ++n) sv[bj][n] = *(const f32x4*)(scale + col0 + bj * HALF + 4 * n);
#pragma unroll
        for (int ai = 0; ai < 2; ++ai) {
            u32x4 gwv[4][2];
#pragma unroll
            for (int m = 0; m < 4; ++m)
#pragma unroll
                for (int bj = 0; bj < 2; ++bj) gwv[m][bj] = *(const u32x4*)(G + (size_t)(row0 + ai * HALF + m * 16) * ldg + col0 + bj * HALF);
#pragma unroll
            for (int m = 0; m < 4; ++m) { const size_t row = (size_t)(row0 + ai * HALF + m * 16);
#pragma unroll
                for (int bj = 0; bj < 2; ++bj) { const u32x4 gw = gwv[m][bj];
                    const f32x4 v0 = acc[ai][bj][m][0] * sv[bj][0], v1 = acc[ai][bj][m][1] * sv[bj][1];
                    u32x4 w;
                    w.x = cvt_pk_bf16(v0[0] * silu_f(bf_lo(gw.x)), v0[1] * silu_f(bf_hi(gw.x))); w.y = cvt_pk_bf16(v0[2] * silu_f(bf_lo(gw.y)), v0[3] * silu_f(bf_hi(gw.y)));
                    w.z = cvt_pk_bf16(v1[0] * silu_f(bf_lo(gw.z)), v1[1] * silu_f(bf_hi(gw.z))); w.w = cvt_pk_bf16(v1[2] * silu_f(bf_lo(gw.w)), v1[3] * silu_f(bf_hi(gw.w)));
                    *(u32x4*)(O + row * 2048 + col0 + bj * HALF) = w; } }
            asm volatile("" ::: "memory"); }
    }
};
template <bool IN_BF16, bool OUT_BF16> struct EpiResT {
    static constexpr bool PERM = true, AFTER_DRAIN = false; static constexpr int STAGGER_TICKS = 0;
    const void* xi; void* xo; const float* gate;
    __device__ __forceinline__ void operator()(const f32x4 (&acc)[2][2][4][2], const Unit& u, int wr, int wc, int fr, int fq) const {
        const int row0 = u.pm * BM + wr * 64 + fr, col0 = u.pn * BM + wc * 32 + 8 * fq;
        const float* gp = gate + (size_t)((u.pm * BM) / SEQ) * 6144 + col0;
        f32x4 gv[2][2];
#pragma unroll
        for (int bj = 0; bj < 2; ++bj)
#pragma unroll
            for (int n = 0; n < 2; ++n) gv[bj][n] = *(const f32x4*)(gp + bj * HALF + 4 * n);
#pragma unroll
        for (int aim = 0; aim < (IN_BF16 ? 2 : 4); ++aim) {
            constexpr int MB = IN_BF16 ? 4 : 2; const int ai = IN_BF16 ? aim : (aim >> 1), mb0 = IN_BF16 ? 0 : (aim & 1) * 2;
            u32x4 raw[4][2][IN_BF16 ? 1 : 2];
#pragma unroll
            for (int m = mb0; m < mb0 + MB; ++m) { const size_t off = (size_t)(row0 + ai * HALF + m * 16) * 2048 + col0;
#pragma unroll
                for (int bj = 0; bj < 2; ++bj) {
                    if (IN_BF16) raw[m][bj][0] = *(const u32x4*)((const bf16_t*)xi + off + bj * HALF);
                    else { raw[m][bj][0] = *(const u32x4*)((const float*)xi + off + bj * HALF); raw[m][bj][IN_BF16 ? 0 : 1] = *(const u32x4*)((const float*)xi + off + bj * HALF + 4); } } }
#pragma unroll
            for (int m = mb0; m < mb0 + MB; ++m) { const size_t off = (size_t)(row0 + ai * HALF + m * 16) * 2048 + col0;
#pragma unroll
                for (int bj = 0; bj < 2; ++bj) { f32x4 x0, x1;
                    if (IN_BF16) { const u32x4 w = raw[m][bj][0]; x0 = (f32x4){bf_lo(w.x), bf_hi(w.x), bf_lo(w.y), bf_hi(w.y)}; x1 = (f32x4){bf_lo(w.z), bf_hi(w.z), bf_lo(w.w), bf_hi(w.w)}; }
                    else { x0 = __builtin_bit_cast(f32x4, raw[m][bj][0]); x1 = __builtin_bit_cast(f32x4, raw[m][bj][IN_BF16 ? 0 : 1]); }
                    const f32x4 v0 = x0 + gv[bj][0] * acc[ai][bj][m][0], v1 = x1 + gv[bj][1] * acc[ai][bj][m][1];
                    if (OUT_BF16) { u32x4 w; w.x = cvt_pk_bf16(v0[0], v0[1]); w.y = cvt_pk_bf16(v0[2], v0[3]); w.z = cvt_pk_bf16(v1[0], v1[1]); w.w = cvt_pk_bf16(v1[2], v1[3]);
                        *(u32x4*)((bf16_t*)xo + off + bj * HALF) = w; }
                    else { *(f32x4*)((float*)xo + off + bj * HALF) = v0; *(f32x4*)((float*)xo + off + bj * HALF + 4) = v1; } } }
            asm volatile("" ::: "memory"); }
    }
};
struct EpiRes {
#ifndef RES_STAGGER_TICKS
#define RES_STAGGER_TICKS 0
#endif
    static constexpr bool PERM = false, AFTER_DRAIN = false; static constexpr int STAGGER_TICKS = RES_STAGGER_TICKS;
    const float* xi; float* xo; const float* gate;
    __device__ __forceinline__ void operator()(const f32x4 (&acc)[2][2][4][2], const Unit& u, int wr, int wc, int fr, int fq) const {
        const int row0 = u.pm * BM + wr * 64 + fr, col0 = u.pn * BM + wc * 32 + 4 * fq;
        const float* gp = gate + (size_t)((u.pm * BM) / SEQ) * 6144 + col0;
        f32x4 gv[2][2];
#pragma unroll
        for (int bj = 0; bj < 2; ++bj)
#pragma unroll
            for (int n = 0; n < 2; ++n) gv[bj][n] = *(const f32x4*)(gp + bj * HALF + n * 16);
#pragma unroll
        for (int ai = 0; ai < 2; ++ai)
#pragma unroll
            for (int mp = 0; mp < 1; ++mp) {
                f32x4 xv[4][2][2];
#pragma unroll
                for (int mm = 0; mm < 4; ++mm) { const size_t off = (size_t)(row0 + ai * HALF + (4 * mp + mm) * 16) * 2048 + col0;
#pragma unroll
                    for (int bj = 0; bj < 2; ++bj)
#pragma unroll
                        for (int n = 0; n < 2; ++n) xv[mm][bj][n] = *(const f32x4*)(xi + off + bj * HALF + n * 16); }
#pragma unroll
                for (int mm = 0; mm < 4; ++mm) { const size_t off = (size_t)(row0 + ai * HALF + (4 * mp + mm) * 16) * 2048 + col0;
#pragma unroll
                    for (int bj = 0; bj < 2; ++bj)
#pragma unroll
                        for (int n = 0; n < 2; ++n) *(f32x4*)(xo + off + bj * HALF + n * 16) = xv[mm][bj][n] + gv[bj][n] * acc[ai][bj][4 * mp + mm][n]; }
                asm volatile("" ::: "memory"); }
    }
};
template <class Epi, class Sched>
__device__ __forceinline__ void gemm_phase(PG8_LAS unsigned char* lds, const Gemm g, const Sched& S, const Epi& E) {
    const int tid = opaque_tid(), wid = __builtin_amdgcn_readfirstlane(tid >> 6), lane = tid & 63, wr = wid >> 2, wc = wid & 3, fr = lane & 15, fq = lane >> 4;
    const int K = g.K, nt = K / BK;
    unsigned voffA[2], voffB[2];
#pragma unroll
    for (int i = 0; i < 2; ++i) { int R, C; stage_rc(tid * 16 + i * 8192, R, C); const int Rb = Epi::PERM ? ((R & ~31) + perm32(R & 31)) : R;
        voffA[i] = (unsigned)(R * g.lda + C) * 2u; voffB[i] = (unsigned)(Rb * g.ldb + C) * 2u; }
    const size_t kstep = (size_t)(BK * 2);
    const size_t hstepA = (size_t)HALF * g.lda * 2, hstepB = (size_t)HALF * g.ldb * 2;
    const unsigned ldsw = (unsigned)wid * 1024u;
    const int aoff = lds_byte(wr * 64 + fr, fq * 8), boff = lds_byte(wc * 32 + fr, fq * 8);
#define PG8_SA(b, h) (((b) * 2 + (h)) * HTB)
#define PG8_SB(b, h) ((4 + (b) * 2 + (h)) * HTB)
#define PG8_STAGE(bufoff, gbase, voff) do { _Pragma("unroll") for (int _i = 0; _i < 2; ++_i) \
        __builtin_amdgcn_global_load_lds((const unsigned*)((const char*)(gbase) + (voff)[_i]), (PG8_LAS unsigned*)(lds + (bufoff) + ldsw + _i * 8192), 16, 0, 0); } while (0)
#define PG8_LDA(dst, b, h) do { _Pragma("unroll") for (int m = 0; m < 4; ++m) _Pragma("unroll") for (int k = 0; k < 2; ++k) dst[m][k] = *(const PG8_LAS bf16x8*)(lds + PG8_SA(b, h) + aoff + m * 2048 + k * 1024); } while (0)
#define PG8_LDB(dst, b, h) do { _Pragma("unroll") for (int n = 0; n < 2; ++n) _Pragma("unroll") for (int k = 0; k < 2; ++k) dst[n][k] = *(const PG8_LAS bf16x8*)(lds + PG8_SB(b, h) + boff + n * 2048 + k * 1024); } while (0)
#define PG8_MMA(ai, bj, At, Bt) do { __builtin_amdgcn_s_setprio(1); _Pragma("unroll") for (int m = 0; m < 4; ++m) _Pragma("unroll") for (int n = 0; n < 2; ++n) _Pragma("unroll") for (int k = 0; k < 2; ++k) \
        acc[ai][bj][m][n] = __builtin_amdgcn_mfma_f32_16x16x32_bf16(Bt[n][k], At[m][k], acc[ai][bj][m][n], 0, 0, 0); __builtin_amdgcn_s_setprio(0); } while (0)
#define PG8_WAIT_V(n) asm volatile("s_waitcnt vmcnt(" #n ")" ::: "memory")
#define PG8_WAIT_L(n) asm volatile("s_waitcnt lgkmcnt(" #n ")" ::: "memory")
#define PG8_BAR __builtin_amdgcn_s_barrier()
#define PG8_SCHED __builtin_amdgcn_sched_barrier(0)
    Unit cur, nxt; int ui = 0;
    if (!S.next(0, cur)) return;
#ifndef GEMM_STAGGER_TICKS
#define GEMM_STAGGER_TICKS 0
#endif
    if (Epi::STAGGER_TICKS > 0) {
        const unsigned long long t0 = __builtin_amdgcn_s_memrealtime(), dl = (unsigned long long)((unsigned)blockIdx.x * (unsigned)Epi::STAGGER_TICKS / (unsigned)gridDim.x);
        while (__builtin_amdgcn_s_memrealtime() - t0 < dl) __builtin_amdgcn_s_sleep(8);
    }
    f32x4 acc[2][2][4][2];
#pragma unroll
    for (int a = 0; a < 2; ++a)
#pragma unroll
        for (int b = 0; b < 2; ++b)
#pragma unroll
            for (int m = 0; m < 4; ++m)
#pragma unroll
                for (int n = 0; n < 2; ++n) acc[a][b][m][n] = (f32x4){0.f, 0.f, 0.f, 0.f};
    bf16x8 At[4][2], B0[2][2], B1[2][2];
    const char* cA = g.aptr(cur); const char* cB = g.bptr(cur);
    S.a_ready(cur);
    PG8_STAGE(PG8_SB(0, 0), cB, voffB); PG8_STAGE(PG8_SA(0, 0), cA, voffA); PG8_STAGE(PG8_SB(0, 1), cB + hstepB, voffB); PG8_STAGE(PG8_SA(0, 1), cA + hstepA, voffA);
    if (wr == 1) PG8_BAR;
    PG8_WAIT_V(4); PG8_BAR;
    PG8_STAGE(PG8_SB(1, 0), cB + kstep, voffB); PG8_STAGE(PG8_SA(1, 0), cA + kstep, voffA); PG8_STAGE(PG8_SB(1, 1), cB + hstepB + kstep, voffB);
    PG8_WAIT_V(6); PG8_BAR;
    for (;;) {
        const bool has_next = S.next(ui + 1, nxt);
        const char* nA = has_next ? g.aptr(nxt) : cA; const char* nB = has_next ? g.bptr(nxt) : cB;
        for (int t = 0; t < nt; t += 2) {
            const bool last = (t == nt - 2);
            const char* a1 = cA + (size_t)(t + 1) * kstep;
            const char* a2 = last ? nA : cA + (size_t)(t + 2) * kstep; const char* b2 = last ? nB : cB + (size_t)(t + 2) * kstep;
            const char* a3 = a2 + kstep; const char* b3 = b2 + kstep;
            if (last && has_next) S.a_ready(nxt);
            PG8_LDB(B0, 0, 0); PG8_SCHED; PG8_LDA(At, 0, 0); PG8_STAGE(PG8_SA(1, 1), a1 + hstepA, voffA);
            PG8_WAIT_L(8); PG8_BAR; PG8_WAIT_L(0); PG8_MMA(0, 0, At, B0); PG8_BAR; PG8_SCHED;
            PG8_LDB(B1, 0, 1); PG8_STAGE(PG8_SB(0, 0), b2, voffB);
            PG8_BAR; PG8_WAIT_L(0); PG8_MMA(0, 1, At, B1); PG8_BAR;
            PG8_LDA(At, 0, 1); PG8_STAGE(PG8_SA(0, 0), a2, voffA);
            PG8_BAR; PG8_WAIT_L(0); PG8_MMA(1, 0, At, B0); PG8_BAR; PG8_SCHED;
            PG8_STAGE(PG8_SB(0, 1), b2 + hstepB, voffB);
            PG8_WAIT_V(6); PG8_BAR; PG8_MMA(1, 1, At, B1); PG8_BAR;
            PG8_LDB(B0, 1, 0); PG8_SCHED; PG8_LDA(At, 1, 0); PG8_STAGE(PG8_SA(0, 1), a2 + hstepA, voffA);
            PG8_WAIT_L(8); PG8_BAR; PG8_WAIT_L(0); PG8_MMA(0, 0, At, B0); PG8_BAR; PG8_SCHED;
            PG8_LDB(B1, 1, 1); PG8_STAGE(PG8_SB(1, 0), b3, voffB);
            PG8_BAR; PG8_WAIT_L(0); PG8_MMA(0, 1, At, B1); PG8_BAR;
            PG8_LDA(At, 1, 1); PG8_STAGE(PG8_SA(1, 0), a3, voffA);
            PG8_BAR; PG8_WAIT_L(0); PG8_MMA(1, 0, At, B0); PG8_BAR; PG8_SCHED;
            PG8_STAGE(PG8_SB(1, 1), b3 + hstepB, voffB);
            PG8_WAIT_V(6); PG8_BAR; PG8_MMA(1, 1, At, B1); PG8_BAR;
        }
            if constexpr (!Epi::AFTER_DRAIN) { E(acc, cur, wr, wc, fr, fq); S.done(cur); }
            if (!has_next) break;
#pragma unroll
        for (int a = 0; a < 2; ++a)
#pragma unroll
            for (int b = 0; b < 2; ++b)
#pragma unroll
                for (int m = 0; m < 4; ++m)
#pragma unroll
                    for (int n = 0; n < 2; ++n) acc[a][b][m][n] = (f32x4){0.f, 0.f, 0.f, 0.f};
        cur = nxt; cA = nA; cB = nB; ++ui;
    }
    PG8_WAIT_V(0);
    if (wr == 0) PG8_BAR;
    PG8_BAR;
    if constexpr (Epi::AFTER_DRAIN) { E.fused(acc, cur, wr, wc, fr, fq, lds, wid, lane); S.done(cur); }
#undef PG8_SA
#undef PG8_SB
#undef PG8_STAGE
#undef PG8_LDA
#undef PG8_LDB
#undef PG8_MMA
#undef PG8_WAIT_V
#undef PG8_WAIT_L
#undef PG8_BAR
#undef PG8_SCHED
}
}


namespace attn {
using bf16 = __hip_bfloat16;
constexpr int   D = 128, NW = 8, QBLK = 32, KVBLK = 64;
constexpr float SCALE = 0.088388347648318440f;
constexpr float THR = 8.f;
constexpr int SDEPTH = 1;
constexpr int LDQ = 5120, LDK = 5120, LDO = 2048;
constexpr size_t SHM_V = KVBLK * D * 2, SHM_K = KVBLK * D * 2, SHM_ATTN = 2 * SHM_V + 2 * SHM_K + NW * 64 * 4;
using bf16x8 = __attribute__((ext_vector_type(8))) short;
using s16x4  = __attribute__((ext_vector_type(4))) short;
using f32x16 = __attribute__((ext_vector_type(16))) float;
using f32x8  = __attribute__((ext_vector_type(8))) float;
using u32x4  = __attribute__((ext_vector_type(4))) unsigned;
#define KSWZ(row, colB) ((row) * 256 + ((colB) ^ (((row) & 7) << 4)))
#define SBAR() __builtin_amdgcn_sched_barrier(0)
__device__ __forceinline__ int crow(int r, int hi) { return (r & 3) + 8 * (r >> 2) + 4 * hi; }
__device__ __forceinline__ unsigned cvtpk(float lo, float hi) {
  unsigned r; asm volatile("v_cvt_pk_bf16_f32 %0, %1, %2" : "=v"(r) : "v"(lo), "v"(hi)); return r;
}
template <typename TIn> struct Stage;
template <> struct Stage<bf16>  { using T = bf16x8;
  __device__ static __forceinline__ T ld8(const bf16* p) { return *reinterpret_cast<const bf16x8*>(p); }
  __device__ static __forceinline__ bf16x8 tobf(T x) { return x; } };
template <> struct Stage<float> { using T = f32x8;
  __device__ static __forceinline__ T ld8(const float* p) { return *reinterpret_cast<const f32x8*>(p); }
  __device__ static __forceinline__ bf16x8 tobf(T x) {
    u32x4 w = {cvtpk(x[0], x[1]), cvtpk(x[2], x[3]), cvtpk(x[4], x[5]), cvtpk(x[6], x[7])}; return *reinterpret_cast<bf16x8*>(&w); } };

__device__ __forceinline__ void partialSM(f32x16& p0, f32x16& p1, float& m_reg, float& mn, float& alpha) {
  constexpr float C = SCALE * 1.4426950408889634f;
  float pmax = p0[0]; for (int r = 1; r < 16; ++r) pmax = fmaxf(pmax, p0[r]); for (int r = 0; r < 16; ++r) pmax = fmaxf(pmax, p1[r]);
  { auto rr = __builtin_amdgcn_permlane32_swap(__float_as_uint(pmax), __float_as_uint(pmax), false, false);
    pmax = fmaxf(__uint_as_float(rr[0]), __uint_as_float(rr[1])); }
  if (__builtin_expect(__all(pmax - m_reg <= THR / SCALE), 1)) { mn = m_reg; alpha = 1.f; }
  else { mn = fmaxf(m_reg, pmax); alpha = __builtin_amdgcn_exp2f((m_reg - mn) * C); m_reg = mn; }
  float mnC = -mn * C;
  for (int r = 0; r < 16; ++r) p0[r] = fmaf(p0[r], C, mnC); for (int r = 0; r < 16; ++r) p1[r] = fmaf(p1[r], C, mnC);
  for (int r = 0; r < 16; ++r) p0[r] = __builtin_amdgcn_exp2f(p0[r]);
}
__device__ __forceinline__ void finishSM(f32x16& p0, f32x16& p1, float alpha, float& l_reg, bf16x8& pa0, bf16x8& pa1, bf16x8& pa2, bf16x8& pa3) {
  for (int r = 0; r < 16; ++r) p1[r] = __builtin_amdgcn_exp2f(p1[r]);
  float ps = 0; for (int r = 0; r < 16; ++r) ps += p0[r]; for (int r = 0; r < 16; ++r) ps += p1[r];
  { auto rr = __builtin_amdgcn_permlane32_swap(__float_as_uint(ps), __float_as_uint(ps), false, false);
    ps = __uint_as_float(rr[0]) + __uint_as_float(rr[1]); }
  l_reg = l_reg * alpha + ps;
#define PK4(P, BASE, OUT) do { unsigned a0 = cvtpk(P[BASE + 0], P[BASE + 1]), a1 = cvtpk(P[BASE + 2], P[BASE + 3]);   \
    unsigned b0 = cvtpk(P[BASE + 4], P[BASE + 5]), b1 = cvtpk(P[BASE + 6], P[BASE + 7]);                              \
    auto r0 = __builtin_amdgcn_permlane32_swap(a0, b0, false, false); auto r1 = __builtin_amdgcn_permlane32_swap(a1, b1, false, false); \
    u32x4 w = {r0[0], r1[0], r0[1], r1[1]}; OUT = *reinterpret_cast<bf16x8*>(&w); } while (0)
  PK4(p0, 0, pa0); PK4(p0, 8, pa1); PK4(p1, 0, pa2); PK4(p1, 8, pa3);
#undef PK4
}
__device__ __forceinline__ void qkt(f32x16& p0, f32x16& p1, const bf16* Ks, const bf16x8* qr, int r32, int hi) {
  p0 = f32x16{}; p1 = f32x16{};
  for (int d0 = 0; d0 < 8; ++d0) { int cb = (d0 * 16 + hi * 8) * 2;
    bf16x8 b0 = *reinterpret_cast<const bf16x8*>((const char*)Ks + KSWZ(r32, cb));
    bf16x8 b1 = *reinterpret_cast<const bf16x8*>((const char*)Ks + KSWZ(32 + r32, cb));
    p0 = __builtin_amdgcn_mfma_f32_32x32x16_bf16(b0, qr[d0], p0, 0, 0, 0);
    p1 = __builtin_amdgcn_mfma_f32_32x32x16_bf16(b1, qr[d0], p1, 0, 0, 0); }
}
__device__ __forceinline__ int v_st(int k, int c) { const int kk = (k & ~0xC) | ((k & 4) << 1) | ((k & 8) >> 1); return ((kk >> 3) * 4 + (c >> 5)) * 512 + ((kk & 7) * 32 + (c & 31)) * 2; }
__device__ __forceinline__ int v_rd_base(int lane) { return ((lane & 3) << 3) | (((lane >> 2) & 3) << 6) | (((lane >> 4) & 1) << 5) | (((lane >> 5) & 1) << 8); }
constexpr int v_rd_off(int d0, int ks, int half) { return d0 * 512 + ks * 4096 + half * 2048; }
template <int OFF> __device__ __forceinline__ s16x4 tr_read(int vb) {
  s16x4 r; asm volatile("ds_read_b64_tr_b16 %0, %1 offset:%2" : "=&v"(r) : "v"(vb), "i"(OFF) : "memory"); return r;
}
template <int D0> __device__ __forceinline__ void pv_one(f32x16& od, int vb, bf16x8 pa0, bf16x8 pa1, bf16x8 pa2, bf16x8 pa3) {
  const s16x4 l0 = tr_read<v_rd_off(D0, 0, 0)>(vb), h0 = tr_read<v_rd_off(D0, 0, 1)>(vb), l1 = tr_read<v_rd_off(D0, 1, 0)>(vb), h1 = tr_read<v_rd_off(D0, 1, 1)>(vb);
  const s16x4 l2 = tr_read<v_rd_off(D0, 2, 0)>(vb), h2 = tr_read<v_rd_off(D0, 2, 1)>(vb), l3 = tr_read<v_rd_off(D0, 3, 0)>(vb), h3 = tr_read<v_rd_off(D0, 3, 1)>(vb);
  asm volatile("s_waitcnt lgkmcnt(0)" ::: "memory"); SBAR();
#define PK(L, H) (bf16x8){L[0], L[1], L[2], L[3], H[0], H[1], H[2], H[3]}
  od = __builtin_amdgcn_mfma_f32_32x32x16_bf16(pa0, PK(l0, h0), od, 0, 0, 0);
  od = __builtin_amdgcn_mfma_f32_32x32x16_bf16(pa1, PK(l1, h1), od, 0, 0, 0);
  od = __builtin_amdgcn_mfma_f32_32x32x16_bf16(pa2, PK(l2, h2), od, 0, 0, 0);
  od = __builtin_amdgcn_mfma_f32_32x32x16_bf16(pa3, PK(l3, h3), od, 0, 0, 0);
#undef PK
}
__device__ __forceinline__ void pv_d0(f32x16* o, int vb, bf16x8 pa0, bf16x8 pa1, bf16x8 pa2, bf16x8 pa3) {
  pv_one<0>(o[0], vb, pa0, pa1, pa2, pa3); pv_one<1>(o[1], vb, pa0, pa1, pa2, pa3); pv_one<2>(o[2], vb, pa0, pa1, pa2, pa3); pv_one<3>(o[3], vb, pa0, pa1, pa2, pa3);
}

template <typename TQ>
__device__ __forceinline__ void attn_dense_body(const TQ* __restrict__ Qb, const bf16* __restrict__ Kh, const bf16* __restrict__ Vh,
                                                const unsigned short* __restrict__ Gb, unsigned short* __restrict__ Ob, int seq, char* lds, int koff,
                                                const float* __restrict__ qgain, const float* __restrict__ rcos, const float* __restrict__ rsin, int tpos0) {
  using St = Stage<bf16>; using SQ = Stage<TQ>;
  const int tid = opaque_tid(), wid = tid >> 6, lane = tid & 63, r32 = lane & 31, hi = lane >> 5;
  bf16* V_lds = (bf16*)lds; bf16* K_lds = (bf16*)(lds + 2 * SHM_V);
  float* ws = (float*)(lds + 2 * SHM_V + 2 * SHM_K) + wid * 64; float* li_l = ws; float* al_l = ws + 32;
  float m_reg = -1e30f, l_reg = 0; f32x16 o[4] = {}; bf16x8 qr[8];
  const TQ* Qw = Qb + (long)(wid * QBLK + r32) * LDQ + hi * 8;
#pragma unroll
  for (int d0 = 0; d0 < 8; ++d0) qr[d0] = SQ::tobf(SQ::ld8(Qw + d0 * 16));
  {
    float ss = 0.f;
#pragma unroll
    for (int d0 = 0; d0 < 8; ++d0) { const u32x4 w = *reinterpret_cast<const u32x4*>(&qr[d0]);
      const float a0 = __uint_as_float(w.x << 16), a1 = __uint_as_float(w.x & 0xffff0000u), a2 = __uint_as_float(w.y << 16), a3 = __uint_as_float(w.y & 0xffff0000u);
      const float a4 = __uint_as_float(w.z << 16), a5 = __uint_as_float(w.z & 0xffff0000u), a6 = __uint_as_float(w.w << 16), a7 = __uint_as_float(w.w & 0xffff0000u);
      ss += (a0 * a0 + a1 * a1) + (a2 * a2 + a3 * a3) + (a4 * a4 + a5 * a5) + (a6 * a6 + a7 * a7); }
    ss += __shfl_xor(ss, 32);
    const float rstd = __builtin_amdgcn_rsqf(ss * (1.f / 128.f) + 1e-6f);
    const int tp = tpos0 + wid * QBLK + r32; const float* cp = rcos + (long)tp * 64 + hi * 4; const float* sp = rsin + (long)tp * 64 + hi * 4; const float* gp = qgain + hi * 8;
#pragma unroll
    for (int d0 = 0; d0 < 8; ++d0) { const u32x4 w = *reinterpret_cast<const u32x4*>(&qr[d0]);
      const float4 g0 = *reinterpret_cast<const float4*>(gp + d0 * 16), g1 = *reinterpret_cast<const float4*>(gp + d0 * 16 + 4), c4 = *reinterpret_cast<const float4*>(cp + d0 * 8), s4 = *reinterpret_cast<const float4*>(sp + d0 * 8);
      const float y0 = __uint_as_float(w.x << 16) * rstd * g0.x, y1 = __uint_as_float(w.x & 0xffff0000u) * rstd * g0.y, y2 = __uint_as_float(w.y << 16) * rstd * g0.z, y3 = __uint_as_float(w.y & 0xffff0000u) * rstd * g0.w;
      const float y4 = __uint_as_float(w.z << 16) * rstd * g1.x, y5 = __uint_as_float(w.z & 0xffff0000u) * rstd * g1.y, y6 = __uint_as_float(w.w << 16) * rstd * g1.z, y7 = __uint_as_float(w.w & 0xffff0000u) * rstd * g1.w;
      u32x4 o = {cvtpk(y0 * c4.x - y1 * s4.x, y0 * s4.x + y1 * c4.x), cvtpk(y2 * c4.y - y3 * s4.y, y2 * s4.y + y3 * c4.y), cvtpk(y4 * c4.z - y5 * s4.z, y4 * s4.z + y5 * c4.z), cvtpk(y6 * c4.w - y7 * s4.w, y6 * s4.w + y7 * c4.w)};
      qr[d0] = *reinterpret_cast<bf16x8*>(&o); }
  }
  const int sr = tid >> 4, sc = (tid & 15) * 8, vst0 = v_st(sr, sc), vst1 = v_st(32 + sr, sc);
  const int vb0 = (int)(uintptr_t)V_lds + v_rd_base(lane);
  struct { typename St::T vs0, vs1, ks0, ks1; } sr_[SDEPTH];
#define SLOAD(i, k0) do { const int kk_ = ((k0) + koff) & (seq - 1); sr_[i].vs0 = St::ld8(&Vh[(long)(kk_ + sr) * LDK + sc]); sr_[i].vs1 = St::ld8(&Vh[(long)(kk_ + 32 + sr) * LDK + sc]); \
    sr_[i].ks0 = St::ld8(&Kh[(long)(kk_ + sr) * LDK + sc]); sr_[i].ks1 = St::ld8(&Kh[(long)(kk_ + 32 + sr) * LDK + sc]); } while (0)
#define SWRITE(b, i) do { *(bf16x8*)((char*)V_lds + (b) * SHM_V + vst0) = St::tobf(sr_[i].vs0);          \
    *(bf16x8*)((char*)V_lds + (b) * SHM_V + vst1) = St::tobf(sr_[i].vs1); int kc = sc * 2;               \
    *(bf16x8*)((char*)K_lds + (b) * SHM_K + KSWZ(sr, kc)) = St::tobf(sr_[i].ks0);                       \
    *(bf16x8*)((char*)K_lds + (b) * SHM_K + KSWZ(32 + sr, kc)) = St::tobf(sr_[i].ks1); } while (0)
#define SWAIT() do { if constexpr (SDEPTH == 2) asm volatile("s_waitcnt vmcnt(4)" ::: "memory"); else asm volatile("s_waitcnt vmcnt(0)" ::: "memory"); } while (0)
#define RESC(a) do { if (__any((a) < 1.f)) { if (hi == 0) al_l[r32] = (a); asm volatile("s_waitcnt lgkmcnt(0)" ::: "memory"); \
    for (int d = 0; d < 4; ++d) for (int r = 0; r < 16; ++r) o[d][r] *= al_l[crow(r, hi)]; } } while (0)
  f32x16 pA0, pA1, pB0, pB1; float mnA, mnB, alA, alB; bf16x8 pa0, pa1, pa2, pa3; const int NT = seq / KVBLK;
  constexpr int SE = 0, SO = SDEPTH - 1;
  SLOAD(SE, 0); asm volatile("s_waitcnt vmcnt(0)" ::: "memory"); SWRITE(0, SE); __syncthreads();
  qkt(pA0, pA1, K_lds, qr, r32, hi); partialSM(pA0, pA1, m_reg, mnA, alA);
  SLOAD(SO, KVBLK); if constexpr (SDEPTH == 2) { if (2 < NT) SLOAD(SE, 2 * KVBLK); }
  SWAIT(); SWRITE(1, SO); __syncthreads();
  for (int j = 1; j + 1 < NT; j += 2) {
    SBAR(); qkt(pB0, pB1, (bf16*)((char*)K_lds + SHM_K), qr, r32, hi);
    finishSM(pA0, pA1, alA, l_reg, pa0, pa1, pa2, pa3); SBAR();
    SLOAD(SO, (j + SDEPTH) * KVBLK); SBAR();
    pv_d0(o, vb0, pa0, pa1, pa2, pa3); partialSM(pB0, pB1, m_reg, mnB, alB);
    __syncthreads(); SWAIT(); SWRITE(0, SE);
    RESC(alB); __syncthreads();
    SBAR(); qkt(pA0, pA1, K_lds, qr, r32, hi);
    finishSM(pB0, pB1, alB, l_reg, pa0, pa1, pa2, pa3); SBAR();
    if (SDEPTH == 1 || j + 3 < NT) SLOAD(SE, (j + 1 + SDEPTH) * KVBLK); SBAR();
    pv_d0(o, vb0 + (int)SHM_V, pa0, pa1, pa2, pa3); partialSM(pA0, pA1, m_reg, mnA, alA);
    __syncthreads(); SWAIT(); SWRITE(1, SO);
    RESC(alA); __syncthreads();
  }
  SBAR(); qkt(pB0, pB1, (bf16*)((char*)K_lds + SHM_K), qr, r32, hi);
  finishSM(pA0, pA1, alA, l_reg, pa0, pa1, pa2, pa3); SBAR();
  pv_d0(o, vb0, pa0, pa1, pa2, pa3); partialSM(pB0, pB1, m_reg, mnB, alB);
  __syncthreads(); RESC(alB);
  finishSM(pB0, pB1, alB, l_reg, pa0, pa1, pa2, pa3); SBAR();
  pv_d0(o, vb0 + (int)SHM_V, pa0, pa1, pa2, pa3);
  if (hi == 0) li_l[r32] = l_reg; asm volatile("s_waitcnt lgkmcnt(0)" ::: "memory");
  float rli[16];
#pragma unroll
  for (int r = 0; r < 16; ++r) rli[r] = __builtin_amdgcn_rcpf(li_l[crow(r, hi)]);
  unsigned short* Ow = Ob + (long)(wid * QBLK) * LDO + r32; const unsigned short* Gw = Gb + (long)(wid * QBLK) * LDQ + r32;
  unsigned short gq[16][4];
#pragma unroll
  for (int r = 0; r < 16; ++r) { const unsigned short* gp = Gw + (long)crow(r, hi) * LDQ;
#pragma unroll
    for (int d0 = 0; d0 < 4; ++d0) gq[r][d0] = gp[d0 * 32]; }
#pragma unroll
  for (int r = 0; r < 16; ++r) { unsigned short* op = Ow + (long)crow(r, hi) * LDO;
#pragma unroll
    for (int d0 = 0; d0 < 4; ++d0) { const float gv = __uint_as_float(((unsigned)gq[r][d0]) << 16);
      const float sg = gv * __builtin_amdgcn_rcpf(1.f + __builtin_amdgcn_exp2f(-1.4426950408889634f * gv));
      const float val = o[d0][r] * rli[r] * sg; unsigned u = __float_as_uint(val); u += 0x7fffu + ((u >> 16) & 1u);
      op[d0 * 32] = (unsigned short)(u >> 16); } }
#undef SLOAD
#undef SWRITE
#undef SWAIT
#undef RESC
}
}

struct Args {
    const float *x, *c, *w_mod, *b_mod, *pool_w_in, *pool_w_grp, *pool_scale, *pool_w_out;
    const float *gla_w_in, *gla_fwd_w1, *gla_fwd_w2, *gla_fwd_b, *gla_bwd_w1, *gla_bwd_w2, *gla_bwd_b, *gla_norm_g, *gla_w_out;
    const float *attn_w_in, *attn_qg, *attn_kg, *attn_w_out, *final_g;
    float* out; unsigned char* ws;
};
#define LDS_WAIT() asm volatile("s_waitcnt lgkmcnt(0)" ::: "memory")

__device__ __forceinline__ void transpose_item(const float* W, int K, int N, bf16_t* WT, int row_off, LAS float* scr, int item, int lane, int ldw = 0) {
    const int nblk = N / 32, kb = item / nblk, nb = item % nblk, k0 = 64 * kb, n0 = 32 * nb; if (ldw == 0) ldw = N;
    float wv[32];
#pragma unroll
    for (int i = 0; i < 32; ++i) wv[i] = W[(size_t)(k0 + 2 * i + (lane >> 5)) * ldw + n0 + (lane & 31)];
#pragma unroll
    for (int i = 0; i < 32; ++i) scr[(2 * i + (lane >> 5)) * 33 + (lane & 31)] = wv[i];
    LDS_WAIT();
    const int c = lane & 7;
#pragma unroll
    for (int j = 0; j < 4; ++j) { const int n = (lane >> 3) + 8 * j; const LAS float* s = scr + (8 * c) * 33 + n;
        u32x4 o; o.x = cvt_pk_bf16(s[0 * 33], s[1 * 33]); o.y = cvt_pk_bf16(s[2 * 33], s[3 * 33]); o.z = cvt_pk_bf16(s[4 * 33], s[5 * 33]); o.w = cvt_pk_bf16(s[6 * 33], s[7 * 33]);
        *(u32x4*)(WT + (size_t)(row_off + n0 + n) * K + k0 + 8 * c) = o; }
    LDS_WAIT();
}
__device__ __forceinline__ void phase_weights(const Args& a, int L, LAS unsigned char* lds) {
    const int tid_ = opaque_tid(), lane = tid_ & 63, wave = __builtin_amdgcn_readfirstlane(tid_ >> 6), gw = blockIdx.x * 8 + wave, NGW = gridDim.x * 8; (void)wave; (void)gw; (void)NGW; (void)lane;
    LAS float* scr = (LAS float*)(lds + wave * 8704);
    bf16_t* WB = (bf16_t*)(a.ws + WS_WB); bf16_t* WBG = (bf16_t*)(a.ws + WS_WB + 16 * MiB); bf16_t* WBO = (bf16_t*)(a.ws + WS_WB + 24 * MiB);
    const int kind = L % 3, j = L / 3;
    if (kind == 0) {
        const float* win = a.pool_w_in + (size_t)j * 2048 * 4096; const float* wgrp = a.pool_w_grp + (size_t)j * 4 * 512 * 512; const float* wout = a.pool_w_out + (size_t)j * 2048 * 2048;
        constexpr int I_IN = 32 * 64, I_G = 8 * 16, I_OUT = 32 * 64;
        { bf16_t* WBU = (bf16_t*)(a.ws + WS_QKK + 300 * MiB);
#pragma clang loop unroll(disable)
          for (int base = gw * 64; base < 2048 * 256; base += NGW * 64) { const int i = base + lane, k = i >> 8, c8 = (i & 255) * 8;
              const f32x4 v0 = *(const f32x4*)(win + (size_t)k * 4096 + c8), v1 = *(const f32x4*)(win + (size_t)k * 4096 + c8 + 4);
              u32x4 o; o.x = cvt_pk_bf16(v0[0], v0[1]); o.y = cvt_pk_bf16(v0[2], v0[3]); o.z = cvt_pk_bf16(v1[0], v1[1]); o.w = cvt_pk_bf16(v1[2], v1[3]);
              *(u32x4*)(WBU + (size_t)k * 2048 + c8) = o; } }
        for (int it = gw; it < I_IN + 4 * I_G + I_OUT; it += NGW) {
            int r = it;
            if (r < I_IN) { transpose_item(win + 2048, 2048, 2048, WB, 2048, scr, r, lane, 4096); continue; } r -= I_IN;
            if (r < 4 * I_G) { const int g = r / I_G; transpose_item(wgrp + (size_t)g * 512 * 512, 512, 512, WBG, g * 512, scr, r % I_G, lane); continue; } r -= 4 * I_G;
            transpose_item(wout, 2048, 2048, WBO, 0, scr, r, lane);
        }
    } else if (kind == 1) {
        constexpr int I_IN = 32 * 192, I_OUT = 32 * 64;
        for (int it = gw; it < I_IN + I_OUT; it += NGW) {
            int r = it;
            if (r < I_IN) { transpose_item(a.gla_w_in, 2048, 6144, WB, 0, scr, r, lane); continue; } r -= I_IN;
            transpose_item(a.gla_w_out, 2048, 2048, WBO, 0, scr, r, lane);
        }
        bf16_t* W1T = (bf16_t*)(a.ws + WS_W1T);
#pragma clang loop unroll(disable)
        for (int base = gw * 64; base < 32 * 2048; base += NGW * 64) { const int i = base + lane, n = i >> 11, k = i & 2047;
            W1T[i] = f2bf(n < 16 ? a.gla_fwd_w1[k * 16 + n] : a.gla_bwd_w1[k * 16 + n - 16]); }
    } else {
        constexpr int I_IN = 32 * 160, I_OUT = 32 * 64;
        for (int it = gw; it < I_IN + I_OUT; it += NGW) {
            int r = it;
            if (r < I_IN) { transpose_item(a.attn_w_in, 2048, 5120, WB, 0, scr, r, lane); continue; } r -= I_IN;
            transpose_item(a.attn_w_out, 2048, 2048, WBO, 0, scr, r, lane);
        }
    }
}
#define ROWS2_LOAD(V, xp, mm) do { _Pragma("unroll") for (int r_ = 0; r_ < 2; ++r_) { const f32x4* xr_ = (const f32x4*)((xp) + (size_t)((mm) + r_ * NGW) * DM) + lane; \
        _Pragma("unroll") for (int j_ = 0; j_ < 8; ++j_) V[r_][j_] = xr_[64 * j_]; } } while (0)
#define ROWS2_SS(V, s) do { _Pragma("unroll") for (int r_ = 0; r_ < 2; ++r_) { float t_ = 0.f; \
        _Pragma("unroll") for (int j_ = 0; j_ < 8; ++j_) t_ += (V[r_][j_].x * V[r_][j_].x + V[r_][j_].y * V[r_][j_].y) + (V[r_][j_].z * V[r_][j_].z + V[r_][j_].w * V[r_][j_].w); s[r_] = t_; } } while (0)
#define ROWS2C_LOAD(V, xp, mm) do { _Pragma("unroll") for (int r_ = 0; r_ < 2; ++r_) { const f32x4* xr_ = (const f32x4*)((xp) + (size_t)((mm) + r_) * DM) + lane; \
        _Pragma("unroll") for (int j_ = 0; j_ < 8; ++j_) V[r_][j_] = xr_[64 * j_]; } } while (0)
__device__ __forceinline__ void phase_norm_mod(const float* x, const float* modL, bf16_t* hb) {
    const int tid_ = opaque_tid(), lane = tid_ & 63, wave = __builtin_amdgcn_readfirstlane(tid_ >> 6), gw = blockIdx.x * 8 + wave, NGW = gridDim.x * 8;
#define NM_PROC(V, mm) do { float s_[2]; ROWS2_SS(V, s_); \
        _Pragma("unroll") for (int r = 0; r < 2; ++r) { const int mr = (mm) + r; const float rstd = __builtin_amdgcn_rsqf(wave_sum(s_[r]) * (1.f / DM) + NEPS); \
            u32x2* o8 = (u32x2*)(hb + (size_t)mr * DM) + lane; \
            _Pragma("unroll") for (int j = 0; j < 8; ++j) { const f32x4 h = V[r][j] * rstd * sc1[j] + sh[j]; u32x2 w; w.x = cvt_pk_bf16(h.x, h.y); w.y = cvt_pk_bf16(h.z, h.w); o8[64 * j] = w; } } } while (0)
    for (int g16 = gw; g16 < MTOK / 16; g16 += NGW) {
        const int m0 = g16 * 16; const float* mp = modL + (size_t)(m0 / SEQ) * 6144;
        f32x4 va[2][8], vb[2][8], sh[8], sc1[8];
        ROWS2C_LOAD(va, x, m0);
#pragma unroll
        for (int j = 0; j < 8; ++j) { sh[j] = *((const f32x4*)mp + lane + 64 * j); sc1[j] = *((const f32x4*)(mp + 2048) + lane + 64 * j) + 1.f; }
#pragma unroll 1
        for (int i = 0; i < 16; i += 4) {
            ROWS2C_LOAD(vb, x, m0 + i + 2);
            NM_PROC(va, m0 + i);
            if (i + 4 < 16) ROWS2C_LOAD(va, x, m0 + i + 4);
            NM_PROC(vb, m0 + i + 2);
        }
    }
#undef NM_PROC
}
__device__ __forceinline__ void phase_norm_mod_bf(const bf16_t* xb, const float* modL, bf16_t* hb) {
    const int tid_ = opaque_tid(), lane = tid_ & 63, wave = __builtin_amdgcn_readfirstlane(tid_ >> 6), gw = blockIdx.x * 8 + wave, NGW = gridDim.x * 8;
    for (int g16 = gw; g16 < MTOK / 16; g16 += NGW) {
        const int m0 = g16 * 16; const float* mp = modL + (size_t)(m0 / SEQ) * 6144;
        u32x4 va[2][4], vb[2][4]; f32x4 sh[4][2], sc1[4][2];
#define NB_LOAD(V, mm) do { _Pragma("unroll") for (int r_ = 0; r_ < 2; ++r_) { const u32x4* xr_ = (const u32x4*)(xb + (size_t)((mm) + r_) * DM) + lane; \
        _Pragma("unroll") for (int j_ = 0; j_ < 4; ++j_) V[r_][j_] = xr_[64 * j_]; } } while (0)
#define NB_PROC(V, mm) do { _Pragma("unroll") for (int r = 0; r < 2; ++r) { float f[4][8]; float s = 0.f; \
        _Pragma("unroll") for (int j = 0; j < 4; ++j) { const u32x4 w = V[r][j]; f[j][0] = bf_lo(w.x); f[j][1] = bf_hi(w.x); f[j][2] = bf_lo(w.y); f[j][3] = bf_hi(w.y); f[j][4] = bf_lo(w.z); f[j][5] = bf_hi(w.z); f[j][6] = bf_lo(w.w); f[j][7] = bf_hi(w.w); \
            _Pragma("unroll") for (int q = 0; q < 8; ++q) s += f[j][q] * f[j][q]; } \
        const float rstd = __builtin_amdgcn_rsqf(wave_sum(s) * (1.f / DM) + NEPS); u32x4* o16 = (u32x4*)(hb + (size_t)((mm) + r) * DM) + lane; \
        _Pragma("unroll") for (int j = 0; j < 4; ++j) { u32x4 w; \
            w.x = cvt_pk_bf16(f[j][0] * rstd * sc1[j][0][0] + sh[j][0][0], f[j][1] * rstd * sc1[j][0][1] + sh[j][0][1]); w.y = cvt_pk_bf16(f[j][2] * rstd * sc1[j][0][2] + sh[j][0][2], f[j][3] * rstd * sc1[j][0][3] + sh[j][0][3]); \
            w.z = cvt_pk_bf16(f[j][4] * rstd * sc1[j][1][0] + sh[j][1][0], f[j][5] * rstd * sc1[j][1][1] + sh[j][1][1]); w.w = cvt_pk_bf16(f[j][6] * rstd * sc1[j][1][2] + sh[j][1][2], f[j][7] * rstd * sc1[j][1][3] + sh[j][1][3]); \
            o16[64 * j] = w; } } } while (0)
        NB_LOAD(va, m0);
#pragma unroll
        for (int j = 0; j < 4; ++j)
#pragma unroll
            for (int q = 0; q < 2; ++q) { sh[j][q] = *(const f32x4*)(mp + (lane + 64 * j) * 8 + 4 * q); sc1[j][q] = *(const f32x4*)(mp + 2048 + (lane + 64 * j) * 8 + 4 * q) + 1.f; }
#pragma unroll 1
        for (int i = 0; i < 16; i += 4) {
            NB_LOAD(vb, m0 + i + 2);
            NB_PROC(va, m0 + i);
            if (i + 4 < 16) NB_LOAD(va, m0 + i + 4);
            NB_PROC(vb, m0 + i + 2);
        }
#undef NB_LOAD
#undef NB_PROC
    }
}
__device__ __forceinline__ void phase_final_norm(const float* x, const float* g, float* outp) {
    const int tid_ = opaque_tid(), lane = tid_ & 63, wave = __builtin_amdgcn_readfirstlane(tid_ >> 6), gw = blockIdx.x * 8 + wave, NGW = gridDim.x * 8;
    f32x4 gg[8];
#pragma unroll
    for (int j = 0; j < 8; ++j) gg[j] = *((const f32x4*)g + lane + 64 * j);
#define FN_PROC(V, mm) do { float s_[2]; ROWS2_SS(V, s_); \
        _Pragma("unroll") for (int r = 0; r < 2; ++r) { f32x4* xr = (f32x4*)(outp + (size_t)((mm) + r) * DM) + lane; const float rstd = __builtin_amdgcn_rsqf(wave_sum(s_[r]) * (1.f / DM) + NEPS); \
            _Pragma("unroll") for (int j = 0; j < 8; ++j) xr[64 * j] = V[r][j] * rstd * gg[j]; } } while (0)
    for (int g16 = gw; g16 < MTOK / 16; g16 += NGW) {
        const int m0 = g16 * 16;
        f32x4 va[2][8], vb[2][8];
        ROWS2C_LOAD(va, x, m0);
#pragma unroll 1
        for (int i = 0; i < 16; i += 4) {
            ROWS2C_LOAD(vb, x, m0 + i + 2);
            FN_PROC(va, m0 + i);
            if (i + 4 < 16) ROWS2C_LOAD(va, x, m0 + i + 4);
            FN_PROC(vb, m0 + i + 2);
        }
    }
#undef FN_PROC
}
__device__ __forceinline__ void phase_mod(const Args& a, LAS unsigned char* lds, float* mod) {
    LAS float* sc = (LAS float*)lds; LAS float* part = (LAS float*)(lds + 32768);
    const int tid = opaque_tid();
    if ((int)blockIdx.x >= 192) return;
    for (int i = tid; i < 8192; i += 512) sc[i] = silu_f(a.c[i]);
    __syncthreads();
    for (int item = blockIdx.x; item < 192; item += gridDim.x) {
        const int layer = item / 48, n0 = (item % 48) * 128, ks = tid >> 5, cq = tid & 31;
        f32x4 acc[4];
#pragma unroll
        for (int b = 0; b < 4; ++b) acc[b] = (f32x4){0.f, 0.f, 0.f, 0.f};
        const float* wp = a.w_mod + ((size_t)layer * 2048 + ks * 128) * 6144 + n0 + cq * 4;
#pragma unroll 16
        for (int k = 0; k < 128; ++k) { const f32x4 w = *(const f32x4*)(wp + (size_t)k * 6144); const int kk = ks * 128 + k;
#pragma unroll
            for (int b = 0; b < 4; ++b) acc[b] += w * sc[b * 2048 + kk]; }
#pragma unroll
        for (int b = 0; b < 4; ++b) *(LAS f32x4*)(part + (ks * 4 + b) * 128 + cq * 4) = acc[b];
        __syncthreads();
        { const int b = tid >> 7, col = tid & 127; float s = a.b_mod[layer * 6144 + n0 + col];
#pragma unroll
          for (int q = 0; q < 16; ++q) s += part[(q * 4 + b) * 128 + col];
          mod[(size_t)(layer * 4 + b) * 6144 + n0 + col] = s; }
        __syncthreads();
    }
}
__device__ __forceinline__ void phase_rope_table(float* rc, float* rs) {
#pragma clang loop unroll(disable)
    for (int idx = blockIdx.x * 512 + opaque_tid(); idx < SEQ * 64; idx += gridDim.x * 512) {
        const int t = idx >> 6, i = idx & 63;
        const float pos = (i < 32) ? (float)((t >> 6) - 64) : (float)((t & 63) - 32);
        const float inv = __builtin_amdgcn_exp2f(-(float)(i & 31) * 0.41524101186092029f);
        const float ang = pos * inv;
        const double xd = (double)ang; const double n = __builtin_rint(xd * 0.63661977236758134); const float rf = (float)(xd - n * 1.5707963267948966);
        const int q = ((int)n) & 3; const float r2 = rf * rf;
        const float sn = rf + rf * r2 * (-1.6666667e-1f + r2 * (8.3333333e-3f + r2 * (-1.9841270e-4f + r2 * 2.7557319e-6f)));
        const float cs = 1.f + r2 * (-0.5f + r2 * (4.1666667e-2f + r2 * (-1.3888889e-3f + r2 * (2.4801587e-5f + r2 * -2.7557319e-7f))));
        const float co = (q == 0) ? cs : (q == 1) ? -sn : (q == 2) ? -cs : sn;
        const float si = (q == 0) ? sn : (q == 1) ? cs : (q == 2) ? -sn : -cs;
        rc[idx] = co; rs[idx] = si;
    }
}
__device__ __forceinline__ void acc8(float (&s)[8], const u32x4 w, const float f) {
    s[0] += f * bf_lo(w.x); s[1] += f * bf_hi(w.x); s[2] += f * bf_lo(w.y); s[3] += f * bf_hi(w.y); s[4] += f * bf_lo(w.z); s[5] += f * bf_hi(w.z); s[6] += f * bf_lo(w.w); s[7] += f * bf_hi(w.w); }
__device__ __forceinline__ void phase_pool(const bf16_t* proj  , bf16_t* yout, const float* scale) {
    const int tid_ = opaque_tid(), lane = tid_ & 63, wave = __builtin_amdgcn_readfirstlane(tid_ >> 6), gw = blockIdx.x * 8 + wave, NGW = gridDim.x * 8;
    for (int unit = gw; unit < (MTOK / 64) * 4; unit += NGW) {
        const int run = unit >> 2, j = unit & 3, half = 1 << j, m0 = run * 64, t0 = m0 & (SEQ - 1), c = (j * 64 + lane) * 8;
        const bf16_t* base = proj + (size_t)(m0 - t0) * 4096 + c; bf16_t* outp = yout + (size_t)(m0 - t0) * 2048 + c;
        const f32x4 sc0 = *(const f32x4*)(scale + c), sc1 = *(const f32x4*)(scale + c + 4);
        float S[8];
#pragma unroll
        for (int q = 0; q < 8; ++q) S[q] = 0.f;
        { u32x4 wi[16]; float fi[16];
#pragma unroll
          for (int q = 0; q < 16; ++q) { const int r = t0 - half + q, rc2 = r < 0 ? 0 : (r >= SEQ ? SEQ - 1 : r); fi[q] = (q < 2 * half && r >= 0 && r < SEQ) ? 1.f : 0.f; wi[q] = *(const u32x4*)(base + (size_t)rc2 * 4096); }
#pragma unroll
          for (int q = 0; q < 16; ++q) acc8(S, wi[q], fi[q]); }
#pragma unroll 8
        for (int tt = 0; tt < 64; ++tt) {
            const int t = t0 + tt, lo = (t - half) > 0 ? (t - half) : 0, hi = (t + half) < SEQ ? (t + half) : SEQ;
            const int ra = (t + half) < SEQ ? (t + half) : (SEQ - 1), rs = (t - half) > 0 ? (t - half) : 0;
            const float fa = (t + half) < SEQ ? 1.f : 0.f, fs = (t - half) >= 0 ? -1.f : 0.f;
            const u32x4 u = *(const u32x4*)(base + (size_t)t * 4096), wa = *(const u32x4*)(base + (size_t)ra * 4096), ws = *(const u32x4*)(base + (size_t)rs * 4096), g = *(const u32x4*)(base + (size_t)t * 4096 + 2048);
            const float ic = 1.f / (float)(hi - lo);
            u32x4 o; o.x = cvt_pk_bf16((S[0] * ic - bf_lo(u.x)) * sc0[0] * silu_f(bf_lo(g.x)), (S[1] * ic - bf_hi(u.x)) * sc0[1] * silu_f(bf_hi(g.x)));
            o.y = cvt_pk_bf16((S[2] * ic - bf_lo(u.y)) * sc0[2] * silu_f(bf_lo(g.y)), (S[3] * ic - bf_hi(u.y)) * sc0[3] * silu_f(bf_hi(g.y)));
            o.z = cvt_pk_bf16((S[4] * ic - bf_lo(u.z)) * sc1[0] * silu_f(bf_lo(g.z)), (S[5] * ic - bf_hi(u.z)) * sc1[1] * silu_f(bf_hi(g.z)));
            o.w = cvt_pk_bf16((S[6] * ic - bf_lo(u.w)) * sc1[2] * silu_f(bf_lo(g.w)), (S[7] * ic - bf_hi(u.w)) * sc1[3] * silu_f(bf_hi(g.w)));
            *(u32x4*)(outp + (size_t)t * 2048) = o;
            acc8(S, wa, fa); acc8(S, ws, fs);
        }
    }
}
__device__ __forceinline__ void phase_knorm_rope(bf16_t* proj, const float* kg, const float* rc, const float* rs) {
    const int tid_ = opaque_tid(), lane = tid_ & 63, wave = __builtin_amdgcn_readfirstlane(tid_ >> 6), gw = blockIdx.x * 8 + wave, NGW = gridDim.x * 8;
    const float k0 = kg[2 * lane], k1 = kg[2 * lane + 1];
    for (int m = gw; m < MTOK; m += 2 * NGW) {
        unsigned w[2][4]; float co[2], si[2];
#pragma unroll
        for (int r = 0; r < 2; ++r) { const int mm = m + r * NGW, t = mm & (SEQ - 1); co[r] = rc[t * 64 + lane]; si[r] = rs[t * 64 + lane];
            const unsigned* row = (const unsigned*)(proj + (size_t)mm * 5120 + 2048) + lane;
#pragma unroll
            for (int h = 0; h < 4; ++h) w[r][h] = row[h * 64]; }
#pragma unroll
        for (int r = 0; r < 2; ++r) { unsigned* row = (unsigned*)(proj + (size_t)(m + r * NGW) * 5120 + 2048) + lane;
#pragma unroll
            for (int h = 0; h < 4; ++h) {
                const float x0 = bf_lo(w[r][h]), x1 = bf_hi(w[r][h]);
                const float rstd = __builtin_amdgcn_rsqf(wave_sum(x0 * x0 + x1 * x1) * (1.f / 128.f) + NEPS);
                const float y0 = x0 * rstd * k0, y1 = x1 * rstd * k1;
                row[h * 64] = cvt_pk_bf16(y0 * co[r] - y1 * si[r], y0 * si[r] + y1 * co[r]);
            } }
    }
}

__device__ __forceinline__ f32x4 mfma16(bf16x8 x, bf16x8 y, f32x4 acc) { return __builtin_amdgcn_mfma_f32_16x16x32_bf16(x, y, acc, 0, 0, 0); }

__device__ __forceinline__ void phase_gla_lowrank(const bf16_t* hb, const bf16_t* w1t, float* R, LAS unsigned char* lds) {
    const int tid_ = opaque_tid(), lane = tid_ & 63, wave = __builtin_amdgcn_readfirstlane(tid_ >> 6), gw = blockIdx.x * 8 + wave, NGW = gridDim.x * 8;
    const int fr = lane & 15, fq = lane >> 4;
    for (int i = tid_; i < 32 * 256; i += 512) { const int n = i >> 8, c16 = i & 255; *(LAS u32x4*)(lds + n * 4112 + c16 * 16) = *(const u32x4*)(w1t + n * 2048 + c16 * 8); }
    __syncthreads();
    const LAS unsigned char* wl = lds + fr * 4112 + fq * 16;
    for (int u = gw; u < MTOK / 16; u += NGW) {
        const bf16_t* ap = hb + (size_t)(u * 16 + fr) * 2048 + fq * 8;
        f32x4 acc0 = (f32x4){0.f, 0.f, 0.f, 0.f}, acc1 = acc0;
#pragma unroll 16
        for (int ks = 0; ks < 64; ++ks) { const bf16x8 av = *(const bf16x8*)(ap + ks * 32);
            acc0 = mfma16(*(const LAS bf16x8*)(wl + ks * 64), av, acc0); acc1 = mfma16(*(const LAS bf16x8*)(wl + 16 * 4112 + ks * 64), av, acc1); }
        float* rp = R + (size_t)(u * 16 + fr) * 32 + 4 * fq;
        *(f32x4*)rp = acc0; *(f32x4*)(rp + 16) = acc1;
    }
    __syncthreads();
}
__device__ __forceinline__ bf16_t f2bf1(float v) { return (bf16_t)(cvt_pk_bf16(v, 0.f) & 0xffffu); }
constexpr int G1_QI = 8192, G1_KI = G1_QI + 32768, G1_QT = G1_KI + 32768, G1_KT = G1_QT + 64 * 528, G1_TOT = G1_KT + 64 * 528, G1_END = G1_TOT + 2048;
__device__ __forceinline__ bf16x8 frag(const LAS unsigned char* base, int pitch, int row, int ks, int fq) { return *(const LAS bf16x8*)(base + row * pitch + ks * 64 + fq * 16); }
template <int dir> __device__ __forceinline__ void gla_prep_dir(const Args& a, LAS unsigned char* lds, const int tid, const int b, const int cc, const int h, const size_t tok0) {
    const LAS float* rl = (const LAS float*)lds; const LAS bf16_t* qi = (const LAS bf16_t*)(lds + G1_QI); const LAS bf16_t* ki = (const LAS bf16_t*)(lds + G1_KI);
    LAS float* tot = (LAS float*)(lds + G1_TOT); LAS float* bl = tot + 256;
    const int d = tid & 255, half = __builtin_amdgcn_readfirstlane(tid >> 8), col = h * 256 + d;
    const int wave = __builtin_amdgcn_readfirstlane(tid >> 6), lane = tid & 63, fr = lane & 15, fq = lane >> 4;
    const float* w2 = dir ? a.gla_bwd_w2 : a.gla_fwd_w2; const float* bs = dir ? a.gla_bwd_b : a.gla_fwd_b;
    float w2c[16];
#pragma unroll
    for (int c = 0; c < 16; ++c) w2c[c] = w2[c * 1024 + col];
    const float bias = bs[col];
    float eb[32]; float run = 0.f;
#pragma unroll
    for (int i = 0; i < 32; ++i) { const int pi = half * 32 + i, t = dir ? 63 - pi : pi; float z = bias;
#pragma unroll
        for (int c4 = 0; c4 < 4; ++c4) { const f32x4 rv = *(const LAS f32x4*)(rl + t * 32 + dir * 16 + c4 * 4);
            z += rv.x * w2c[c4 * 4] + rv.y * w2c[c4 * 4 + 1] + rv.z * w2c[c4 * 4 + 2] + rv.w * w2c[c4 * 4 + 3]; }
        const float ls = fminf(z, 0.f) - __logf(1.f + __expf(-fabsf(z)));
        run += ls * 0.0625f; eb[i] = run; if ((i & 3) == 3) asm volatile("" ::: "memory"); }
    if (half == 0) tot[d] = run;
    __syncthreads();
    const float add = half ? tot[d] : 0.f;
    if (half == 1) bl[d] = run + add;
    __syncthreads();
    const float ebl = __expf(bl[d]);
    bf16_t* khp = (bf16_t*)(a.ws + WS_QKK + 256 * MiB) + ((((size_t)dir * 4 + b) * 128 + cc) * 4 + h) * (256 * 64) + (size_t)d * 64;
#pragma unroll
    for (int gi = 0; gi < 4; ++gi) {
        float kh[8];
#pragma unroll
        for (int q = 0; q < 8; ++q) { const int i = gi * 8 + q, pi = half * 32 + i, t = dir ? 63 - pi : pi;
            const float e = __expf(eb[i] + add);
            *(LAS bf16_t*)(lds + G1_QT + t * 528 + d * 2) = f2bf1(bf2f(qi[t * 256 + d]) * 0.0625f * e);
            const float ktv = bf2f(ki[t * 256 + d]) * __builtin_amdgcn_rcpf(e);
            *(LAS bf16_t*)(lds + G1_KT + t * 528 + d * 2) = f2bf1(ktv); kh[q] = ktv * ebl; }
        u32x4 o;
        if (dir) { o.x = cvt_pk_bf16(kh[7], kh[6]); o.y = cvt_pk_bf16(kh[5], kh[4]); o.z = cvt_pk_bf16(kh[3], kh[2]); o.w = cvt_pk_bf16(kh[1], kh[0]); }
        else     { o.x = cvt_pk_bf16(kh[0], kh[1]); o.y = cvt_pk_bf16(kh[2], kh[3]); o.z = cvt_pk_bf16(kh[4], kh[5]); o.w = cvt_pk_bf16(kh[6], kh[7]); }
        *(u32x4*)(khp + (dir ? 56 - half * 32 - gi * 8 : half * 32 + gi * 8)) = o;
        asm volatile("" ::: "memory");
    }
    if (half == 0) ((float*)(a.ws + WS_DL))[(((size_t)dir * 4 + b) * 128 + cc) * 1024 + col] = ebl;
    __syncthreads();
    { const int it = wave >> 1, jt0 = (wave & 1) * 2; f32x4 am[2] = {(f32x4){0.f, 0.f, 0.f, 0.f}, (f32x4){0.f, 0.f, 0.f, 0.f}};
#pragma unroll
      for (int ks = 0; ks < 8; ++ks) { const bf16x8 fqt = frag(lds + G1_QT, 528, it * 16 + fr, ks, fq);
#pragma unroll
          for (int n = 0; n < 2; ++n) am[n] = __builtin_amdgcn_mfma_f32_16x16x32_bf16(frag(lds + G1_KT, 528, (jt0 + n) * 16 + fr, ks, fq), fqt, am[n], 0, 0, 0); }
      bf16_t* amg = (bf16_t*)(a.ws + WS_QKK + 128 * MiB) + ((((size_t)dir * 4 + b) * 128 + cc) * 4 + h) * (64 * 64);
#pragma unroll
      for (int n = 0; n < 2; ++n) { const int i = it * 16 + fr, j0 = (jt0 + n) * 16 + 4 * fq; float v[4];
#pragma unroll
          for (int r = 0; r < 4; ++r) { const int j = j0 + r; const bool keep = dir ? (j > i) : (j <= i); v[r] = keep ? am[n][r] : 0.f; }
          u32x2 w; w.x = cvt_pk_bf16(v[0], v[1]); w.y = cvt_pk_bf16(v[2], v[3]); *(u32x2*)(amg + i * 64 + j0) = w; } }
    { bf16_t* QT = (bf16_t*)(a.ws + WS_QKK) + (size_t)dir * MTOK * 1024; const unsigned stoff = ((unsigned)(tid >> 5) * 1024u + (unsigned)(tid & 31) * 8u) * 2u;
#pragma unroll
      for (int i = 0; i < 4; ++i) { char* p = (char*)(QT + (tok0 + 16 * i) * 1024 + h * 256);
          *(u32x4*)(p + stoff) = *(const LAS u32x4*)(lds + G1_QT + ((tid >> 5) + 16 * i) * 528 + (tid & 31) * 16); } }
    __syncthreads();
}
__device__ __forceinline__ void phase_gla_prep(const Args& a, LAS unsigned char* lds) {
    const int tid = opaque_tid();
    const bf16_t* proj = (const bf16_t*)(a.ws + WS_PROJ); const float* R = (const float*)(a.ws + WS_R);
    const unsigned ltoff = ((unsigned)(tid >> 5) * 6144u + (unsigned)(tid & 31) * 8u) * 2u;
    for (int u = blockIdx.x; u < 2048; u += gridDim.x) {
        const int b = u >> 9, cc = (u >> 2) & 127, h = u & 3; const size_t tok0 = (size_t)b * SEQ + cc * 64;
#pragma unroll
        for (int i = 0; i < 4; ++i) { const char* p = (const char*)(proj + (tok0 + 16 * i) * 6144 + h * 256); const int idx = tid + 512 * i;
            *(LAS u32x4*)(lds + G1_QI + idx * 16) = *(const u32x4*)(p + ltoff); *(LAS u32x4*)(lds + G1_KI + idx * 16) = *(const u32x4*)(p + 2048 + ltoff); }
        *(LAS f32x4*)((LAS float*)lds + tid * 4) = *(const f32x4*)(R + tok0 * 32 + tid * 4);
        __syncthreads();
        gla_prep_dir<0>(a, lds, tid, b, cc, h, tok0);
        gla_prep_dir<1>(a, lds, tid, b, cc, h, tok0);
    }
}
constexpr int SC_PQ = 528, SC_PS = 144;
constexpr int SC_QT = 0, SC_KH = SC_QT + 64 * SC_PQ, SC_VT = SC_KH + 256 * SC_PS, SC_ST = SC_VT + 64 * SC_PS, SC_AM = SC_ST + 64 * SC_PQ, SC_DL = SC_AM + 64 * SC_PS, SC_END = SC_DL + 1024;
__device__ __forceinline__ void phase_gla_scan(const Args& a, LAS unsigned char* lds) {
    const int tid = opaque_tid(), wave = __builtin_amdgcn_readfirstlane(tid >> 6), lane = tid & 63, fr = lane & 15, fq = lane >> 4;
    const bf16_t* proj = (const bf16_t*)(a.ws + WS_PROJ); const float* DLg = (const float*)(a.ws + WS_DL);
    for (int item = blockIdx.x; item < 256; item += gridDim.x) {
        const int xcd = item & 7, jj = item >> 3, bhd = xcd * 4 + (jj >> 3), es = jj & 7, b = bhd >> 3, h = (bhd >> 1) & 3, dir = bhd & 1;
        const bf16_t* QT = (const bf16_t*)(a.ws + WS_QKK) + (size_t)dir * MTOK * 1024 + h * 256;
        const bf16_t* AMG = (const bf16_t*)(a.ws + WS_QKK + 128 * MiB);
        const bf16_t* KH = (const bf16_t*)(a.ws + WS_QKK + 256 * MiB);
        const bf16_t* V = proj + 2048 + h * 512 + es * 64;
        bf16_t* O = dir ? ((bf16_t*)(a.ws + WS_PROJ) + h * 512 + es * 64) : ((bf16_t*)(a.ws + WS_HB) + h * 512 + es * 64); const int ldo = dir ? 6144 : 2048;
        for (int i = tid; i < 64 * SC_PQ / 16; i += 512) *(LAS u32x4*)(lds + SC_ST + i * 16) = (u32x4){0u, 0u, 0u, 0u};
        f32x4 S[2][4];
#pragma unroll
        for (int i = 0; i < 2; ++i)
#pragma unroll
            for (int j = 0; j < 4; ++j) S[i][j] = (f32x4){0.f, 0.f, 0.f, 0.f};
        u32x4 rq[4], rkh[4], rv, ram; f32x4 rdl = (f32x4){0.f, 0.f, 0.f, 0.f};
#define SC_LOAD(c) do { const int cc_ = dir ? 127 - (c) : (c); const size_t tok0_ = (size_t)b * SEQ + cc_ * 64; const size_t ci_ = (((size_t)dir * 4 + b) * 128 + cc_) * 4 + h; \
        _Pragma("unroll") for (int i_ = 0; i_ < 4; ++i_) { const int idx_ = tid + 512 * i_; rq[i_] = *(const u32x4*)(QT + (tok0_ + (idx_ >> 5)) * 1024 + (idx_ & 31) * 8); } \
        const bf16_t* khc_ = KH + ci_ * (256 * 64); \
        _Pragma("unroll") for (int i_ = 0; i_ < 4; ++i_) rkh[i_] = *(const u32x4*)(khc_ + (size_t)(tid + 512 * i_) * 8); \
        ram = *(const u32x4*)(AMG + ci_ * (64 * 64) + (size_t)tid * 8); \
        rv = *(const u32x4*)(V + (tok0_ + (tid & 63)) * 6144 + (tid >> 6) * 8); \
        if (tid < 64) rdl = *(const f32x4*)(DLg + (((size_t)dir * 4 + b) * 128 + cc_) * 1024 + h * 256 + tid * 4); } while (0)
        SC_LOAD(0);
        for (int c = 0; c < 128; ++c) {
            const int cc = dir ? 127 - c : c; const size_t tok0 = (size_t)b * SEQ + cc * 64;
#pragma unroll
            for (int i = 0; i < 4; ++i) { const int idx = tid + 512 * i; *(LAS u32x4*)(lds + SC_QT + (idx >> 5) * SC_PQ + (idx & 31) * 16) = rq[i];
                *(LAS u32x4*)(lds + SC_KH + (idx >> 3) * SC_PS + (idx & 7) * 16) = rkh[i]; }
            *(LAS u32x4*)(lds + SC_AM + (tid >> 3) * SC_PS + (tid & 7) * 16) = ram;
            { LAS bf16_t* vt = (LAS bf16_t*)(lds + SC_VT) + ((tid >> 6) * 8) * (SC_PS / 2) + (tid & 63);
              vt[0 * (SC_PS / 2)] = (bf16_t)(rv.x & 0xffffu); vt[1 * (SC_PS / 2)] = (bf16_t)(rv.x >> 16); vt[2 * (SC_PS / 2)] = (bf16_t)(rv.y & 0xffffu); vt[3 * (SC_PS / 2)] = (bf16_t)(rv.y >> 16);
              vt[4 * (SC_PS / 2)] = (bf16_t)(rv.z & 0xffffu); vt[5 * (SC_PS / 2)] = (bf16_t)(rv.z >> 16); vt[6 * (SC_PS / 2)] = (bf16_t)(rv.w & 0xffffu); vt[7 * (SC_PS / 2)] = (bf16_t)(rv.w >> 16); }
            if (tid < 64) *(LAS f32x4*)(lds + SC_DL + tid * 16) = rdl;
            __syncthreads();
            if (c + 1 < 128) SC_LOAD(c + 1);
            const int it = wave >> 1, et0 = (wave & 1) * 2;
            f32x4 oacc[2];
#pragma unroll
            for (int n = 0; n < 2; ++n) oacc[n] = (f32x4){0.f, 0.f, 0.f, 0.f};
#pragma unroll
            for (int ks = 0; ks < 8; ++ks) { const bf16x8 fqt = frag(lds + SC_QT, SC_PQ, it * 16 + fr, ks, fq);
#pragma unroll
                for (int n = 0; n < 2; ++n) oacc[n] = mfma16(frag(lds + SC_ST, SC_PQ, (et0 + n) * 16 + fr, ks, fq), fqt, oacc[n]); }
#pragma unroll
            for (int ks = 0; ks < 2; ++ks) { const bf16x8 fa = frag(lds + SC_AM, SC_PS, it * 16 + fr, ks, fq);
#pragma unroll
                for (int n = 0; n < 2; ++n) oacc[n] = mfma16(frag(lds + SC_VT, SC_PS, (et0 + n) * 16 + fr, ks, fq), fa, oacc[n]); }
#pragma unroll
            for (int n = 0; n < 2; ++n) { u32x2 w; w.x = cvt_pk_bf16(oacc[n][0], oacc[n][1]); w.y = cvt_pk_bf16(oacc[n][2], oacc[n][3]);
                *(u32x2*)(O + (tok0 + it * 16 + fr) * ldo + (et0 + n) * 16 + 4 * fq) = w; }
#pragma unroll
            for (int i = 0; i < 2; ++i) { const f32x4 dl4 = *(const LAS f32x4*)(lds + SC_DL + ((wave * 2 + i) * 16 + 4 * fq) * 4);
#pragma unroll
                for (int j = 0; j < 4; ++j) S[i][j] *= dl4; }
#pragma unroll
            for (int ks = 0; ks < 2; ++ks) {
                bf16x8 fv[4];
#pragma unroll
                for (int j = 0; j < 4; ++j) fv[j] = frag(lds + SC_VT, SC_PS, j * 16 + fr, ks, fq);
#pragma unroll
                for (int i = 0; i < 2; ++i) { const bf16x8 fk = frag(lds + SC_KH, SC_PS, (wave * 2 + i) * 16 + fr, ks, fq);
#pragma unroll
                    for (int j = 0; j < 4; ++j) S[i][j] = mfma16(fk, fv[j], S[i][j]); } }
            __syncthreads();
#pragma unroll
            for (int i = 0; i < 2; ++i)
#pragma unroll
                for (int j = 0; j < 4; ++j) { u32x2 w; w.x = cvt_pk_bf16(S[i][j][0], S[i][j][1]); w.y = cvt_pk_bf16(S[i][j][2], S[i][j][3]);
                    *(LAS u32x2*)(lds + SC_ST + (j * 16 + fr) * SC_PQ + ((wave * 2 + i) * 16 + 4 * fq) * 2) = w; }
        }
        __syncthreads();
#undef SC_LOAD
    }
}
__device__ __forceinline__ void phase_gla_post(bf16_t* hb, const bf16_t* proj, const float* ng) {
    const int tid_ = opaque_tid(), lane = tid_ & 63, wave = __builtin_amdgcn_readfirstlane(tid_ >> 6), gw = blockIdx.x * 8 + wave, NGW = gridDim.x * 8;
    float g8[8];
#pragma unroll
    for (int q = 0; q < 8; ++q) g8[q] = ng[lane * 8 + q];
    for (int m = gw; m < MTOK; m += 2 * NGW) {
        u32x4 wf[2][4], wb[2][4], wg[2][4];
#pragma unroll
        for (int r = 0; r < 2; ++r) { const size_t mm = (size_t)(m + r * NGW);
#pragma unroll
            for (int hh = 0; hh < 4; ++hh) { const int c = hh * 512 + lane * 8;
                wf[r][hh] = *(const u32x4*)(hb + mm * 2048 + c); wb[r][hh] = *(const u32x4*)(proj + mm * 6144 + c); wg[r][hh] = *(const u32x4*)(proj + mm * 6144 + 4096 + c); } }
#pragma unroll
        for (int r = 0; r < 2; ++r) { const size_t mm = (size_t)(m + r * NGW);
#pragma unroll
            for (int hh = 0; hh < 4; ++hh) { const int c = hh * 512 + lane * 8; const u32x4 f = wf[r][hh], bk = wb[r][hh], gg = wg[r][hh];
                float o[8] = {bf_lo(f.x) + bf_lo(bk.x), bf_hi(f.x) + bf_hi(bk.x), bf_lo(f.y) + bf_lo(bk.y), bf_hi(f.y) + bf_hi(bk.y), bf_lo(f.z) + bf_lo(bk.z), bf_hi(f.z) + bf_hi(bk.z), bf_lo(f.w) + bf_lo(bk.w), bf_hi(f.w) + bf_hi(bk.w)};
                const float g[8] = {bf_lo(gg.x), bf_hi(gg.x), bf_lo(gg.y), bf_hi(gg.y), bf_lo(gg.z), bf_hi(gg.z), bf_lo(gg.w), bf_hi(gg.w)};
                float s = 0.f;
#pragma unroll
                for (int q = 0; q < 8; ++q) s += o[q] * o[q];
                const float rstd = __builtin_amdgcn_rsqf(wave_sum(s) * (1.f / 512.f) + NEPS);
#pragma unroll
                for (int q = 0; q < 8; ++q) o[q] = o[q] * rstd * g8[q] * silu_f(g[q]);
                u32x4 w; w.x = cvt_pk_bf16(o[0], o[1]); w.y = cvt_pk_bf16(o[2], o[3]); w.z = cvt_pk_bf16(o[4], o[5]); w.w = cvt_pk_bf16(o[6], o[7]);
                *(u32x4*)(hb + mm * 2048 + c) = w; } }
    }
}

#define RLX_AGENT __ATOMIC_RELAXED, __HIP_MEMORY_SCOPE_AGENT
#define XB_TMO      128
#define XB_XCNT(j)  (256  + 64 * (j))
#define XB_XSUB(j)  (1280 + 64 * (j))
#define XB_XGEN(j)  (2304 + 64 * (j))
#define XB_TOP      3328
#define XB_TOPGEN   3392
#define XCD_BAR_WORDS 3456
#define XB_SPIN_CAP (1u << 18)

__device__ __forceinline__ unsigned xb_ld(unsigned* p)              { return __hip_atomic_load(p, __ATOMIC_RELAXED, __HIP_MEMORY_SCOPE_AGENT); }
__device__ __forceinline__ unsigned xb_add(unsigned* p, unsigned v) { return __hip_atomic_fetch_add(p, v, __ATOMIC_RELAXED, __HIP_MEMORY_SCOPE_AGENT); }
__device__ __forceinline__ unsigned xb_xcc_id() { return (unsigned)__builtin_amdgcn_s_getreg((3 << 11) | 20) & 0xFu; }
#define XB_SPIN(cond, bar) do { unsigned _sp = 0; while (cond) { __builtin_amdgcn_s_sleep(1); \
    if ((++_sp & 255u) == 0u) { if (xb_ld(&(bar)[XB_TMO])) break; if (_sp > XB_SPIN_CAP) { atomicAdd(&(bar)[XB_TMO], 1u); break; } } } } while (0)

struct XcdBarrier {
    unsigned* bar; unsigned x;
    volatile LAS unsigned* st;
};

__device__ __forceinline__ XcdBarrier xcd_barrier_post(unsigned* bar, volatile LAS unsigned* st) {
    XcdBarrier b; b.bar = bar; b.x = xb_xcc_id(); b.st = st;
    if (threadIdx.x == 0) (void)xb_add(&bar[XB_XCNT(b.x)], 1u);
    return b;
}
__device__ __forceinline__ void xcd_barrier_complete(unsigned* bar, unsigned x, unsigned& nloc, unsigned& nx) {
    const unsigned G = gridDim.x * gridDim.y * gridDim.z;
    unsigned sum, cnt, mine, sp = 0u;
    for (;;) {
        sum = 0u; cnt = 0u; mine = 0u;
#pragma unroll
        for (unsigned j = 0; j < 16; ++j) { const unsigned c = xb_ld(&bar[XB_XCNT(j)]); sum += c; cnt += (c > 0u) ? 1u : 0u; mine = (j == x) ? c : mine; }
        if (sum == G) break;
        __builtin_amdgcn_s_sleep(1);
        if ((++sp & 255u) == 0u) { if (xb_ld(&bar[XB_TMO])) break; if (sp > XB_SPIN_CAP) { atomicAdd(&bar[XB_TMO], 1u); break; } }
    }
    nloc = mine > 0u ? mine : 1u; nx = cnt > 0u ? cnt : 1u;
}

__device__ __forceinline__ void xcd_barrier(const XcdBarrier& b) {
    asm volatile("s_waitcnt vmcnt(0)" ::: "memory");
    __syncthreads();
    if (threadIdx.x == 0) {
        unsigned* bar = b.bar;
        __builtin_amdgcn_s_waitcnt(0);
        unsigned nloc = b.st[0], nx = b.st[1];
        if (nloc == 0u) { xcd_barrier_complete(bar, b.x, nloc, nx); b.st[0] = nloc; b.st[1] = nx; }
        const unsigned old = xb_add(&bar[XB_XSUB(b.x)], 1u);
        const unsigned gen = old / nloc;
        if (old + 1u == (gen + 1u) * nloc) {
            __builtin_amdgcn_fence(__ATOMIC_RELEASE, "agent");
            asm volatile("s_waitcnt vmcnt(0)" ::: "memory");
            const unsigned og = xb_add(&bar[XB_TOP], 1u);
            const unsigned tg = og / nx;
            if (og + 1u == (tg + 1u) * nx) xb_add(&bar[XB_TOPGEN], 1u);
            else XB_SPIN(xb_ld(&bar[XB_TOPGEN]) == tg, bar);
            __builtin_amdgcn_fence(__ATOMIC_ACQUIRE, "agent");
            xb_add(&bar[XB_XGEN(b.x)], 1u);
            asm volatile("s_waitcnt vmcnt(0)" ::: "memory");
        } else {
            XB_SPIN(xb_ld(&bar[XB_XGEN(b.x)]) == gen, bar);
            __builtin_amdgcn_fence(__ATOMIC_ACQUIRE, "agent");
            asm volatile("s_waitcnt vmcnt(0)" ::: "memory");
        }
    }
    __syncthreads();
}


#ifndef NLAYERS
#define NLAYERS 4
#endif
#ifndef REP_ATTN
#define REP_ATTN 1
#endif
#ifndef REP_SCAN
#define REP_SCAN 1
#endif
#ifndef REP_PREP
#define REP_PREP 1
#endif
#ifndef REP_GEMM0
#define REP_GEMM0 1
#endif
#ifndef REP_POOL
#define REP_POOL 1
#endif
#ifndef REP_SYNC
#define REP_SYNC 0
#endif
#ifndef REP_GRP
#define REP_GRP 1
#endif
#ifndef REP_OUT0
#define REP_OUT0 1
#endif
#ifndef REP_PRO
#define REP_PRO 1
#endif
#ifndef REP_LOWRANK
#define REP_LOWRANK 1
#endif
#ifndef REP_NORM
#define REP_NORM 1
#endif
constexpr int LDS_BYTES = 160 * 1024;
static_assert(SC_END <= LDS_BYTES - 64 && (int)attn::SHM_ATTN <= LDS_BYTES && pg8::STAGE_BYTES <= LDS_BYTES, "LDS map");

#define CG_SYNC() do { asm volatile("s_waitcnt vmcnt(0) lgkmcnt(0)" ::: "memory"); grid.sync(); __builtin_amdgcn_fence(__ATOMIC_ACQUIRE, "agent"); asm volatile("s_waitcnt vmcnt(0)" ::: "memory"); } while (0)
#define GRID_SYNC() xcd_barrier(xbar)
__global__ void __launch_bounds__(512, 2) fwd_megakernel(Args a) {
    extern __shared__ __attribute__((aligned(16))) unsigned char lds_raw[];
    LAS unsigned char* lds = (LAS unsigned char*)lds_raw;
    cg::grid_group grid = cg::this_grid();
    if (threadIdx.x < 16) ((LAS unsigned*)(lds + LDS_BYTES - 64))[threadIdx.x] = 0u;
    __syncthreads();
    XcdBarrier xbar = xcd_barrier_post((unsigned*)(a.ws + WS_BAR), (volatile LAS unsigned*)(lds + LDS_BYTES - 64));
    const int G = gridDim.x;
    float* mod = (float*)(a.ws + WS_MOD); float* rc = (float*)(a.ws + WS_ROPE); float* rs = rc + SEQ * 64;
    bf16_t* WB = (bf16_t*)(a.ws + WS_WB); bf16_t* WBG = (bf16_t*)(a.ws + WS_WB + 16 * MiB); bf16_t* WBO = (bf16_t*)(a.ws + WS_WB + 24 * MiB);
    bf16_t* HB = (bf16_t*)(a.ws + WS_HB); bf16_t* PROJ = (bf16_t*)(a.ws + WS_PROJ); bf16_t* YB = (bf16_t*)(a.ws + WS_QKK);

    for (int rep = 0; rep < REP_PRO; ++rep) {
    phase_mod(a, lds, mod);
    __syncthreads();
    phase_rope_table(rc, rs);
    phase_weights(a, 0, lds);
    GRID_SYNC(); }
    if (a.ws == nullptr) CG_SYNC();

    bf16_t* XB = (bf16_t*)a.out;
    float* XF = (float*)(a.ws + WS_QKK + 128 * MiB);
    for (int L = 0; L < NLAYERS; ++L) {
        const int kind = L % 3, j = L / 3, N = (kind == 0) ? 4096 : (kind == 1) ? 6144 : 5120;
        const float* modL = mod + (size_t)L * 4 * 6144;
        if (L > 0) { phase_weights(a, L, lds); if (kind == 0) GRID_SYNC(); }
        if (kind == 0) {
            pg8::Gemm g{WBG, (const bf16_t*)(a.ws + WS_QKK + 300 * MiB), 2048, 2048, 512, 512, 2048, 2}; pg8::StaticOrder S; S.init(2048, 2048, G, (int)blockIdx.x);
            pg8::EpiStore E{WB, 2048}; pg8::gemm_phase<pg8::EpiStore, pg8::StaticOrder>(lds, g, S, E);
        }
        if (L == 0) phase_norm_mod(a.x, modL, HB); else phase_norm_mod_bf(XB, modL, HB);
        GRID_SYNC();
        if (kind == 1) for (int rep = 0; rep < REP_LOWRANK; ++rep) phase_gla_lowrank(HB, (const bf16_t*)(a.ws + WS_W1T), (float*)(a.ws + WS_R), lds);
        for (int rep = 0; rep < REP_GEMM0; ++rep) {
        { pg8::Gemm g{HB, WB, MTOK, N, 2048, 2048, 2048, 0}; pg8::StaticOrder S; S.init(MTOK, N, G, (int)blockIdx.x);
          pg8::EpiStore E{PROJ, N}; pg8::gemm_phase<pg8::EpiStore, pg8::StaticOrder>(lds, g, S, E); }
        GRID_SYNC(); }
        if (kind == 0) {
            for (int rep = 0; rep < REP_POOL; ++rep) {
            phase_pool(PROJ, YB, a.pool_scale + (size_t)j * 2048);
            GRID_SYNC(); }
        } else if (kind == 1) {
            for (int rep = 0; rep < REP_PREP; ++rep) {
            phase_gla_prep(a, lds);
            GRID_SYNC(); }
            for (int rep = 0; rep < REP_SCAN; ++rep) {
            phase_gla_scan(a, lds);
            GRID_SYNC(); }
            phase_gla_post(HB, PROJ, a.gla_norm_g);
            GRID_SYNC();
        } else {
            phase_knorm_rope(PROJ, a.attn_kg, rc, rs);
            GRID_SYNC();
            for (int rep = 0; rep < REP_ATTN; ++rep) {
            for (int u = blockIdx.x; u < 2048; u += G) {
                const int bk = u >> 7, b = bk >> 2, kvh = bk & 3, hq = kvh * 4 + ((u >> 5) & 3), qb = u & 31;
                const size_t row0 = (size_t)b * SEQ + qb * 256;
                attn::attn_dense_body<attn::bf16>((const attn::bf16*)(PROJ + row0 * 5120 + hq * 128), (const attn::bf16*)(PROJ + (size_t)b * SEQ * 5120 + 2048 + kvh * 128),
                    (const attn::bf16*)(PROJ + (size_t)b * SEQ * 5120 + 2560 + kvh * 128), PROJ + row0 * 5120 + 3072 + hq * 128, YB + row0 * 2048 + hq * 128, SEQ, (char*)lds_raw, 0, a.attn_qg, rc, rs, qb * 256);
                __syncthreads();
            }
            GRID_SYNC(); }
        }
        { pg8::Gemm g{kind == 1 ? HB : YB, WBO, MTOK, 2048, 2048, 2048, 2048, 0}; pg8::StaticOrder S; S.init(MTOK, 2048, G, (int)blockIdx.x);
          if (L == 0) { pg8::EpiResT<false, true> E{a.x, XB, modL + 4096}; pg8::gemm_phase<pg8::EpiResT<false, true>, pg8::StaticOrder>(lds, g, S, E); }
          else if (L < 3) { pg8::EpiResT<true, true> E{XB, XB, modL + 4096}; pg8::gemm_phase<pg8::EpiResT<true, true>, pg8::StaticOrder>(lds, g, S, E); }
          else { pg8::EpiResT<true, false> E{XB, XF, modL + 4096}; pg8::gemm_phase<pg8::EpiResT<true, false>, pg8::StaticOrder>(lds, g, S, E); } }
        GRID_SYNC();
    }
    phase_final_norm(XF, a.final_g, a.out);
}

extern "C" void kernel_launch(void* const* d_in, const int* in_sizes, int n_in, void* d_out, int out_size, void* d_ws, size_t ws_size, hipStream_t stream) {
    static int grid = 0;
    if (grid == 0) {
        if (n_in != 22 || in_sizes[0] != MTOK * DM || out_size != MTOK * DM || ws_size < WS_END) {
            fprintf(stderr, "kernel_launch: unexpected shapes: n_in %d in0 %d out %d ws %zu (need %zu)\n", n_in, n_in > 0 ? in_sizes[0] : -1, out_size, ws_size, (size_t)WS_END); grid = -1; return; }
        int dev = 0, cus = 0, per_cu = 0;
        hipGetDevice(&dev); hipDeviceGetAttribute(&cus, hipDeviceAttributeMultiprocessorCount, dev);
        if (hipFuncSetAttribute((const void*)fwd_megakernel, hipFuncAttributeMaxDynamicSharedMemorySize, LDS_BYTES) != hipSuccess) { fprintf(stderr, "kernel_launch: hipFuncSetAttribute failed\n"); grid = -1; return; }
        if (hipOccupancyMaxActiveBlocksPerMultiprocessor(&per_cu, (const void*)fwd_megakernel, 512, LDS_BYTES) != hipSuccess || per_cu < 1) { fprintf(stderr, "kernel_launch: occupancy query gave %d\n", per_cu); per_cu = 1; }
        (void)hipGetLastError();
        grid = cus;
        fprintf(stderr, "kernel_launch: cus %d per_cu %d grid %d\n", cus, per_cu, grid);
    }
    if (grid < 0) return;
    Args a{};
    const float** p = (const float**)&a;
    for (int i = 0; i < 22; ++i) p[i] = (const float*)d_in[i];
    a.out = (float*)d_out; a.ws = (unsigned char*)d_ws;
    if (hipMemsetAsync((char*)d_ws + WS_BAR, 0, 16384, stream) != hipSuccess) { fprintf(stderr, "kernel_launch: memset of the barrier words failed\n"); return; }
    void* args[] = {&a};
    hipError_t e = hipLaunchCooperativeKernel((const void*)fwd_megakernel, dim3(grid), dim3(512), args, LDS_BYTES, stream);
    if (e != hipSuccess) fprintf(stderr, "kernel_launch: cooperative launch failed: %s (grid %d)\n", hipGetErrorString(e), grid);
}
```

```cpp
#include <hip/hip_runtime.h>
#include <hip/hip_bf16.h>
#include <hip/hip_cooperative_groups.h>
#include <cstdio>
#include <cstdint>
#include <cmath>
namespace cg = cooperative_groups;

constexpr int NB = 4, SEQ = 8192, DM = 2048, MTOK = NB * SEQ;
constexpr float NEPS = 1e-6f;
constexpr size_t MiB = (size_t)1 << 20;
constexpr size_t WS_MOD = 0;
constexpr size_t WS_ROPE = 1 * MiB;
constexpr size_t WS_R = 5 * MiB;
constexpr size_t WS_DL = 9 * MiB;
constexpr size_t WS_W1T = 13 * MiB;
constexpr size_t WS_BAR = 15 * MiB;
constexpr size_t WS_WB = 16 * MiB;
constexpr size_t WS_HB = 52 * MiB;
constexpr size_t WS_PROJ = 180 * MiB;
constexpr size_t WS_QKK = 564 * MiB;
constexpr size_t WS_END = 948 * MiB;

typedef unsigned short bf16_t;
typedef short bf16x8 __attribute__((ext_vector_type(8)));
typedef float f32x4 __attribute__((ext_vector_type(4)));
typedef unsigned u32x4 __attribute__((ext_vector_type(4)));
typedef unsigned u32x2 __attribute__((ext_vector_type(2)));
#define LAS __attribute__((address_space(3)))

typedef float f32x2 __attribute__((ext_vector_type(2)));
typedef __bf16 bf16x2_t __attribute__((ext_vector_type(2)));
__device__ __forceinline__ unsigned cvt_pk_bf16(float lo, float hi) { f32x2 v = {lo, hi}; bf16x2_t b = __builtin_convertvector(v, bf16x2_t); return __builtin_bit_cast(unsigned, b); }
__device__ __forceinline__ float bf_lo(unsigned w) { return __uint_as_float(w << 16); }
__device__ __forceinline__ float bf_hi(unsigned w) { return __uint_as_float(w & 0xffff0000u); }
__device__ __forceinline__ float bf2f(bf16_t b) { return __uint_as_float(((unsigned)b) << 16); }
__device__ __forceinline__ bf16_t f2bf(float f) { unsigned u = __float_as_uint(f); u += 0x7fffu + ((u >> 16) & 1u); return (bf16_t)(u >> 16); }
__device__ __forceinline__ float silu_f(float v) { return v * __builtin_amdgcn_rcpf(1.f + __builtin_amdgcn_exp2f(-1.4426950408889634f * v)); }
__device__ __forceinline__ float wave_sum(float v) {
#pragma unroll
    for (int o = 1; o < 64; o <<= 1) v += __shfl_xor(v, o);
    return v;
}
__device__ __forceinline__ int opaque_tid() { int t; asm volatile("v_mov_b32 %0, %1" : "=v"(t) : "v"((int)threadIdx.x)); return t; }

namespace pg8 {
#define PG8_LAS __attribute__((address_space(3)))
constexpr int BM = 256, BK = 64, HALF = 128, HTB = HALF * BK * 2  , STAGE_BYTES = 8 * HTB, NXCD = 8, WGM = 4;
__host__ __device__ __forceinline__ int lds_byte(int r, int c) { const int st = (r >> 4) * 2 + (c >> 5), rr = r & 15, cc = c & 31, ob = rr * 64 + cc * 2; return st * 1024 + (ob ^ (((ob >> 9) & 1) << 5)); }
__host__ __device__ __forceinline__ void stage_rc(int b, int& R, int& C) { const int st = b / 1024, sb = b % 1024, swz = sb ^ (((sb >> 9) & 1) << 5); R = (st >> 1) * 16 + swz / 64; C = (st & 1) * 32 + (swz % 64) / 2; }
__host__ __device__ __forceinline__ int perm32(int rho) { const int n = rho >> 4, i = rho & 15; return 8 * (i >> 2) + 4 * n + (i & 3); }
struct Unit { int pm, pn; };
struct Gemm { const bf16_t* A; const bf16_t* Bt; int M, N, K, lda, ldb, grp;
    __device__ __forceinline__ const char* aptr(const Unit& u) const { return (const char*)(A + (size_t)u.pm * BM * lda + (grp == 1 ? (size_t)(u.pn >> 1) * K : (size_t)0)); }
    __device__ __forceinline__ const char* bptr(const Unit& u) const { return (const char*)(Bt + (size_t)u.pn * BM * ldb + (grp == 2 ? (size_t)(u.pm >> 1) * K : (size_t)0)); } };
struct StaticOrder {
    int nM, nN, nwg, G, c;
    __host__ __device__ void init(int M, int N, int G_, int c_) { nM = M / BM; nN = N / BM; nwg = nM * nN; G = G_; c = c_; }
    __host__ __device__ bool next(int i, Unit& u) const {
        const long L = (long)i * G + c; if (L >= nwg) return false;
        int wgid = (int)L; { const int q = nwg / NXCD, r = nwg % NXCD, xcd = wgid % NXCD, off = wgid / NXCD; wgid = (xcd < r ? xcd * (q + 1) : r * (q + 1) + (xcd - r) * q) + off; }
        const int nig = WGM * nN, gid = wgid / nig, fm = gid * WGM, gsz = (nM - fm) < WGM ? (nM - fm) : WGM;
        u.pm = fm + ((wgid % nig) % gsz); u.pn = (wgid % nig) / gsz; return true;
    }
    __device__ __forceinline__ void a_ready(const Unit&) const {}
    __device__ __forceinline__ void done(const Unit&) const {}
};
struct EpiStore {
    static constexpr bool PERM = true, AFTER_DRAIN = false; static constexpr int STAGGER_TICKS = 0;
    bf16_t* O; int ldc;
    __device__ __forceinline__ void operator()(const f32x4 (&acc)[2][2][4][2], const Unit& u, int wr, int wc, int fr, int fq) const {
        const int row0 = u.pm * BM + wr * 64 + fr, col0 = u.pn * BM + wc * 32 + 8 * fq;
#pragma unroll
        for (int ai = 0; ai < 2; ++ai)
#pragma unroll
            for (int m = 0; m < 4; ++m) { bf16_t* rowp = O + (size_t)(row0 + ai * HALF + m * 16) * ldc + col0;
#pragma unroll
                for (int bj = 0; bj < 2; ++bj) { const f32x4 v0 = acc[ai][bj][m][0], v1 = acc[ai][bj][m][1];
                    u32x4 w; w.x = cvt_pk_bf16(v0[0], v0[1]); w.y = cvt_pk_bf16(v0[2], v0[3]); w.z = cvt_pk_bf16(v1[0], v1[1]); w.w = cvt_pk_bf16(v1[2], v1[3]);
                    *(u32x4*)(rowp + bj * HALF) = w; } }
    }
};
struct EpiNull {
    static constexpr bool PERM = true, AFTER_DRAIN = false; static constexpr int STAGGER_TICKS = 0;
    bf16_t* O;
    __device__ __forceinline__ void operator()(const f32x4 (&acc)[2][2][4][2], const Unit& u, int wr, int wc, int fr, int fq) const {
        f32x4 s = (f32x4){0.f, 0.f, 0.f, 0.f};
#pragma unroll
        for (int ai = 0; ai < 2; ++ai)
#pragma unroll
            for (int bj = 0; bj < 2; ++bj)
#pragma unroll
                for (int m = 0; m < 4; ++m) { s += acc[ai][bj][m][0]; s += acc[ai][bj][m][1]; }
        if (s[0] + s[1] + s[2] + s[3] == 1234.5678f) O[0] = 0;
    }
};
struct EpiPool {
    static constexpr bool PERM = true, AFTER_DRAIN = false; static constexpr int STAGGER_TICKS = 0;
    bf16_t* O; const bf16_t* G; int ldg; const float* scale;
    __device__ __forceinline__ void operator()(const f32x4 (&acc)[2][2][4][2], const Unit& u, int wr, int wc, int fr, int fq) const {
        const int row0 = u.pm * BM + wr * 64 + fr, col0 = u.pn * BM + wc * 32 + 8 * fq;
        f32x4 sv[2][2];
#pragma unroll
        for (int bj = 0; bj < 2; ++bj)
#pragma unroll
            for (int n = 0; n < 2; ++n) sv[bj][n] = *(const f32x4*)(scale + col0 + bj * HALF + 4 * n);
#pragma unroll
        for (int ai = 0; ai < 2; ++ai) {
            u32x4 gwv[4][2];
#pragma unroll
            for (int m = 0; m < 4; ++m)
#pragma unroll
                for (int bj = 0; bj < 2; ++bj) gwv[m][bj] = *(const u32x4*)(G + (size_t)(row0 + ai * HALF + m * 16) * ldg + col0 + bj * HALF);
#pragma unroll
            for (int m = 0; m < 4; ++m) { const size_t row = (size_t)(row0 + ai * HALF + m * 16);
#pragma unroll
                for (int bj = 0; bj < 2; ++bj) { const u32x4 gw = gwv[m][bj];
                    const f32x4 v0 = acc[ai][bj][m][0] * sv[bj][0], v1 = acc[ai][bj][m][1] * sv[bj][1];
                    u32x4 w;
                    w.x = cvt_pk_bf16(v0[0] * silu_f(bf_lo(gw.x)), v0[1] * silu_f(bf_hi(gw.x))); w.y = cvt_pk_bf16(v0[2] * silu_f(bf_lo(gw.y)), v0[3] * silu_f(bf_hi(gw.y)));
                    w.z = cvt_pk_bf16(v1[0] * silu_f(bf_lo(gw.z)), v1[1] * silu_f(bf_hi(gw.z))); w.w = cvt_pk_bf16(v1[2] * silu_f(bf_lo(gw.w)), v1[3] * silu_f(bf_hi(gw.w)));
                    *(u32x4*)(O + row * 2048 + col0 + bj * HALF) = w; } }
            asm volatile("" ::: "memory"); }
    }
};
template <bool IN_BF16, bool OUT_BF16> struct EpiResT {
    static constexpr bool PERM = true, AFTER_DRAIN = false; static constexpr int STAGGER_TICKS = 0;
    const void* xi; void* xo; const float* gate;
    __device__ __forceinline__ void operator()(const f32x4 (&acc)[2][2][4][2], const Unit& u, int wr, int wc, int fr, int fq) const {
        const int row0 = u.pm * BM + wr * 64 + fr, col0 = u.pn * BM + wc * 32 + 8 * fq;
        const float* gp = gate + (size_t)((u.pm * BM) / SEQ) * 6144 + col0;
        f32x4 gv[2][2];
#pragma unroll
        for (int bj = 0; bj < 2; ++bj)
#pragma unroll
            for (int n = 0; n < 2; ++n) gv[bj][n] = *(const f32x4*)(gp + bj * HALF + 4 * n);
#pragma unroll
        for (int aim = 0; aim < (IN_BF16 ? 2 : 4); ++aim) {
            constexpr int MB = IN_BF16 ? 4 : 2; const int ai = IN_BF16 ? aim : (aim >> 1), mb0 = IN_BF16 ? 0 : (aim & 1) * 2;
            u32x4 raw[4][2][IN_BF16 ? 1 : 2];
#pragma unroll
            for (int m = mb0; m < mb0 + MB; ++m) { const size_t off = (size_t)(row0 + ai * HALF + m * 16) * 2048 + col0;
#pragma unroll
                for (int bj = 0; bj < 2; ++bj) {
                    if (IN_BF16) raw[m][bj][0] = *(const u32x4*)((const bf16_t*)xi + off + bj * HALF);
                    else { raw[m][bj][0] = *(const u32x4*)((const float*)xi + off + bj * HALF); raw[m][bj][IN_BF16 ? 0 : 1] = *(const u32x4*)((const float*)xi + off + bj * HALF + 4); } } }
#pragma unroll
            for (int m = mb0; m < mb0 + MB; ++m) { const size_t off = (size_t)(row0 + ai * HALF + m * 16) * 2048 + col0;
#pragma unroll
                for (int bj = 0; bj < 2; ++bj) { f32x4 x0, x1;
                    if (IN_BF16) { const u32x4 w = raw[m][bj][0]; x0 = (f32x4){bf_lo(w.x), bf_hi(w.x), bf_lo(w.y), bf_hi(w.y)}; x1 = (f32x4){bf_lo(w.z), bf_hi(w.z), bf_lo(w.w), bf_hi(w.w)}; }
                    else { x0 = __builtin_bit_cast(f32x4, raw[m][bj][0]); x1 = __builtin_bit_cast(f32x4, raw[m][bj][IN_BF16 ? 0 : 1]); }
                    const f32x4 v0 = x0 + gv[bj][0] * acc[ai][bj][m][0], v1 = x1 + gv[bj][1] * acc[ai][bj][m][1];
                    if (OUT_BF16) { u32x4 w; w.x = cvt_pk_bf16(v0[0], v0[1]); w.y = cvt_pk_bf16(v0[2], v0[3]); w.z = cvt_pk_bf16(v1[0], v1[1]); w.w = cvt_pk_bf16(v1[2], v1[3]);
                        *(u32x4*)((bf16_t*)xo + off + bj * HALF) = w; }
                    else { *(f32x4*)((float*)xo + off + bj * HALF) = v0; *(f32x4*)((float*)xo + off + bj * HALF + 4) = v1; } } }
            asm volatile("" ::: "memory"); }
    }
};
struct EpiRes {
#ifndef RES_STAGGER_TICKS
#define RES_STAGGER_TICKS 0
#endif
    static constexpr bool PERM = false, AFTER_DRAIN = false; static constexpr int STAGGER_TICKS = RES_STAGGER_TICKS;
    const float* xi; float* xo; const float* gate;
    __device__ __forceinline__ void operator()(const f32x4 (&acc)[2][2][4][2], const Unit& u, int wr, int wc, int fr, int fq) const {
        const int row0 = u.pm * BM + wr * 64 + fr, col0 = u.pn * BM + wc * 32 + 4 * fq;
        const float* gp = gate + (size_t)((u.pm * BM) / SEQ) * 6144 + col0;
        f32x4 gv[2][2];
#pragma unroll
        for (int bj = 0; bj < 2; ++bj)
#pragma unroll
            for (int n = 0; n < 2; ++n) gv[bj][n] = *(const f32x4*)(gp + bj * HALF + n * 16);
#pragma unroll
        for (int ai = 0; ai < 2; ++ai)
#pragma unroll
            for (int mp = 0; mp < 1; ++mp) {
                f32x4 xv[4][2][2];
#pragma unroll
                for (int mm = 0; mm < 4; ++mm) { const size_t off = (size_t)(row0 + ai * HALF + (4 * mp + mm) * 16) * 2048 + col0;
#pragma unroll
                    for (int bj = 0; bj < 2; ++bj)
#pragma unroll
                        for (int n = 0; n < 2; ++n) xv[mm][bj][n] = *(const f32x4*)(xi + off + bj * HALF + n * 16); }
#pragma unroll
                for (int mm = 0; mm < 4; ++mm) { const size_t off = (size_t)(row0 + ai * HALF + (4 * mp + mm) * 16) * 2048 + col0;
#pragma unroll
                    for (int bj = 0; bj < 2; ++bj)
#pragma unroll
                        for (int n = 0; n < 2; ++n) *(f32x4*)(xo + off + bj * HALF + n * 16) = xv[mm][bj][n] + gv[bj][n] * acc[ai][bj][4 * mp + mm][n]; }
                asm volatile("" ::: "memory"); }
    }
};
template <class Epi, class Sched>
__device__ __forceinline__ void gemm_phase(PG8_LAS unsigned char* lds, const Gemm g, const Sched& S, const Epi& E) {
    const int tid = opaque_tid(), wid = __builtin_amdgcn_readfirstlane(tid >> 6), lane = tid & 63, wr = wid >> 2, wc = wid & 3, fr = lane & 15, fq = lane >> 4;
    const int K = g.K, nt = K / BK;
    unsigned voffA[2], voffB[2];
#pragma unroll
    for (int i = 0; i < 2; ++i) { int R, C; stage_rc(tid * 16 + i * 8192, R, C); const int Rb = Epi::PERM ? ((R & ~31) + perm32(R & 31)) : R;
        voffA[i] = (unsigned)(R * g.lda + C) * 2u; voffB[i] = (unsigned)(Rb * g.ldb + C) * 2u; }
    const size_t kstep = (size_t)(BK * 2);
    const size_t hstepA = (size_t)HALF * g.lda * 2, hstepB = (size_t)HALF * g.ldb * 2;
    const unsigned ldsw = (unsigned)wid * 1024u;
    const int aoff = lds_byte(wr * 64 + fr, fq * 8), boff = lds_byte(wc * 32 + fr, fq * 8);
#define PG8_SA(b, h) (((b) * 2 + (h)) * HTB)
#define PG8_SB(b, h) ((4 + (b) * 2 + (h)) * HTB)
#define PG8_STAGE(bufoff, gbase, voff) do { _Pragma("unroll") for (int _i = 0; _i < 2; ++_i) \
        __builtin_amdgcn_global_load_lds((const unsigned*)((const char*)(gbase) + (voff)[_i]), (PG8_LAS unsigned*)(lds + (bufoff) + ldsw + _i * 8192), 16, 0, 0); } while (0)
#define PG8_LDA(dst, b, h) do { _Pragma("unroll") for (int m = 0; m < 4; ++m) _Pragma("unroll") for (int k = 0; k < 2; ++k) dst[m][k] = *(const PG8_LAS bf16x8*)(lds + PG8_SA(b, h) + aoff + m * 2048 + k * 1024); } while (0)
#define PG8_LDB(dst, b, h) do { _Pragma("unroll") for (int n = 0; n < 2; ++n) _Pragma("unroll") for (int k = 0; k < 2; ++k) dst[n][k] = *(const PG8_LAS bf16x8*)(lds + PG8_SB(b, h) + boff + n * 2048 + k * 1024); } while (0)
#define PG8_MMA(ai, bj, At, Bt) do { __builtin_amdgcn_s_setprio(1); _Pragma("unroll") for (int m = 0; m < 4; ++m) _Pragma("unroll") for (int n = 0; n < 2; ++n) _Pragma("unroll") for (int k = 0; k < 2; ++k) \
        acc[ai][bj][m][n] = __builtin_amdgcn_mfma_f32_16x16x32_bf16(Bt[n][k], At[m][k], acc[ai][bj][m][n], 0, 0, 0); __builtin_amdgcn_s_setprio(0); } while (0)
#define PG8_WAIT_V(n) asm volatile("s_waitcnt vmcnt(" #n ")" ::: "memory")
#define PG8_WAIT_L(n) asm volatile("s_waitcnt lgkmcnt(" #n ")" ::: "memory")
#define PG8_BAR __builtin_amdgcn_s_barrier()
#define PG8_SCHED __builtin_amdgcn_sched_barrier(0)
    Unit cur, nxt; int ui = 0;
    if (!S.next(0, cur)) return;
#ifndef GEMM_STAGGER_TICKS
#define GEMM_STAGGER_TICKS 0
#endif
    if (Epi::STAGGER_TICKS > 0) {
        const unsigned long long t0 = __builtin_amdgcn_s_memrealtime(), dl = (unsigned long long)((unsigned)blockIdx.x * (unsigned)Epi::STAGGER_TICKS / (unsigned)gridDim.x);
        while (__builtin_amdgcn_s_memrealtime() - t0 < dl) __builtin_amdgcn_s_sleep(8);
    }
    f32x4 acc[2][2][4][2];
#pragma unroll
    for (int a = 0; a < 2; ++a)
#pragma unroll
        for (int b = 0; b < 2; ++b)
#pragma unroll
            for (int m = 0; m < 4; ++m)
#pragma unroll
                for (int n = 0; n < 2; ++n) acc[a][b][m][n] = (f32x4){0.f, 0.f, 0.f, 0.f};
    bf16x8 At[4][2], B0[2][2], B1[2][2];
    const char* cA = g.aptr(cur); const char* cB = g.bptr(cur);
    S.a_ready(cur);
    PG8_STAGE(PG8_SB(0, 0), cB, voffB); PG8_STAGE(PG8_SA(0, 0), cA, voffA); PG8_STAGE(PG8_SB(0, 1), cB + hstepB, voffB); PG8_STAGE(PG8_SA(0, 1), cA + hstepA, voffA);
    if (wr == 1) PG8_BAR;
    PG8_WAIT_V(4); PG8_BAR;
    PG8_STAGE(PG8_SB(1, 0), cB + kstep, voffB); PG8_STAGE(PG8_SA(1, 0), cA + kstep, voffA); PG8_STAGE(PG8_SB(1, 1), cB + hstepB + kstep, voffB);
    PG8_WAIT_V(6); PG8_BAR;
    for (;;) {
        const bool has_next = S.next(ui + 1, nxt);
        const char* nA = has_next ? g.aptr(nxt) : cA; const char* nB = has_next ? g.bptr(nxt) : cB;
        for (int t = 0; t < nt; t += 2) {
            const bool last = (t == nt - 2);
            const char* a1 = cA + (size_t)(t + 1) * kstep;
            const char* a2 = last ? nA : cA + (size_t)(t + 2) * kstep; const char* b2 = last ? nB : cB + (size_t)(t + 2) * kstep;
            const char* a3 = a2 + kstep; const char* b3 = b2 + kstep;
            if (last && has_next) S.a_ready(nxt);
            PG8_LDB(B0, 0, 0); PG8_SCHED; PG8_LDA(At, 0, 0); PG8_STAGE(PG8_SA(1, 1), a1 + hstepA, voffA);
            PG8_WAIT_L(8); PG8_BAR; PG8_WAIT_L(0); PG8_MMA(0, 0, At, B0); PG8_BAR; PG8_SCHED;
            PG8_LDB(B1, 0, 1); PG8_STAGE(PG8_SB(0, 0), b2, voffB);
            PG8_BAR; PG8_WAIT_L(0); PG8_MMA(0, 1, At, B1); PG8_BAR;
            PG8_LDA(At, 0, 1); PG8_STAGE(PG8_SA(0, 0), a2, voffA);
            PG8_BAR; PG8_WAIT_L(0); PG8_MMA(1, 0, At, B0); PG8_BAR; PG8_SCHED;
            PG8_STAGE(PG8_SB(0, 1), b2 + hstepB, voffB);
            PG8_WAIT_V(6); PG8_BAR; PG8_MMA(1, 1, At, B1); PG8_BAR;
            PG8_LDB(B0, 1, 0); PG8_SCHED; PG8_LDA(At, 1, 0); PG8_STAGE(PG8_SA(0, 1), a2 + hstepA, voffA);
            PG8_WAIT_L(8); PG8_BAR; PG8_WAIT_L(0); PG8_MMA(0, 0, At, B0); PG8_BAR; PG8_SCHED;
            PG8_LDB(B1, 1, 1); PG8_STAGE(PG8_SB(1, 0), b3, voffB);
            PG8_BAR; PG8_WAIT_L(0); PG8_MMA(0, 1, At, B1); PG8_BAR;
            PG8_LDA(At, 1, 1); PG8_STAGE(PG8_SA(1, 0), a3, voffA);
            PG8_BAR; PG8_WAIT_L(0); PG8_MMA(1, 0, At, B0); PG8_BAR; PG8_SCHED;
            PG8_STAGE(PG8_SB(1, 1), b3 + hstepB, voffB);
            PG8_WAIT_V(6); PG8_BAR; PG8_MMA(1, 1, At, B1); PG8_BAR;
        }
            if constexpr (!Epi::AFTER_DRAIN) { E(acc, cur, wr, wc, fr, fq); S.done(cur); }
            if (!has_next) break;
#pragma unroll
        for (int a = 0; a < 2; ++a)
#pragma unroll
            for (int b = 0; b < 2; ++b)
#pragma unroll
                for (int m = 0; m < 4; ++m)
#pragma unroll
                    for (int n = 0; n < 2; ++n) acc[a][b][m][n] = (f32x4){0.f, 0.f, 0.f, 0.f};
        cur = nxt; cA = nA; cB = nB; ++ui;
    }
    PG8_WAIT_V(0);
    if (wr == 0) PG8_BAR;
    PG8_BAR;
    if constexpr (Epi::AFTER_DRAIN) { E.fused(acc, cur, wr, wc, fr, fq, lds, wid, lane); S.done(cur); }
#undef PG8_SA
#undef PG8_SB
#undef PG8_STAGE
#undef PG8_LDA
#undef PG8_LDB
#undef PG8_MMA
#undef PG8_WAIT_V
#undef PG8_WAIT_L
#undef PG8_BAR
#undef PG8_SCHED
}
}


namespace attn {
using bf16 = __hip_bfloat16;
constexpr int   D = 128, NW = 8, QBLK = 32, KVBLK = 64;
constexpr float SCALE = 0.088388347648318440f;
constexpr float THR = 8.f;
constexpr int SDEPTH = 1;
constexpr int LDQ = 5120, LDK = 5120, LDO = 2048;
constexpr size_t SHM_V = KVBLK * D * 2, SHM_K = KVBLK * D * 2, SHM_ATTN = 2 * SHM_V + 2 * SHM_K + NW * 64 * 4;
using bf16x8 = __attribute__((ext_vector_type(8))) short;
using s16x4  = __attribute__((ext_vector_type(4))) short;
using f32x16 = __attribute__((ext_vector_type(16))) float;
using f32x8  = __attribute__((ext_vector_type(8))) float;
using u32x4  = __attribute__((ext_vector_type(4))) unsigned;
#define KSWZ(row, colB) ((row) * 256 + ((colB) ^ (((row) & 7) << 4)))
#define SBAR() __builtin_amdgcn_sched_barrier(0)
__device__ __forceinline__ int crow(int r, int hi) { return (r & 3) + 8 * (r >> 2) + 4 * hi; }
__device__ __forceinline__ unsigned cvtpk(float lo, float hi) {
  unsigned r; asm volatile("v_cvt_pk_bf16_f32 %0, %1, %2" : "=v"(r) : "v"(lo), "v"(hi)); return r;
}
template <typename TIn> struct Stage;
template <> struct Stage<bf16>  { using T = bf16x8;
  __device__ static __forceinline__ T ld8(const bf16* p) { return *reinterpret_cast<const bf16x8*>(p); }
  __device__ static __forceinline__ bf16x8 tobf(T x) { return x; } };
template <> struct Stage<float> { using T = f32x8;
  __device__ static __forceinline__ T ld8(const float* p) { return *reinterpret_cast<const f32x8*>(p); }
  __device__ static __forceinline__ bf16x8 tobf(T x) {
    u32x4 w = {cvtpk(x[0], x[1]), cvtpk(x[2], x[3]), cvtpk(x[4], x[5]), cvtpk(x[6], x[7])}; return *reinterpret_cast<bf16x8*>(&w); } };

__device__ __forceinline__ void partialSM(f32x16& p0, f32x16& p1, float& m_reg, float& mn, float& alpha) {
  constexpr float C = SCALE * 1.4426950408889634f;
  float pmax = p0[0]; for (int r = 1; r < 16; ++r) pmax = fmaxf(pmax, p0[r]); for (int r = 0; r < 16; ++r) pmax = fmaxf(pmax, p1[r]);
  { auto rr = __builtin_amdgcn_permlane32_swap(__float_as_uint(pmax), __float_as_uint(pmax), false, false);
    pmax = fmaxf(__uint_as_float(rr[0]), __uint_as_float(rr[1])); }
  if (__builtin_expect(__all(pmax - m_reg <= THR / SCALE), 1)) { mn = m_reg; alpha = 1.f; }
  else { mn = fmaxf(m_reg, pmax); alpha = __builtin_amdgcn_exp2f((m_reg - mn) * C); m_reg = mn; }
  float mnC = -mn * C;
  for (int r = 0; r < 16; ++r) p0[r] = fmaf(p0[r], C, mnC); for (int r = 0; r < 16; ++r) p1[r] = fmaf(p1[r], C, mnC);
  for (int r = 0; r < 16; ++r) p0[r] = __builtin_amdgcn_exp2f(p0[r]);
}
__device__ __forceinline__ void finishSM(f32x16& p0, f32x16& p1, float alpha, float& l_reg, bf16x8& pa0, bf16x8& pa1, bf16x8& pa2, bf16x8& pa3) {
  for (int r = 0; r < 16; ++r) p1[r] = __builtin_amdgcn_exp2f(p1[r]);
  float ps = 0; for (int r = 0; r < 16; ++r) ps += p0[r]; for (int r = 0; r < 16; ++r) ps += p1[r];
  { auto rr = __builtin_amdgcn_permlane32_swap(__float_as_uint(ps), __float_as_uint(ps), false, false);
    ps = __uint_as_float(rr[0]) + __uint_as_float(rr[1]); }
  l_reg = l_reg * alpha + ps;
#define PK4(P, BASE, OUT) do { unsigned a0 = cvtpk(P[BASE + 0], P[BASE + 1]), a1 = cvtpk(P[BASE + 2], P[BASE + 3]);   \
    unsigned b0 = cvtpk(P[BASE + 4], P[BASE + 5]), b1 = cvtpk(P[BASE + 6], P[BASE + 7]);                              \
    auto r0 = __builtin_amdgcn_permlane32_swap(a0, b0, false, false); auto r1 = __builtin_amdgcn_permlane32_swap(a1, b1, false, false); \
    u32x4 w = {r0[0], r1[0], r0[1], r1[1]}; OUT = *reinterpret_cast<bf16x8*>(&w); } while (0)
  PK4(p0, 0, pa0); PK4(p0, 8, pa1); PK4(p1, 0, pa2); PK4(p1, 8, pa3);
#undef PK4
}
__device__ __forceinline__ void qkt(f32x16& p0, f32x16& p1, const bf16* Ks, const bf16x8* qr, int r32, int hi) {
  p0 = f32x16{}; p1 = f32x16{};
  for (int d0 = 0; d0 < 8; ++d0) { int cb = (d0 * 16 + hi * 8) * 2;
    bf16x8 b0 = *reinterpret_cast<const bf16x8*>((const char*)Ks + KSWZ(r32, cb));
    bf16x8 b1 = *reinterpret_cast<const bf16x8*>((const char*)Ks + KSWZ(32 + r32, cb));
    p0 = __builtin_amdgcn_mfma_f32_32x32x16_bf16(b0, qr[d0], p0, 0, 0, 0);
    p1 = __builtin_amdgcn_mfma_f32_32x32x16_bf16(b1, qr[d0], p1, 0, 0, 0); }
}
__device__ __forceinline__ int v_st(int k, int c) { const int kk = (k & ~0xC) | ((k & 4) << 1) | ((k & 8) >> 1); return ((kk >> 3) * 4 + (c >> 5)) * 512 + ((kk & 7) * 32 + (c & 31)) * 2; }
__device__ __forceinline__ int v_rd_base(int lane) { return ((lane & 3) << 3) | (((lane >> 2) & 3) << 6) | (((lane >> 4) & 1) << 5) | (((lane >> 5) & 1) << 8); }
constexpr int v_rd_off(int d0, int ks, int half) { return d0 * 512 + ks * 4096 + half * 2048; }
template <int OFF> __device__ __forceinline__ s16x4 tr_read(int vb) {
  s16x4 r; asm volatile("ds_read_b64_tr_b16 %0, %1 offset:%2" : "=&v"(r) : "v"(vb), "i"(OFF) : "memory"); return r;
}
template <int D0> __device__ __forceinline__ void pv_one(f32x16& od, int vb, bf16x8 pa0, bf16x8 pa1, bf16x8 pa2, bf16x8 pa3) {
  const s16x4 l0 = tr_read<v_rd_off(D0, 0, 0)>(vb), h0 = tr_read<v_rd_off(D0, 0, 1)>(vb), l1 = tr_read<v_rd_off(D0, 1, 0)>(vb), h1 = tr_read<v_rd_off(D0, 1, 1)>(vb);
  const s16x4 l2 = tr_read<v_rd_off(D0, 2, 0)>(vb), h2 = tr_read<v_rd_off(D0, 2, 1)>(vb), l3 = tr_read<v_rd_off(D0, 3, 0)>(vb), h3 = tr_read<v_rd_off(D0, 3, 1)>(vb);
  asm volatile("s_waitcnt lgkmcnt(0)" ::: "memory"); SBAR();
#define PK(L, H) (bf16x8){L[0], L[1], L[2], L[3], H[0], H[1], H[2], H[3]}
  od = __builtin_amdgcn_mfma_f32_32x32x16_bf16(pa0, PK(l0, h0), od, 0, 0, 0);
  od = __builtin_amdgcn_mfma_f32_32x32x16_bf16(pa1, PK(l1, h1), od, 0, 0, 0);
  od = __builtin_amdgcn_mfma_f32_32x32x16_bf16(pa2, PK(l2, h2), od, 0, 0, 0);
  od = __builtin_amdgcn_mfma_f32_32x32x16_bf16(pa3, PK(l3, h3), od, 0, 0, 0);
#undef PK
}
__device__ __forceinline__ void pv_d0(f32x16* o, int vb, bf16x8 pa0, bf16x8 pa1, bf16x8 pa2, bf16x8 pa3) {
  pv_one<0>(o[0], vb, pa0, pa1, pa2, pa3); pv_one<1>(o[1], vb, pa0, pa1, pa2, pa3); pv_one<2>(o[2], vb, pa0, pa1, pa2, pa3); pv_one<3>(o[3], vb, pa0, pa1, pa2, pa3);
}

template <typename TQ>
__device__ __forceinline__ void attn_dense_body(const TQ* __restrict__ Qb, const bf16* __restrict__ Kh, const bf16* __restrict__ Vh,
                                                const unsigned short* __restrict__ Gb, unsigned short* __restrict__ Ob, int seq, char* lds, int koff,
                                                const float* __restrict__ qgain, const float* __restrict__ rcos, const float* __restrict__ rsin, int tpos0) {
  using St = Stage<bf16>; using SQ = Stage<TQ>;
  const int tid = opaque_tid(), wid = tid >> 6, lane = tid & 63, r32 = lane & 31, hi = lane >> 5;
  bf16* V_lds = (bf16*)lds; bf16* K_lds = (bf16*)(lds + 2 * SHM_V);
  float* ws = (float*)(lds + 2 * SHM_V + 2 * SHM_K) + wid * 64; float* li_l = ws; float* al_l = ws + 32;
  float m_reg = -1e30f, l_reg = 0; f32x16 o[4] = {}; bf16x8 qr[8];
  const TQ* Qw = Qb + (long)(wid * QBLK + r32) * LDQ + hi * 8;
#pragma unroll
  for (int d0 = 0; d0 < 8; ++d0) qr[d0] = SQ::tobf(SQ::ld8(Qw + d0 * 16));
  {
    float ss = 0.f;
#pragma unroll
    for (int d0 = 0; d0 < 8; ++d0) { const u32x4 w = *reinterpret_cast<const u32x4*>(&qr[d0]);
      const float a0 = __uint_as_float(w.x << 16), a1 = __uint_as_float(w.x & 0xffff0000u), a2 = __uint_as_float(w.y << 16), a3 = __uint_as_float(w.y & 0xffff0000u);
      const float a4 = __uint_as_float(w.z << 16), a5 = __uint_as_float(w.z & 0xffff0000u), a6 = __uint_as_float(w.w << 16), a7 = __uint_as_float(w.w & 0xffff0000u);
      ss += (a0 * a0 + a1 * a1) + (a2 * a2 + a3 * a3) + (a4 * a4 + a5 * a5) + (a6 * a6 + a7 * a7); }
    ss += __shfl_xor(ss, 32);
    const float rstd = __builtin_amdgcn_rsqf(ss * (1.f / 128.f) + 1e-6f);
    const int tp = tpos0 + wid * QBLK + r32; const float* cp = rcos + (long)tp * 64 + hi * 4; const float* sp = rsin + (long)tp * 64 + hi * 4; const float* gp = qgain + hi * 8;
#pragma unroll
    for (int d0 = 0; d0 < 8; ++d0) { const u32x4 w = *reinterpret_cast<const u32x4*>(&qr[d0]);
      const float4 g0 = *reinterpret_cast<const float4*>(gp + d0 * 16), g1 = *reinterpret_cast<const float4*>(gp + d0 * 16 + 4), c4 = *reinterpret_cast<const float4*>(cp + d0 * 8), s4 = *reinterpret_cast<const float4*>(sp + d0 * 8);
      const float y0 = __uint_as_float(w.x << 16) * rstd * g0.x, y1 = __uint_as_float(w.x & 0xffff0000u) * rstd * g0.y, y2 = __uint_as_float(w.y << 16) * rstd * g0.z, y3 = __uint_as_float(w.y & 0xffff0000u) * rstd * g0.w;
      const float y4 = __uint_as_float(w.z << 16) * rstd * g1.x, y5 = __uint_as_float(w.z & 0xffff0000u) * rstd * g1.y, y6 = __uint_as_float(w.w << 16) * rstd * g1.z, y7 = __uint_as_float(w.w & 0xffff0000u) * rstd * g1.w;
      u32x4 o = {cvtpk(y0 * c4.x - y1 * s4.x, y0 * s4.x + y1 * c4.x), cvtpk(y2 * c4.y - y3 * s4.y, y2 * s4.y + y3 * c4.y), cvtpk(y4 * c4.z - y5 * s4.z, y4 * s4.z + y5 * c4.z), cvtpk(y6 * c4.w - y7 * s4.w, y6 * s4.w + y7 * c4.w)};
      qr[d0] = *reinterpret_cast<bf16x8*>(&o); }
  }
  const int sr = tid >> 4, sc = (tid & 15) * 8, vst0 = v_st(sr, sc), vst1 = v_st(32 + sr, sc);
  const int vb0 = (int)(uintptr_t)V_lds + v_rd_base(lane);
  struct { typename St::T vs0, vs1, ks0, ks1; } sr_[SDEPTH];
#define SLOAD(i, k0) do { const int kk_ = ((k0) + koff) & (seq - 1); sr_[i].vs0 = St::ld8(&Vh[(long)(kk_ + sr) * LDK + sc]); sr_[i].vs1 = St::ld8(&Vh[(long)(kk_ + 32 + sr) * LDK + sc]); \
    sr_[i].ks0 = St::ld8(&Kh[(long)(kk_ + sr) * LDK + sc]); sr_[i].ks1 = St::ld8(&Kh[(long)(kk_ + 32 + sr) * LDK + sc]); } while (0)
#define SWRITE(b, i) do { *(bf16x8*)((char*)V_lds + (b) * SHM_V + vst0) = St::tobf(sr_[i].vs0);          \
    *(bf16x8*)((char*)V_lds + (b) * SHM_V + vst1) = St::tobf(sr_[i].vs1); int kc = sc * 2;               \
    *(bf16x8*)((char*)K_lds + (b) * SHM_K + KSWZ(sr, kc)) = St::tobf(sr_[i].ks0);                       \
    *(bf16x8*)((char*)K_lds + (b) * SHM_K + KSWZ(32 + sr, kc)) = St::tobf(sr_[i].ks1); } while (0)
#define SWAIT() do { if constexpr (SDEPTH == 2) asm volatile("s_waitcnt vmcnt(4)" ::: "memory"); else asm volatile("s_waitcnt vmcnt(0)" ::: "memory"); } while (0)
#define RESC(a) do { if (__any((a) < 1.f)) { if (hi == 0) al_l[r32] = (a); asm volatile("s_waitcnt lgkmcnt(0)" ::: "memory"); \
    for (int d = 0; d < 4; ++d) for (int r = 0; r < 16; ++r) o[d][r] *= al_l[crow(r, hi)]; } } while (0)
  f32x16 pA0, pA1, pB0, pB1; float mnA, mnB, alA, alB; bf16x8 pa0, pa1, pa2, pa3; const int NT = seq / KVBLK;
  constexpr int SE = 0, SO = SDEPTH - 1;
  SLOAD(SE, 0); asm volatile("s_waitcnt vmcnt(0)" ::: "memory"); SWRITE(0, SE); __syncthreads();
  qkt(pA0, pA1, K_lds, qr, r32, hi); partialSM(pA0, pA1, m_reg, mnA, alA);
  SLOAD(SO, KVBLK); if constexpr (SDEPTH == 2) { if (2 < NT) SLOAD(SE, 2 * KVBLK); }
  SWAIT(); SWRITE(1, SO); __syncthreads();
  for (int j = 1; j + 1 < NT; j += 2) {
    SBAR(); qkt(pB0, pB1, (bf16*)((char*)K_lds + SHM_K), qr, r32, hi);
    finishSM(pA0, pA1, alA, l_reg, pa0, pa1, pa2, pa3); SBAR();
    SLOAD(SO, (j + SDEPTH) * KVBLK); SBAR();
    pv_d0(o, vb0, pa0, pa1, pa2, pa3); partialSM(pB0, pB1, m_reg, mnB, alB);
    __syncthreads(); SWAIT(); SWRITE(0, SE);
    RESC(alB); __syncthreads();
    SBAR(); qkt(pA0, pA1, K_lds, qr, r32, hi);
    finishSM(pB0, pB1, alB, l_reg, pa0, pa1, pa2, pa3); SBAR();
    if (SDEPTH == 1 || j + 3 < NT) SLOAD(SE, (j + 1 + SDEPTH) * KVBLK); SBAR();
    pv_d0(o, vb0 + (int)SHM_V, pa0, pa1, pa2, pa3); partialSM(pA0, pA1, m_reg, mnA, alA);
    __syncthreads(); SWAIT(); SWRITE(1, SO);
    RESC(alA); __syncthreads();
  }
  SBAR(); qkt(pB0, pB1, (bf16*)((char*)K_lds + SHM_K), qr, r32, hi);
  finishSM(pA0, pA1, alA, l_reg, pa0, pa1, pa2, pa3); SBAR();
  pv_d0(o, vb0, pa0, pa1, pa2, pa3); partialSM(pB0, pB1, m_reg, mnB, alB);
  __syncthreads(); RESC(alB);
  finishSM(pB0, pB1, alB, l_reg, pa0, pa1, pa2, pa3); SBAR();
  pv_d0(o, vb0 + (int)SHM_V, pa0, pa1, pa2, pa3);
  if (hi == 0) li_l[r32] = l_reg; asm volatile("s_waitcnt lgkmcnt(0)" ::: "memory");
  float rli[16];
#pragma unroll
  for (int r = 0; r < 16; ++r) rli[r] = __builtin_amdgcn_rcpf(li_l[crow(r, hi)]);
  unsigned short* Ow = Ob + (long)(wid * QBLK) * LDO + r32; const unsigned short* Gw = Gb + (long)(wid * QBLK) * LDQ + r32;
  unsigned short gq[16][4];
#pragma unroll
  for (int r = 0; r < 16; ++r) { const unsigned short* gp = Gw + (long)crow(r, hi) * LDQ;
#pragma unroll
    for (int d0 = 0; d0 < 4; ++d0) gq[r][d0] = gp[d0 * 32]; }
#pragma unroll
  for (int r = 0; r < 16; ++r) { unsigned short* op = Ow + (long)crow(r, hi) * LDO;
#pragma unroll
    for (int d0 = 0; d0 < 4; ++d0) { const float gv = __uint_as_float(((unsigned)gq[r][d0]) << 16);
      const float sg = gv * __builtin_amdgcn_rcpf(1.f + __builtin_amdgcn_exp2f(-1.4426950408889634f * gv));
      const float val = o[d0][r] * rli[r] * sg; unsigned u = __float_as_uint(val); u += 0x7fffu + ((u >> 16) & 1u);
      op[d0 * 32] = (unsigned short)(u >> 16); } }
#undef SLOAD
#undef SWRITE
#undef SWAIT
#undef RESC
}
}

struct Args {
    const float *x, *c, *w_mod, *b_mod, *pool_w_in, *pool_w_grp, *pool_scale, *pool_w_out;
    const float *gla_w_in, *gla_fwd_w1, *gla_fwd_w2, *gla_fwd_b, *gla_bwd_w1, *gla_bwd_w2, *gla_bwd_b, *gla_norm_g, *gla_w_out;
    const float *attn_w_in, *attn_qg, *attn_kg, *attn_w_out, *final_g;
    float* out; unsigned char* ws;
};
#define LDS_WAIT() asm volatile("s_waitcnt lgkmcnt(0)" ::: "memory")

__device__ __forceinline__ void transpose_item(const float* W, int K, int N, bf16_t* WT, int row_off, LAS float* scr, int item, int lane, int ldw = 0) {
    const int nblk = N / 32, kb = item / nblk, nb = item % nblk, k0 = 64 * kb, n0 = 32 * nb; if (ldw == 0) ldw = N;
    float wv[32];
#pragma unroll
    for (int i = 0; i < 32; ++i) wv[i] = W[(size_t)(k0 + 2 * i + (lane >> 5)) * ldw + n0 + (lane & 31)];
#pragma unroll
    for (int i = 0; i < 32; ++i) scr[(2 * i + (lane >> 5)) * 33 + (lane & 31)] = wv[i];
    LDS_WAIT();
    const int c = lane & 7;
#pragma unroll
    for (int j = 0; j < 4; ++j) { const int n = (lane >> 3) + 8 * j; const LAS float* s = scr + (8 * c) * 33 + n;
        u32x4 o; o.x = cvt_pk_bf16(s[0 * 33], s[1 * 33]); o.y = cvt_pk_bf16(s[2 * 33], s[3 * 33]); o.z = cvt_pk_bf16(s[4 * 33], s[5 * 33]); o.w = cvt_pk_bf16(s[6 * 33], s[7 * 33]);
        *(u32x4*)(WT + (size_t)(row_off + n0 + n) * K + k0 + 8 * c) = o; }
    LDS_WAIT();
}
__device__ __forceinline__ void phase_weights(const Args& a, int L, LAS unsigned char* lds) {
    const int tid_ = opaque_tid(), lane = tid_ & 63, wave = __builtin_amdgcn_readfirstlane(tid_ >> 6), gw = blockIdx.x * 8 + wave, NGW = gridDim.x * 8; (void)wave; (void)gw; (void)NGW; (void)lane;
    LAS float* scr = (LAS float*)(lds + wave * 8704);
    bf16_t* WB = (bf16_t*)(a.ws + WS_WB); bf16_t* WBG = (bf16_t*)(a.ws + WS_WB + 16 * MiB); bf16_t* WBO = (bf16_t*)(a.ws + WS_WB + 24 * MiB);
    const int kind = L % 3, j = L / 3;
    if (kind == 0) {
        const float* win = a.pool_w_in + (size_t)j * 2048 * 4096; const float* wgrp = a.pool_w_grp + (size_t)j * 4 * 512 * 512; const float* wout = a.pool_w_out + (size_t)j * 2048 * 2048;
        constexpr int I_IN = 32 * 64, I_G = 8 * 16, I_OUT = 32 * 64;
        { bf16_t* WBU = (bf16_t*)(a.ws + WS_QKK + 300 * MiB);
#pragma clang loop unroll(disable)
          for (int base = gw * 64; base < 2048 * 256; base += NGW * 64) { const int i = base + lane, k = i >> 8, c8 = (i & 255) * 8;
              const f32x4 v0 = *(const f32x4*)(win + (size_t)k * 4096 + c8), v1 = *(const f32x4*)(win + (size_t)k * 4096 + c8 + 4);
              u32x4 o; o.x = cvt_pk_bf16(v0[0], v0[1]); o.y = cvt_pk_bf16(v0[2], v0[3]); o.z = cvt_pk_bf16(v1[0], v1[1]); o.w = cvt_pk_bf16(v1[2], v1[3]);
              *(u32x4*)(WBU + (size_t)k * 2048 + c8) = o; } }
        for (int it = gw; it < I_IN + 4 * I_G + I_OUT; it += NGW) {
            int r = it;
            if (r < I_IN) { transpose_item(win + 2048, 2048, 2048, WB, 2048, scr, r, lane, 4096); continue; } r -= I_IN;
            if (r < 4 * I_G) { const int g = r / I_G; transpose_item(wgrp + (size_t)g * 512 * 512, 512, 512, WBG, g * 512, scr, r % I_G, lane); continue; } r -= 4 * I_G;
            transpose_item(wout, 2048, 2048, WBO, 0, scr, r, lane);
        }
    } else if (kind == 1) {
        constexpr int I_IN = 32 * 192, I_OUT = 32 * 64;
        for (int it = gw; it < I_IN + I_OUT; it += NGW) {
            int r = it;
            if (r < I_IN) { transpose_item(a.gla_w_in, 2048, 6144, WB, 0, scr, r, lane); continue; } r -= I_IN;
            transpose_item(a.gla_w_out, 2048, 2048, WBO, 0, scr, r, lane);
        }
        bf16_t* W1T = (bf16_t*)(a.ws + WS_W1T);
#pragma clang loop unroll(disable)
        for (int base = gw * 64; base < 32 * 2048; base += NGW * 64) { const int i = base + lane, n = i >> 11, k = i & 2047;
            W1T[i] = f2bf(n < 16 ? a.gla_fwd_w1[k * 16 + n] : a.gla_bwd_w1[k * 16 + n - 16]); }
    } else {
        constexpr int I_IN = 32 * 160, I_OUT = 32 * 64;
        for (int it = gw; it < I_IN + I_OUT; it += NGW) {
            int r = it;
            if (r < I_IN) { transpose_item(a.attn_w_in, 2048, 5120, WB, 0, scr, r, lane); continue; } r -= I_IN;
            transpose_item(a.attn_w_out, 2048, 2048, WBO, 0, scr, r, lane);
        }
    }
}
#define ROWS2_LOAD(V, xp, mm) do { _Pragma("unroll") for (int r_ = 0; r_ < 2; ++r_) { const f32x4* xr_ = (const f32x4*)((xp) + (size_t)((mm) + r_ * NGW) * DM) + lane; \
        _Pragma("unroll") for (int j_ = 0; j_ < 8; ++j_) V[r_][j_] = xr_[64 * j_]; } } while (0)
#define ROWS2_SS(V, s) do { _Pragma("unroll") for (int r_ = 0; r_ < 2; ++r_) { float t_ = 0.f; \
        _Pragma("unroll") for (int j_ = 0; j_ < 8; ++j_) t_ += (V[r_][j_].x * V[r_][j_].x + V[r_][j_].y * V[r_][j_].y) + (V[r_][j_].z * V[r_][j_].z + V[r_][j_].w * V[r_][j_].w); s[r_] = t_; } } while (0)
#define ROWS2C_LOAD(V, xp, mm) do { _Pragma("unroll") for (int r_ = 0; r_ < 2; ++r_) { const f32x4* xr_ = (const f32x4*)((xp) + (size_t)((mm) + r_) * DM) + lane; \
        _Pragma("unroll") for (int j_ = 0; j_ < 8; ++j_) V[r_][j_] = xr_[64 * j_]; } } while (0)
__device__ __forceinline__ void phase_norm_mod(const float* x, const float* modL, bf16_t* hb) {
    const int tid_ = opaque_tid(), lane = tid_ & 63, wave = __builtin_amdgcn_readfirstlane(tid_ >> 6), gw = blockIdx.x * 8 + wave, NGW = gridDim.x * 8;
#define NM_PROC(V, mm) do { float s_[2]; ROWS2_SS(V, s_); \
        _Pragma("unroll") for (int r = 0; r < 2; ++r) { const int mr = (mm) + r; const float rstd = __builtin_amdgcn_rsqf(wave_sum(s_[r]) * (1.f / DM) + NEPS); \
            u32x2* o8 = (u32x2*)(hb + (size_t)mr * DM) + lane; \
            _Pragma("unroll") for (int j = 0; j < 8; ++j) { const f32x4 h = V[r][j] * rstd * sc1[j] + sh[j]; u32x2 w; w.x = cvt_pk_bf16(h.x, h.y); w.y = cvt_pk_bf16(h.z, h.w); o8[64 * j] = w; } } } while (0)
    for (int g16 = gw; g16 < MTOK / 16; g16 += NGW) {
        const int m0 = g16 * 16; const float* mp = modL + (size_t)(m0 / SEQ) * 6144;
        f32x4 va[2][8], vb[2][8], sh[8], sc1[8];
        ROWS2C_LOAD(va, x, m0);
#pragma unroll
        for (int j = 0; j < 8; ++j) { sh[j] = *((const f32x4*)mp + lane + 64 * j); sc1[j] = *((const f32x4*)(mp + 2048) + lane + 64 * j) + 1.f; }
#pragma unroll 1
        for (int i = 0; i < 16; i += 4) {
            ROWS2C_LOAD(vb, x, m0 + i + 2);
            NM_PROC(va, m0 + i);
            if (i + 4 < 16) ROWS2C_LOAD(va, x, m0 + i + 4);
            NM_PROC(vb, m0 + i + 2);
        }
    }
#undef NM_PROC
}
__device__ __forceinline__ void phase_norm_mod_bf(const bf16_t* xb, const float* modL, bf16_t* hb) {
    const int tid_ = opaque_tid(), lane = tid_ & 63, wave = __builtin_amdgcn_readfirstlane(tid_ >> 6), gw = blockIdx.x * 8 + wave, NGW = gridDim.x * 8;
    for (int g16 = gw; g16 < MTOK / 16; g16 += NGW) {
        const int m0 = g16 * 16; const float* mp = modL + (size_t)(m0 / SEQ) * 6144;
        u32x4 va[2][4], vb[2][4]; f32x4 sh[4][2], sc1[4][2];
#define NB_LOAD(V, mm) do { _Pragma("unroll") for (int r_ = 0; r_ < 2; ++r_) { const u32x4* xr_ = (const u32x4*)(xb + (size_t)((mm) + r_) * DM) + lane; \
        _Pragma("unroll") for (int j_ = 0; j_ < 4; ++j_) V[r_][j_] = xr_[64 * j_]; } } while (0)
#define NB_PROC(V, mm) do { _Pragma("unroll") for (int r = 0; r < 2; ++r) { float f[4][8]; float s = 0.f; \
        _Pragma("unroll") for (int j = 0; j < 4; ++j) { const u32x4 w = V[r][j]; f[j][0] = bf_lo(w.x); f[j][1] = bf_hi(w.x); f[j][2] = bf_lo(w.y); f[j][3] = bf_hi(w.y); f[j][4] = bf_lo(w.z); f[j][5] = bf_hi(w.z); f[j][6] = bf_lo(w.w); f[j][7] = bf_hi(w.w); \
            _Pragma("unroll") for (int q = 0; q < 8; ++q) s += f[j][q] * f[j][q]; } \
        const float rstd = __builtin_amdgcn_rsqf(wave_sum(s) * (1.f / DM) + NEPS); u32x4* o16 = (u32x4*)(hb + (size_t)((mm) + r) * DM) + lane; \
        _Pragma("unroll") for (int j = 0; j < 4; ++j) { u32x4 w; \
            w.x = cvt_pk_bf16(f[j][0] * rstd * sc1[j][0][0] + sh[j][0][0], f[j][1] * rstd * sc1[j][0][1] + sh[j][0][1]); w.y = cvt_pk_bf16(f[j][2] * rstd * sc1[j][0][2] + sh[j][0][2], f[j][3] * rstd * sc1[j][0][3] + sh[j][0][3]); \
            w.z = cvt_pk_bf16(f[j][4] * rstd * sc1[j][1][0] + sh[j][1][0], f[j][5] * rstd * sc1[j][1][1] + sh[j][1][1]); w.w = cvt_pk_bf16(f[j][6] * rstd * sc1[j][1][2] + sh[j][1][2], f[j][7] * rstd * sc1[j][1][3] + sh[j][1][3]); \
            o16[64 * j] = w; } } } while (0)
        NB_LOAD(va, m0);
#pragma unroll
        for (int j = 0; j < 4; ++j)
#pragma unroll
            for (int q = 0; q < 2; ++q) { sh[j][q] = *(const f32x4*)(mp + (lane + 64 * j) * 8 + 4 * q); sc1[j][q] = *(const f32x4*)(mp + 2048 + (lane + 64 * j) * 8 + 4 * q) + 1.f; }
#pragma unroll 1
        for (int i = 0; i < 16; i += 4) {
            NB_LOAD(vb, m0 + i + 2);
            NB_PROC(va, m0 + i);
            if (i + 4 < 16) NB_LOAD(va, m0 + i + 4);
            NB_PROC(vb, m0 + i + 2);
        }
#undef NB_LOAD
#undef NB_PROC
    }
}
__device__ __forceinline__ void phase_final_norm(const float* x, const float* g, float* outp) {
    const int tid_ = opaque_tid(), lane = tid_ & 63, wave = __builtin_amdgcn_readfirstlane(tid_ >> 6), gw = blockIdx.x * 8 + wave, NGW = gridDim.x * 8;
    f32x4 gg[8];
#pragma unroll
    for (int j = 0; j < 8; ++j) gg[j] = *((const f32x4*)g + lane + 64 * j);
#define FN_PROC(V, mm) do { float s_[2]; ROWS2_SS(V, s_); \
        _Pragma("unroll") for (int r = 0; r < 2; ++r) { f32x4* xr = (f32x4*)(outp + (size_t)((mm) + r) * DM) + lane; const float rstd = __builtin_amdgcn_rsqf(wave_sum(s_[r]) * (1.f / DM) + NEPS); \
            _Pragma("unroll") for (int j = 0; j < 8; ++j) xr[64 * j] = V[r][j] * rstd * gg[j]; } } while (0)
    for (int g16 = gw; g16 < MTOK / 16; g16 += NGW) {
        const int m0 = g16 * 16;
        f32x4 va[2][8], vb[2][8];
        ROWS2C_LOAD(va, x, m0);
#pragma unroll 1
        for (int i = 0; i < 16; i += 4) {
            ROWS2C_LOAD(vb, x, m0 + i + 2);
            FN_PROC(va, m0 + i);
            if (i + 4 < 16) ROWS2C_LOAD(va, x, m0 + i + 4);
            FN_PROC(vb, m0 + i + 2);
        }
    }
#undef FN_PROC
}
__device__ __forceinline__ void phase_mod(const Args& a, LAS unsigned char* lds, float* mod) {
    LAS float* sc = (LAS float*)lds; LAS float* part = (LAS float*)(lds + 32768);
    const int tid = opaque_tid();
    if ((int)blockIdx.x >= 192) return;
    for (int i = tid; i < 8192; i += 512) sc[i] = silu_f(a.c[i]);
    __syncthreads();
    for (int item = blockIdx.x; item < 192; item += gridDim.x) {
        const int layer = item / 48, n0 = (item % 48) * 128, ks = tid >> 5, cq = tid & 31;
        f32x4 acc[4];
#pragma unroll
        for (int b = 0; b < 4; ++b) acc[b] = (f32x4){0.f, 0.f, 0.f, 0.f};
        const float* wp = a.w_mod + ((size_t)layer * 2048 + ks * 128) * 6144 + n0 + cq * 4;
#pragma unroll 1
        for (int k0 = 0; k0 < 128; k0 += 16) {
            f32x4 wv[16];
#pragma unroll
            for (int q = 0; q < 16; ++q) wv[q] = *(const f32x4*)(wp + (size_t)(k0 + q) * 6144);
#pragma unroll
            for (int q = 0; q < 16; ++q) { const int kk = ks * 128 + k0 + q;
#pragma unroll
                for (int b = 0; b < 4; ++b) acc[b] += wv[q] * sc[b * 2048 + kk]; } }
#pragma unroll
        for (int b = 0; b < 4; ++b) *(LAS f32x4*)(part + (ks * 4 + b) * 128 + cq * 4) = acc[b];
        __syncthreads();
        { const int b = tid >> 7, col = tid & 127; float s = a.b_mod[layer * 6144 + n0 + col];
#pragma unroll
          for (int q = 0; q < 16; ++q) s += part[(q * 4 + b) * 128 + col];
          mod[(size_t)(layer * 4 + b) * 6144 + n0 + col] = s; }
        __syncthreads();
    }
}
__device__ __forceinline__ void phase_rope_table(float* rc, float* rs) {
#pragma clang loop unroll(disable)
    for (int idx = blockIdx.x * 512 + opaque_tid(); idx < SEQ * 64; idx += gridDim.x * 512) {
        const int t = idx >> 6, i = idx & 63;
        const float pos = (i < 32) ? (float)((t >> 6) - 64) : (float)((t & 63) - 32);
        const float inv = __builtin_amdgcn_exp2f(-(float)(i & 31) * 0.41524101186092029f);
        const float ang = pos * inv;
        const double xd = (double)ang; const double n = __builtin_rint(xd * 0.63661977236758134); const float rf = (float)(xd - n * 1.5707963267948966);
        const int q = ((int)n) & 3; const float r2 = rf * rf;
        const float sn = rf + rf * r2 * (-1.6666667e-1f + r2 * (8.3333333e-3f + r2 * (-1.9841270e-4f + r2 * 2.7557319e-6f)));
        const float cs = 1.f + r2 * (-0.5f + r2 * (4.1666667e-2f + r2 * (-1.3888889e-3f + r2 * (2.4801587e-5f + r2 * -2.7557319e-7f))));
        const float co = (q == 0) ? cs : (q == 1) ? -sn : (q == 2) ? -cs : sn;
        const float si = (q == 0) ? sn : (q == 1) ? cs : (q == 2) ? -sn : -cs;
        rc[idx] = co; rs[idx] = si;
    }
}
__device__ __forceinline__ void acc8(float (&s)[8], const u32x4 w, const float f) {
    s[0] += f * bf_lo(w.x); s[1] += f * bf_hi(w.x); s[2] += f * bf_lo(w.y); s[3] += f * bf_hi(w.y); s[4] += f * bf_lo(w.z); s[5] += f * bf_hi(w.z); s[6] += f * bf_lo(w.w); s[7] += f * bf_hi(w.w); }
__device__ __forceinline__ void phase_pool(const bf16_t* proj  , bf16_t* yout, const float* scale) {
    const int tid_ = opaque_tid(), lane = tid_ & 63, wave = __builtin_amdgcn_readfirstlane(tid_ >> 6), gw = blockIdx.x * 8 + wave, NGW = gridDim.x * 8;
    for (int unit = gw; unit < (MTOK / 64) * 4; unit += NGW) {
        const int run = unit >> 2, j = unit & 3, half = 1 << j, m0 = run * 64, t0 = m0 & (SEQ - 1), c = (j * 64 + lane) * 8;
        const bf16_t* base = proj + (size_t)(m0 - t0) * 4096 + c; bf16_t* outp = yout + (size_t)(m0 - t0) * 2048 + c;
        const f32x4 sc0 = *(const f32x4*)(scale + c), sc1 = *(const f32x4*)(scale + c + 4);
        float S[8];
#pragma unroll
        for (int q = 0; q < 8; ++q) S[q] = 0.f;
        { u32x4 wi[16]; float fi[16];
#pragma unroll
          for (int q = 0; q < 16; ++q) { const int r = t0 - half + q, rc2 = r < 0 ? 0 : (r >= SEQ ? SEQ - 1 : r); fi[q] = (q < 2 * half && r >= 0 && r < SEQ) ? 1.f : 0.f; wi[q] = *(const u32x4*)(base + (size_t)rc2 * 4096); }
#pragma unroll
          for (int q = 0; q < 16; ++q) acc8(S, wi[q], fi[q]); }
#pragma unroll 8
        for (int tt = 0; tt < 64; ++tt) {
            const int t = t0 + tt, lo = (t - half) > 0 ? (t - half) : 0, hi = (t + half) < SEQ ? (t + half) : SEQ;
            const int ra = (t + half) < SEQ ? (t + half) : (SEQ - 1), rs = (t - half) > 0 ? (t - half) : 0;
            const float fa = (t + half) < SEQ ? 1.f : 0.f, fs = (t - half) >= 0 ? -1.f : 0.f;
            const u32x4 u = *(const u32x4*)(base + (size_t)t * 4096), wa = *(const u32x4*)(base + (size_t)ra * 4096), ws = *(const u32x4*)(base + (size_t)rs * 4096), g = *(const u32x4*)(base + (size_t)t * 4096 + 2048);
            const float ic = 1.f / (float)(hi - lo);
            u32x4 o; o.x = cvt_pk_bf16((S[0] * ic - bf_lo(u.x)) * sc0[0] * silu_f(bf_lo(g.x)), (S[1] * ic - bf_hi(u.x)) * sc0[1] * silu_f(bf_hi(g.x)));
            o.y = cvt_pk_bf16((S[2] * ic - bf_lo(u.y)) * sc0[2] * silu_f(bf_lo(g.y)), (S[3] * ic - bf_hi(u.y)) * sc0[3] * silu_f(bf_hi(g.y)));
            o.z = cvt_pk_bf16((S[4] * ic - bf_lo(u.z)) * sc1[0] * silu_f(bf_lo(g.z)), (S[5] * ic - bf_hi(u.z)) * sc1[1] * silu_f(bf_hi(g.z)));
            o.w = cvt_pk_bf16((S[6] * ic - bf_lo(u.w)) * sc1[2] * silu_f(bf_lo(g.w)), (S[7] * ic - bf_hi(u.w)) * sc1[3] * silu_f(bf_hi(g.w)));
            *(u32x4*)(outp + (size_t)t * 2048) = o;
            acc8(S, wa, fa); acc8(S, ws, fs);
        }
    }
}
__device__ __forceinline__ void phase_knorm_rope(bf16_t* proj, const float* kg, const float* rc, const float* rs) {
    const int tid_ = opaque_tid(), lane = tid_ & 63, wave = __builtin_amdgcn_readfirstlane(tid_ >> 6), gw = blockIdx.x * 8 + wave, NGW = gridDim.x * 8;
    const float k0 = kg[2 * lane], k1 = kg[2 * lane + 1];
    for (int m = gw; m < MTOK; m += 2 * NGW) {
        unsigned w[2][4]; float co[2], si[2];
#pragma unroll
        for (int r = 0; r < 2; ++r) { const int mm = m + r * NGW, t = mm & (SEQ - 1); co[r] = rc[t * 64 + lane]; si[r] = rs[t * 64 + lane];
            const unsigned* row = (const unsigned*)(proj + (size_t)mm * 5120 + 2048) + lane;
#pragma unroll
            for (int h = 0; h < 4; ++h) w[r][h] = row[h * 64]; }
#pragma unroll
        for (int r = 0; r < 2; ++r) { unsigned* row = (unsigned*)(proj + (size_t)(m + r * NGW) * 5120 + 2048) + lane;
#pragma unroll
            for (int h = 0; h < 4; ++h) {
                const float x0 = bf_lo(w[r][h]), x1 = bf_hi(w[r][h]);
                const float rstd = __builtin_amdgcn_rsqf(wave_sum(x0 * x0 + x1 * x1) * (1.f / 128.f) + NEPS);
                const float y0 = x0 * rstd * k0, y1 = x1 * rstd * k1;
                row[h * 64] = cvt_pk_bf16(y0 * co[r] - y1 * si[r], y0 * si[r] + y1 * co[r]);
            } }
    }
}

__device__ __forceinline__ f32x4 mfma16(bf16x8 x, bf16x8 y, f32x4 acc) { return __builtin_amdgcn_mfma_f32_16x16x32_bf16(x, y, acc, 0, 0, 0); }

__device__ __forceinline__ void phase_gla_lowrank(const bf16_t* hb, const bf16_t* w1t, float* R, LAS unsigned char* lds) {
    const int tid_ = opaque_tid(), lane = tid_ & 63, wave = __builtin_amdgcn_readfirstlane(tid_ >> 6), gw = blockIdx.x * 8 + wave, NGW = gridDim.x * 8;
    const int fr = lane & 15, fq = lane >> 4;
    for (int i = tid_; i < 32 * 256; i += 512) { const int n = i >> 8, c16 = i & 255; *(LAS u32x4*)(lds + n * 4112 + c16 * 16) = *(const u32x4*)(w1t + n * 2048 + c16 * 8); }
    __syncthreads();
    const LAS unsigned char* wl = lds + fr * 4112 + fq * 16;
    for (int u = gw; u < MTOK / 16; u += NGW) {
        const bf16_t* ap = hb + (size_t)(u * 16 + fr) * 2048 + fq * 8;
        f32x4 acc0 = (f32x4){0.f, 0.f, 0.f, 0.f}, acc1 = acc0;
#pragma unroll 1
        for (int k0 = 0; k0 < 64; k0 += 16) {
            bf16x8 av[16];
#pragma unroll
            for (int q = 0; q < 16; ++q) av[q] = *(const bf16x8*)(ap + (k0 + q) * 32);
#pragma unroll
            for (int q = 0; q < 16; ++q) { acc0 = mfma16(*(const LAS bf16x8*)(wl + (k0 + q) * 64), av[q], acc0); acc1 = mfma16(*(const LAS bf16x8*)(wl + 16 * 4112 + (k0 + q) * 64), av[q], acc1); } }
        float* rp = R + (size_t)(u * 16 + fr) * 32 + 4 * fq;
        *(f32x4*)rp = acc0; *(f32x4*)(rp + 16) = acc1;
    }
    __syncthreads();
}
__device__ __forceinline__ bf16_t f2bf1(float v) { return (bf16_t)(cvt_pk_bf16(v, 0.f) & 0xffffu); }
constexpr int G1_QI = 8192, G1_KI = G1_QI + 32768, G1_QT = G1_KI + 32768, G1_KT = G1_QT + 64 * 528, G1_TOT = G1_KT + 64 * 528, G1_END = G1_TOT + 2048;
__device__ __forceinline__ bf16x8 frag(const LAS unsigned char* base, int pitch, int row, int ks, int fq) { return *(const LAS bf16x8*)(base + row * pitch + ks * 64 + fq * 16); }
template <int dir> __device__ __forceinline__ void gla_prep_dir(const Args& a, LAS unsigned char* lds, const int tid, const int b, const int cc, const int h, const size_t tok0) {
    const LAS float* rl = (const LAS float*)lds; const LAS bf16_t* qi = (const LAS bf16_t*)(lds + G1_QI); const LAS bf16_t* ki = (const LAS bf16_t*)(lds + G1_KI);
    LAS float* tot = (LAS float*)(lds + G1_TOT); LAS float* bl = tot + 256;
    const int d = tid & 255, half = __builtin_amdgcn_readfirstlane(tid >> 8), col = h * 256 + d;
    const int wave = __builtin_amdgcn_readfirstlane(tid >> 6), lane = tid & 63, fr = lane & 15, fq = lane >> 4;
    const float* w2 = dir ? a.gla_bwd_w2 : a.gla_fwd_w2; const float* bs = dir ? a.gla_bwd_b : a.gla_fwd_b;
    float w2c[16];
#pragma unroll
    for (int c = 0; c < 16; ++c) w2c[c] = w2[c * 1024 + col];
    const float bias = bs[col];
    float eb[32]; float run = 0.f;
#pragma unroll
    for (int i = 0; i < 32; ++i) { const int pi = half * 32 + i, t = dir ? 63 - pi : pi; float z = bias;
#pragma unroll
        for (int c4 = 0; c4 < 4; ++c4) { const f32x4 rv = *(const LAS f32x4*)(rl + t * 32 + dir * 16 + c4 * 4);
            z += rv.x * w2c[c4 * 4] + rv.y * w2c[c4 * 4 + 1] + rv.z * w2c[c4 * 4 + 2] + rv.w * w2c[c4 * 4 + 3]; }
        const float ls = fminf(z, 0.f) - __logf(1.f + __expf(-fabsf(z)));
        run += ls * 0.0625f; eb[i] = run; if ((i & 3) == 3) asm volatile("" ::: "memory"); }
    if (half == 0) tot[d] = run;
    __syncthreads();
    const float add = half ? tot[d] : 0.f;
    if (half == 1) bl[d] = run + add;
    __syncthreads();
    const float ebl = __expf(bl[d]);
    bf16_t* khp = (bf16_t*)(a.ws + WS_QKK + 256 * MiB) + ((((size_t)dir * 4 + b) * 128 + cc) * 4 + h) * (256 * 64) + (size_t)d * 64;
#pragma unroll
    for (int gi = 0; gi < 4; ++gi) {
        float kh[8];
#pragma unroll
        for (int q = 0; q < 8; ++q) { const int i = gi * 8 + q, pi = half * 32 + i, t = dir ? 63 - pi : pi;
            const float e = __expf(eb[i] + add);
            *(LAS bf16_t*)(lds + G1_QT + t * 528 + d * 2) = f2bf1(bf2f(qi[t * 256 + d]) * 0.0625f * e);
            const float ktv = bf2f(ki[t * 256 + d]) * __builtin_amdgcn_rcpf(e);
            *(LAS bf16_t*)(lds + G1_KT + t * 528 + d * 2) = f2bf1(ktv); kh[q] = ktv * ebl; }
        u32x4 o;
        if (dir) { o.x = cvt_pk_bf16(kh[7], kh[6]); o.y = cvt_pk_bf16(kh[5], kh[4]); o.z = cvt_pk_bf16(kh[3], kh[2]); o.w = cvt_pk_bf16(kh[1], kh[0]); }
        else     { o.x = cvt_pk_bf16(kh[0], kh[1]); o.y = cvt_pk_bf16(kh[2], kh[3]); o.z = cvt_pk_bf16(kh[4], kh[5]); o.w = cvt_pk_bf16(kh[6], kh[7]); }
        *(u32x4*)(khp + (dir ? 56 - half * 32 - gi * 8 : half * 32 + gi * 8)) = o;
        asm volatile("" ::: "memory");
    }
    if (half == 0) ((float*)(a.ws + WS_DL))[(((size_t)dir * 4 + b) * 128 + cc) * 1024 + col] = ebl;
    __syncthreads();
    { const int it = wave >> 1, jt0 = (wave & 1) * 2; f32x4 am[2] = {(f32x4){0.f, 0.f, 0.f, 0.f}, (f32x4){0.f, 0.f, 0.f, 0.f}};
#pragma unroll
      for (int ks = 0; ks < 8; ++ks) { const bf16x8 fqt = frag(lds + G1_QT, 528, it * 16 + fr, ks, fq);
#pragma unroll
          for (int n = 0; n < 2; ++n) am[n] = __builtin_amdgcn_mfma_f32_16x16x32_bf16(frag(lds + G1_KT, 528, (jt0 + n) * 16 + fr, ks, fq), fqt, am[n], 0, 0, 0); }
      bf16_t* amg = (bf16_t*)(a.ws + WS_QKK + 128 * MiB) + ((((size_t)dir * 4 + b) * 128 + cc) * 4 + h) * (64 * 64);
#pragma unroll
      for (int n = 0; n < 2; ++n) { const int i = it * 16 + fr, j0 = (jt0 + n) * 16 + 4 * fq; float v[4];
#pragma unroll
          for (int r = 0; r < 4; ++r) { const int j = j0 + r; const bool keep = dir ? (j > i) : (j <= i); v[r] = keep ? am[n][r] : 0.f; }
          u32x2 w; w.x = cvt_pk_bf16(v[0], v[1]); w.y = cvt_pk_bf16(v[2], v[3]); *(u32x2*)(amg + i * 64 + j0) = w; } }
    { bf16_t* QT = (bf16_t*)(a.ws + WS_QKK) + (size_t)dir * MTOK * 1024; const unsigned stoff = ((unsigned)(tid >> 5) * 1024u + (unsigned)(tid & 31) * 8u) * 2u;
#pragma unroll
      for (int i = 0; i < 4; ++i) { char* p = (char*)(QT + (tok0 + 16 * i) * 1024 + h * 256);
          *(u32x4*)(p + stoff) = *(const LAS u32x4*)(lds + G1_QT + ((tid >> 5) + 16 * i) * 528 + (tid & 31) * 16); } }
    __syncthreads();
}
__device__ __forceinline__ void phase_gla_prep(const Args& a, LAS unsigned char* lds) {
    const int tid = opaque_tid();
    const bf16_t* proj = (const bf16_t*)(a.ws + WS_PROJ); const float* R = (const float*)(a.ws + WS_R);
    const unsigned ltoff = ((unsigned)(tid >> 5) * 6144u + (unsigned)(tid & 31) * 8u) * 2u;
    for (int u = blockIdx.x; u < 2048; u += gridDim.x) {
        const int b = u >> 9, cc = (u >> 2) & 127, h = u & 3; const size_t tok0 = (size_t)b * SEQ + cc * 64;
#pragma unroll
        for (int i = 0; i < 4; ++i) { const char* p = (const char*)(proj + (tok0 + 16 * i) * 6144 + h * 256); const int idx = tid + 512 * i;
            *(LAS u32x4*)(lds + G1_QI + idx * 16) = *(const u32x4*)(p + ltoff); *(LAS u32x4*)(lds + G1_KI + idx * 16) = *(const u32x4*)(p + 2048 + ltoff); }
        *(LAS f32x4*)((LAS float*)lds + tid * 4) = *(const f32x4*)(R + tok0 * 32 + tid * 4);
        __syncthreads();
        gla_prep_dir<0>(a, lds, tid, b, cc, h, tok0);
        gla_prep_dir<1>(a, lds, tid, b, cc, h, tok0);
    }
}
constexpr int SC_PQ = 528, SC_PS = 144;
constexpr int SC_QT = 0, SC_KH = SC_QT + 64 * SC_PQ, SC_VT = SC_KH + 256 * SC_PS, SC_ST = SC_VT + 64 * SC_PS, SC_AM = SC_ST + 64 * SC_PQ, SC_DL = SC_AM + 64 * SC_PS, SC_END = SC_DL + 1024;
__device__ __forceinline__ void phase_gla_scan(const Args& a, LAS unsigned char* lds) {
    const int tid = opaque_tid(), wave = __builtin_amdgcn_readfirstlane(tid >> 6), lane = tid & 63, fr = lane & 15, fq = lane >> 4;
    const bf16_t* proj = (const bf16_t*)(a.ws + WS_PROJ); const float* DLg = (const float*)(a.ws + WS_DL);
    for (int item = blockIdx.x; item < 256; item += gridDim.x) {
        const int xcd = item & 7, jj = item >> 3, bhd = xcd * 4 + (jj >> 3), es = jj & 7, b = bhd >> 3, h = (bhd >> 1) & 3, dir = bhd & 1;
        const bf16_t* QT = (const bf16_t*)(a.ws + WS_QKK) + (size_t)dir * MTOK * 1024 + h * 256;
        const bf16_t* AMG = (const bf16_t*)(a.ws + WS_QKK + 128 * MiB);
        const bf16_t* KH = (const bf16_t*)(a.ws + WS_QKK + 256 * MiB);
        const bf16_t* V = proj + 2048 + h * 512 + es * 64;
        bf16_t* O = dir ? ((bf16_t*)(a.ws + WS_PROJ) + h * 512 + es * 64) : ((bf16_t*)(a.ws + WS_HB) + h * 512 + es * 64); const int ldo = dir ? 6144 : 2048;
        for (int i = tid; i < 64 * SC_PQ / 16; i += 512) *(LAS u32x4*)(lds + SC_ST + i * 16) = (u32x4){0u, 0u, 0u, 0u};
        f32x4 S[2][4];
#pragma unroll
        for (int i = 0; i < 2; ++i)
#pragma unroll
            for (int j = 0; j < 4; ++j) S[i][j] = (f32x4){0.f, 0.f, 0.f, 0.f};
        u32x4 rq[4], rkh[4], rv, ram; f32x4 rdl = (f32x4){0.f, 0.f, 0.f, 0.f};
#define SC_LOAD(c) do { const int cc_ = dir ? 127 - (c) : (c); const size_t tok0_ = (size_t)b * SEQ + cc_ * 64; const size_t ci_ = (((size_t)dir * 4 + b) * 128 + cc_) * 4 + h; \
        _Pragma("unroll") for (int i_ = 0; i_ < 4; ++i_) { const int idx_ = tid + 512 * i_; rq[i_] = *(const u32x4*)(QT + (tok0_ + (idx_ >> 5)) * 1024 + (idx_ & 31) * 8); } \
        const bf16_t* khc_ = KH + ci_ * (256 * 64); \
        _Pragma("unroll") for (int i_ = 0; i_ < 4; ++i_) rkh[i_] = *(const u32x4*)(khc_ + (size_t)(tid + 512 * i_) * 8); \
        ram = *(const u32x4*)(AMG + ci_ * (64 * 64) + (size_t)tid * 8); \
        rv = *(const u32x4*)(V + (tok0_ + (tid & 63)) * 6144 + (tid >> 6) * 8); \
        if (tid < 64) rdl = *(const f32x4*)(DLg + (((size_t)dir * 4 + b) * 128 + cc_) * 1024 + h * 256 + tid * 4); } while (0)
        SC_LOAD(0);
        for (int c = 0; c < 128; ++c) {
            const int cc = dir ? 127 - c : c; const size_t tok0 = (size_t)b * SEQ + cc * 64;
#pragma unroll
            for (int i = 0; i < 4; ++i) { const int idx = tid + 512 * i; *(LAS u32x4*)(lds + SC_QT + (idx >> 5) * SC_PQ + (idx & 31) * 16) = rq[i];
                *(LAS u32x4*)(lds + SC_KH + (idx >> 3) * SC_PS + (idx & 7) * 16) = rkh[i]; }
            *(LAS u32x4*)(lds + SC_AM + (tid >> 3) * SC_PS + (tid & 7) * 16) = ram;
            { LAS bf16_t* vt = (LAS bf16_t*)(lds + SC_VT) + ((tid >> 6) * 8) * (SC_PS / 2) + (tid & 63);
              vt[0 * (SC_PS / 2)] = (bf16_t)(rv.x & 0xffffu); vt[1 * (SC_PS / 2)] = (bf16_t)(rv.x >> 16); vt[2 * (SC_PS / 2)] = (bf16_t)(rv.y & 0xffffu); vt[3 * (SC_PS / 2)] = (bf16_t)(rv.y >> 16);
              vt[4 * (SC_PS / 2)] = (bf16_t)(rv.z & 0xffffu); vt[5 * (SC_PS / 2)] = (bf16_t)(rv.z >> 16); vt[6 * (SC_PS / 2)] = (bf16_t)(rv.w & 0xffffu); vt[7 * (SC_PS / 2)] = (bf16_t)(rv.w >> 16); }
            if (tid < 64) *(LAS f32x4*)(lds + SC_DL + tid * 16) = rdl;
            __syncthreads();
            if (c + 1 < 128) SC_LOAD(c + 1);
            const int it = wave >> 1, et0 = (wave & 1) * 2;
            f32x4 oacc[2];
#pragma unroll
            for (int n = 0; n < 2; ++n) oacc[n] = (f32x4){0.f, 0.f, 0.f, 0.f};
#pragma unroll
            for (int ks = 0; ks < 8; ++ks) { const bf16x8 fqt = frag(lds + SC_QT, SC_PQ, it * 16 + fr, ks, fq);
#pragma unroll
                for (int n = 0; n < 2; ++n) oacc[n] = mfma16(frag(lds + SC_ST, SC_PQ, (et0 + n) * 16 + fr, ks, fq), fqt, oacc[n]); }
#pragma unroll
            for (int ks = 0; ks < 2; ++ks) { const bf16x8 fa = frag(lds + SC_AM, SC_PS, it * 16 + fr, ks, fq);
#pragma unroll
                for (int n = 0; n < 2; ++n) oacc[n] = mfma16(frag(lds + SC_VT, SC_PS, (et0 + n) * 16 + fr, ks, fq), fa, oacc[n]); }
#pragma unroll
            for (int n = 0; n < 2; ++n) { u32x2 w; w.x = cvt_pk_bf16(oacc[n][0], oacc[n][1]); w.y = cvt_pk_bf16(oacc[n][2], oacc[n][3]);
                *(u32x2*)(O + (tok0 + it * 16 + fr) * ldo + (et0 + n) * 16 + 4 * fq) = w; }
#pragma unroll
            for (int i = 0; i < 2; ++i) { const f32x4 dl4 = *(const LAS f32x4*)(lds + SC_DL + ((wave * 2 + i) * 16 + 4 * fq) * 4);
#pragma unroll
                for (int j = 0; j < 4; ++j) S[i][j] *= dl4; }
#pragma unroll
            for (int ks = 0; ks < 2; ++ks) {
                bf16x8 fv[4];
#pragma unroll
                for (int j = 0; j < 4; ++j) fv[j] = frag(lds + SC_VT, SC_PS, j * 16 + fr, ks, fq);
#pragma unroll
                for (int i = 0; i < 2; ++i) { const bf16x8 fk = frag(lds + SC_KH, SC_PS, (wave * 2 + i) * 16 + fr, ks, fq);
#pragma unroll
                    for (int j = 0; j < 4; ++j) S[i][j] = mfma16(fk, fv[j], S[i][j]); } }
            __syncthreads();
#pragma unroll
            for (int i = 0; i < 2; ++i)
#pragma unroll
                for (int j = 0; j < 4; ++j) { u32x2 w; w.x = cvt_pk_bf16(S[i][j][0], S[i][j][1]); w.y = cvt_pk_bf16(S[i][j][2], S[i][j][3]);
                    *(LAS u32x2*)(lds + SC_ST + (j * 16 + fr) * SC_PQ + ((wave * 2 + i) * 16 + 4 * fq) * 2) = w; }
        }
        __syncthreads();
#undef SC_LOAD
    }
}
__device__ __forceinline__ void phase_gla_post(bf16_t* hb, const bf16_t* proj, const float* ng) {
    const int tid_ = opaque_tid(), lane = tid_ & 63, wave = __builtin_amdgcn_readfirstlane(tid_ >> 6), gw = blockIdx.x * 8 + wave, NGW = gridDim.x * 8;
    float g8[8];
#pragma unroll
    for (int q = 0; q < 8; ++q) g8[q] = ng[lane * 8 + q];
    for (int m = gw; m < MTOK; m += 2 * NGW) {
        u32x4 wf[2][4], wb[2][4], wg[2][4];
#pragma unroll
        for (int r = 0; r < 2; ++r) { const size_t mm = (size_t)(m + r * NGW);
#pragma unroll
            for (int hh = 0; hh < 4; ++hh) { const int c = hh * 512 + lane * 8;
                wf[r][hh] = *(const u32x4*)(hb + mm * 2048 + c); wb[r][hh] = *(const u32x4*)(proj + mm * 6144 + c); wg[r][hh] = *(const u32x4*)(proj + mm * 6144 + 4096 + c); } }
#pragma unroll
        for (int r = 0; r < 2; ++r) { const size_t mm = (size_t)(m + r * NGW);
#pragma unroll
            for (int hh = 0; hh < 4; ++hh) { const int c = hh * 512 + lane * 8; const u32x4 f = wf[r][hh], bk = wb[r][hh], gg = wg[r][hh];
                float o[8] = {bf_lo(f.x) + bf_lo(bk.x), bf_hi(f.x) + bf_hi(bk.x), bf_lo(f.y) + bf_lo(bk.y), bf_hi(f.y) + bf_hi(bk.y), bf_lo(f.z) + bf_lo(bk.z), bf_hi(f.z) + bf_hi(bk.z), bf_lo(f.w) + bf_lo(bk.w), bf_hi(f.w) + bf_hi(bk.w)};
                const float g[8] = {bf_lo(gg.x), bf_hi(gg.x), bf_lo(gg.y), bf_hi(gg.y), bf_lo(gg.z), bf_hi(gg.z), bf_lo(gg.w), bf_hi(gg.w)};
                float s = 0.f;
#pragma unroll
                for (int q = 0; q < 8; ++q) s += o[q] * o[q];
                const float rstd = __builtin_amdgcn_rsqf(wave_sum(s) * (1.f / 512.f) + NEPS);
#pragma unroll
                for (int q = 0; q < 8; ++q) o[q] = o[q] * rstd * g8[q] * silu_f(g[q]);
                u32x4 w; w.x = cvt_pk_bf16(o[0], o[1]); w.y = cvt_pk_bf16(o[2], o[3]); w.z = cvt_pk_bf16(o[4], o[5]); w.w = cvt_pk_bf16(o[6], o[7]);
                *(u32x4*)(hb + mm * 2048 + c) = w; } }
    }
}

#define RLX_AGENT __ATOMIC_RELAXED, __HIP_MEMORY_SCOPE_AGENT
#define XB_TMO      128
#define XB_XCNT(j)  (256  + 64 * (j))
#define XB_XSUB(j)  (1280 + 64 * (j))
#define XB_XGEN(j)  (2304 + 64 * (j))
#define XB_TOP      3328
#define XB_TOPGEN   3392
#define XCD_BAR_WORDS 3456
#define XB_SPIN_CAP (1u << 18)

__device__ __forceinline__ unsigned xb_ld(unsigned* p)              { return __hip_atomic_load(p, __ATOMIC_RELAXED, __HIP_MEMORY_SCOPE_AGENT); }
__device__ __forceinline__ unsigned xb_add(unsigned* p, unsigned v) { return __hip_atomic_fetch_add(p, v, __ATOMIC_RELAXED, __HIP_MEMORY_SCOPE_AGENT); }
__device__ __forceinline__ unsigned xb_xcc_id() { return (unsigned)__builtin_amdgcn_s_getreg((3 << 11) | 20) & 0xFu; }
#define XB_SPIN(cond, bar) do { unsigned _sp = 0; while (cond) { __builtin_amdgcn_s_sleep(1); \
    if ((++_sp & 255u) == 0u) { if (xb_ld(&(bar)[XB_TMO])) break; if (_sp > XB_SPIN_CAP) { atomicAdd(&(bar)[XB_TMO], 1u); break; } } } } while (0)

struct XcdBarrier {
    unsigned* bar; unsigned x;
    volatile LAS unsigned* st;
};

__device__ __forceinline__ XcdBarrier xcd_barrier_post(unsigned* bar, volatile LAS unsigned* st) {
    XcdBarrier b; b.bar = bar; b.x = xb_xcc_id(); b.st = st;
    if (threadIdx.x == 0) (void)xb_add(&bar[XB_XCNT(b.x)], 1u);
    return b;
}
__device__ __forceinline__ void xcd_barrier_complete(unsigned* bar, unsigned x, unsigned& nloc, unsigned& nx) {
    const unsigned G = gridDim.x * gridDim.y * gridDim.z;
    unsigned sum, cnt, mine, sp = 0u;
    for (;;) {
        sum = 0u; cnt = 0u; mine = 0u;
#pragma unroll
        for (unsigned j = 0; j < 16; ++j) { const unsigned c = xb_ld(&bar[XB_XCNT(j)]); sum += c; cnt += (c > 0u) ? 1u : 0u; mine = (j == x) ? c : mine; }
        if (sum == G) break;
        __builtin_amdgcn_s_sleep(1);
        if ((++sp & 255u) == 0u) { if (xb_ld(&bar[XB_TMO])) break; if (sp > XB_SPIN_CAP) { atomicAdd(&bar[XB_TMO], 1u); break; } }
    }
    nloc = mine > 0u ? mine : 1u; nx = cnt > 0u ? cnt : 1u;
}

__device__ __forceinline__ void xcd_barrier(const XcdBarrier& b) {
    asm volatile("s_waitcnt vmcnt(0)" ::: "memory");
    __syncthreads();
    if (threadIdx.x == 0) {
        unsigned* bar = b.bar;
        __builtin_amdgcn_s_waitcnt(0);
        unsigned nloc = b.st[0], nx = b.st[1];
        if (nloc == 0u) { xcd_barrier_complete(bar, b.x, nloc, nx); b.st[0] = nloc; b.st[1] = nx; }
        const unsigned old = xb_add(&bar[XB_XSUB(b.x)], 1u);
        const unsigned gen = old / nloc;
        if (old + 1u == (gen + 1u) * nloc) {
            __builtin_amdgcn_fence(__ATOMIC_RELEASE, "agent");
            asm volatile("s_waitcnt vmcnt(0)" ::: "memory");
            const unsigned og = xb_add(&bar[XB_TOP], 1u);
            const unsigned tg = og / nx;
            if (og + 1u == (tg + 1u) * nx) xb_add(&bar[XB_TOPGEN], 1u);
            else XB_SPIN(xb_ld(&bar[XB_TOPGEN]) == tg, bar);
            __builtin_amdgcn_fence(__ATOMIC_ACQUIRE, "agent");
            xb_add(&bar[XB_XGEN(b.x)], 1u);
            asm volatile("s_waitcnt vmcnt(0)" ::: "memory");
        } else {
            XB_SPIN(xb_ld(&bar[XB_XGEN(b.x)]) == gen, bar);
            __builtin_amdgcn_fence(__ATOMIC_ACQUIRE, "agent");
            asm volatile("s_waitcnt vmcnt(0)" ::: "memory");
        }
    }
    __syncthreads();
}


#ifndef NLAYERS
#define NLAYERS 4
#endif
#ifndef REP_ATTN
#define REP_ATTN 1
#endif
#ifndef REP_SCAN
#define REP_SCAN 1
#endif
#ifndef REP_PREP
#define REP_PREP 1
#endif
#ifndef REP_GEMM0
#define REP_GEMM0 1
#endif
#ifndef REP_POOL
#define REP_POOL 1
#endif
#ifndef REP_SYNC
#define REP_SYNC 0
#endif
#ifndef REP_GRP
#define REP_GRP 1
#endif
#ifndef REP_OUT0
#define REP_OUT0 1
#endif
#ifndef REP_PRO
#define REP_PRO 1
#endif
#ifndef REP_LOWRANK
#define REP_LOWRANK 1
#endif
#ifndef REP_NORM
#define REP_NORM 1
#endif
constexpr int LDS_BYTES = 160 * 1024;
static_assert(SC_END <= LDS_BYTES - 64 && (int)attn::SHM_ATTN <= LDS_BYTES && pg8::STAGE_BYTES <= LDS_BYTES, "LDS map");

#define CG_SYNC() do { asm volatile("s_waitcnt vmcnt(0) lgkmcnt(0)" ::: "memory"); grid.sync(); __builtin_amdgcn_fence(__ATOMIC_ACQUIRE, "agent"); asm volatile("s_waitcnt vmcnt(0)" ::: "memory"); } while (0)
#define GRID_SYNC() xcd_barrier(xbar)
__global__ void __launch_bounds__(512, 2) fwd_megakernel(Args a) {
    extern __shared__ __attribute__((aligned(16))) unsigned char lds_raw[];
    LAS unsigned char* lds = (LAS unsigned char*)lds_raw;
    cg::grid_group grid = cg::this_grid();
    if (threadIdx.x < 16) ((LAS unsigned*)(lds + LDS_BYTES - 64))[threadIdx.x] = 0u;
    __syncthreads();
    XcdBarrier xbar = xcd_barrier_post((unsigned*)(a.ws + WS_BAR), (volatile LAS unsigned*)(lds + LDS_BYTES - 64));
    const int G = gridDim.x;
    float* mod = (float*)(a.ws + WS_MOD); float* rc = (float*)(a.ws + WS_ROPE); float* rs = rc + SEQ * 64;
    bf16_t* WB = (bf16_t*)(a.ws + WS_WB); bf16_t* WBG = (bf16_t*)(a.ws + WS_WB + 16 * MiB); bf16_t* WBO = (bf16_t*)(a.ws + WS_WB + 24 * MiB);
    bf16_t* HB = (bf16_t*)(a.ws + WS_HB); bf16_t* PROJ = (bf16_t*)(a.ws + WS_PROJ); bf16_t* YB = (bf16_t*)(a.ws + WS_QKK);

    for (int rep = 0; rep < REP_PRO; ++rep) {
    phase_mod(a, lds, mod);
    __syncthreads();
    phase_rope_table(rc, rs);
    phase_weights(a, 0, lds);
    GRID_SYNC(); }
    if (a.ws == nullptr) CG_SYNC();

    bf16_t* XB = (bf16_t*)a.out;
    float* XF = (float*)(a.ws + WS_QKK + 128 * MiB);
    for (int L = 0; L < NLAYERS; ++L) {
        const int kind = L % 3, j = L / 3, N = (kind == 0) ? 4096 : (kind == 1) ? 6144 : 5120;
        const float* modL = mod + (size_t)L * 4 * 6144;
        if (L > 0) { phase_weights(a, L, lds); if (kind == 0) GRID_SYNC(); }
        if (kind == 0) {
            pg8::Gemm g{WBG, (const bf16_t*)(a.ws + WS_QKK + 300 * MiB), 2048, 2048, 512, 512, 2048, 2}; pg8::StaticOrder S; S.init(2048, 2048, G, (int)blockIdx.x);
            pg8::EpiStore E{WB, 2048}; pg8::gemm_phase<pg8::EpiStore, pg8::StaticOrder>(lds, g, S, E);
        }
        if (L == 0) phase_norm_mod(a.x, modL, HB); else phase_norm_mod_bf(XB, modL, HB);
        GRID_SYNC();
        if (kind == 1) for (int rep = 0; rep < REP_LOWRANK; ++rep) phase_gla_lowrank(HB, (const bf16_t*)(a.ws + WS_W1T), (float*)(a.ws + WS_R), lds);
        for (int rep = 0; rep < REP_GEMM0; ++rep) {
        { pg8::Gemm g{HB, WB, MTOK, N, 2048, 2048, 2048, 0}; pg8::StaticOrder S; S.init(MTOK, N, G, (int)blockIdx.x);
          pg8::EpiStore E{PROJ, N}; pg8::gemm_phase<pg8::EpiStore, pg8::StaticOrder>(lds, g, S, E); }
        GRID_SYNC(); }
        if (kind == 0) {
            for (int rep = 0; rep < REP_POOL; ++rep) {
            phase_pool(PROJ, YB, a.pool_scale + (size_t)j * 2048);
            GRID_SYNC(); }
        } else if (kind == 1) {
            for (int rep = 0; rep < REP_PREP; ++rep) {
            phase_gla_prep(a, lds);
            GRID_SYNC(); }
            for (int rep = 0; rep < REP_SCAN; ++rep) {
            phase_gla_scan(a, lds);
            GRID_SYNC(); }
            phase_gla_post(HB, PROJ, a.gla_norm_g);
            GRID_SYNC();
        } else {
            phase_knorm_rope(PROJ, a.attn_kg, rc, rs);
            GRID_SYNC();
            for (int rep = 0; rep < REP_ATTN; ++rep) {
            for (int u = blockIdx.x; u < 2048; u += G) {
                const int bk = u >> 7, b = bk >> 2, kvh = bk & 3, hq = kvh * 4 + ((u >> 5) & 3), qb = u & 31;
                const size_t row0 = (size_t)b * SEQ + qb * 256;
                attn::attn_dense_body<attn::bf16>((const attn::bf16*)(PROJ + row0 * 5120 + hq * 128), (const attn::bf16*)(PROJ + (size_t)b * SEQ * 5120 + 2048 + kvh * 128),
                    (const attn::bf16*)(PROJ + (size_t)b * SEQ * 5120 + 2560 + kvh * 128), PROJ + row0 * 5120 + 3072 + hq * 128, YB + row0 * 2048 + hq * 128, SEQ, (char*)lds_raw, 0, a.attn_qg, rc, rs, qb * 256);
                __syncthreads();
            }
            GRID_SYNC(); }
        }
        { pg8::Gemm g{kind == 1 ? HB : YB, WBO, MTOK, 2048, 2048, 2048, 2048, 0}; pg8::StaticOrder S; S.init(MTOK, 2048, G, (int)blockIdx.x);
          if (L == 0) { pg8::EpiResT<false, true> E{a.x, XB, modL + 4096}; pg8::gemm_phase<pg8::EpiResT<false, true>, pg8::StaticOrder>(lds, g, S, E); }
          else if (L < 3) { pg8::EpiResT<true, true> E{XB, XB, modL + 4096}; pg8::gemm_phase<pg8::EpiResT<true, true>, pg8::StaticOrder>(lds, g, S, E); }
          else { pg8::EpiResT<true, false> E{XB, XF, modL + 4096}; pg8::gemm_phase<pg8::EpiResT<true, false>, pg8::StaticOrder>(lds, g, S, E); } }
        GRID_SYNC();
    }
    phase_final_norm(XF, a.final_g, a.out);
}

extern "C" void kernel_launch(void* const* d_in, const int* in_sizes, int n_in, void* d_out, int out_size, void* d_ws, size_t ws_size, hipStream_t stream) {
    static int grid = 0;
    if (grid == 0) {
        if (n_in != 22 || in_sizes[0] != MTOK * DM || out_size != MTOK * DM || ws_size < WS_END) {
            fprintf(stderr, "kernel_launch: unexpected shapes: n_in %d in0 %d out %d ws %zu (need %zu)\n", n_in, n_in > 0 ? in_sizes[0] : -1, out_size, ws_size, (size_t)WS_END); grid = -1; return; }
        int dev = 0, cus = 0, per_cu = 0;
        hipGetDevice(&dev); hipDeviceGetAttribute(&cus, hipDeviceAttributeMultiprocessorCount, dev);
        if (hipFuncSetAttribute((const void*)fwd_megakernel, hipFuncAttributeMaxDynamicSharedMemorySize, LDS_BYTES) != hipSuccess) { fprintf(stderr, "kernel_launch: hipFuncSetAttribute failed\n"); grid = -1; return; }
        if (hipOccupancyMaxActiveBlocksPerMultiprocessor(&per_cu, (const void*)fwd_megakernel, 512, LDS_BYTES) != hipSuccess || per_cu < 1) { fprintf(stderr, "kernel_launch: occupancy query gave %d\n", per_cu); per_cu = 1; }
        (void)hipGetLastError();
        grid = cus;
        fprintf(stderr, "kernel_launch: cus %d per_cu %d grid %d\n", cus, per_cu, grid);
    }
    if (grid < 0) return;
    Args a{};
    const float** p = (const float**)&a;
    for (int i = 0; i < 22; ++i) p[i] = (const float*)d_in[i];
    a.out = (float*)d_out; a.ws = (unsigned char*)d_ws;
    if (hipMemsetAsync((char*)d_ws + WS_BAR, 0, 16384, stream) != hipSuccess) { fprintf(stderr, "kernel_launch: memset of the barrier words failed\n"); return; }
    void* args[] = {&a};
    hipError_t e = hipLaunchCooperativeKernel((const void*)fwd_megakernel, dim3(grid), dim3(512), args, LDS_BYTES, stream);
    if (e != hipSuccess) fprintf(stderr, "kernel_launch: cooperative launch failed: %s (grid %d)\n", hipGetErrorString(e), grid);
}
```
